# Optimizing an MI355X kernel written in HIP

```python
import jax
import jax.numpy as jnp
from jax import lax
import numpy as np

D_MODEL = 1024
BATCH = 2
SEQ = 8192
DEPTH = 4

HEAD_DIM = 64
PLE_DIM = 256
ROPE_THETA = 10000.0
BLOCK = 128
N_MIXERS = 3
LN_EPS = 1e-5
DEEPNORM_ALPHA = (2 * DEPTH) ** 0.25
DEEPNORM_BETA = (8 * DEPTH) ** -0.25

A_GROUPS = ((128, 1), (512, 4), (2048, 16))
A_HEADS = D_MODEL // HEAD_DIM
A_WIDTH = A_HEADS * HEAD_DIM
A_IN = 3 * len(A_GROUPS) * A_WIDTH + A_WIDTH

B_HEADS = D_MODEL // HEAD_DIM
B_KV_HEADS = 2
B_WINDOW = 128
B_WIDTH = B_HEADS * HEAD_DIM
B_KV = B_KV_HEADS * HEAD_DIM
B_IN = 2 * B_WIDTH + 2 * B_KV

C_HEADS = D_MODEL // HEAD_DIM
C_KV_HEADS = 4
C_WIDTH = C_HEADS * HEAD_DIM
C_KV = C_KV_HEADS * HEAD_DIM
C_CMP_LEN = 32
C_CMP_STRIDE = 16
C_SEL_LEN = 64
C_N_SEL = 16
C_WINDOW = 512
C_SEL_OVERLAP = (1.0, 2.0, 2.0, 2.0, 1.0)
C_IN = 2 * C_WIDTH + 6 * C_KV + 3 * C_HEADS

N_A_LAYERS = len(range(0, DEPTH, N_MIXERS))
N_B_LAYERS = len(range(1, DEPTH, N_MIXERS))
N_C_LAYERS = len(range(2, DEPTH, N_MIXERS))

kernel_name = 'hybrid_dilated_swa_nsa_deepnorm'


def split_cols(h, sizes):
    out, start = [], 0
    for s in sizes:
        out.append(h[..., start:start + s])
        start += s
    return out


def rope_tables(seq_len):
    inv = 1.0 / (ROPE_THETA ** (jnp.arange(0, HEAD_DIM, 2, dtype=jnp.float32) / HEAD_DIM))
    ang = jnp.arange(seq_len, dtype=jnp.float32)[:, None] * inv[None, :]
    return jnp.cos(ang), jnp.sin(ang)


def apply_rope(t, cos, sin):
    tf = t.astype(jnp.float32)
    half = HEAD_DIM // 2
    t1, t2 = tf[..., :half], tf[..., half:]
    c, s = cos[None, :, None, :], sin[None, :, None, :]
    return jnp.concatenate([t1 * c - t2 * s, t2 * c + t1 * s], axis=-1).astype(t.dtype)


def layer_norm(x, g, b):
    xf = x.astype(jnp.float32)
    mu = jnp.mean(xf, axis=-1, keepdims=True)
    var = jnp.mean(jnp.square(xf - mu), axis=-1, keepdims=True)
    y = (xf - mu) * lax.rsqrt(var + LN_EPS) * g.astype(jnp.float32) + b.astype(jnp.float32)
    return y.astype(x.dtype)


def banded_attention(q, k, v, max_dist, sinks=None):
    B_, L, Hk, G, dh = q.shape
    nb = -(-L // BLOCK)
    pad = nb * BLOCK - L
    npv = -(-max_dist // BLOCK)
    W = (npv + 1) * BLOCK
    qb = jnp.pad(q, ((0, 0), (0, pad), (0, 0), (0, 0), (0, 0))).reshape(B_, nb, BLOCK, Hk, G, dh)

    def windows(t):
        tp = jnp.pad(t, ((0, 0), (npv * BLOCK, pad), (0, 0), (0, 0))).reshape(B_, nb + npv, BLOCK, Hk, dh)
        return jnp.concatenate([tp[:, j:j + nb] for j in range(npv + 1)], axis=2)

    kw, vw = windows(k), windows(v)
    s = jnp.einsum('bnqhgd,bnkhd->bnhgqk', qb, kw).astype(jnp.float32) * (dh ** -0.5)
    dist = np.arange(BLOCK)[:, None] + npv * BLOCK - np.arange(W)[None, :]
    band = (dist >= 0) & (dist <= max_dist)
    kpos = np.arange(nb)[:, None] * BLOCK - npv * BLOCK + np.arange(W)[None, :]
    mask = band[None, :, :] & (kpos >= 0)[:, None, :]
    s = jnp.where(mask[None, :, None, None, :, :], s, -jnp.inf)
    m = jnp.max(s, axis=-1, keepdims=True)
    if sinks is not None:
        sk = sinks.astype(jnp.float32).reshape(1, 1, Hk, G, 1, 1)
        m = jnp.maximum(m, sk)
    e = jnp.exp(s - m)
    l = jnp.sum(e, axis=-1, keepdims=True)
    if sinks is not None:
        l = l + jnp.exp(sk - m)
    o = jnp.einsum('bnhgqk,bnkhd->bnqhgd', e, vw.astype(jnp.float32))
    o = o / jnp.transpose(l, (0, 1, 4, 2, 3, 5))
    lse = jnp.transpose((m + jnp.log(l))[..., 0], (0, 1, 4, 2, 3))
    o = o.reshape(B_, nb * BLOCK, Hk, G, dh)[:, :L]
    lse = lse.reshape(B_, nb * BLOCK, Hk, G)[:, :L]
    return o, lse


def mixer_a(x, w_in, w_out, cos, sin):
    B_, S, _ = x.shape
    h = x @ w_in
    outs, lses = [], []
    for gi, (window, dil) in enumerate(A_GROUPS):
        base = 3 * gi * A_WIDTH
        q, k, v = split_cols(h[..., base:base + 3 * A_WIDTH], [A_WIDTH] * 3)
        q = apply_rope(q.reshape(B_, S, A_HEADS, HEAD_DIM), cos, sin)
        k = apply_rope(k.reshape(B_, S, A_HEADS, HEAD_DIM), cos, sin)
        v = v.reshape(B_, S, A_HEADS, HEAD_DIM)
        Ls = S // dil

        def strided(t):
            return jnp.transpose(t.reshape(B_, Ls, dil, A_HEADS, HEAD_DIM), (0, 2, 1, 3, 4)).reshape(B_ * dil, Ls, A_HEADS, HEAD_DIM)

        o, lse = banded_attention(strided(q)[:, :, :, None, :], strided(k), strided(v), window // dil)
        o = jnp.transpose(o.reshape(B_, dil, Ls, A_HEADS, HEAD_DIM), (0, 2, 1, 3, 4)).reshape(B_, S, A_HEADS, HEAD_DIM)
        lse = jnp.transpose(lse.reshape(B_, dil, Ls, A_HEADS), (0, 2, 1, 3)).reshape(B_, S, A_HEADS)
        outs.append(o)
        lses.append(lse)
    wts = jax.nn.softmax(jnp.stack(lses, axis=0), axis=0)
    o = jnp.einsum('gbsh,gbshd->bshd', wts, jnp.stack(outs, axis=0))
    z = h[..., -A_WIDTH:]
    o = o.reshape(B_, S, A_WIDTH).astype(x.dtype)
    return (o * jax.nn.silu(z)) @ w_out


def mixer_b(x, w_in, sinks, w_out, cos, sin):
    B_, S, _ = x.shape
    G = B_HEADS // B_KV_HEADS
    q, k, v, z = split_cols(x @ w_in, [B_WIDTH, B_KV, B_KV, B_WIDTH])
    q = apply_rope(q.reshape(B_, S, B_HEADS, HEAD_DIM), cos, sin).reshape(B_, S, B_KV_HEADS, G, HEAD_DIM)
    k = apply_rope(k.reshape(B_, S, B_KV_HEADS, HEAD_DIM), cos, sin)
    v = v.reshape(B_, S, B_KV_HEADS, HEAD_DIM)
    o, _ = banded_attention(q, k, v, B_WINDOW - 1, sinks)
    o = o.reshape(B_, S, B_WIDTH).astype(x.dtype)
    return (o * jax.nn.silu(z)) @ w_out


def mixer_c(x, w_in, w_ck, w_cv, pos_cmp, w_out, cos, sin):
    B_, S, _ = x.shape
    Hk, G, dh = C_KV_HEADS, C_HEADS // C_KV_HEADS, HEAD_DIM
    scale = dh ** -0.5
    q, kc, vc, ks, vs, kw, vw, gl, z = split_cols(x @ w_in, [C_WIDTH] + [C_KV] * 6 + [3 * C_HEADS, C_WIDTH])
    q = apply_rope(q.reshape(B_, S, C_HEADS, dh), cos, sin).reshape(B_, S, Hk, G, dh)
    kv_shape = (B_, S, Hk, dh)
    kc = apply_rope(kc.reshape(kv_shape), cos, sin)
    ks = apply_rope(ks.reshape(kv_shape), cos, sin)
    kw = apply_rope(kw.reshape(kv_shape), cos, sin)
    vc, vs, vw = vc.reshape(kv_shape), vs.reshape(kv_shape), vw.reshape(kv_shape)

    n_c = S // C_CMP_STRIDE - 1

    def compress(t, w):
        tr = t.reshape(B_, S // C_CMP_STRIDE, C_CMP_STRIDE, Hk, dh)
        blk = jnp.concatenate([tr[:, :-1], tr[:, 1:]], axis=2)
        return jnp.einsum('bnjhd,jde->bnhe', blk + pos_cmp[None, None, :, None, :], w)

    k_cmp, v_cmp = compress(kc, w_ck), compress(vc, w_cv)
    cmp_end = jnp.arange(n_c) * C_CMP_STRIDE + C_CMP_LEN - 1

    n_s = S // C_SEL_LEN
    n_sel = min(C_N_SEL, n_s)
    ks_blocks = jnp.transpose(ks.reshape(B_, n_s, C_SEL_LEN, Hk, dh), (0, 3, 1, 2, 4))
    vs_blocks = jnp.transpose(vs.reshape(B_, n_s, C_SEL_LEN, Hk, dh), (0, 3, 1, 2, 4))
    bi = jnp.arange(B_)[:, None, None, None]
    hi = jnp.arange(Hk)[None, None, :, None]
    blk_ids = jnp.arange(n_s)

    def query_block(args):
        qb, t0 = args
        tq = t0 + jnp.arange(BLOCK)
        s = jnp.einsum('bqhgd,bnhd->bqhgn', qb, k_cmp).astype(jnp.float32) * scale
        cvalid = cmp_end[None, :] <= tq[:, None]
        s = jnp.where(cvalid[None, :, None, None, :], s, -jnp.inf)
        m = jnp.max(s, axis=-1, keepdims=True)
        m = jnp.where(jnp.isfinite(m), m, 0.0)
        e = jnp.exp(s - m)
        pc = e / jnp.maximum(jnp.sum(e, axis=-1, keepdims=True), 1e-30)
        o_cmp = jnp.einsum('bqhgn,bnhd->bqhgd', pc, v_cmp.astype(jnp.float32))
        imp = jnp.pad(jnp.sum(pc, axis=3), ((0, 0), (0, 0), (0, 0), (1, 1)))
        imp_s = C_SEL_OVERLAP[0] * imp[..., 0::4][..., :n_s]
        for o_off in range(1, len(C_SEL_OVERLAP)):
            imp_s = imp_s + C_SEL_OVERLAP[o_off] * imp[..., o_off::4][..., :n_s]
        cur = tq // C_SEL_LEN
        forced = (blk_ids[None, :] == 0) | (blk_ids[None, :] == cur[:, None]) | (blk_ids[None, :] == cur[:, None] - 1)
        bvalid = blk_ids[None, :] * C_SEL_LEN <= tq[:, None]
        score = jnp.where(forced[None, :, None, :], 1e4, jnp.where(bvalid[None, :, None, :], imp_s, -1.0))
        _, idx = lax.top_k(score, n_sel)
        ksel = ks_blocks[bi, hi, idx]
        vsel = vs_blocks[bi, hi, idx]
        kpos = idx[..., None] * C_SEL_LEN + jnp.arange(C_SEL_LEN)
        smask = kpos <= tq[None, :, None, None, None]
        ss = jnp.einsum('bqhgd,bqhnkd->bqhgnk', qb, ksel).astype(jnp.float32) * scale
        ss = jnp.where(smask[:, :, :, None], ss, -jnp.inf)
        ps = jax.nn.softmax(ss.reshape(ss.shape[:4] + (n_sel * C_SEL_LEN,)), axis=-1).reshape(ss.shape)
        o_slc = jnp.einsum('bqhgnk,bqhnkd->bqhgd', ps, vsel.astype(jnp.float32))
        return o_cmp, o_slc

    nqb = S // BLOCK
    q_blocks = jnp.transpose(q.reshape(B_, nqb, BLOCK, Hk, G, dh), (1, 0, 2, 3, 4, 5))
    t0s = jnp.arange(nqb, dtype=jnp.int32) * BLOCK
    o_cmp, o_slc = lax.map(query_block, (q_blocks, t0s))
    o_cmp = jnp.transpose(o_cmp, (1, 0, 2, 3, 4, 5)).reshape(B_, S, Hk, G, dh)
    o_slc = jnp.transpose(o_slc, (1, 0, 2, 3, 4, 5)).reshape(B_, S, Hk, G, dh)
    o_win, _ = banded_attention(q, kw, vw, C_WINDOW - 1)
    g = jax.nn.sigmoid(gl.astype(jnp.float32)).reshape(B_, S, 3, Hk, G, 1)
    o = g[:, :, 0] * o_cmp + g[:, :, 1] * o_slc + g[:, :, 2] * o_win
    o = o.reshape(B_, S, C_WIDTH).astype(x.dtype)
    return (o * jax.nn.silu(z)) @ w_out


def setup_inputs(seed: int = 0) -> dict:
    key = jax.random.key(seed)
    ks = jax.random.split(key, 16)

    def nrm(k, shape, scale):
        return jax.random.normal(k, shape, jnp.float32) * scale

    return {
        'x': nrm(ks[0], (BATCH, SEQ, D_MODEL), 1.0),
        'p': nrm(ks[1], (DEPTH, BATCH, SEQ, PLE_DIM), 1.0),
        'a_w_in': nrm(ks[2], (N_A_LAYERS, D_MODEL, A_IN), D_MODEL ** -0.5),
        'a_w_out': nrm(ks[3], (N_A_LAYERS, A_WIDTH, D_MODEL), A_WIDTH ** -0.5 * DEEPNORM_BETA),
        'b_w_in': nrm(ks[4], (N_B_LAYERS, D_MODEL, B_IN), D_MODEL ** -0.5),
        'b_sinks': nrm(ks[5], (N_B_LAYERS, B_HEADS), 1.0),
        'b_w_out': nrm(ks[6], (N_B_LAYERS, B_WIDTH, D_MODEL), B_WIDTH ** -0.5 * DEEPNORM_BETA),
        'c_w_in': nrm(ks[7], (N_C_LAYERS, D_MODEL, C_IN), D_MODEL ** -0.5),
        'c_w_ck': nrm(ks[8], (N_C_LAYERS, C_CMP_LEN, HEAD_DIM, HEAD_DIM), (C_CMP_LEN * HEAD_DIM) ** -0.5),
        'c_w_cv': nrm(ks[9], (N_C_LAYERS, C_CMP_LEN, HEAD_DIM, HEAD_DIM), (C_CMP_LEN * HEAD_DIM) ** -0.5),
        'c_pos': nrm(ks[10], (N_C_LAYERS, C_CMP_LEN, HEAD_DIM), 0.5),
        'c_w_out': nrm(ks[11], (N_C_LAYERS, C_WIDTH, D_MODEL), C_WIDTH ** -0.5 * DEEPNORM_BETA),
        'ln_g': 1.0 + nrm(ks[12], (DEPTH, D_MODEL), 0.05),
        'ln_b': nrm(ks[13], (DEPTH, D_MODEL), 0.05),
        'ple_w_proj': nrm(ks[14], (DEPTH, PLE_DIM, D_MODEL), PLE_DIM ** -0.5),
        'ple_w_gate': nrm(ks[15], (DEPTH, D_MODEL, D_MODEL), D_MODEL ** -0.5),
    }


def reference(x, p, a_w_in, a_w_out, b_w_in, b_sinks, b_w_out, c_w_in, c_w_ck, c_w_cv, c_pos, c_w_out, ln_g, ln_b, ple_w_proj, ple_w_gate):
    cos, sin = rope_tables(x.shape[1])
    for i in range(DEPTH):
        j = i // N_MIXERS
        kind = i % N_MIXERS
        if kind == 0:
            h = mixer_a(x, a_w_in[j], a_w_out[j], cos, sin)
        elif kind == 1:
            h = mixer_b(x, b_w_in[j], b_sinks[j], b_w_out[j], cos, sin)
        else:
            h = mixer_c(x, c_w_in[j], c_w_ck[j], c_w_cv[j], c_pos[j], c_w_out[j], cos, sin)
        x = layer_norm(DEEPNORM_ALPHA * x + h, ln_g[i], ln_b[i])
        gate = jax.nn.sigmoid((x @ ple_w_gate[i]).astype(jnp.float32))
        x = (x.astype(jnp.float32) + gate * (p[i] @ ple_w_proj[i]).astype(jnp.float32)).astype(x.dtype)
    return x
```

```cpp
#include <hip/hip_runtime.h>
#include <hip/hip_cooperative_groups.h>
#include <cstdio>
#include <cstdint>
namespace cg = cooperative_groups;

typedef unsigned short u16;
using bf16x8 = __attribute__((ext_vector_type(8))) short;
using s16x4  = __attribute__((ext_vector_type(4))) short;
using f32x4  = __attribute__((ext_vector_type(4))) float;
using u32x4  = __attribute__((ext_vector_type(4))) unsigned;
using u32x2  = __attribute__((ext_vector_type(2))) unsigned;
#define DEV __device__ __forceinline__
using h16x8 = __attribute__((ext_vector_type(8))) _Float16;
#define MFMA16(a, b, c) __builtin_amdgcn_mfma_f32_16x16x32_f16(__builtin_bit_cast(h16x8, (a)), __builtin_bit_cast(h16x8, (b)), (c), 0, 0, 0)
#define LAS __attribute__((address_space(3)))

constexpr int T = 16384, S = 8192;
constexpr float LN_EPS = 1e-5f;
constexpr float DN_ALPHA = 1.6817928305074290f;
constexpr float NEG_INF = -__builtin_huge_valf();

constexpr size_t OFF_BAR   = 0;
constexpr size_t OFF_COS   = 16384;
constexpr size_t OFF_SIN   = OFF_COS + (size_t)8192 * 32 * 4;
constexpr size_t OFF_BIAS  = OFF_SIN + (size_t)8192 * 32 * 4;
constexpr size_t OFF_WA_IN = OFF_BIAS + 1024;
constexpr size_t SZ_WA_IN  = (size_t)10240 * 1024 * 2;
constexpr size_t SZ_SQ     = (size_t)1024 * 1024 * 2;
constexpr size_t OFF_WA_OUT = OFF_WA_IN + 2 * SZ_WA_IN;
constexpr size_t OFF_WB_IN  = OFF_WA_OUT + 2 * SZ_SQ;
constexpr size_t OFF_WB_OUT = OFF_WB_IN + (size_t)2304 * 1024 * 2;
constexpr size_t OFF_WC_IN  = OFF_WB_OUT + SZ_SQ;
constexpr size_t OFF_WC_OUT = OFF_WC_IN + (size_t)3712 * 1024 * 2;
constexpr size_t OFF_WG     = OFF_WC_OUT + SZ_SQ;
constexpr size_t OFF_WP     = OFF_WG + 4 * SZ_SQ;
constexpr size_t SZ_WP      = (size_t)1024 * 256 * 2;
constexpr size_t OFF_WCK    = OFF_WP + 4 * SZ_WP;
constexpr size_t OFF_WCV    = OFF_WCK + (size_t)64 * 2048 * 2;
constexpr size_t OFF_XB     = OFF_WCV + (size_t)64 * 2048 * 2;
constexpr size_t SZ_ACT     = (size_t)T * 1024 * 2;
constexpr size_t OFF_G      = OFF_XB + SZ_ACT;
constexpr size_t OFF_H      = OFF_G + SZ_ACT;
constexpr size_t SZ_HMAX    = (size_t)T * 3712 * 2;
constexpr size_t OFF_VT0    = OFF_H + SZ_HMAX;
constexpr size_t SZ_VT      = (size_t)2 * 4 * 8192 * 64 * 2;
constexpr size_t OFF_VT1    = OFF_VT0 + SZ_VT;
constexpr size_t OFF_VT2    = OFF_VT1 + SZ_VT;
constexpr size_t OFF_KCMP   = OFF_VT2 + SZ_VT;
constexpr size_t SZ_CMP     = (size_t)2 * 512 * 4 * 64 * 2;
constexpr size_t OFF_VCMP   = OFF_KCMP + SZ_CMP;
constexpr size_t WS_END     = OFF_VCMP + SZ_CMP;
constexpr size_t OFF_XLB    = OFF_H;
constexpr size_t OFF_PB     = OFF_H + SZ_ACT;

struct Prm { const float* in[16]; float* out; unsigned char* ws; };

DEV u16 f2bf(float f) { return __builtin_bit_cast(u16, (_Float16)f); }
DEV float bf2f(u16 h) { return (float)__builtin_bit_cast(_Float16, h); }
DEV unsigned pack2(float a, float b) { return (unsigned)f2bf(a) | ((unsigned)f2bf(b) << 16); }
DEV float bflo(unsigned u) { return bf2f((u16)(u & 0xffffu)); }
DEV float bfhi(unsigned u) { return bf2f((u16)(u >> 16)); }
DEV float sigmoidf_(float x) { return 1.f / (1.f + __expf(-x)); }
DEV float siluf_(float x) { return x / (1.f + __expf(-x)); }
DEV float red16_max(float v) { v = fmaxf(v, __shfl_xor(v, 16)); v = fmaxf(v, __shfl_xor(v, 32)); return v; }
DEV float red16_sum(float v) { v += __shfl_xor(v, 16); v += __shfl_xor(v, 32); return v; }
DEV float wave_sum(float v) { for (int o = 32; o > 0; o >>= 1) v += __shfl_xor(v, o); return v; }

#define XB_TMO      128
#define XB_XCNT(j)  (256  + 64 * (j))
#define XB_XSUB(j)  (1280 + 64 * (j))
#define XB_XGEN(j)  (2304 + 64 * (j))
#define XB_TOP      3328
#define XB_TOPGEN   3392
#define XCD_BAR_WORDS 3456
#define XB_SPIN_CAP (1u << 24)
DEV unsigned xb_ld(unsigned* p)              { return __hip_atomic_load(p, __ATOMIC_RELAXED, __HIP_MEMORY_SCOPE_AGENT); }
DEV unsigned xb_add(unsigned* p, unsigned v) { return __hip_atomic_fetch_add(p, v, __ATOMIC_RELAXED, __HIP_MEMORY_SCOPE_AGENT); }
DEV unsigned xb_xcc_id() { return (unsigned)__builtin_amdgcn_s_getreg((3 << 11) | 20) & 0xFu; }
#define XB_SPIN(cond, bar) do { unsigned _sp = 0; while (cond) { __builtin_amdgcn_s_sleep(1); \
    if ((++_sp & 255u) == 0u) { if (xb_ld(&(bar)[XB_TMO])) break; if (_sp > XB_SPIN_CAP) { atomicAdd(&(bar)[XB_TMO], 1u); break; } } } } while (0)
struct XcdBarrier { unsigned* bar; unsigned x; volatile LAS unsigned* st; };
DEV XcdBarrier xcd_barrier_post(unsigned* bar, volatile LAS unsigned* st) {
    XcdBarrier b; b.bar = bar; b.x = xb_xcc_id(); b.st = st;
    if (threadIdx.x == 0) (void)xb_add(&bar[XB_XCNT(b.x)], 1u);
    return b;
}
DEV void xcd_barrier_complete(unsigned* bar, unsigned x, unsigned& nloc, unsigned& nx) {
    const unsigned G = gridDim.x * gridDim.y * gridDim.z;
    unsigned sum, cnt, mine, sp = 0u;
    for (;;) {
        sum = 0u; cnt = 0u; mine = 0u;
#pragma unroll
        for (unsigned j = 0; j < 16; ++j) { const unsigned c = xb_ld(&bar[XB_XCNT(j)]); sum += c; cnt += (c > 0u) ? 1u : 0u; mine = (j == x) ? c : mine; }
        if (sum == G) break;
        __builtin_amdgcn_s_sleep(1);
        if ((++sp & 255u) == 0u) { if (xb_ld(&bar[XB_TMO])) break; if (sp > XB_SPIN_CAP) { atomicAdd(&bar[XB_TMO], 1u); break; } }
    }
    nloc = mine > 0u ? mine : 1u; nx = cnt > 0u ? cnt : 1u;
}
DEV void xcd_barrier(const XcdBarrier& b) {
    asm volatile("s_waitcnt vmcnt(0)" ::: "memory");
    __syncthreads();
    if (threadIdx.x == 0) {
        unsigned* bar = b.bar;
        __builtin_amdgcn_s_waitcnt(0);
        unsigned nloc = b.st[0], nx = b.st[1];
        if (nloc == 0u) { xcd_barrier_complete(bar, b.x, nloc, nx); b.st[0] = nloc; b.st[1] = nx; }
        const unsigned old = xb_add(&bar[XB_XSUB(b.x)], 1u);
        const unsigned gen = old / nloc;
        if (old + 1u == (gen + 1u) * nloc) {
            __builtin_amdgcn_fence(__ATOMIC_RELEASE, "agent");
            asm volatile("s_waitcnt vmcnt(0)" ::: "memory");
            const unsigned og = xb_add(&bar[XB_TOP], 1u);
            const unsigned tg = og / nx;
            if (og + 1u == (tg + 1u) * nx) xb_add(&bar[XB_TOPGEN], 1u);
            else XB_SPIN(xb_ld(&bar[XB_TOPGEN]) == tg, bar);
            __builtin_amdgcn_fence(__ATOMIC_ACQUIRE, "agent");
            xb_add(&bar[XB_XGEN(b.x)], 1u);
            asm volatile("s_waitcnt vmcnt(0)" ::: "memory");
        } else {
            XB_SPIN(xb_ld(&bar[XB_XGEN(b.x)]) == gen, bar);
            __builtin_amdgcn_fence(__ATOMIC_ACQUIRE, "agent");
            asm volatile("s_waitcnt vmcnt(0)" ::: "memory");
        }
    }
    __syncthreads();
}

DEV int colmap(int kind, int n) {
    if (kind == 0) return n;
    if (kind == 1) {
        const int c = n / 2560, nn = n - c * 2560;
        if (nn < 2304) { const int g = nn / 768, rem = nn - g * 768, part = rem >> 8, hh = (rem & 255) >> 6, d = rem & 63;
                         return g * 3072 + part * 1024 + (c * 4 + hh) * 64 + d; }
        const int z = nn - 2304; return 9216 + (c * 4 + (z >> 6)) * 64 + (z & 63);
    }
    if (n < 2560) return n;
    if (n < 3584) return n - 2560 + 2608;
    if (n < 3632) return n - 3584 + 2560;
    return -1;
}
DEV void tconv(float* lds, const float* __restrict__ src, int K, int Nsrc, u16* __restrict__ dst, int Ndst, int kind, int& acc_tiles) {
    const int G = gridDim.x, tid = threadIdx.x;
    const int ntn = Ndst >> 6, ntk = K >> 6, nt = ntn * ntk;
    int first = ((int)blockIdx.x - (acc_tiles % G) + G) % G;
    acc_tiles += nt;
    for (int t = first; t < nt; t += G) {
        const int tn = t / ntk, tk = t - tn * ntk;
        const int n0 = tn << 6, k0 = tk << 6;
        const int nl = tid & 63;
        const int c = colmap(kind, n0 + nl);
#pragma unroll
        for (int i = 0; i < 16; ++i) {
            const int kl = (tid >> 6) + 4 * i;
            const float v = (c >= 0) ? src[(size_t)(k0 + kl) * Nsrc + c] : 0.f;
            lds[kl * 65 + nl] = v;
        }
        __syncthreads();
        const int r = tid >> 2, kk = (tid & 3) << 4;
        unsigned o[8];
#pragma unroll
        for (int i = 0; i < 8; ++i) o[i] = pack2(lds[(kk + 2 * i) * 65 + r], lds[(kk + 2 * i + 1) * 65 + r]);
        u32x4* dp = (u32x4*)(dst + (size_t)(n0 + r) * K + k0 + kk);
        dp[0] = u32x4{o[0], o[1], o[2], o[3]};
        dp[1] = u32x4{o[4], o[5], o[6], o[7]};
        __syncthreads();
    }
}

DEV void phase0(const Prm& P, unsigned char* smem) {
    float* lds = (float*)smem;
    unsigned char* ws = P.ws;
    int acc = 0;
    tconv(lds, P.in[2], 1024, 10240, (u16*)(ws + OFF_WA_IN), 10240, 1, acc);
    tconv(lds, P.in[2] + (size_t)1024 * 10240, 1024, 10240, (u16*)(ws + OFF_WA_IN + SZ_WA_IN), 10240, 1, acc);
    tconv(lds, P.in[3], 1024, 1024, (u16*)(ws + OFF_WA_OUT), 1024, 0, acc);
    tconv(lds, P.in[3] + (size_t)1024 * 1024, 1024, 1024, (u16*)(ws + OFF_WA_OUT + SZ_SQ), 1024, 0, acc);
    tconv(lds, P.in[4], 1024, 2304, (u16*)(ws + OFF_WB_IN), 2304, 0, acc);
    tconv(lds, P.in[6], 1024, 1024, (u16*)(ws + OFF_WB_OUT), 1024, 0, acc);
    tconv(lds, P.in[7], 1024, 3632, (u16*)(ws + OFF_WC_IN), 3712, 2, acc);
    tconv(lds, P.in[11], 1024, 1024, (u16*)(ws + OFF_WC_OUT), 1024, 0, acc);
    for (int i = 0; i < 4; ++i) {
        tconv(lds, P.in[15] + (size_t)i * 1024 * 1024, 1024, 1024, (u16*)(ws + OFF_WG + i * SZ_SQ), 1024, 0, acc);
        tconv(lds, P.in[14] + (size_t)i * 256 * 1024, 256, 1024, (u16*)(ws + OFF_WP + i * SZ_WP), 1024, 0, acc);
    }
    tconv(lds, P.in[8], 2048, 64, (u16*)(ws + OFF_WCK), 64, 0, acc);
    tconv(lds, P.in[9], 2048, 64, (u16*)(ws + OFF_WCV), 64, 0, acc);

    const size_t gtid = (size_t)blockIdx.x * 256 + threadIdx.x, gsz = (size_t)gridDim.x * 256;
    {
        const float* x = P.in[0]; u16* xb = (u16*)(ws + OFF_XB);
        for (size_t i = gtid; i < (size_t)T * 1024 / 8; i += gsz) {
            const f32x4 a = *(const f32x4*)(x + i * 8), b = *(const f32x4*)(x + i * 8 + 4);
            *(u32x4*)(xb + i * 8) = u32x4{pack2(a[0], a[1]), pack2(a[2], a[3]), pack2(b[0], b[1]), pack2(b[2], b[3])};
        }
    }
    {
        float* ct = (float*)(ws + OFF_COS); float* st = (float*)(ws + OFF_SIN);
        for (size_t i = gtid; i < (size_t)8192 * 32; i += gsz) {
            const int pos = (int)(i >> 5), k = (int)(i & 31);
            const float inv = (float)(1.0 / pow(10000.0, (double)(2 * k) / 64.0));
            const float ang = (float)pos * inv;
            ct[i] = (float)cos((double)ang); st[i] = (float)sin((double)ang);
        }
    }
    {
        const int lane = threadIdx.x & 63;
        const int wid = blockIdx.x * 4 + (threadIdx.x >> 6);
        if (wid < 128) {
            const float* w = (wid < 64) ? P.in[8] : P.in[9];
            const int e = wid & 63;
            float s = 0.f;
            for (int jd = lane; jd < 2048; jd += 64) s += P.in[10][jd] * w[(size_t)jd * 64 + e];
            s = wave_sum(s);
            if (lane == 0) ((float*)(ws + OFF_BIAS))[wid] = s;
        }
    }
}

DEV void gemm_mainloop(unsigned char* smem, const u16* __restrict__ A, int lda, const u16* __restrict__ Bt, int ldb, int K,
                       int m0, int n0, bool nonswap, f32x4 (&acc)[4][4]) {
    const int tid = threadIdx.x, lane = tid & 63, w = tid >> 6, wm = w >> 1, wn = w & 1;
    const int lrow = tid >> 3, lch = tid & 7;
    const u16* ag = A + (size_t)(m0 + lrow) * lda + lch * 8;
    const u16* bg = Bt + (size_t)(n0 + lrow) * ldb + lch * 8;
    unsigned char* la = smem; unsigned char* lb = smem + 128 * 128;
    const int st_off = lrow * 128 + ((lch ^ (lrow & 7)) << 4);
    const int fr = lane & 15, fq = lane >> 4;
    const int a_base = (wm * 64 + fr) * 128, b_base = (wn * 64 + fr) * 128;
    u32x4 ra[4], rb[4];
    const int nk = K >> 6;
#pragma unroll
    for (int i = 0; i < 4; ++i) { ra[i] = *(const u32x4*)(ag + (size_t)i * 32 * lda); rb[i] = *(const u32x4*)(bg + (size_t)i * 32 * ldb); }
    for (int kt = 0; kt < nk; ++kt) {
        __syncthreads();
#pragma unroll
        for (int i = 0; i < 4; ++i) { *(u32x4*)(la + st_off + i * 4096) = ra[i]; *(u32x4*)(lb + st_off + i * 4096) = rb[i]; }
        __syncthreads();
        if (kt + 1 < nk) {
            const int k1 = (kt + 1) << 6;
#pragma unroll
            for (int i = 0; i < 4; ++i) { ra[i] = *(const u32x4*)(ag + (size_t)i * 32 * lda + k1); rb[i] = *(const u32x4*)(bg + (size_t)i * 32 * ldb + k1); }
        }
#pragma unroll
        for (int ks = 0; ks < 2; ++ks) {
            const int coff = ((ks * 4 + fq) ^ (fr & 7)) << 4;
            bf16x8 a[4], b[4];
#pragma unroll
            for (int i = 0; i < 4; ++i) { a[i] = *(const bf16x8*)(la + a_base + i * 2048 + coff); b[i] = *(const bf16x8*)(lb + b_base + i * 2048 + coff); }
            if (nonswap) {
#pragma unroll
                for (int mt = 0; mt < 4; ++mt)
#pragma unroll
                    for (int nt = 0; nt < 4; ++nt) acc[mt][nt] = MFMA16(a[mt], b[nt], acc[mt][nt]);
            } else {
#pragma unroll
                for (int mt = 0; mt < 4; ++mt)
#pragma unroll
                    for (int nt = 0; nt < 4; ++nt) acc[mt][nt] = MFMA16(b[nt], a[mt], acc[mt][nt]);
            }
        }
    }
}

DEV int vblock() { const int G = gridDim.x, b = blockIdx.x; return ((G & 7) == 0) ? (b & 7) * (G >> 3) + (b >> 3) : b; }
DEV void tile_mn(int t, int nN, int& mi, int& ni) { const int per = 8 * nN; const int mg = t / per, r = t - mg * per; mi = mg * 8 + (r & 7); ni = r >> 3; }

DEV void gemm_in_phase(unsigned char* smem, const Prm& P, int kind, const u16* Wt, int N) {
    unsigned char* ws = P.ws;
    const u16* A = (const u16*)(ws + OFF_XB);
    u16* H = (u16*)(ws + OFF_H);
    const float* cosT = (const float*)(ws + OFF_COS); const float* sinT = (const float*)(ws + OFF_SIN);
    const int nN = N >> 7, ntiles = 128 * nN;
    const int lane = threadIdx.x & 63, w = threadIdx.x >> 6, wm = w >> 1, wn = w & 1, fr = lane & 15, fq = lane >> 4;
    for (int t = vblock(); t < ntiles; t += gridDim.x) {
        int mi, ni; tile_mn(t, nN, mi, ni);
        const int m0 = mi << 7, n0 = ni << 7;
        const int ncol = n0 + wn * 64, cgi = ncol >> 6;
        int mode = 0;
        int vsel = 0, vth = 0, dsh = 0, nhv = 4;
        if (kind == 0) {
            if (cgi < 36) { const int g = cgi / 12, part = (cgi - g * 12) >> 2; vth = cgi & 3; if (part < 2) mode = 1; else { mode = 2; vsel = g; dsh = 2 * g; } }
        } else if (kind == 1) {
            if (cgi < 18) mode = 1; else if (cgi < 20) { mode = 2; vsel = 0; vth = cgi - 18; nhv = 2; }
        } else {
            if (cgi < 20) mode = 1; else if (cgi < 24) mode = 0; else if (cgi < 28) mode = 1; else if (cgi < 32) { mode = 2; vsel = 0; vth = cgi - 28; }
            else if (cgi < 36) mode = 1; else if (cgi < 40) { mode = 2; vsel = 1; vth = cgi - 36; }
        }
        f32x4 acc[4][4];
#pragma unroll
        for (int i = 0; i < 4; ++i)
#pragma unroll
            for (int j = 0; j < 4; ++j) acc[i][j] = f32x4{0.f, 0.f, 0.f, 0.f};
        gemm_mainloop(smem, A, 1024, Wt, 1024, 1024, m0, n0, mode == 2, acc);
        const int mw = m0 + wm * 64;
        if (mode == 2) {
            u16* vt = (u16*)(ws + (vsel == 0 ? OFF_VT0 : (vsel == 1 ? OFF_VT1 : OFF_VT2)));
            const int dmask = (1 << dsh) - 1, lsh = 13 - dsh;
#pragma unroll
            for (int mt = 0; mt < 4; ++mt)
#pragma unroll
                for (int j = 0; j < 4; ++j) {
                    const int m = mw + mt * 16 + fq * 4 + j;
                    const int b = m >> 13, s = m & 8191;
                    const int p = ((s & dmask) << lsh) + (s >> dsh);
                    u16* dst = vt + ((((size_t)(b * nhv + vth)) * 512 + (p >> 4)) * 64) * 16 + (p & 15);
#pragma unroll
                    for (int nt = 0; nt < 4; ++nt) dst[(nt * 16 + fr) * 16] = f2bf(acc[mt][nt][j]);
                }
        } else {
#pragma unroll
            for (int mt = 0; mt < 4; ++mt) {
                const int m = mw + mt * 16 + fr;
                const int s = m & 8191;
                u16* hrow = H + (size_t)m * N + ncol + fq * 4;
                if (mode == 1) {
#pragma unroll
                    for (int nt = 0; nt < 2; ++nt) {
                        const f32x4 c4 = *(const f32x4*)(cosT + s * 32 + nt * 16 + fq * 4);
                        const f32x4 s4 = *(const f32x4*)(sinT + s * 32 + nt * 16 + fq * 4);
                        const f32x4 x1 = acc[mt][nt], x2 = acc[mt][nt + 2];
                        const f32x4 o1 = x1 * c4 - x2 * s4, o2 = x2 * c4 + x1 * s4;
                        *(u32x2*)(hrow + nt * 16) = u32x2{pack2(o1[0], o1[1]), pack2(o1[2], o1[3])};
                        *(u32x2*)(hrow + (nt + 2) * 16) = u32x2{pack2(o2[0], o2[1]), pack2(o2[2], o2[3])};
                    }
                } else {
#pragma unroll
                    for (int nt = 0; nt < 4; ++nt) { const f32x4 v = acc[mt][nt]; *(u32x2*)(hrow + nt * 16) = u32x2{pack2(v[0], v[1]), pack2(v[2], v[3])}; }
                }
            }
        }
    }
}

DEV void gemm_out_phase(unsigned char* smem, const Prm& P, const u16* Wt, const float* xin) {
    const u16* A = (const u16*)(P.ws + OFF_G);
    const int lane = threadIdx.x & 63, w = threadIdx.x >> 6, wm = w >> 1, wn = w & 1, fr = lane & 15, fq = lane >> 4;
    for (int t = vblock(); t < 1024; t += gridDim.x) {
        int mi, ni; tile_mn(t, 8, mi, ni);
        const int m0 = mi << 7, n0 = ni << 7;
        f32x4 acc[4][4];
#pragma unroll
        for (int i = 0; i < 4; ++i)
#pragma unroll
            for (int j = 0; j < 4; ++j) acc[i][j] = f32x4{0.f, 0.f, 0.f, 0.f};
        gemm_mainloop(smem, A, 1024, Wt, 1024, 1024, m0, n0, false, acc);
#pragma unroll
        for (int mt = 0; mt < 4; ++mt) {
            const size_t off = (size_t)(m0 + wm * 64 + mt * 16 + fr) * 1024 + n0 + wn * 64 + fq * 4;
#pragma unroll
            for (int nt = 0; nt < 4; ++nt) {
                const f32x4 xv = *(const f32x4*)(xin + off + nt * 16);
                *(f32x4*)(P.out + off + nt * 16) = xv * DN_ALPHA + acc[mt][nt];
            }
        }
    }
}

DEV void gemm_gate_phase(unsigned char* smem, const Prm& P, const u16* Wg, const u16* Wp) {
    const u16* A1 = (const u16*)(P.ws + OFF_XLB);
    const u16* A2 = (const u16*)(P.ws + OFF_PB);
    u16* xb = (u16*)(P.ws + OFF_XB);
    const int lane = threadIdx.x & 63, w = threadIdx.x >> 6, wm = w >> 1, wn = w & 1, fr = lane & 15, fq = lane >> 4;
    for (int t = vblock(); t < 1024; t += gridDim.x) {
        int mi, ni; tile_mn(t, 8, mi, ni);
        const int m0 = mi << 7, n0 = ni << 7;
        f32x4 acc[4][4], acc2[4][4];
#pragma unroll
        for (int i = 0; i < 4; ++i)
#pragma unroll
            for (int j = 0; j < 4; ++j) { acc[i][j] = f32x4{0.f, 0.f, 0.f, 0.f}; acc2[i][j] = f32x4{0.f, 0.f, 0.f, 0.f}; }
        gemm_mainloop(smem, A1, 1024, Wg, 1024, 1024, m0, n0, false, acc);
        gemm_mainloop(smem, A2, 256, Wp, 256, 256, m0, n0, false, acc2);
#pragma unroll
        for (int mt = 0; mt < 4; ++mt) {
            const size_t off = (size_t)(m0 + wm * 64 + mt * 16 + fr) * 1024 + n0 + wn * 64 + fq * 4;
#pragma unroll
            for (int nt = 0; nt < 4; ++nt) {
                const f32x4 xv = *(const f32x4*)(P.out + off + nt * 16);
                f32x4 r;
#pragma unroll
                for (int j = 0; j < 4; ++j) r[j] = xv[j] + sigmoidf_(acc[mt][nt][j]) * acc2[mt][nt][j];
                *(f32x4*)(P.out + off + nt * 16) = r;
                *(u32x2*)(xb + off + nt * 16) = u32x2{pack2(r[0], r[1]), pack2(r[2], r[3])};
            }
        }
    }
}

DEV void ln_phase(const Prm& P, int layer) {
    const int lane = threadIdx.x & 63, w = threadIdx.x >> 6;
    const float* g = P.in[12] + layer * 1024; const float* bb = P.in[13] + layer * 1024;
    u16* xlb = (u16*)(P.ws + OFF_XLB);
    for (int row = blockIdx.x * 4 + w; row < T; row += gridDim.x * 4) {
        float* xr = P.out + (size_t)row * 1024;
        f32x4 v[4];
        float s = 0.f;
#pragma unroll
        for (int i = 0; i < 4; ++i) { v[i] = *(const f32x4*)(xr + i * 256 + lane * 4); s += v[i][0] + v[i][1] + v[i][2] + v[i][3]; }
        const float mean = wave_sum(s) * (1.f / 1024.f);
        float q = 0.f;
#pragma unroll
        for (int i = 0; i < 4; ++i)
#pragma unroll
            for (int j = 0; j < 4; ++j) { const float d = v[i][j] - mean; q += d * d; }
        const float rstd = rsqrtf(wave_sum(q) * (1.f / 1024.f) + LN_EPS);
#pragma unroll
        for (int i = 0; i < 4; ++i) {
            const f32x4 gg = *(const f32x4*)(g + i * 256 + lane * 4), bv = *(const f32x4*)(bb + i * 256 + lane * 4);
            f32x4 y;
#pragma unroll
            for (int j = 0; j < 4; ++j) y[j] = (v[i][j] - mean) * rstd * gg[j] + bv[j];
            *(f32x4*)(xr + i * 256 + lane * 4) = y;
            *(u32x2*)(xlb + (size_t)row * 1024 + i * 256 + lane * 4) = u32x2{pack2(y[0], y[1]), pack2(y[2], y[3])};
        }
    }
    const float* p = P.in[1] + (size_t)layer * T * 256; u16* pb = (u16*)(P.ws + OFF_PB);
    const size_t gtid = (size_t)blockIdx.x * 256 + threadIdx.x, gsz = (size_t)gridDim.x * 256;
    for (size_t i = gtid; i < (size_t)T * 256 / 8; i += gsz) {
        const f32x4 a = *(const f32x4*)(p + i * 8), b = *(const f32x4*)(p + i * 8 + 4);
        *(u32x4*)(pb + i * 8) = u32x4{pack2(a[0], a[1]), pack2(a[2], a[3]), pack2(b[0], b[1]), pack2(b[2], b[3])};
    }
}

struct KV { bf16x8 ka0, ka1, kb0, kb1; bf16x8 v0, v1, v2, v3; };
DEV void load_kv(KV& t, const u16* Kl, int ldk, int rowa, int rowb, const u16* Vl, int blka, int blkb) {
    const u16* pa = Kl + (size_t)rowa * ldk; const u16* pb = Kl + (size_t)rowb * ldk;
    t.ka0 = *(const bf16x8*)pa; t.ka1 = *(const bf16x8*)(pa + 32);
    t.kb0 = *(const bf16x8*)pb; t.kb1 = *(const bf16x8*)(pb + 32);
    const u16* va = Vl + (size_t)blka * 1024; const u16* vb = Vl + (size_t)blkb * 1024;
    t.v0 = __builtin_shufflevector(*(const s16x4*)(va), *(const s16x4*)(vb), 0, 1, 2, 3, 4, 5, 6, 7);
    t.v1 = __builtin_shufflevector(*(const s16x4*)(va + 256), *(const s16x4*)(vb + 256), 0, 1, 2, 3, 4, 5, 6, 7);
    t.v2 = __builtin_shufflevector(*(const s16x4*)(va + 512), *(const s16x4*)(vb + 512), 0, 1, 2, 3, 4, 5, 6, 7);
    t.v3 = __builtin_shufflevector(*(const s16x4*)(va + 768), *(const s16x4*)(vb + 768), 0, 1, 2, 3, 4, 5, 6, 7);
}
DEV bf16x8 pack8(const float (&p)[8]) {
    return __builtin_bit_cast(bf16x8, u32x4{pack2(p[0], p[1]), pack2(p[2], p[3]), pack2(p[4], p[5]), pack2(p[6], p[7])});
}
DEV void qk_scores(const KV& t, const bf16x8& q0, const bf16x8& q1, f32x4& sa, f32x4& sb) {
    sa = f32x4{0.f, 0.f, 0.f, 0.f}; sb = f32x4{0.f, 0.f, 0.f, 0.f};
    sa = MFMA16(t.ka0, q0, sa); sa = MFMA16(t.ka1, q1, sa);
    sb = MFMA16(t.kb0, q0, sb); sb = MFMA16(t.kb1, q1, sb);
}
DEV void flash_core(float& m, float& l, f32x4 (&o)[4], const bf16x8& q0, const bf16x8& q1, const KV& t, unsigned mask8) {
    f32x4 sa, sb; qk_scores(t, q0, q1, sa, sb);
    float x[8];
#pragma unroll
    for (int j = 0; j < 4; ++j) { x[j] = ((mask8 >> j) & 1u) ? sa[j] * 0.125f : NEG_INF; x[4 + j] = ((mask8 >> (4 + j)) & 1u) ? sb[j] * 0.125f : NEG_INF; }
    float mx = fmaxf(fmaxf(fmaxf(x[0], x[1]), fmaxf(x[2], x[3])), fmaxf(fmaxf(x[4], x[5]), fmaxf(x[6], x[7])));
    mx = red16_max(mx);
    const float mn = fmaxf(m, mx);
    const float mu = (mn == NEG_INF) ? 0.f : mn;
    const float alpha = __expf(m - mu);
    float p[8]; float ps = 0.f;
#pragma unroll
    for (int j = 0; j < 8; ++j) { p[j] = __expf(x[j] - mu); ps += p[j]; }
    l = l * alpha + ps; m = mn;
#pragma unroll
    for (int d = 0; d < 4; ++d) o[d] *= alpha;
    const bf16x8 pf = pack8(p);
    o[0] = MFMA16(t.v0, pf, o[0]); o[1] = MFMA16(t.v1, pf, o[1]); o[2] = MFMA16(t.v2, pf, o[2]); o[3] = MFMA16(t.v3, pf, o[3]);
}

DEV void band_loop(float& m, float& l, f32x4 (&o)[4], const bf16x8& q0, const bf16x8& q1, const u16* Kl, int ldk, int dsh, int rg,
                   const u16* Vl, int vblk0, int ustart, int nsteps, int uq, int maxd) {
    const int c = threadIdx.x & 15, g4 = (threadIdx.x & 63) >> 4;
    KV cur, nxt;
    {
        const int ua = ustart, ub = ustart + 16;
        load_kv(cur, Kl, ldk, (max(ua + c, 0) << dsh) + rg, (max(ub + c, 0) << dsh) + rg, Vl, vblk0 + (max(ua, 0) >> 4), vblk0 + (max(ub, 0) >> 4));
    }
    for (int st = 0; st < nsteps; ++st) {
        const int ua = ustart + st * 32;
        if (st + 1 < nsteps) {
            const int na = ua + 32, nb = ua + 48;
            load_kv(nxt, Kl, ldk, (max(na + c, 0) << dsh) + rg, (max(nb + c, 0) << dsh) + rg, Vl, vblk0 + (max(na, 0) >> 4), vblk0 + (max(nb, 0) >> 4));
        }
        unsigned mask8 = 0;
#pragma unroll
        for (int j = 0; j < 8; ++j) {
            const int u = ua + (j >> 2) * 16 + g4 * 4 + (j & 3);
            const int dist = uq - u;
            if (u >= 0 && dist >= 0 && dist <= maxd) mask8 |= (1u << j);
        }
        flash_core(m, l, o, q0, q1, cur, mask8);
        cur = nxt;
    }
}

DEV void attnA_phase(const Prm& P, int chunk) {
    unsigned char* ws = P.ws;
    const u16* H = (const u16*)(ws + OFF_H);
    u16* G = (u16*)(ws + OFF_G);
    const int lane = threadIdx.x & 63, w = threadIdx.x >> 6, c = lane & 15, g4 = lane >> 4;
    constexpr int LD = 2560;
    for (int it = blockIdx.x; it < 1024; it += gridDim.x) {
        const int rq = it & 3, tbi = (it >> 2) & 31, hh = (it >> 7) & 3, b = it >> 9;
        const int r = rq * 4 + w, tb = tbi * 256;
        const int sq = tb + r + 16 * c;
        const size_t rowq = (size_t)b * 8192 + sq;
        float m = NEG_INF, l = 0.f;
        f32x4 o[4];
#pragma unroll
        for (int d = 0; d < 4; ++d) o[d] = f32x4{0.f, 0.f, 0.f, 0.f};
#pragma unroll 1
        for (int g = 0; g < 3; ++g) {
            const int dsh = 2 * g, dmask = (1 << dsh) - 1;
            const int rg = r & dmask;
            const int uq = sq >> dsh, uq0 = (tb + r) >> dsh;
            int ustart = (uq0 - 128) & ~15;
            const int ulast = (uq0 + (15 << (4 - dsh))) & ~15;
            int ntile = ((ulast - ustart) >> 4) + 1;
            if (ntile & 1) { ustart -= 16; ntile += 1; }
            const u16* Hq = H + rowq * LD + g * 768 + hh * 64 + g4 * 8;
            const bf16x8 q0 = *(const bf16x8*)Hq, q1 = *(const bf16x8*)(Hq + 32);
            const u16* Kl = H + (size_t)b * 8192 * LD + g * 768 + 256 + hh * 64 + g4 * 8;
            const u16* vtb = (const u16*)(ws + (g == 0 ? OFF_VT0 : (g == 1 ? OFF_VT1 : OFF_VT2)));
            const u16* Vl = vtb + ((size_t)(b * 4 + hh) * 512) * 1024 + c * 16 + g4 * 4;
            const int vblk0 = rg * ((8192 >> dsh) >> 4);
            band_loop(m, l, o, q0, q1, Kl, LD, dsh, rg, Vl, vblk0, ustart, ntile >> 1, uq, 128);
        }
        l = red16_sum(l);
        const float inv = 1.f / l;
#pragma unroll
        for (int dt = 0; dt < 4; ++dt) {
            const int dh = dt * 16 + g4 * 4;
            const u32x2 z = *(const u32x2*)(H + rowq * LD + 2304 + hh * 64 + dh);
            const float r0 = o[dt][0] * inv * siluf_(bflo(z[0])), r1 = o[dt][1] * inv * siluf_(bfhi(z[0]));
            const float r2 = o[dt][2] * inv * siluf_(bflo(z[1])), r3 = o[dt][3] * inv * siluf_(bfhi(z[1]));
            *(u32x2*)(G + rowq * 1024 + (chunk * 4 + hh) * 64 + dh) = u32x2{pack2(r0, r1), pack2(r2, r3)};
        }
    }
}

DEV void attnB_phase(const Prm& P) {
    unsigned char* ws = P.ws;
    const u16* H = (const u16*)(ws + OFF_H);
    u16* G = (u16*)(ws + OFF_G);
    const float* sinks = P.in[5];
    const int lane = threadIdx.x & 63, w = threadIdx.x >> 6, c = lane & 15, g4 = lane >> 4;
    constexpr int LD = 2304;
    for (int it = blockIdx.x; it < 4096; it += gridDim.x) {
        const int b = it >> 11, rem = it & 2047, tile = rem >> 2, hq = rem & 3;
        const int head = hq * 4 + w, kvh = head >> 3;
        const int t0 = tile * 16, sq = t0 + c;
        const size_t rowq = (size_t)b * 8192 + sq;
        float m = NEG_INF, l = 0.f;
        f32x4 o[4];
#pragma unroll
        for (int d = 0; d < 4; ++d) o[d] = f32x4{0.f, 0.f, 0.f, 0.f};
        const u16* Hq = H + rowq * LD + head * 64 + g4 * 8;
        const bf16x8 q0 = *(const bf16x8*)Hq, q1 = *(const bf16x8*)(Hq + 32);
        const u16* Kl = H + (size_t)b * 8192 * LD + 1024 + kvh * 64 + g4 * 8;
        const u16* Vl = (const u16*)(ws + OFF_VT0) + ((size_t)(b * 2 + kvh) * 512) * 1024 + c * 16 + g4 * 4;
        band_loop(m, l, o, q0, q1, Kl, LD, 0, 0, Vl, 0, t0 - 144, 5, sq, 127);
        l = red16_sum(l);
        const float sk = sinks[head];
        const float mf = fmaxf(m, sk);
        const float sc = __expf(m - mf);
        const float lf = l * sc + __expf(sk - mf);
        const float inv = sc / lf;
#pragma unroll
        for (int dt = 0; dt < 4; ++dt) {
            const int dh = dt * 16 + g4 * 4;
            const u32x2 z = *(const u32x2*)(H + rowq * LD + 1280 + head * 64 + dh);
            const float r0 = o[dt][0] * inv * siluf_(bflo(z[0])), r1 = o[dt][1] * inv * siluf_(bfhi(z[0]));
            const float r2 = o[dt][2] * inv * siluf_(bflo(z[1])), r3 = o[dt][3] * inv * siluf_(bfhi(z[1]));
            *(u32x2*)(G + rowq * 1024 + head * 64 + dh) = u32x2{pack2(r0, r1), pack2(r2, r3)};
        }
    }
}

DEV void compress_phase(const Prm& P) {
    unsigned char* ws = P.ws;
    const u16* H = (const u16*)(ws + OFF_H);
    constexpr int LD = 3712;
    const float* bias = (const float*)(ws + OFF_BIAS);
    const int lane = threadIdx.x & 63, w = threadIdx.x >> 6, c = lane & 15, g4 = lane >> 4;
    for (int it = blockIdx.x; it < 128; it += gridDim.x) {
        const int unit = it * 4 + w;
        const int which = unit >> 8, b = (unit >> 7) & 1, kvh = (unit >> 5) & 3, ntile = unit & 31;
        const u16* Wt = (const u16*)(ws + (which ? OFF_WCV : OFF_WCK));
        const int colbase = (which ? 1280 : 1024) + kvh * 64;
        const int n = ntile * 16 + c;
        const u16* Wl = Wt + (size_t)c * 2048 + g4 * 8;
        f32x4 acc[4];
#pragma unroll
        for (int e = 0; e < 4; ++e) acc[e] = f32x4{0.f, 0.f, 0.f, 0.f};
#pragma unroll 4
        for (int kk = 0; kk < 64; ++kk) {
            const int j = kk >> 1, d0 = (kk & 1) * 32 + g4 * 8;
            int s = 16 * n + j; s = min(s, 8191);
            const bf16x8 xf = *(const bf16x8*)(H + ((size_t)b * 8192 + s) * LD + colbase + d0);
            bf16x8 wf[4];
#pragma unroll
            for (int e = 0; e < 4; ++e) wf[e] = *(const bf16x8*)(Wl + (size_t)e * 16 * 2048 + kk * 32);
            if (which == 0) {
#pragma unroll
                for (int e = 0; e < 4; ++e) acc[e] = MFMA16(wf[e], xf, acc[e]);
            } else {
#pragma unroll
                for (int e = 0; e < 4; ++e) acc[e] = MFMA16(xf, wf[e], acc[e]);
            }
        }
        if (which == 0) {
            u16* kc = (u16*)(ws + OFF_KCMP) + ((size_t)(b * 512 + n) * 4 + kvh) * 64;
#pragma unroll
            for (int e = 0; e < 4; ++e) {
                const int e0 = e * 16 + g4 * 4;
                const f32x4 bv = *(const f32x4*)(bias + e0);
                const f32x4 r = acc[e] + bv;
                *(u32x2*)(kc + e0) = u32x2{pack2(r[0], r[1]), pack2(r[2], r[3])};
            }
        } else {
            u16* vc = (u16*)(ws + OFF_VCMP) + (((size_t)(b * 4 + kvh) * 32 + ntile) * 64) * 16;
#pragma unroll
            for (int e = 0; e < 4; ++e) {
                const int ee = e * 16 + c;
                const float bv = bias[64 + ee];
                *(u32x2*)(vc + ee * 16 + g4 * 4) = u32x2{pack2(acc[e][0] + bv, acc[e][1] + bv), pack2(acc[e][2] + bv, acc[e][3] + bv)};
            }
        }
    }
}

DEV void attnC_phase(const Prm& P, unsigned char* smem) {
    unsigned char* ws = P.ws;
    const u16* H = (const u16*)(ws + OFF_H);
    u16* G = (u16*)(ws + OFF_G);
    constexpr int LD = 3712;
    float* imp = (float*)smem;
    float* scb = (float*)(smem + 32768);
    float* oslc = (float*)(smem + 34816);
    const int tid = threadIdx.x, lane = tid & 63, w = tid >> 6, c = lane & 15, g4 = lane >> 4;
    for (int it = blockIdx.x; it < 4096; it += gridDim.x) {
        const int b = it >> 11, rem = it & 2047, tile = rem >> 2, kvh = rem & 3;
        const int t0 = tile * 16;
        for (int i = tid; i < 8192; i += 256) imp[i] = 0.f;
        __syncthreads();
        const int head = kvh * 4 + w;
        const size_t rowq = (size_t)b * 8192 + t0 + c;
        const u16* Hq = H + rowq * LD + head * 64 + g4 * 8;
        const bf16x8 q0 = *(const bf16x8*)Hq, q1 = *(const bf16x8*)(Hq + 32);
        f32x4 oacc[4];
#pragma unroll
        for (int d = 0; d < 4; ++d) oacc[d] = f32x4{0.f, 0.f, 0.f, 0.f};
        const int nmax = (t0 + c - 31) >> 4;
        const int nmaxw = (t0 - 16) >> 4;
        const float g0 = sigmoidf_(bf2f(H[rowq * LD + 3584 + head]));
        const float g1 = sigmoidf_(bf2f(H[rowq * LD + 3584 + 16 + head]));
        const float g2 = sigmoidf_(bf2f(H[rowq * LD + 3584 + 32 + head]));
        if (nmaxw >= 0) {
            const int nsteps = (nmaxw >> 5) + 1;
            const u16* Kl = (const u16*)(ws + OFF_KCMP) + (size_t)b * 512 * 256 + kvh * 64 + g4 * 8;
            const u16* Vl = (const u16*)(ws + OFF_VCMP) + ((size_t)(b * 4 + kvh) * 32) * 1024 + c * 16 + g4 * 4;
            float m = NEG_INF, l = 0.f;
            for (int st = 0; st < nsteps; ++st) {
                KV t; const int na = st * 32;
                const u16* pa = Kl + (size_t)(na + c) * 256; const u16* pb = Kl + (size_t)min(na + 16 + c, 511) * 256;
                t.ka0 = *(const bf16x8*)pa; t.ka1 = *(const bf16x8*)(pa + 32); t.kb0 = *(const bf16x8*)pb; t.kb1 = *(const bf16x8*)(pb + 32);
                f32x4 sa, sb; qk_scores(t, q0, q1, sa, sb);
                float mx = NEG_INF; float x[8];
#pragma unroll
                for (int j = 0; j < 8; ++j) {
                    const int n = na + (j >> 2) * 16 + g4 * 4 + (j & 3);
                    x[j] = (n <= nmax) ? ((j < 4) ? sa[j & 3] : sb[j & 3]) * 0.125f : NEG_INF;
                    mx = fmaxf(mx, x[j]);
                }
                const float mn = fmaxf(m, mx);
                const float mu = (mn == NEG_INF) ? 0.f : mn;
                float ps = 0.f;
#pragma unroll
                for (int j = 0; j < 8; ++j) ps += __expf(x[j] - mu);
                l = l * __expf(m - mu) + ps; m = mn;
            }
            float mall = red16_max(m);
            mall = (mall == NEG_INF) ? 0.f : mall;
            l = l * __expf(m - mall);
            l = red16_sum(l);
            const float invl = (l > 0.f) ? 1.f / l : 0.f;
            for (int st = 0; st < nsteps; ++st) {
                KV t; const int na = st * 32;
                load_kv(t, Kl, 256, na + c, min(na + 16 + c, 511), Vl, na >> 4, min((na >> 4) + 1, 31));
                f32x4 sa, sb; qk_scores(t, q0, q1, sa, sb);
                float p[8];
#pragma unroll
                for (int j = 0; j < 8; ++j) {
                    const int n = na + (j >> 2) * 16 + g4 * 4 + (j & 3);
                    const float sv = ((j < 4) ? sa[j & 3] : sb[j & 3]) * 0.125f;
                    p[j] = (n <= nmax) ? __expf(sv - mall) * invl : 0.f;
                    if (n <= nmax) atomicAdd(&imp[n * 16 + c], p[j]);
                }
                const bf16x8 pf = pack8(p);
                oacc[0] = MFMA16(t.v0, pf, oacc[0]); oacc[1] = MFMA16(t.v1, pf, oacc[1]);
                oacc[2] = MFMA16(t.v2, pf, oacc[2]); oacc[3] = MFMA16(t.v3, pf, oacc[3]);
            }
#pragma unroll
            for (int d = 0; d < 4; ++d) oacc[d] *= g0;
        }
        {
            float m = NEG_INF, l = 0.f;
            f32x4 o[4];
#pragma unroll
            for (int d = 0; d < 4; ++d) o[d] = f32x4{0.f, 0.f, 0.f, 0.f};
            const u16* Kl = H + (size_t)b * 8192 * LD + 2048 + kvh * 64 + g4 * 8;
            const u16* Vl = (const u16*)(ws + OFF_VT1) + ((size_t)(b * 4 + kvh) * 512) * 1024 + c * 16 + g4 * 4;
            band_loop(m, l, o, q0, q1, Kl, LD, 0, 0, Vl, 0, t0 - 528, 17, t0 + c, 511);
            l = red16_sum(l);
            const float sc = g2 / l;
#pragma unroll
            for (int d = 0; d < 4; ++d) oacc[d] += o[d] * sc;
        }
        __syncthreads();
        unsigned long long mlo[4], mhi[4];
#pragma unroll
        for (int i = 0; i < 4; ++i) {
            const int tok = 4 * w + i, tq = t0 + tok, cur = tq >> 6;
            float my0, my1;
            {
                const int j0 = lane, j1 = lane + 64;
                float a0 = 2.f * (imp[(4 * j0) * 16 + tok] + imp[(4 * j0 + 1) * 16 + tok] + imp[(4 * j0 + 2) * 16 + tok]) + imp[(4 * j0 + 3) * 16 + tok];
                if (j0 > 0) a0 += imp[(4 * j0 - 1) * 16 + tok];
                const float a1 = 2.f * (imp[(4 * j1) * 16 + tok] + imp[(4 * j1 + 1) * 16 + tok] + imp[(4 * j1 + 2) * 16 + tok]) + imp[(4 * j1 + 3) * 16 + tok]
                                 + imp[(4 * j1 - 1) * 16 + tok];
                const bool f0 = (j0 == 0) || (j0 == cur) || (j0 == cur - 1);
                const bool f1 = (j1 == cur) || (j1 == cur - 1);
                my0 = f0 ? 1e4f : ((j0 <= cur) ? a0 : -1.f);
                my1 = f1 ? 1e4f : ((j1 <= cur) ? a1 : -1.f);
            }
            __syncthreads();
            scb[w * 128 + lane] = my0; scb[w * 128 + 64 + lane] = my1;
            __syncthreads();
            int c0 = 0, c1 = 0;
            for (int jj = 0; jj < 128; ++jj) {
                const float sv = scb[w * 128 + jj];
                c0 += (sv > my0 || (sv == my0 && jj < lane)) ? 1 : 0;
                c1 += (sv > my1 || (sv == my1 && jj < lane + 64)) ? 1 : 0;
            }
            mlo[i] = __ballot((c0 < 16) && (lane <= cur));
            mhi[i] = __ballot((c1 < 16) && (lane + 64 <= cur));
        }
        {
            const int tokL = 4 * w + (c >> 2), tq = t0 + tokL, hd = kvh * 4 + (c & 3);
            const size_t rq = (size_t)b * 8192 + tq;
            const u16* Hs = H + rq * LD + hd * 64 + g4 * 8;
            const bf16x8 s0 = *(const bf16x8*)Hs, s1 = *(const bf16x8*)(Hs + 32);
            const u16* Kl = H + (size_t)b * 8192 * LD + 1536 + kvh * 64 + g4 * 8;
            const u16* Vl = (const u16*)(ws + OFF_VT0) + ((size_t)(b * 4 + kvh) * 512) * 1024 + c * 16 + g4 * 4;
            float m = NEG_INF, l = 0.f;
            f32x4 o[4];
#pragma unroll
            for (int d = 0; d < 4; ++d) o[d] = f32x4{0.f, 0.f, 0.f, 0.f};
            const int ti = c >> 2;
            const unsigned long long mylo = (ti == 0) ? mlo[0] : (ti == 1) ? mlo[1] : (ti == 2) ? mlo[2] : mlo[3];
            const unsigned long long myhi = (ti == 0) ? mhi[0] : (ti == 1) ? mhi[1] : (ti == 2) ? mhi[2] : mhi[3];
            unsigned long long ulo = mlo[0] | mlo[1] | mlo[2] | mlo[3];
            unsigned long long uhi = mhi[0] | mhi[1] | mhi[2] | mhi[3];
            int j = -1, half = 0;
            if (ulo) { j = __builtin_ctzll(ulo); ulo &= ulo - 1; } else if (uhi) { j = 64 + __builtin_ctzll(uhi); uhi &= uhi - 1; }
            KV cur, nxt;
            if (j >= 0) { const int ua = j * 64; load_kv(cur, Kl, LD, ua + c, ua + 16 + c, Vl, ua >> 4, (ua >> 4) + 1); }
            while (j >= 0) {
                int jn = j, hn = half + 1;
                if (hn == 2) {
                    hn = 0;
                    if (ulo) { jn = __builtin_ctzll(ulo); ulo &= ulo - 1; } else if (uhi) { jn = 64 + __builtin_ctzll(uhi); uhi &= uhi - 1; } else jn = -1;
                }
                if (jn >= 0) { const int ua = jn * 64 + hn * 32; load_kv(nxt, Kl, LD, ua + c, ua + 16 + c, Vl, ua >> 4, (ua >> 4) + 1); }
                const bool selj = (j < 64) ? ((mylo >> j) & 1ull) : ((myhi >> (j - 64)) & 1ull);
                const int ua = j * 64 + half * 32;
                unsigned mask8 = 0;
#pragma unroll
                for (int jj = 0; jj < 8; ++jj) {
                    const int u = ua + (jj >> 2) * 16 + g4 * 4 + (jj & 3);
                    if (selj && u <= tq) mask8 |= (1u << jj);
                }
                flash_core(m, l, o, s0, s1, cur, mask8);
                cur = nxt; j = jn; half = hn;
            }
            l = red16_sum(l);
            const float inv = 1.f / l;
#pragma unroll
            for (int dt = 0; dt < 4; ++dt)
                *(f32x4*)(oslc + (tokL * 4 + (c & 3)) * 64 + dt * 16 + g4 * 4) = o[dt] * inv;
        }
        __syncthreads();
#pragma unroll
        for (int dt = 0; dt < 4; ++dt) {
            const int dh = dt * 16 + g4 * 4;
            const f32x4 os = *(const f32x4*)(oslc + (c * 4 + w) * 64 + dh);
            const f32x4 r = oacc[dt] + os * g1;
            const u32x2 z = *(const u32x2*)(H + rowq * LD + 2560 + head * 64 + dh);
            const float r0 = r[0] * siluf_(bflo(z[0])), r1 = r[1] * siluf_(bfhi(z[0]));
            const float r2 = r[2] * siluf_(bflo(z[1])), r3 = r[3] * siluf_(bfhi(z[1]));
            *(u32x2*)(G + rowq * 1024 + head * 64 + dh) = u32x2{pack2(r0, r1), pack2(r2, r3)};
        }
        __syncthreads();
    }
}

__global__ void __launch_bounds__(256, 1) mk_fwd(Prm P) {
    __shared__ __attribute__((aligned(16))) unsigned char smem[51200];
    __shared__ uint4 xb_words;
    if (threadIdx.x == 0) xb_words = make_uint4(0u, 0u, 0u, 0u);
    __syncthreads();
    XcdBarrier bar = xcd_barrier_post((unsigned*)(P.ws + OFF_BAR), (volatile LAS unsigned*)&xb_words);
    unsigned char* ws = P.ws;

    phase0(P, smem);
    cg::this_grid().sync();

#pragma unroll 1
    for (int layer = 0; layer < 4; ++layer) {
        const int kind = layer % 3, lj = layer / 3;
        const u16* Win; const u16* Wout; int N, nsub;
        if (kind == 0)      { Win = (const u16*)(ws + OFF_WA_IN + (size_t)lj * SZ_WA_IN); Wout = (const u16*)(ws + OFF_WA_OUT + (size_t)lj * SZ_SQ); N = 2560; nsub = 4; }
        else if (kind == 1) { Win = (const u16*)(ws + OFF_WB_IN); Wout = (const u16*)(ws + OFF_WB_OUT); N = 2304; nsub = 1; }
        else                { Win = (const u16*)(ws + OFF_WC_IN); Wout = (const u16*)(ws + OFF_WC_OUT); N = 3712; nsub = 1; }
#pragma unroll 1
        for (int sub = 0; sub < nsub; ++sub) {
            gemm_in_phase(smem, P, kind, Win + (size_t)sub * 2560 * 1024, N);
            xcd_barrier(bar);
            if (kind == 0) attnA_phase(P, sub);
            else if (kind == 1) attnB_phase(P);
            else { compress_phase(P); xcd_barrier(bar); attnC_phase(P, smem); }
            xcd_barrier(bar);
        }
        gemm_out_phase(smem, P, Wout, layer == 0 ? P.in[0] : P.out);
        xcd_barrier(bar);
        ln_phase(P, layer);
        xcd_barrier(bar);
        gemm_gate_phase(smem, P, (const u16*)(ws + OFF_WG + (size_t)layer * SZ_SQ), (const u16*)(ws + OFF_WP + (size_t)layer * SZ_WP));
        if (layer < 3) xcd_barrier(bar);
    }
}

extern "C" void kernel_launch(void* const* d_in, const int* in_sizes, int n_in, void* d_out, int out_size, void* d_ws, size_t ws_size,
                              hipStream_t stream) {
    static int grid_blocks = 0;
    if (!grid_blocks) {
        int dev = 0, cus = 0, per_cu = 0;
        hipGetDevice(&dev);
        hipDeviceGetAttribute(&cus, hipDeviceAttributeMultiprocessorCount, dev);
        hipOccupancyMaxActiveBlocksPerMultiprocessor(&per_cu, (const void*)mk_fwd, 256, 0);
        if (per_cu > 2) per_cu = 2;
        if (per_cu < 1) per_cu = 1;
        grid_blocks = cus * per_cu;
        if (ws_size < WS_END || n_in != 16) { fprintf(stderr, "kernel_launch: workspace too small (%zu < %zu) or n_in %d != 16\n", ws_size, (size_t)WS_END, n_in); grid_blocks = -1; }
    }
    if (grid_blocks < 0) return;
    hipMemsetAsync((char*)d_ws + OFF_BAR, 0, 16384, stream);
    Prm p{};
    for (int i = 0; i < 16; ++i) p.in[i] = (const float*)d_in[i];
    p.out = (float*)d_out; p.ws = (unsigned char*)d_ws;
    void* args[] = {&p};
    hipError_t e = hipLaunchCooperativeKernel((const void*)mk_fwd, dim3(grid_blocks), dim3(256), args, 0, stream);
    if (e != hipSuccess) fprintf(stderr, "cooperative launch failed: %s (grid %d)\n", hipGetErrorString(e), grid_blocks);
}
```

```cpp
#include <hip/hip_runtime.h>
#include <hip/hip_cooperative_groups.h>
#include <cstdio>
#include <cstdint>
namespace cg = cooperative_groups;

typedef unsigned short u16;
using bf16x8 = __attribute__((ext_vector_type(8))) short;
using s16x4  = __attribute__((ext_vector_type(4))) short;
using f32x4  = __attribute__((ext_vector_type(4))) float;
using u32x4  = __attribute__((ext_vector_type(4))) unsigned;
using u32x2  = __attribute__((ext_vector_type(2))) unsigned;
#define DEV __device__ __forceinline__
using h16x8 = __attribute__((ext_vector_type(8))) _Float16;
#define MFMA16(a, b, c) __builtin_amdgcn_mfma_f32_16x16x32_f16(__builtin_bit_cast(h16x8, (a)), __builtin_bit_cast(h16x8, (b)), (c), 0, 0, 0)
#define LAS __attribute__((address_space(3)))

constexpr int T = 16384, S = 8192;
constexpr float LN_EPS = 1e-5f;
constexpr float DN_ALPHA = 1.6817928305074290f;
constexpr float NEG_INF = -__builtin_huge_valf();

constexpr size_t OFF_BAR   = 0;
constexpr size_t OFF_COS   = 16384;
constexpr size_t OFF_SIN   = OFF_COS + (size_t)8192 * 32 * 4;
constexpr size_t OFF_BIAS  = OFF_SIN + (size_t)8192 * 32 * 4;
constexpr size_t OFF_WA_IN = OFF_BIAS + 1024;
constexpr size_t SZ_WA_IN  = (size_t)10240 * 1024 * 2;
constexpr size_t SZ_SQ     = (size_t)1024 * 1024 * 2;
constexpr size_t OFF_WA_OUT = OFF_WA_IN + 2 * SZ_WA_IN;
constexpr size_t OFF_WB_IN  = OFF_WA_OUT + 2 * SZ_SQ;
constexpr size_t OFF_WB_OUT = OFF_WB_IN + (size_t)2304 * 1024 * 2;
constexpr size_t OFF_WC_IN  = OFF_WB_OUT + SZ_SQ;
constexpr size_t OFF_WC_OUT = OFF_WC_IN + (size_t)3840 * 1024 * 2;
constexpr size_t OFF_WG     = OFF_WC_OUT + SZ_SQ;
constexpr size_t OFF_WP     = OFF_WG + 4 * SZ_SQ;
constexpr size_t SZ_WP      = (size_t)1024 * 256 * 2;
constexpr size_t OFF_WCK    = OFF_WP + 4 * SZ_WP;
constexpr size_t OFF_WCV    = OFF_WCK + (size_t)64 * 2048 * 2;
constexpr size_t OFF_XB     = OFF_WCV + (size_t)64 * 2048 * 2;
constexpr size_t SZ_ACT     = (size_t)T * 1024 * 2;
constexpr size_t OFF_G      = OFF_XB + SZ_ACT;
constexpr size_t OFF_H      = OFF_G + SZ_ACT;
constexpr size_t SZ_HMAX    = (size_t)T * 3840 * 2;
constexpr size_t OFF_VT0    = OFF_H + SZ_HMAX;
constexpr size_t SZ_VT      = (size_t)2 * 4 * 8192 * 64 * 2;
constexpr size_t OFF_VT1    = OFF_VT0 + SZ_VT;
constexpr size_t OFF_VT2    = OFF_VT1 + SZ_VT;
constexpr size_t OFF_KCMP   = OFF_VT2 + SZ_VT;
constexpr size_t SZ_CMP     = (size_t)2 * 512 * 4 * 64 * 2;
constexpr size_t OFF_VCMP   = OFF_KCMP + SZ_CMP;
constexpr size_t WS_END     = OFF_VCMP + SZ_CMP;
constexpr size_t OFF_XLB    = OFF_H;
constexpr size_t OFF_PB     = OFF_H + SZ_ACT;
constexpr size_t OFF_PP     = OFF_H + SZ_ACT + (size_t)16 * 1024 * 1024;

struct Prm { const float* in[16]; float* out; unsigned char* ws; };

DEV u16 f2bf(float f) { return __builtin_bit_cast(u16, (_Float16)f); }
DEV float bf2f(u16 h) { return (float)__builtin_bit_cast(_Float16, h); }
DEV unsigned pack2(float a, float b) { return (unsigned)f2bf(a) | ((unsigned)f2bf(b) << 16); }
DEV float bflo(unsigned u) { return bf2f((u16)(u & 0xffffu)); }
DEV float bfhi(unsigned u) { return bf2f((u16)(u >> 16)); }
DEV float sigmoidf_(float x) { return 1.f / (1.f + __expf(-x)); }
DEV float siluf_(float x) { return x / (1.f + __expf(-x)); }
DEV float red16_max(float v) { v = fmaxf(v, __shfl_xor(v, 16)); v = fmaxf(v, __shfl_xor(v, 32)); return v; }
DEV float red16_sum(float v) { v += __shfl_xor(v, 16); v += __shfl_xor(v, 32); return v; }
DEV float wave_sum(float v) { for (int o = 32; o > 0; o >>= 1) v += __shfl_xor(v, o); return v; }

DEV int opaque_tid() { int t = threadIdx.x; asm volatile("" : "+v"(t)); return t; }
#define XB_TMO      128
#define XB_XCNT(j)  (256  + 64 * (j))
#define XB_XSUB(j)  (1280 + 64 * (j))
#define XB_XGEN(j)  (2304 + 64 * (j))
#define XB_TOP      3328
#define XB_TOPGEN   3392
#define XCD_BAR_WORDS 3456
#define XB_SPIN_CAP (1u << 24)
DEV unsigned xb_ld(unsigned* p)              { return __hip_atomic_load(p, __ATOMIC_RELAXED, __HIP_MEMORY_SCOPE_AGENT); }
DEV unsigned xb_add(unsigned* p, unsigned v) { return __hip_atomic_fetch_add(p, v, __ATOMIC_RELAXED, __HIP_MEMORY_SCOPE_AGENT); }
DEV unsigned xb_xcc_id() { return (unsigned)__builtin_amdgcn_s_getreg((3 << 11) | 20) & 0xFu; }
#define XB_SPIN(cond, bar) do { unsigned _sp = 0; while (cond) { __builtin_amdgcn_s_sleep(1); \
    if ((++_sp & 255u) == 0u) { if (xb_ld(&(bar)[XB_TMO])) break; if (_sp > XB_SPIN_CAP) { atomicAdd(&(bar)[XB_TMO], 1u); break; } } } } while (0)
struct XcdBarrier { unsigned* bar; unsigned x; volatile LAS unsigned* st; };
DEV XcdBarrier xcd_barrier_post(unsigned* bar, volatile LAS unsigned* st) {
    XcdBarrier b; b.bar = bar; b.x = xb_xcc_id(); b.st = st;
    if (threadIdx.x == 0) (void)xb_add(&bar[XB_XCNT(b.x)], 1u);
    return b;
}
DEV void xcd_barrier_complete(unsigned* bar, unsigned x, unsigned& nloc, unsigned& nx) {
    const unsigned G = gridDim.x * gridDim.y * gridDim.z;
    unsigned sum, cnt, mine, sp = 0u;
    for (;;) {
        sum = 0u; cnt = 0u; mine = 0u;
#pragma unroll
        for (unsigned j = 0; j < 16; ++j) { const unsigned c = xb_ld(&bar[XB_XCNT(j)]); sum += c; cnt += (c > 0u) ? 1u : 0u; mine = (j == x) ? c : mine; }
        if (sum == G) break;
        __builtin_amdgcn_s_sleep(1);
        if ((++sp & 255u) == 0u) { if (xb_ld(&bar[XB_TMO])) break; if (sp > XB_SPIN_CAP) { atomicAdd(&bar[XB_TMO], 1u); break; } }
    }
    nloc = mine > 0u ? mine : 1u; nx = cnt > 0u ? cnt : 1u;
}
DEV void xcd_barrier(const XcdBarrier& b) {
    asm volatile("s_waitcnt vmcnt(0)" ::: "memory");
    __syncthreads();
    if (threadIdx.x == 0) {
        unsigned* bar = b.bar;
        __builtin_amdgcn_s_waitcnt(0);
        unsigned nloc = b.st[0], nx = b.st[1];
        if (nloc == 0u) { xcd_barrier_complete(bar, b.x, nloc, nx); b.st[0] = nloc; b.st[1] = nx; }
        const unsigned old = xb_add(&bar[XB_XSUB(b.x)], 1u);
        const unsigned gen = old / nloc;
        if (old + 1u == (gen + 1u) * nloc) {
            __builtin_amdgcn_fence(__ATOMIC_RELEASE, "agent");
            asm volatile("s_waitcnt vmcnt(0)" ::: "memory");
            const unsigned og = xb_add(&bar[XB_TOP], 1u);
            const unsigned tg = og / nx;
            if (og + 1u == (tg + 1u) * nx) xb_add(&bar[XB_TOPGEN], 1u);
            else XB_SPIN(xb_ld(&bar[XB_TOPGEN]) == tg, bar);
            __builtin_amdgcn_fence(__ATOMIC_ACQUIRE, "agent");
            xb_add(&bar[XB_XGEN(b.x)], 1u);
            asm volatile("s_waitcnt vmcnt(0)" ::: "memory");
        } else {
            XB_SPIN(xb_ld(&bar[XB_XGEN(b.x)]) == gen, bar);
            __builtin_amdgcn_fence(__ATOMIC_ACQUIRE, "agent");
            asm volatile("s_waitcnt vmcnt(0)" ::: "memory");
        }
    }
    __syncthreads();
}

DEV int colmap(int kind, int n) {
    if (kind == 0) return n;
    if (kind == 1) {
        const int c = n / 2560, nn = n - c * 2560;
        if (nn < 2304) { const int g = nn / 768, rem = nn - g * 768, part = rem >> 8, hh = (rem & 255) >> 6, d = rem & 63;
                         return g * 3072 + part * 1024 + (c * 4 + hh) * 64 + d; }
        const int z = nn - 2304; return 9216 + (c * 4 + (z >> 6)) * 64 + (z & 63);
    }
    if (n < 2560) return n;
    if (n < 3584) return n - 2560 + 2608;
    if (n < 3632) return n - 3584 + 2560;
    return -1;
}
DEV void tconv(const int tid_, float* lds, const float* __restrict__ src, int K, int Nsrc, u16* __restrict__ dst, int Ndst, int kind, int& acc_tiles) {
    const int G = gridDim.x, tid = tid_;
    const int ntn = Ndst >> 6, ntk = K >> 6, nt = ntn * ntk;
    int first = ((int)blockIdx.x - (acc_tiles % G) + G) % G;
    acc_tiles += nt;
    for (int t = first; t < nt; t += G) {
        const int tn = t / ntk, tk = t - tn * ntk;
        const int n0 = tn << 6, k0 = tk << 6;
        const int nl = tid & 63;
        const int c = colmap(kind, n0 + nl);
#pragma unroll
        for (int i = 0; i < 16; ++i) {
            const int kl = (tid >> 6) + 4 * i;
            const float v = (c >= 0) ? src[(size_t)(k0 + kl) * Nsrc + c] : 0.f;
            lds[kl * 65 + nl] = v;
        }
        __syncthreads();
        const int r = tid >> 2, kk = (tid & 3) << 4;
        unsigned o[8];
#pragma unroll
        for (int i = 0; i < 8; ++i) o[i] = pack2(lds[(kk + 2 * i) * 65 + r], lds[(kk + 2 * i + 1) * 65 + r]);
        u32x4* dp = (u32x4*)(dst + (size_t)(n0 + r) * K + k0 + kk);
        dp[0] = u32x4{o[0], o[1], o[2], o[3]};
        dp[1] = u32x4{o[4], o[5], o[6], o[7]};
        __syncthreads();
    }
}

DEV void phase0(const Prm& P, unsigned char* smem) {
    const int tid_ = opaque_tid();
    float* lds = (float*)smem;
    unsigned char* ws = P.ws;
    int acc = 0;
    tconv(tid_, lds, P.in[2], 1024, 10240, (u16*)(ws + OFF_WA_IN), 10240, 1, acc);
    tconv(tid_, lds, P.in[2] + (size_t)1024 * 10240, 1024, 10240, (u16*)(ws + OFF_WA_IN + SZ_WA_IN), 10240, 1, acc);
    tconv(tid_, lds, P.in[3], 1024, 1024, (u16*)(ws + OFF_WA_OUT), 1024, 0, acc);
    tconv(tid_, lds, P.in[3] + (size_t)1024 * 1024, 1024, 1024, (u16*)(ws + OFF_WA_OUT + SZ_SQ), 1024, 0, acc);
    tconv(tid_, lds, P.in[4], 1024, 2304, (u16*)(ws + OFF_WB_IN), 2304, 0, acc);
    tconv(tid_, lds, P.in[6], 1024, 1024, (u16*)(ws + OFF_WB_OUT), 1024, 0, acc);
    tconv(tid_, lds, P.in[7], 1024, 3632, (u16*)(ws + OFF_WC_IN), 3840, 2, acc);
    tconv(tid_, lds, P.in[11], 1024, 1024, (u16*)(ws + OFF_WC_OUT), 1024, 0, acc);
    for (int i = 0; i < 4; ++i) {
        tconv(tid_, lds, P.in[15] + (size_t)i * 1024 * 1024, 1024, 1024, (u16*)(ws + OFF_WG + i * SZ_SQ), 1024, 0, acc);
        tconv(tid_, lds, P.in[14] + (size_t)i * 256 * 1024, 256, 1024, (u16*)(ws + OFF_WP + i * SZ_WP), 1024, 0, acc);
    }
    tconv(tid_, lds, P.in[8], 2048, 64, (u16*)(ws + OFF_WCK), 64, 0, acc);
    tconv(tid_, lds, P.in[9], 2048, 64, (u16*)(ws + OFF_WCV), 64, 0, acc);

    const size_t gtid = (size_t)blockIdx.x * 256 + tid_, gsz = (size_t)gridDim.x * 256;
    {
        const float* x = P.in[0]; u16* xb = (u16*)(ws + OFF_XB);
        for (size_t i = gtid; i < (size_t)T * 1024 / 8; i += gsz) {
            const f32x4 a = *(const f32x4*)(x + i * 8), b = *(const f32x4*)(x + i * 8 + 4);
            *(u32x4*)(xb + i * 8) = u32x4{pack2(a[0], a[1]), pack2(a[2], a[3]), pack2(b[0], b[1]), pack2(b[2], b[3])};
        }
    }
    {
        float* ct = (float*)(ws + OFF_COS); float* st = (float*)(ws + OFF_SIN);
        for (size_t i = gtid; i < (size_t)8192 * 32; i += gsz) {
            const int pos = (int)(i >> 5), k = (int)(i & 31);
            const float inv = (float)(1.0 / pow(10000.0, (double)(2 * k) / 64.0));
            const float ang = (float)pos * inv;
            ct[i] = (float)cos((double)ang); st[i] = (float)sin((double)ang);
        }
    }
    {
        const int lane = tid_ & 63;
        const int wid = blockIdx.x * 4 + __builtin_amdgcn_readfirstlane(tid_ >> 6);
        if (wid < 128) {
            const float* w = (wid < 64) ? P.in[8] : P.in[9];
            const int e = wid & 63;
            float s = 0.f;
            for (int jd = lane; jd < 2048; jd += 64) s += P.in[10][jd] * w[(size_t)jd * 64 + e];
            s = wave_sum(s);
            if (lane == 0) ((float*)(ws + OFF_BIAS))[wid] = s;
        }
    }
}

constexpr int GSTAGE = 24576;
DEV int gsw(int r) { return (0x78 >> (2 * ((r >> 2) & 3))) & 3; }
DEV void gemm_issue(unsigned char* stage, const u16* ag, const u16* bg, int lda, int ldb, int k0, int w) {
#pragma unroll
    for (int i = 0; i < 2; ++i)
        __builtin_amdgcn_global_load_lds((const unsigned*)(ag + (size_t)i * 64 * lda + k0), (unsigned*)(stage + w * 1024 + i * 4096), 16, 0, 0);
#pragma unroll
    for (int i = 0; i < 4; ++i)
        __builtin_amdgcn_global_load_lds((const unsigned*)(bg + (size_t)i * 64 * ldb + k0), (unsigned*)(stage + 8192 + w * 1024 + i * 4096), 16, 0, 0);
}
template <bool NONSWAP>
DEV void gemm_mainloop(const int tid_, unsigned char* smem, const u16* __restrict__ A, int lda, const u16* __restrict__ Bt, int ldb, int K,
                       int m0, int n0, f32x4 (&acc)[32]) {
    const int tid = tid_, lane = tid & 63, w = __builtin_amdgcn_readfirstlane(tid >> 6), wm = w >> 1, wn = w & 1;
    const int lrow = tid >> 2, lsw = ((tid & 3) ^ gsw(lrow)) * 8;
    const u16* ag = A + (size_t)(m0 + lrow) * lda + lsw;
    const u16* bg = Bt + (size_t)(n0 + lrow) * ldb + lsw;
    const int fr = lane & 15, fq = lane >> 4;
    const int coff = (fq ^ gsw(fr)) << 4;
    const int a_base = (wm * 64 + fr) * 64 + coff, b_base = 8192 + (wn * 128 + fr) * 64 + coff;
    const int nk = K >> 5;
    asm volatile("s_waitcnt vmcnt(0)" ::: "memory");
    __builtin_amdgcn_s_barrier();
    gemm_issue(smem, ag, bg, lda, ldb, 0, w);
    gemm_issue(smem + GSTAGE, ag, bg, lda, ldb, 32, w);
    int sc = 0, si = 2;
    for (int kt = 0; kt < nk; ++kt) {
        if (kt + 1 < nk) asm volatile("s_waitcnt vmcnt(6)" ::: "memory"); else asm volatile("s_waitcnt vmcnt(0)" ::: "memory");
        __builtin_amdgcn_s_barrier();
        if (kt + 2 < nk) { gemm_issue(smem + si * GSTAGE, ag, bg, lda, ldb, (kt + 2) << 5, w); si = (si == 2) ? 0 : si + 1; }
        const unsigned char* st = smem + sc * GSTAGE; sc = (sc == 2) ? 0 : sc + 1;
        bf16x8 a[4], b[8];
#pragma unroll
        for (int i = 0; i < 4; ++i) a[i] = *(const bf16x8*)(st + a_base + i * 1024);
#pragma unroll
        for (int i = 0; i < 8; ++i) b[i] = *(const bf16x8*)(st + b_base + i * 1024);
        if (NONSWAP) {
#pragma unroll
            for (int mt = 0; mt < 4; ++mt)
#pragma unroll
                for (int nt = 0; nt < 8; ++nt) acc[mt * 8 + nt] = MFMA16(a[mt], b[nt], acc[mt * 8 + nt]);
        } else {
#pragma unroll
            for (int nt = 0; nt < 8; ++nt)
#pragma unroll
                for (int mt = 0; mt < 4; ++mt) acc[nt * 4 + mt] = MFMA16(b[nt], a[mt], acc[nt * 4 + mt]);
        }
    }
}

DEV int vblock() { const int G = gridDim.x, b = blockIdx.x; return ((G & 7) == 0) ? (b & 7) * (G >> 3) + (b >> 3) : b; }
DEV void tile_mn(int t, int nN, int& mi, int& ni) { const int per = 8 * nN; const int mg = t / per, r = t - mg * per; mi = mg * 8 + (r & 7); ni = r >> 3; }
#define ZERO_ACC(acc) _Pragma("unroll") for (int i_ = 0; i_ < 32; ++i_) acc[i_] = f32x4{0.f, 0.f, 0.f, 0.f}

DEV void classify(int kind, int cgi, int& mode, int& vsel, int& vth, int& dsh, int& nhv) {
    mode = 0; vsel = 0; vth = 0; dsh = 0; nhv = 4;
    if (kind == 0) {
        if (cgi < 36) { const int g = cgi / 12, part = (cgi - g * 12) >> 2; vth = cgi & 3; if (part < 2) mode = 1; else { mode = 2; vsel = g; dsh = 2 * g; } }
    } else if (kind == 1) {
        if (cgi < 18) mode = 1; else if (cgi < 20) { mode = 2; vsel = 0; vth = cgi - 18; nhv = 2; }
    } else {
        if (cgi < 20) mode = 1; else if (cgi < 24) mode = 0; else if (cgi < 28) mode = 1; else if (cgi < 32) { mode = 2; vsel = 0; vth = cgi - 28; }
        else if (cgi < 36) mode = 1; else if (cgi < 40) { mode = 2; vsel = 1; vth = cgi - 36; }
    }
}

DEV void gemm_in_phase(unsigned char* smem, const Prm& P, int kind, const u16* Wt, int N) {
    const int tid_ = opaque_tid();
    unsigned char* ws = P.ws;
    const u16* A = (const u16*)(ws + OFF_XB);
    u16* H = (u16*)(ws + OFF_H);
    const float* cosT = (const float*)(ws + OFF_COS); const float* sinT = (const float*)(ws + OFF_SIN);
    const int nN = N >> 8, ntiles = 128 * nN;
    const int lane = tid_ & 63, w = __builtin_amdgcn_readfirstlane(tid_ >> 6), wm = w >> 1, wn = w & 1, fr = lane & 15, fq = lane >> 4;
    for (int t = vblock(); t < ntiles; t += gridDim.x) {
        int mi, ni; tile_mn(t, nN, mi, ni);
        const int m0 = mi << 7, n0 = ni << 8;
        const int ncol = n0 + wn * 128, cg0 = ncol >> 6;
        int mode, vsel, vth, dsh, nhv; classify(kind, cg0, mode, vsel, vth, dsh, nhv);
        const int mw = m0 + wm * 64;
        f32x4 acc[32]; ZERO_ACC(acc);
        if (mode == 2) {
            gemm_mainloop<true>(tid_, smem, A, 1024, Wt, 1024, 1024, m0, n0, acc);
            u16* vt = (u16*)(ws + (vsel == 0 ? OFF_VT0 : (vsel == 1 ? OFF_VT1 : OFF_VT2)));
            const int dmask = (1 << dsh) - 1, lsh = 13 - dsh;
#pragma unroll
            for (int mt = 0; mt < 4; ++mt)
#pragma unroll
                for (int j = 0; j < 4; ++j) {
                    const int m = mw + mt * 16 + fq * 4 + j;
                    const int b = m >> 13, s = m & 8191;
                    const int p = ((s & dmask) << lsh) + (s >> dsh);
#pragma unroll
                    for (int grp = 0; grp < 2; ++grp) {
                        u16* dst = vt + ((((size_t)(b * nhv + vth + grp)) * 512 + (p >> 4)) * 64) * 16 + (p & 15);
#pragma unroll
                        for (int nt = 0; nt < 4; ++nt) dst[(nt * 16 + fr) * 16] = f2bf(acc[mt * 8 + grp * 4 + nt][j]);
                    }
                }
        } else {
            gemm_mainloop<false>(tid_, smem, A, 1024, Wt, 1024, 1024, m0, n0, acc);
#pragma unroll
            for (int mt = 0; mt < 4; ++mt) {
                const int m = mw + mt * 16 + fr;
                const int s = m & 8191;
                u16* hrow = H + (size_t)m * N + ncol + fq * 4;
                if (mode == 1) {
#pragma unroll
                    for (int nt = 0; nt < 2; ++nt) {
                        const f32x4 c4 = *(const f32x4*)(cosT + s * 32 + nt * 16 + fq * 4);
                        const f32x4 s4 = *(const f32x4*)(sinT + s * 32 + nt * 16 + fq * 4);
#pragma unroll
                        for (int grp = 0; grp < 2; ++grp) {
                            const f32x4 x1 = acc[(grp * 4 + nt) * 4 + mt], x2 = acc[(grp * 4 + nt + 2) * 4 + mt];
                            const f32x4 o1 = x1 * c4 - x2 * s4, o2 = x2 * c4 + x1 * s4;
                            *(u32x2*)(hrow + grp * 64 + nt * 16) = u32x2{pack2(o1[0], o1[1]), pack2(o1[2], o1[3])};
                            *(u32x2*)(hrow + grp * 64 + (nt + 2) * 16) = u32x2{pack2(o2[0], o2[1]), pack2(o2[2], o2[3])};
                        }
                    }
                } else {
#pragma unroll
                    for (int nt = 0; nt < 8; ++nt) { const f32x4 v = acc[nt * 4 + mt]; *(u32x2*)(hrow + nt * 16) = u32x2{pack2(v[0], v[1]), pack2(v[2], v[3])}; }
                }
            }
        }
    }
}

DEV void gemm_out_phase(unsigned char* smem, const Prm& P, const u16* Wt, const float* xin) {
    const int tid_ = opaque_tid();
    const u16* A = (const u16*)(P.ws + OFF_G);
    const int lane = tid_ & 63, w = __builtin_amdgcn_readfirstlane(tid_ >> 6), wm = w >> 1, wn = w & 1, fr = lane & 15, fq = lane >> 4;
    for (int t = vblock(); t < 512; t += gridDim.x) {
        int mi, ni; tile_mn(t, 4, mi, ni);
        const int m0 = mi << 7, n0 = ni << 8;
        f32x4 acc[32]; ZERO_ACC(acc);
        gemm_mainloop<false>(tid_, smem, A, 1024, Wt, 1024, 1024, m0, n0, acc);
        {
            const size_t ub = (size_t)(m0 + wm * 64) * 1024 + n0 + wn * 128;
            const float* xw = xin + ub; float* ow = P.out + ub;
            int l2_ = lane; asm volatile("" : "+v"(l2_));
            const unsigned lo = (unsigned)((l2_ & 15) * 1024 + (l2_ >> 4) * 4);
#pragma unroll
            for (int mt = 0; mt < 4; ++mt) {
#pragma unroll
                for (int nt = 0; nt < 8; ++nt) {
                    const unsigned ix = lo + mt * 16384 + nt * 16;
                    const f32x4 xv = *(const f32x4*)(xw + ix);
                    *(f32x4*)(ow + ix) = xv * DN_ALPHA + acc[nt * 4 + mt];
                }
                __builtin_amdgcn_sched_barrier(0);
            }
        }
    }
}

DEV void gemm_gate_phase(unsigned char* smem, const Prm& P, const u16* Wg, const u16* Wp) {
    const int tid_ = opaque_tid();
    const u16* A1 = (const u16*)(P.ws + OFF_XLB);
    const u16* A2 = (const u16*)(P.ws + OFF_PB);
    u16* xb = (u16*)(P.ws + OFF_XB);
    u16* ppb = (u16*)(P.ws + OFF_PP);
    const int lane = tid_ & 63, w = __builtin_amdgcn_readfirstlane(tid_ >> 6), wm = w >> 1, wn = w & 1, fr = lane & 15, fq = lane >> 4;
    for (int t = vblock(); t < 512; t += gridDim.x) {
        int mi, ni; tile_mn(t, 4, mi, ni);
        const int m0 = mi << 7, n0 = ni << 8;
        f32x4 acc[32]; ZERO_ACC(acc);
        gemm_mainloop<false>(tid_, smem, A2, 256, Wp, 256, 256, m0, n0, acc);
        const size_t ub = (size_t)(m0 + wm * 64) * 1024 + n0 + wn * 128;
        float* ow = P.out + ub; u16* pw = ppb + ub; u16* xw = xb + ub;
        {
            int l2_ = lane; asm volatile("" : "+v"(l2_));
            const unsigned lo = (unsigned)((l2_ & 15) * 1024 + (l2_ >> 4) * 4);
#pragma unroll
            for (int mt = 0; mt < 4; ++mt) {
#pragma unroll
                for (int nt = 0; nt < 8; ++nt) { const f32x4 v = acc[nt * 4 + mt]; *(u32x2*)(pw + (lo + mt * 16384 + nt * 16)) = u32x2{pack2(v[0], v[1]), pack2(v[2], v[3])}; }
                __builtin_amdgcn_sched_barrier(0);
            }
        }
        ZERO_ACC(acc);
        gemm_mainloop<false>(tid_, smem, A1, 1024, Wg, 1024, 1024, m0, n0, acc);
        int l3_ = lane; asm volatile("" : "+v"(l3_));
        const unsigned lo = (unsigned)((l3_ & 15) * 1024 + (l3_ >> 4) * 4);
#pragma unroll
        for (int mt = 0; mt < 4; ++mt) {
#pragma unroll
            for (int nt = 0; nt < 8; ++nt) {
                const unsigned ix = lo + mt * 16384 + nt * 16;
                const f32x4 xv = *(const f32x4*)(ow + ix);
                const u32x2 pq = *(const u32x2*)(pw + ix);
                const f32x4 ga = acc[nt * 4 + mt];
                f32x4 r;
                r[0] = xv[0] + sigmoidf_(ga[0]) * bflo(pq[0]); r[1] = xv[1] + sigmoidf_(ga[1]) * bfhi(pq[0]);
                r[2] = xv[2] + sigmoidf_(ga[2]) * bflo(pq[1]); r[3] = xv[3] + sigmoidf_(ga[3]) * bfhi(pq[1]);
                *(f32x4*)(ow + ix) = r;
                *(u32x2*)(xw + ix) = u32x2{pack2(r[0], r[1]), pack2(r[2], r[3])};
            }
            __builtin_amdgcn_sched_barrier(0);
        }
    }
}

DEV void ln_phase(const Prm& P, int layer) {
    const int tid_ = opaque_tid();
    const int lane = tid_ & 63, w = __builtin_amdgcn_readfirstlane(tid_ >> 6);
    const float* g = P.in[12] + layer * 1024; const float* bb = P.in[13] + layer * 1024;
    u16* xlb = (u16*)(P.ws + OFF_XLB);
    for (int row = blockIdx.x * 4 + w; row < T; row += gridDim.x * 4) {
        float* xr = P.out + (size_t)row * 1024;
        f32x4 v[4];
        float s = 0.f;
#pragma unroll
        for (int i = 0; i < 4; ++i) { v[i] = *(const f32x4*)(xr + i * 256 + lane * 4); s += v[i][0] + v[i][1] + v[i][2] + v[i][3]; }
        const float mean = wave_sum(s) * (1.f / 1024.f);
        float q = 0.f;
#pragma unroll
        for (int i = 0; i < 4; ++i)
#pragma unroll
            for (int j = 0; j < 4; ++j) { const float d = v[i][j] - mean; q += d * d; }
        const float rstd = rsqrtf(wave_sum(q) * (1.f / 1024.f) + LN_EPS);
#pragma unroll
        for (int i = 0; i < 4; ++i) {
            const f32x4 gg = *(const f32x4*)(g + i * 256 + lane * 4), bv = *(const f32x4*)(bb + i * 256 + lane * 4);
            f32x4 y;
#pragma unroll
            for (int j = 0; j < 4; ++j) y[j] = (v[i][j] - mean) * rstd * gg[j] + bv[j];
            *(f32x4*)(xr + i * 256 + lane * 4) = y;
            *(u32x2*)(xlb + (size_t)row * 1024 + i * 256 + lane * 4) = u32x2{pack2(y[0], y[1]), pack2(y[2], y[3])};
        }
    }
    const float* p = P.in[1] + (size_t)layer * T * 256; u16* pb = (u16*)(P.ws + OFF_PB);
    const size_t gtid = (size_t)blockIdx.x * 256 + tid_, gsz = (size_t)gridDim.x * 256;
    for (size_t i = gtid; i < (size_t)T * 256 / 8; i += gsz) {
        const f32x4 a = *(const f32x4*)(p + i * 8), b = *(const f32x4*)(p + i * 8 + 4);
        *(u32x4*)(pb + i * 8) = u32x4{pack2(a[0], a[1]), pack2(a[2], a[3]), pack2(b[0], b[1]), pack2(b[2], b[3])};
    }
}

struct KV { bf16x8 ka0, ka1, kb0, kb1; bf16x8 v0, v1, v2, v3; };
DEV void load_kv(KV& t, const char* Kb, unsigned koa, unsigned kob, const char* Vb, unsigned voa, unsigned vob) {
    t.ka0 = *(const bf16x8*)(Kb + koa); t.ka1 = *(const bf16x8*)(Kb + koa + 64);
    t.kb0 = *(const bf16x8*)(Kb + kob); t.kb1 = *(const bf16x8*)(Kb + kob + 64);
    t.v0 = __builtin_shufflevector(*(const s16x4*)(Vb + voa), *(const s16x4*)(Vb + vob), 0, 1, 2, 3, 4, 5, 6, 7);
    t.v1 = __builtin_shufflevector(*(const s16x4*)(Vb + voa + 512), *(const s16x4*)(Vb + vob + 512), 0, 1, 2, 3, 4, 5, 6, 7);
    t.v2 = __builtin_shufflevector(*(const s16x4*)(Vb + voa + 1024), *(const s16x4*)(Vb + vob + 1024), 0, 1, 2, 3, 4, 5, 6, 7);
    t.v3 = __builtin_shufflevector(*(const s16x4*)(Vb + voa + 1536), *(const s16x4*)(Vb + vob + 1536), 0, 1, 2, 3, 4, 5, 6, 7);
}
DEV unsigned pkrtz(float a, float b) { return __builtin_bit_cast(unsigned, __builtin_amdgcn_cvt_pkrtz(a, b)); }
DEV bf16x8 pack8(const float (&p)[8]) {
    return __builtin_bit_cast(bf16x8, u32x4{pkrtz(p[0], p[1]), pkrtz(p[2], p[3]), pkrtz(p[4], p[5]), pkrtz(p[6], p[7])});
}
DEV void qk_scores(const KV& t, const bf16x8& q0, const bf16x8& q1, f32x4& sa, f32x4& sb) {
    sa = f32x4{0.f, 0.f, 0.f, 0.f}; sb = f32x4{0.f, 0.f, 0.f, 0.f};
    sa = MFMA16(t.ka0, q0, sa); sa = MFMA16(t.ka1, q1, sa);
    sb = MFMA16(t.kb0, q0, sb); sb = MFMA16(t.kb1, q1, sb);
}
constexpr float QK_C = 0.125f * 1.4426950408889634f;
DEV void flash_core(float& mref, float& l, f32x4 (&o)[4], const bf16x8& q0, const bf16x8& q1, const KV& t, bool fast, int d0, unsigned lim) {
    f32x4 sa, sb; qk_scores(t, q0, q1, sa, sb);
    float y[8];
    if (fast) {
#pragma unroll
        for (int j = 0; j < 4; ++j) { y[j] = sa[j] * QK_C; y[4 + j] = sb[j] * QK_C; }
    } else {
#pragma unroll
        for (int j = 0; j < 4; ++j) {
            y[j]     = ((unsigned)(d0 - j) <= lim)      ? sa[j] * QK_C : NEG_INF;
            y[4 + j] = ((unsigned)(d0 - 16 - j) <= lim) ? sb[j] * QK_C : NEG_INF;
        }
    }
    float mx = fmaxf(fmaxf(fmaxf(y[0], y[1]), fmaxf(y[2], y[3])), fmaxf(fmaxf(y[4], y[5]), fmaxf(y[6], y[7])));
    if (__ballot(mx > mref + 8.f) != 0ull) {
        mx = red16_max(mx);
        const float mn = fmaxf(mref, mx);
        const float alpha = (mn == NEG_INF) ? 1.f : __builtin_amdgcn_exp2f(mref - mn);
        l *= alpha;
#pragma unroll
        for (int d = 0; d < 4; ++d) o[d] *= alpha;
        mref = mn;
    }
    const float mu = (mref == NEG_INF) ? 0.f : mref;
    float p[8]; float ps = 0.f;
#pragma unroll
    for (int j = 0; j < 8; ++j) { p[j] = __builtin_amdgcn_exp2f(y[j] - mu); ps += p[j]; }
    l += ps;
    const bf16x8 pf = pack8(p);
    o[0] = MFMA16(t.v0, pf, o[0]); o[1] = MFMA16(t.v1, pf, o[1]); o[2] = MFMA16(t.v2, pf, o[2]); o[3] = MFMA16(t.v3, pf, o[3]);
}

#define RING4(NSTEPS, LOADSTEP, COMPUTE) do { \
    KV r0_, r1_, r2_; const int nl_ = (NSTEPS) - 1; \
    LOADSTEP(r0_, 0); LOADSTEP(r1_, min(1, nl_)); \
    for (int st_ = 0; st_ < (NSTEPS); st_ += 3) { \
        LOADSTEP(r2_, min(st_ + 2, nl_)); COMPUTE(r0_, st_); \
        LOADSTEP(r0_, min(st_ + 3, nl_)); if (st_ + 1 < (NSTEPS)) COMPUTE(r1_, st_ + 1); \
        LOADSTEP(r1_, min(st_ + 4, nl_)); if (st_ + 2 < (NSTEPS)) COMPUTE(r2_, st_ + 2); \
    } } while (0)

DEV void band_loop(const int tid_, float& m, float& l, f32x4 (&o)[4], const bf16x8& q0, const bf16x8& q1, const char* Kb, int row_bytes, int dsh, int rg,
                   const char* Vb, int vblk0, int ustart, int nsteps, int uq, int uq0, int qspan, int maxd) {
    const int c = tid_ & 15, g4 = (tid_ & 63) >> 4;
    const unsigned kl = g4 * 16, vl = c * 32 + g4 * 8;
    const unsigned lim = (unsigned)min(maxd, uq);
#define BL_LOAD(R, S) do { const int ua_ = ustart + (S) * 32, ub_ = ua_ + 16; \
        load_kv(R, Kb, (unsigned)((max(ua_ + c, 0) << dsh) + rg) * (unsigned)row_bytes + kl, (unsigned)((max(ub_ + c, 0) << dsh) + rg) * (unsigned)row_bytes + kl, \
                Vb, (unsigned)(vblk0 + (max(ua_, 0) >> 4)) * 2048u + vl, (unsigned)(vblk0 + (max(ub_, 0) >> 4)) * 2048u + vl); } while (0)
#define BL_COMP(R, S) do { const int ua_ = ustart + (S) * 32; \
        const bool fast_ = (ua_ >= 0) && (ua_ + 31 <= uq0) && (uq0 + qspan - ua_ <= maxd); \
        flash_core(m, l, o, q0, q1, R, fast_, uq - ua_ - g4 * 4, lim); } while (0)
    RING4(nsteps, BL_LOAD, BL_COMP);
#undef BL_LOAD
#undef BL_COMP
}

DEV void attnA_phase(const Prm& P, int chunk) {
    const int tid_ = opaque_tid();
    unsigned char* ws = P.ws;
    const u16* H = (const u16*)(ws + OFF_H);
    u16* G = (u16*)(ws + OFF_G);
    const int lane = tid_ & 63, w = __builtin_amdgcn_readfirstlane(tid_ >> 6), c = lane & 15, g4 = lane >> 4;
    constexpr int LD = 2560;
    const int xcd_ = blockIdx.x & 7, slot_ = blockIdx.x >> 3, nslot_ = gridDim.x >> 3;
    for (int i_ = slot_; i_ < 128; i_ += nslot_) {
        const int rq = i_ & 3, tbi = i_ >> 2, hh = xcd_ & 3, b = xcd_ >> 2;
        const int r = rq * 4 + w, tb = tbi * 256;
        const int sq = tb + r + 16 * c;
        const size_t rowq = (size_t)b * 8192 + sq;
        float m = NEG_INF, l = 0.f;
        f32x4 o[4];
#pragma unroll
        for (int d = 0; d < 4; ++d) o[d] = f32x4{0.f, 0.f, 0.f, 0.f};
#pragma unroll 1
        for (int g = 0; g < 3; ++g) {
            const int dsh = 2 * g, dmask = (1 << dsh) - 1;
            const int rg = r & dmask;
            const int uq = sq >> dsh, uq0 = (tb + r) >> dsh;
            int ustart = (uq0 - 128) & ~15;
            const int ulast = (uq0 + (15 << (4 - dsh))) & ~15;
            int ntile = ((ulast - ustart) >> 4) + 1;
            if (ntile & 1) { ustart -= 16; ntile += 1; }
            const u16* Hq = H + rowq * LD + g * 768 + hh * 64 + g4 * 8;
            const bf16x8 q0 = *(const bf16x8*)Hq, q1 = *(const bf16x8*)(Hq + 32);
            const char* Kb = (const char*)(H + (size_t)b * 8192 * LD + g * 768 + 256 + hh * 64);
            const char* Vb = (const char*)((const u16*)(ws + (g == 0 ? OFF_VT0 : (g == 1 ? OFF_VT1 : OFF_VT2))) + ((size_t)(b * 4 + hh) * 512) * 1024);
            const int vblk0 = rg * ((8192 >> dsh) >> 4);
            band_loop(tid_, m, l, o, q0, q1, Kb, LD * 2, dsh, rg, Vb, vblk0, ustart, ntile >> 1, uq, uq0, 15 << (4 - dsh), 128);
        }
        l = red16_sum(l);
        const float inv = 1.f / l;
#pragma unroll
        for (int dt = 0; dt < 4; ++dt) {
            const int dh = dt * 16 + g4 * 4;
            const u32x2 z = *(const u32x2*)(H + rowq * LD + 2304 + hh * 64 + dh);
            const float r0 = o[dt][0] * inv * siluf_(bflo(z[0])), r1 = o[dt][1] * inv * siluf_(bfhi(z[0]));
            const float r2 = o[dt][2] * inv * siluf_(bflo(z[1])), r3 = o[dt][3] * inv * siluf_(bfhi(z[1]));
            *(u32x2*)(G + rowq * 1024 + (chunk * 4 + hh) * 64 + dh) = u32x2{pack2(r0, r1), pack2(r2, r3)};
        }
    }
}

DEV void attnB_phase(const Prm& P) {
    const int tid_ = opaque_tid();
    unsigned char* ws = P.ws;
    const u16* H = (const u16*)(ws + OFF_H);
    u16* G = (u16*)(ws + OFF_G);
    const float* sinks = P.in[5];
    const int lane = tid_ & 63, w = __builtin_amdgcn_readfirstlane(tid_ >> 6), c = lane & 15, g4 = lane >> 4;
    constexpr int LD = 2304;
    const int xcd_ = blockIdx.x & 7, slot_ = blockIdx.x >> 3, nslot_ = gridDim.x >> 3;
    for (int tile = slot_; tile < 512; tile += nslot_) {
        const int b = xcd_ >> 2, hq = xcd_ & 3;
        const int head = hq * 4 + w, kvh = head >> 3;
        const int t0 = tile * 16, sq = t0 + c;
        const size_t rowq = (size_t)b * 8192 + sq;
        float m = NEG_INF, l = 0.f;
        f32x4 o[4];
#pragma unroll
        for (int d = 0; d < 4; ++d) o[d] = f32x4{0.f, 0.f, 0.f, 0.f};
        const u16* Hq = H + rowq * LD + head * 64 + g4 * 8;
        const bf16x8 q0 = *(const bf16x8*)Hq, q1 = *(const bf16x8*)(Hq + 32);
        const char* Kb = (const char*)(H + (size_t)b * 8192 * LD + 1024 + kvh * 64);
        const char* Vb = (const char*)((const u16*)(ws + OFF_VT0) + ((size_t)(b * 2 + kvh) * 512) * 1024);
        band_loop(tid_, m, l, o, q0, q1, Kb, LD * 2, 0, 0, Vb, 0, t0 - 144, 5, sq, t0, 15, 127);
        l = red16_sum(l);
        const float mu = (m == NEG_INF) ? 0.f : m;
        const float lf = l + __builtin_amdgcn_exp2f(sinks[head] * 1.4426950408889634f - mu);
        const float inv = 1.f / lf;
#pragma unroll
        for (int dt = 0; dt < 4; ++dt) {
            const int dh = dt * 16 + g4 * 4;
            const u32x2 z = *(const u32x2*)(H + rowq * LD + 1280 + head * 64 + dh);
            const float r0 = o[dt][0] * inv * siluf_(bflo(z[0])), r1 = o[dt][1] * inv * siluf_(bfhi(z[0]));
            const float r2 = o[dt][2] * inv * siluf_(bflo(z[1])), r3 = o[dt][3] * inv * siluf_(bfhi(z[1]));
            *(u32x2*)(G + rowq * 1024 + head * 64 + dh) = u32x2{pack2(r0, r1), pack2(r2, r3)};
        }
    }
}

DEV void compress_phase(const Prm& P) {
    const int tid_ = opaque_tid();
    unsigned char* ws = P.ws;
    const u16* H = (const u16*)(ws + OFF_H);
    constexpr int LD = 3840;
    const float* bias = (const float*)(ws + OFF_BIAS);
    const int lane = tid_ & 63, w = __builtin_amdgcn_readfirstlane(tid_ >> 6), c = lane & 15, g4 = lane >> 4;
    for (int it = blockIdx.x; it < 128; it += gridDim.x) {
        const int unit = it * 4 + w;
        const int which = unit >> 8, b = (unit >> 7) & 1, kvh = (unit >> 5) & 3, ntile = unit & 31;
        const u16* Wt = (const u16*)(ws + (which ? OFF_WCV : OFF_WCK));
        const int colbase = (which ? 1280 : 1024) + kvh * 64;
        const int n = ntile * 16 + c;
        const u16* Wl = Wt + (size_t)c * 2048 + g4 * 8;
        f32x4 acc[4];
#pragma unroll
        for (int e = 0; e < 4; ++e) acc[e] = f32x4{0.f, 0.f, 0.f, 0.f};
#pragma unroll 4
        for (int kk = 0; kk < 64; ++kk) {
            const int j = kk >> 1, d0 = (kk & 1) * 32 + g4 * 8;
            int s = 16 * n + j; s = min(s, 8191);
            const bf16x8 xf = *(const bf16x8*)(H + ((size_t)b * 8192 + s) * LD + colbase + d0);
            bf16x8 wf[4];
#pragma unroll
            for (int e = 0; e < 4; ++e) wf[e] = *(const bf16x8*)(Wl + (size_t)e * 16 * 2048 + kk * 32);
            if (which == 0) {
#pragma unroll
                for (int e = 0; e < 4; ++e) acc[e] = MFMA16(wf[e], xf, acc[e]);
            } else {
#pragma unroll
                for (int e = 0; e < 4; ++e) acc[e] = MFMA16(xf, wf[e], acc[e]);
            }
        }
        if (which == 0) {
            u16* kc = (u16*)(ws + OFF_KCMP) + ((size_t)(b * 512 + n) * 4 + kvh) * 64;
#pragma unroll
            for (int e = 0; e < 4; ++e) {
                const int e0 = e * 16 + g4 * 4;
                const f32x4 bv = *(const f32x4*)(bias + e0);
                const f32x4 r = acc[e] + bv;
                *(u32x2*)(kc + e0) = u32x2{pack2(r[0], r[1]), pack2(r[2], r[3])};
            }
        } else {
            u16* vc = (u16*)(ws + OFF_VCMP) + (((size_t)(b * 4 + kvh) * 32 + ntile) * 64) * 16;
#pragma unroll
            for (int e = 0; e < 4; ++e) {
                const int ee = e * 16 + c;
                const float bv = bias[64 + ee];
                *(u32x2*)(vc + ee * 16 + g4 * 4) = u32x2{pack2(acc[e][0] + bv, acc[e][1] + bv), pack2(acc[e][2] + bv, acc[e][3] + bv)};
            }
        }
    }
}

DEV void attnC_phase(const Prm& P, unsigned char* smem) {
    const int tid_ = opaque_tid();
    unsigned char* ws = P.ws;
    const u16* H = (const u16*)(ws + OFF_H);
    u16* G = (u16*)(ws + OFF_G);
    constexpr int LD = 3840;
    float* imp = (float*)smem;
    float* scb = (float*)(smem + 32768);
    float* oslc = (float*)(smem + 34816);
    const int tid = tid_, lane = tid & 63, w = __builtin_amdgcn_readfirstlane(tid >> 6), c = lane & 15, g4 = lane >> 4;
    const int xcd_ = blockIdx.x & 7, slot_ = blockIdx.x >> 3, nslot_ = gridDim.x >> 3;
    for (int tile = slot_; tile < 512; tile += nslot_) {
        const int b = xcd_ >> 2, kvh = xcd_ & 3;
        const int t0 = tile * 16;
        for (int i = tid; i < 8192; i += 256) imp[i] = 0.f;
        __syncthreads();
        const int head = kvh * 4 + w;
        const size_t rowq = (size_t)b * 8192 + t0 + c;
        const u16* Hq = H + rowq * LD + head * 64 + g4 * 8;
        const bf16x8 q0 = *(const bf16x8*)Hq, q1 = *(const bf16x8*)(Hq + 32);
        f32x4 oacc[4];
#pragma unroll
        for (int d = 0; d < 4; ++d) oacc[d] = f32x4{0.f, 0.f, 0.f, 0.f};
        const int nmax = (t0 + c - 31) >> 4;
        const int nmaxw = (t0 - 16) >> 4;
        const float g0 = sigmoidf_(bf2f(H[rowq * LD + 3584 + head]));
        const float g1 = sigmoidf_(bf2f(H[rowq * LD + 3584 + 16 + head]));
        const float g2 = sigmoidf_(bf2f(H[rowq * LD + 3584 + 32 + head]));
        if (nmaxw >= 0) {
            const int nsteps = (nmaxw >> 5) + 1;
            const char* Kb = (const char*)((const u16*)(ws + OFF_KCMP) + (size_t)b * 512 * 256 + kvh * 64);
            const char* Vb = (const char*)((const u16*)(ws + OFF_VCMP) + ((size_t)(b * 4 + kvh) * 32) * 1024);
            const unsigned kl = g4 * 16, vl = c * 32 + g4 * 8;
            float m = NEG_INF, l = 0.f;
#define CM_LOAD(R, S) do { const int na_ = (S) * 32; load_kv(R, Kb, (unsigned)(na_ + c) * 512u + kl, (unsigned)min(na_ + 16 + c, 511) * 512u + kl, \
        Vb, (unsigned)(na_ >> 4) * 2048u + vl, (unsigned)min((na_ >> 4) + 1, 31) * 2048u + vl); } while (0)
#define CM_PASS1(R, S) do { const int na_ = (S) * 32; f32x4 sa, sb; qk_scores(R, q0, q1, sa, sb); float mx = NEG_INF; float x[8]; \
        _Pragma("unroll") for (int j = 0; j < 8; ++j) { const int n = na_ + (j >> 2) * 16 + g4 * 4 + (j & 3); \
            x[j] = (n <= nmax) ? ((j < 4) ? sa[j & 3] : sb[j & 3]) * 0.125f : NEG_INF; mx = fmaxf(mx, x[j]); } \
        const float mn = fmaxf(m, mx); const float mu = (mn == NEG_INF) ? 0.f : mn; float ps = 0.f; \
        _Pragma("unroll") for (int j = 0; j < 8; ++j) ps += __expf(x[j] - mu); \
        l = l * __expf(m - mu) + ps; m = mn; } while (0)
            RING4(nsteps, CM_LOAD, CM_PASS1);
            float mall = red16_max(m);
            mall = (mall == NEG_INF) ? 0.f : mall;
            l = l * __expf(m - mall);
            l = red16_sum(l);
            const float invl = (l > 0.f) ? 1.f / l : 0.f;
#define CM_PASS2(R, S) do { const int na_ = (S) * 32; f32x4 sa, sb; qk_scores(R, q0, q1, sa, sb); float p[8]; \
        _Pragma("unroll") for (int j = 0; j < 8; ++j) { const int n = na_ + (j >> 2) * 16 + g4 * 4 + (j & 3); \
            const float sv = ((j < 4) ? sa[j & 3] : sb[j & 3]) * 0.125f; \
            p[j] = (n <= nmax) ? __expf(sv - mall) * invl : 0.f; \
            if (n <= nmax) atomicAdd(&imp[n * 16 + c], p[j]); } \
        const bf16x8 pf = pack8(p); \
        oacc[0] = MFMA16(R.v0, pf, oacc[0]); oacc[1] = MFMA16(R.v1, pf, oacc[1]); \
        oacc[2] = MFMA16(R.v2, pf, oacc[2]); oacc[3] = MFMA16(R.v3, pf, oacc[3]); } while (0)
            RING4(nsteps, CM_LOAD, CM_PASS2);
#undef CM_LOAD
#undef CM_PASS1
#undef CM_PASS2
#pragma unroll
            for (int d = 0; d < 4; ++d) oacc[d] *= g0;
        }
        {
            float m = NEG_INF, l = 0.f;
            f32x4 o[4];
#pragma unroll
            for (int d = 0; d < 4; ++d) o[d] = f32x4{0.f, 0.f, 0.f, 0.f};
            const char* Kb = (const char*)(H + (size_t)b * 8192 * LD + 2048 + kvh * 64);
            const char* Vb = (const char*)((const u16*)(ws + OFF_VT1) + ((size_t)(b * 4 + kvh) * 512) * 1024);
            band_loop(tid_, m, l, o, q0, q1, Kb, LD * 2, 0, 0, Vb, 0, t0 - 528, 17, t0 + c, t0, 15, 511);
            l = red16_sum(l);
            const float sc = g2 / l;
#pragma unroll
            for (int d = 0; d < 4; ++d) oacc[d] += o[d] * sc;
        }
        __syncthreads();
        unsigned long long* msk = (unsigned long long*)(smem + 51200) + w * 8;
#pragma unroll 1
        for (int i = 0; i < 4; ++i) {
            const int tok = 4 * w + i, tq = t0 + tok, cur = tq >> 6;
            float my0, my1;
            {
                const int j0 = lane, j1 = lane + 64;
                float a0 = 2.f * (imp[(4 * j0) * 16 + tok] + imp[(4 * j0 + 1) * 16 + tok] + imp[(4 * j0 + 2) * 16 + tok]) + imp[(4 * j0 + 3) * 16 + tok];
                if (j0 > 0) a0 += imp[(4 * j0 - 1) * 16 + tok];
                const float a1 = 2.f * (imp[(4 * j1) * 16 + tok] + imp[(4 * j1 + 1) * 16 + tok] + imp[(4 * j1 + 2) * 16 + tok]) + imp[(4 * j1 + 3) * 16 + tok]
                                 + imp[(4 * j1 - 1) * 16 + tok];
                const bool f0 = (j0 == 0) || (j0 == cur) || (j0 == cur - 1);
                const bool f1 = (j1 == cur) || (j1 == cur - 1);
                my0 = f0 ? 1e4f : ((j0 <= cur) ? a0 : -1.f);
                my1 = f1 ? 1e4f : ((j1 <= cur) ? a1 : -1.f);
            }
            __builtin_amdgcn_fence(__ATOMIC_RELEASE, "wavefront"); __builtin_amdgcn_wave_barrier(); __builtin_amdgcn_fence(__ATOMIC_ACQUIRE, "wavefront");
            scb[w * 128 + lane] = my0; scb[w * 128 + 64 + lane] = my1;
            __builtin_amdgcn_fence(__ATOMIC_RELEASE, "wavefront"); __builtin_amdgcn_wave_barrier(); __builtin_amdgcn_fence(__ATOMIC_ACQUIRE, "wavefront");
            int c0 = 0, c1 = 0;
#pragma unroll 8
            for (int jj = 0; jj < 128; ++jj) {
                const float sv = scb[w * 128 + jj];
                c0 += (sv > my0 || (sv == my0 && jj < lane)) ? 1 : 0;
                c1 += (sv > my1 || (sv == my1 && jj < lane + 64)) ? 1 : 0;
            }
            const unsigned long long lo = __ballot((c0 < 16) && (lane <= cur));
            const unsigned long long hi = __ballot((c1 < 16) && (lane + 64 <= cur));
            if (lane == 0) { msk[i * 2] = lo; msk[i * 2 + 1] = hi; }
        }
        __builtin_amdgcn_fence(__ATOMIC_RELEASE, "wavefront"); __builtin_amdgcn_wave_barrier(); __builtin_amdgcn_fence(__ATOMIC_ACQUIRE, "wavefront");
        {
            const int tokL = 4 * w + (c >> 2), tq = t0 + tokL, hd = kvh * 4 + (c & 3);
            const size_t rq = (size_t)b * 8192 + tq;
            const u16* Hs = H + rq * LD + hd * 64 + g4 * 8;
            const bf16x8 s0 = *(const bf16x8*)Hs, s1 = *(const bf16x8*)(Hs + 32);
            const char* Kb = (const char*)(H + (size_t)b * 8192 * LD + 1536 + kvh * 64);
            const char* Vb = (const char*)((const u16*)(ws + OFF_VT0) + ((size_t)(b * 4 + kvh) * 512) * 1024);
            const unsigned kl = g4 * 16, vl = c * 32 + g4 * 8;
            float m = NEG_INF, l = 0.f;
            f32x4 o[4];
#pragma unroll
            for (int d = 0; d < 4; ++d) o[d] = f32x4{0.f, 0.f, 0.f, 0.f};
            const int ti = c >> 2;
            const unsigned long long mylo = msk[ti * 2], myhi = msk[ti * 2 + 1];
            const unsigned long long ulo = msk[0] | msk[2] | msk[4] | msk[6];
            const unsigned long long uhi = msk[1] | msk[3] | msk[5] | msk[7];
            const unsigned long long alo = msk[0] & msk[2] & msk[4] & msk[6], ahi = msk[1] & msk[3] & msk[5] & msk[7];
            int* blist = (int*)(scb + w * 128);
            const int nlo = __builtin_popcountll(ulo), nblk = nlo + __builtin_popcountll(uhi);
            if ((ulo >> lane) & 1ull) blist[__builtin_popcountll(ulo & ((1ull << lane) - 1ull))] = lane;
            if ((uhi >> lane) & 1ull) blist[nlo + __builtin_popcountll(uhi & ((1ull << lane) - 1ull))] = 64 + lane;
            __builtin_amdgcn_fence(__ATOMIC_RELEASE, "wavefront");
            __builtin_amdgcn_wave_barrier();
            __builtin_amdgcn_fence(__ATOMIC_ACQUIRE, "wavefront");
            const int nst = 2 * nblk;
#define SL_LOAD(R, S) do { const int j_ = __builtin_amdgcn_readfirstlane(blist[(S) >> 1]); const int ua_ = j_ * 64 + ((S) & 1) * 32; \
        load_kv(R, Kb, (unsigned)(ua_ + c) * (unsigned)(LD * 2) + kl, (unsigned)(ua_ + 16 + c) * (unsigned)(LD * 2) + kl, \
                Vb, (unsigned)(ua_ >> 4) * 2048u + vl, (unsigned)((ua_ >> 4) + 1) * 2048u + vl); } while (0)
#define SL_COMP(R, S) do { const int j_ = __builtin_amdgcn_readfirstlane(blist[(S) >> 1]); const int ua_ = j_ * 64 + ((S) & 1) * 32; \
        const bool selj = (j_ < 64) ? ((mylo >> j_) & 1ull) : ((myhi >> (j_ - 64)) & 1ull); \
        const bool alls_ = (j_ < 64) ? ((alo >> j_) & 1ull) : ((ahi >> (j_ - 64)) & 1ull); \
        const bool fast_ = alls_ && (ua_ + 31 <= t0 + 4 * w); \
        flash_core(m, l, o, s0, s1, R, fast_, selj ? (tq - ua_ - g4 * 4) : -(1 << 30), 0x7fffffffu); } while (0)
            RING4(nst, SL_LOAD, SL_COMP);
#undef SL_LOAD
#undef SL_COMP
            l = red16_sum(l);
            const float inv = 1.f / l;
#pragma unroll
            for (int dt = 0; dt < 4; ++dt)
                *(f32x4*)(oslc + (tokL * 4 + (c & 3)) * 64 + dt * 16 + g4 * 4) = o[dt] * inv;
        }
        __syncthreads();
#pragma unroll
        for (int dt = 0; dt < 4; ++dt) {
            const int dh = dt * 16 + g4 * 4;
            const f32x4 os = *(const f32x4*)(oslc + (c * 4 + w) * 64 + dh);
            const f32x4 r = oacc[dt] + os * g1;
            const u32x2 z = *(const u32x2*)(H + rowq * LD + 2560 + head * 64 + dh);
            const float r0 = r[0] * siluf_(bflo(z[0])), r1 = r[1] * siluf_(bfhi(z[0]));
            const float r2 = r[2] * siluf_(bflo(z[1])), r3 = r[3] * siluf_(bfhi(z[1]));
            *(u32x2*)(G + rowq * 1024 + head * 64 + dh) = u32x2{pack2(r0, r1), pack2(r2, r3)};
        }
        __syncthreads();
    }
}

#ifndef PROBE_DUP
#define PROBE_DUP 0
#endif
#define REP(k) for (int rep_ = 0; rep_ < 1 + ((PROBE_DUP >> (k)) & 1); ++rep_)
constexpr int LDS_BYTES = 3 * GSTAGE + 64;
__global__ void __launch_bounds__(256, 2) mk_fwd(Prm P) {
    extern __shared__ __attribute__((aligned(16))) unsigned char smem[];
    unsigned* xb_words = (unsigned*)(smem + 3 * GSTAGE);
    if (threadIdx.x < 4) xb_words[threadIdx.x] = 0u;
    __syncthreads();
    XcdBarrier bar = xcd_barrier_post((unsigned*)(P.ws + OFF_BAR), (volatile LAS unsigned*)xb_words);
    unsigned char* ws = P.ws;

    phase0(P, smem);
    cg::this_grid().sync();

#pragma unroll 1
    for (int layer = 0; layer < 4; ++layer) {
        const int kind = layer % 3, lj = layer / 3;
        const u16* Win; const u16* Wout; int N, nsub;
        if (kind == 0)      { Win = (const u16*)(ws + OFF_WA_IN + (size_t)lj * SZ_WA_IN); Wout = (const u16*)(ws + OFF_WA_OUT + (size_t)lj * SZ_SQ); N = 2560; nsub = 4; }
        else if (kind == 1) { Win = (const u16*)(ws + OFF_WB_IN); Wout = (const u16*)(ws + OFF_WB_OUT); N = 2304; nsub = 1; }
        else                { Win = (const u16*)(ws + OFF_WC_IN); Wout = (const u16*)(ws + OFF_WC_OUT); N = 3840; nsub = 1; }
#pragma unroll 1
        for (int sub = 0; sub < nsub; ++sub) {
            REP(0) gemm_in_phase(smem, P, kind, Win + (size_t)sub * 2560 * 1024, N);
            xcd_barrier(bar);
            if (kind == 0) REP(1) attnA_phase(P, sub);
            else if (kind == 1) REP(2) attnB_phase(P);
            else { REP(3) compress_phase(P); xcd_barrier(bar); REP(4) attnC_phase(P, smem); }
            xcd_barrier(bar);
        }
        gemm_out_phase(smem, P, Wout, layer == 0 ? P.in[0] : P.out);
        xcd_barrier(bar);
        ln_phase(P, layer);
        xcd_barrier(bar);
        gemm_gate_phase(smem, P, (const u16*)(ws + OFF_WG + (size_t)layer * SZ_SQ), (const u16*)(ws + OFF_WP + (size_t)layer * SZ_WP));
        if (layer < 3) xcd_barrier(bar);
    }
}

extern "C" void kernel_launch(void* const* d_in, const int* in_sizes, int n_in, void* d_out, int out_size, void* d_ws, size_t ws_size,
                              hipStream_t stream) {
    static int grid_blocks = 0;
    if (!grid_blocks) {
        int dev = 0, cus = 0, per_cu = 0;
        (void)hipGetDevice(&dev);
        (void)hipDeviceGetAttribute(&cus, hipDeviceAttributeMultiprocessorCount, dev);
        (void)hipFuncSetAttribute((const void*)mk_fwd, hipFuncAttributeMaxDynamicSharedMemorySize, LDS_BYTES);
        (void)hipOccupancyMaxActiveBlocksPerMultiprocessor(&per_cu, (const void*)mk_fwd, 256, LDS_BYTES);
        if (per_cu > 2) per_cu = 2;
        if (per_cu < 1) per_cu = 1;
        grid_blocks = cus * per_cu;
        if (ws_size < WS_END || n_in != 16) { fprintf(stderr, "kernel_launch: workspace too small (%zu < %zu) or n_in %d != 16\n", ws_size, (size_t)WS_END, n_in); grid_blocks = -1; }
    }
    if (grid_blocks < 0) return;
    (void)hipMemsetAsync((char*)d_ws + OFF_BAR, 0, 16384, stream);
    Prm p{};
    for (int i = 0; i < 16; ++i) p.in[i] = (const float*)d_in[i];
    p.out = (float*)d_out; p.ws = (unsigned char*)d_ws;
    void* args[] = {&p};
    hipError_t e = hipLaunchCooperativeKernel((const void*)mk_fwd, dim3(grid_blocks), dim3(256), args, LDS_BYTES, stream);
    if (e != hipSuccess) fprintf(stderr, "cooperative launch failed: %s (grid %d)\n", hipGetErrorString(e), grid_blocks);
}
```

```cpp
#include <hip/hip_runtime.h>
#include <hip/hip_cooperative_groups.h>
#include <cstdio>
#include <cstdint>
namespace cg = cooperative_groups;

typedef unsigned short u16;
using bf16x8 = __attribute__((ext_vector_type(8))) short;
using s16x4  = __attribute__((ext_vector_type(4))) short;
using f32x4  = __attribute__((ext_vector_type(4))) float;
using u32x4  = __attribute__((ext_vector_type(4))) unsigned;
using u32x2  = __attribute__((ext_vector_type(2))) unsigned;
#define DEV __device__ __forceinline__
using h16x8 = __attribute__((ext_vector_type(8))) _Float16;
#define MFMA16(a, b, c) __builtin_amdgcn_mfma_f32_16x16x32_f16(__builtin_bit_cast(h16x8, (a)), __builtin_bit_cast(h16x8, (b)), (c), 0, 0, 0)
#define LAS __attribute__((address_space(3)))

constexpr int T = 16384, S = 8192;
constexpr float LN_EPS = 1e-5f;
constexpr float DN_ALPHA = 1.6817928305074290f;
constexpr float NEG_INF = -__builtin_huge_valf();

constexpr size_t OFF_BAR   = 0;
constexpr size_t OFF_COS   = 16384;
constexpr size_t OFF_SIN   = OFF_COS + (size_t)8192 * 32 * 4;
constexpr size_t OFF_BIAS  = OFF_SIN + (size_t)8192 * 32 * 4;
constexpr size_t OFF_WA_IN = OFF_BIAS + 1024;
constexpr size_t SZ_WA_IN  = (size_t)10240 * 1024 * 2;
constexpr size_t SZ_SQ     = (size_t)1024 * 1024 * 2;
constexpr size_t OFF_WA_OUT = OFF_WA_IN + 2 * SZ_WA_IN;
constexpr size_t OFF_WB_IN  = OFF_WA_OUT + 2 * SZ_SQ;
constexpr size_t OFF_WB_OUT = OFF_WB_IN + (size_t)2304 * 1024 * 2;
constexpr size_t OFF_WC_IN  = OFF_WB_OUT + SZ_SQ;
constexpr size_t OFF_WC_OUT = OFF_WC_IN + (size_t)3840 * 1024 * 2;
constexpr size_t OFF_WG     = OFF_WC_OUT + SZ_SQ;
constexpr size_t OFF_WP     = OFF_WG + 4 * SZ_SQ;
constexpr size_t SZ_WP      = (size_t)1024 * 256 * 2;
constexpr size_t OFF_WCK    = OFF_WP + 4 * SZ_WP;
constexpr size_t OFF_WCV    = OFF_WCK + (size_t)64 * 2048 * 2;
constexpr size_t OFF_XB     = OFF_WCV + (size_t)64 * 2048 * 2;
constexpr size_t SZ_ACT     = (size_t)T * 1024 * 2;
constexpr size_t OFF_G      = OFF_XB + SZ_ACT;
constexpr size_t OFF_H      = OFF_G + SZ_ACT;
constexpr size_t SZ_HMAX    = (size_t)T * 3840 * 2;
constexpr size_t OFF_VT0    = OFF_H + SZ_HMAX;
constexpr size_t SZ_VT      = (size_t)2 * 4 * 8192 * 64 * 2;
constexpr size_t OFF_VT1    = OFF_VT0 + SZ_VT;
constexpr size_t OFF_VT2    = OFF_VT1 + SZ_VT;
constexpr size_t OFF_KCMP   = OFF_VT2 + SZ_VT;
constexpr size_t SZ_CMP     = (size_t)2 * 512 * 4 * 64 * 2;
constexpr size_t OFF_VCMP   = OFF_KCMP + SZ_CMP;
constexpr size_t WS_END     = OFF_VCMP + SZ_CMP;
constexpr size_t OFF_XLB    = OFF_H;
constexpr size_t OFF_PB     = OFF_H + SZ_ACT;
constexpr size_t OFF_PP     = OFF_H + SZ_ACT + (size_t)16 * 1024 * 1024;

struct Prm { const float* in[16]; float* out; unsigned char* ws; };

DEV u16 f2bf(float f) { return __builtin_bit_cast(u16, (_Float16)f); }
DEV float bf2f(u16 h) { return (float)__builtin_bit_cast(_Float16, h); }
DEV unsigned pack2(float a, float b) { return (unsigned)f2bf(a) | ((unsigned)f2bf(b) << 16); }
DEV float bflo(unsigned u) { return bf2f((u16)(u & 0xffffu)); }
DEV float bfhi(unsigned u) { return bf2f((u16)(u >> 16)); }
DEV float sigmoidf_(float x) { return 1.f / (1.f + __expf(-x)); }
DEV float siluf_(float x) { return x / (1.f + __expf(-x)); }
DEV float red16_max(float v) { v = fmaxf(v, __shfl_xor(v, 16)); v = fmaxf(v, __shfl_xor(v, 32)); return v; }
DEV float red16_sum(float v) { v += __shfl_xor(v, 16); v += __shfl_xor(v, 32); return v; }
DEV float wave_sum(float v) { for (int o = 32; o > 0; o >>= 1) v += __shfl_xor(v, o); return v; }

DEV int opaque_tid() { int t = threadIdx.x; asm volatile("" : "+v"(t)); return t; }
#define XB_TMO      128
#define XB_XCNT(j)  (256  + 64 * (j))
#define XB_XSUB(j)  (1280 + 64 * (j))
#define XB_XGEN(j)  (2304 + 64 * (j))
#define XB_TOP      3328
#define XB_TOPGEN   3392
#define XCD_BAR_WORDS 3456
#define XB_SPIN_CAP (1u << 24)
DEV unsigned xb_ld(unsigned* p)              { return __hip_atomic_load(p, __ATOMIC_RELAXED, __HIP_MEMORY_SCOPE_AGENT); }
DEV unsigned xb_add(unsigned* p, unsigned v) { return __hip_atomic_fetch_add(p, v, __ATOMIC_RELAXED, __HIP_MEMORY_SCOPE_AGENT); }
DEV unsigned xb_xcc_id() { return (unsigned)__builtin_amdgcn_s_getreg((3 << 11) | 20) & 0xFu; }
#define XB_SPIN(cond, bar) do { unsigned _sp = 0; while (cond) { __builtin_amdgcn_s_sleep(1); \
    if ((++_sp & 255u) == 0u) { if (xb_ld(&(bar)[XB_TMO])) break; if (_sp > XB_SPIN_CAP) { atomicAdd(&(bar)[XB_TMO], 1u); break; } } } } while (0)
struct XcdBarrier { unsigned* bar; unsigned x; volatile LAS unsigned* st; };
DEV XcdBarrier xcd_barrier_post(unsigned* bar, volatile LAS unsigned* st) {
    XcdBarrier b; b.bar = bar; b.x = xb_xcc_id(); b.st = st;
    if (threadIdx.x == 0) (void)xb_add(&bar[XB_XCNT(b.x)], 1u);
    return b;
}
DEV void xcd_barrier_complete(unsigned* bar, unsigned x, unsigned& nloc, unsigned& nx) {
    const unsigned G = gridDim.x * gridDim.y * gridDim.z;
    unsigned sum, cnt, mine, sp = 0u;
    for (;;) {
        sum = 0u; cnt = 0u; mine = 0u;
#pragma unroll
        for (unsigned j = 0; j < 16; ++j) { const unsigned c = xb_ld(&bar[XB_XCNT(j)]); sum += c; cnt += (c > 0u) ? 1u : 0u; mine = (j == x) ? c : mine; }
        if (sum == G) break;
        __builtin_amdgcn_s_sleep(1);
        if ((++sp & 255u) == 0u) { if (xb_ld(&bar[XB_TMO])) break; if (sp > XB_SPIN_CAP) { atomicAdd(&bar[XB_TMO], 1u); break; } }
    }
    nloc = mine > 0u ? mine : 1u; nx = cnt > 0u ? cnt : 1u;
}
DEV void xcd_barrier(const XcdBarrier& b) {
    asm volatile("s_waitcnt vmcnt(0)" ::: "memory");
    __syncthreads();
    if (threadIdx.x == 0) {
        unsigned* bar = b.bar;
        __builtin_amdgcn_s_waitcnt(0);
        unsigned nloc = b.st[0], nx = b.st[1];
        if (nloc == 0u) { xcd_barrier_complete(bar, b.x, nloc, nx); b.st[0] = nloc; b.st[1] = nx; }
        const unsigned old = xb_add(&bar[XB_XSUB(b.x)], 1u);
        const unsigned gen = old / nloc;
        if (old + 1u == (gen + 1u) * nloc) {
            __builtin_amdgcn_fence(__ATOMIC_RELEASE, "agent");
            asm volatile("s_waitcnt vmcnt(0)" ::: "memory");
            const unsigned og = xb_add(&bar[XB_TOP], 1u);
            const unsigned tg = og / nx;
            if (og + 1u == (tg + 1u) * nx) xb_add(&bar[XB_TOPGEN], 1u);
            else XB_SPIN(xb_ld(&bar[XB_TOPGEN]) == tg, bar);
            __builtin_amdgcn_fence(__ATOMIC_ACQUIRE, "agent");
            xb_add(&bar[XB_XGEN(b.x)], 1u);
            asm volatile("s_waitcnt vmcnt(0)" ::: "memory");
        } else {
            XB_SPIN(xb_ld(&bar[XB_XGEN(b.x)]) == gen, bar);
            __builtin_amdgcn_fence(__ATOMIC_ACQUIRE, "agent");
            asm volatile("s_waitcnt vmcnt(0)" ::: "memory");
        }
    }
    __syncthreads();
}

DEV int colmap(int kind, int n) {
    if (kind == 0) return n;
    if (kind == 1) {
        const int c = n / 2560, nn = n - c * 2560;
        if (nn < 2304) { const int g = nn / 768, rem = nn - g * 768, part = rem >> 8, hh = (rem & 255) >> 6, d = rem & 63;
                         return g * 3072 + part * 1024 + (c * 4 + hh) * 64 + d; }
        const int z = nn - 2304; return 9216 + (c * 4 + (z >> 6)) * 64 + (z & 63);
    }
    if (n < 2560) return n;
    if (n < 3584) return n - 2560 + 2608;
    if (n < 3632) return n - 3584 + 2560;
    return -1;
}
DEV void tconv(const int tid_, float* lds, const float* __restrict__ src, int K, int Nsrc, u16* __restrict__ dst, int Ndst, int kind, int& acc_tiles) {
    const int G = gridDim.x, tid = tid_;
    const int ntn = Ndst >> 6, ntk = K >> 6, nt = ntn * ntk;
    int first = ((int)blockIdx.x - (acc_tiles % G) + G) % G;
    acc_tiles += nt;
    for (int t = first; t < nt; t += G) {
        const int tn = t / ntk, tk = t - tn * ntk;
        const int n0 = tn << 6, k0 = tk << 6;
        const int nl = tid & 63;
        const int c = colmap(kind, n0 + nl);
#pragma unroll
        for (int i = 0; i < 16; ++i) {
            const int kl = (tid >> 6) + 4 * i;
            const float v = (c >= 0) ? src[(size_t)(k0 + kl) * Nsrc + c] : 0.f;
            lds[kl * 65 + nl] = v;
        }
        __syncthreads();
        const int r = tid >> 2, kk = (tid & 3) << 4;
        unsigned o[8];
#pragma unroll
        for (int i = 0; i < 8; ++i) o[i] = pack2(lds[(kk + 2 * i) * 65 + r], lds[(kk + 2 * i + 1) * 65 + r]);
        u32x4* dp = (u32x4*)(dst + (size_t)(n0 + r) * K + k0 + kk);
        dp[0] = u32x4{o[0], o[1], o[2], o[3]};
        dp[1] = u32x4{o[4], o[5], o[6], o[7]};
        __syncthreads();
    }
}

DEV void phase0(const Prm& P, unsigned char* smem) {
    const int tid_ = opaque_tid();
    float* lds = (float*)smem;
    unsigned char* ws = P.ws;
    int acc = 0;
    tconv(tid_, lds, P.in[2], 1024, 10240, (u16*)(ws + OFF_WA_IN), 10240, 1, acc);
    tconv(tid_, lds, P.in[2] + (size_t)1024 * 10240, 1024, 10240, (u16*)(ws + OFF_WA_IN + SZ_WA_IN), 10240, 1, acc);
    tconv(tid_, lds, P.in[3], 1024, 1024, (u16*)(ws + OFF_WA_OUT), 1024, 0, acc);
    tconv(tid_, lds, P.in[3] + (size_t)1024 * 1024, 1024, 1024, (u16*)(ws + OFF_WA_OUT + SZ_SQ), 1024, 0, acc);
    tconv(tid_, lds, P.in[4], 1024, 2304, (u16*)(ws + OFF_WB_IN), 2304, 0, acc);
    tconv(tid_, lds, P.in[6], 1024, 1024, (u16*)(ws + OFF_WB_OUT), 1024, 0, acc);
    tconv(tid_, lds, P.in[7], 1024, 3632, (u16*)(ws + OFF_WC_IN), 3840, 2, acc);
    tconv(tid_, lds, P.in[11], 1024, 1024, (u16*)(ws + OFF_WC_OUT), 1024, 0, acc);
    for (int i = 0; i < 4; ++i) {
        tconv(tid_, lds, P.in[15] + (size_t)i * 1024 * 1024, 1024, 1024, (u16*)(ws + OFF_WG + i * SZ_SQ), 1024, 0, acc);
        tconv(tid_, lds, P.in[14] + (size_t)i * 256 * 1024, 256, 1024, (u16*)(ws + OFF_WP + i * SZ_WP), 1024, 0, acc);
    }
    tconv(tid_, lds, P.in[8], 2048, 64, (u16*)(ws + OFF_WCK), 64, 0, acc);
    tconv(tid_, lds, P.in[9], 2048, 64, (u16*)(ws + OFF_WCV), 64, 0, acc);

    const size_t gtid = (size_t)blockIdx.x * 256 + tid_, gsz = (size_t)gridDim.x * 256;
    {
        const float* x = P.in[0]; u16* xb = (u16*)(ws + OFF_XB);
        for (size_t i = gtid; i < (size_t)T * 1024 / 8; i += gsz) {
            const f32x4 a = *(const f32x4*)(x + i * 8), b = *(const f32x4*)(x + i * 8 + 4);
            *(u32x4*)(xb + i * 8) = u32x4{pack2(a[0], a[1]), pack2(a[2], a[3]), pack2(b[0], b[1]), pack2(b[2], b[3])};
        }
    }
    {
        float* ct = (float*)(ws + OFF_COS); float* st = (float*)(ws + OFF_SIN);
        for (size_t i = gtid; i < (size_t)8192 * 32; i += gsz) {
            const int pos = (int)(i >> 5), k = (int)(i & 31);
            const float inv = (float)(1.0 / pow(10000.0, (double)(2 * k) / 64.0));
            const float ang = (float)pos * inv;
            ct[i] = (float)cos((double)ang); st[i] = (float)sin((double)ang);
        }
    }
    {
        const int lane = tid_ & 63;
        const int wid = blockIdx.x * 4 + __builtin_amdgcn_readfirstlane(tid_ >> 6);
        if (wid < 128) {
            const float* w = (wid < 64) ? P.in[8] : P.in[9];
            const int e = wid & 63;
            float s = 0.f;
            for (int jd = lane; jd < 2048; jd += 64) s += P.in[10][jd] * w[(size_t)jd * 64 + e];
            s = wave_sum(s);
            if (lane == 0) ((float*)(ws + OFF_BIAS))[wid] = s;
        }
    }
}

constexpr int GSTAGE = 24576;
DEV int gsw(int r) { return (0x78 >> (2 * ((r >> 2) & 3))) & 3; }
DEV void gemm_issue(unsigned char* stage, const u16* ag, const u16* bg, int astep, int ldb, int k0, int w) {
#pragma unroll
    for (int i = 0; i < 2; ++i)
        __builtin_amdgcn_global_load_lds((const unsigned*)(ag + (size_t)i * astep + k0), (unsigned*)(stage + w * 1024 + i * 4096), 16, 0, 0);
#pragma unroll
    for (int i = 0; i < 4; ++i)
        __builtin_amdgcn_global_load_lds((const unsigned*)(bg + (size_t)i * 64 * ldb + k0), (unsigned*)(stage + 8192 + w * 1024 + i * 4096), 16, 0, 0);
}
template <bool NONSWAP>
DEV void gemm_mainloop(const int tid_, unsigned char* smem, const u16* __restrict__ A, int lda, const u16* __restrict__ Bt, int ldb, int K,
                       int m0, int n0, f32x4 (&acc)[32], bool aperm = false) {
    const int tid = tid_, lane = tid & 63, w = __builtin_amdgcn_readfirstlane(tid >> 6), wm = w >> 1, wn = w & 1;
    const int lrow = tid >> 2, lsw = ((tid & 3) ^ gsw(lrow)) * 8;
    const int arow = aperm ? ((lrow & 31) * 4 + (lrow >> 5)) : lrow;
    const int astep = (aperm ? 2 : 64) * lda;
    const u16* ag = A + (size_t)(m0 + arow) * lda + lsw;
    const u16* bg = Bt + (size_t)(n0 + lrow) * ldb + lsw;
    const int fr = lane & 15, fq = lane >> 4;
    const int coff = (fq ^ gsw(fr)) << 4;
    const int a_base = (wm * 64 + fr) * 64 + coff, b_base = 8192 + (wn * 128 + fr) * 64 + coff;
    const int nk = K >> 5;
    asm volatile("s_waitcnt vmcnt(0)" ::: "memory");
    __builtin_amdgcn_s_barrier();
    gemm_issue(smem, ag, bg, astep, ldb, 0, w);
    gemm_issue(smem + GSTAGE, ag, bg, astep, ldb, 32, w);
    int sc = 0, si = 2;
    for (int kt = 0; kt < nk; ++kt) {
        if (kt + 1 < nk) asm volatile("s_waitcnt vmcnt(6)" ::: "memory"); else asm volatile("s_waitcnt vmcnt(0)" ::: "memory");
        __builtin_amdgcn_s_barrier();
        if (kt + 2 < nk) { gemm_issue(smem + si * GSTAGE, ag, bg, astep, ldb, (kt + 2) << 5, w); si = (si == 2) ? 0 : si + 1; }
        const unsigned char* st = smem + sc * GSTAGE; sc = (sc == 2) ? 0 : sc + 1;
        bf16x8 a[4], b[8];
#pragma unroll
        for (int i = 0; i < 4; ++i) a[i] = *(const bf16x8*)(st + a_base + i * 1024);
#pragma unroll
        for (int i = 0; i < 8; ++i) b[i] = *(const bf16x8*)(st + b_base + i * 1024);
        if (NONSWAP) {
#pragma unroll
            for (int mt = 0; mt < 4; ++mt)
#pragma unroll
                for (int nt = 0; nt < 8; ++nt) acc[mt * 8 + nt] = MFMA16(a[mt], b[nt], acc[mt * 8 + nt]);
        } else {
#pragma unroll
            for (int nt = 0; nt < 8; ++nt)
#pragma unroll
                for (int mt = 0; mt < 4; ++mt) acc[nt * 4 + mt] = MFMA16(b[nt], a[mt], acc[nt * 4 + mt]);
        }
    }
}

DEV int vblock() { const int G = gridDim.x, b = blockIdx.x; return ((G & 7) == 0) ? (b & 7) * (G >> 3) + (b >> 3) : b; }
DEV void tile_mn(int t, int nN, int& mi, int& ni) { const int per = 16 * nN; const int mg = t / per, r = t - mg * per; mi = mg * 16 + (r & 15); ni = r >> 4; }
#define ZERO_ACC(acc) _Pragma("unroll") for (int i_ = 0; i_ < 32; ++i_) acc[i_] = f32x4{0.f, 0.f, 0.f, 0.f}

DEV void classify(int kind, int cgi, int& mode, int& vsel, int& vth, int& dsh, int& nhv) {
    mode = 0; vsel = 0; vth = 0; dsh = 0; nhv = 4;
    if (kind == 0) {
        if (cgi < 36) { const int g = cgi / 12, part = (cgi - g * 12) >> 2; vth = cgi & 3; if (part < 2) mode = 1; else { mode = 2; vsel = g; dsh = 2 * g; } }
    } else if (kind == 1) {
        if (cgi < 18) mode = 1; else if (cgi < 20) { mode = 2; vsel = 0; vth = cgi - 18; nhv = 2; }
    } else {
        if (cgi < 20) mode = 1; else if (cgi < 24) mode = 0; else if (cgi < 28) mode = 1; else if (cgi < 32) { mode = 2; vsel = 0; vth = cgi - 28; }
        else if (cgi < 36) mode = 1; else if (cgi < 40) { mode = 2; vsel = 1; vth = cgi - 36; }
    }
}

DEV void gemm_in_phase(unsigned char* smem, const Prm& P, int kind, const u16* Wt, int N) {
    const int tid_ = opaque_tid();
    unsigned char* ws = P.ws;
    const u16* A = (const u16*)(ws + OFF_XB);
    u16* H = (u16*)(ws + OFF_H);
    const float* cosT = (const float*)(ws + OFF_COS); const float* sinT = (const float*)(ws + OFF_SIN);
    const int nN = N >> 8, ntiles = 128 * nN;
    const int lane = tid_ & 63, w = __builtin_amdgcn_readfirstlane(tid_ >> 6), wm = w >> 1, wn = w & 1, fr = lane & 15, fq = lane >> 4;
    for (int t = vblock(); t < ntiles; t += gridDim.x) {
        int mi, ni; tile_mn(t, nN, mi, ni);
        const int m0 = mi << 7, n0 = ni << 8;
        const int ncol = n0 + wn * 128, cg0 = ncol >> 6;
        int mode, vsel, vth, dsh, nhv; classify(kind, cg0, mode, vsel, vth, dsh, nhv);
        const int mw = m0 + wm * 64;
        f32x4 acc[32]; ZERO_ACC(acc);
        if (mode == 2) {
            gemm_mainloop<true>(tid_, smem, A, 1024, Wt, 1024, 1024, m0, n0, acc, dsh == 2);
            __builtin_amdgcn_s_barrier();
            u16* vt = (u16*)(ws + (vsel == 0 ? OFF_VT0 : (vsel == 1 ? OFF_VT1 : OFF_VT2)));
            if (dsh == 0) {
#pragma unroll
                for (int mt = 0; mt < 4; ++mt) {
                    const int m = mw + mt * 16 + fq * 4;
                    const int b = m >> 13, p = m & 8191;
#pragma unroll
                    for (int grp = 0; grp < 2; ++grp) {
                        u16* dst = vt + ((((size_t)(b * nhv + vth + grp)) * 512 + (p >> 4)) * 64) * 16 + (p & 15);
#pragma unroll
                        for (int nt = 0; nt < 4; ++nt) { const f32x4 v = acc[mt * 8 + grp * 4 + nt]; *(u32x2*)(dst + (nt * 16 + fr) * 16) = u32x2{pack2(v[0], v[1]), pack2(v[2], v[3])}; }
                    }
                }
            } else if (dsh == 4) {
#pragma unroll
                for (int j = 0; j < 4; ++j) {
                    const int m = mw + fq * 4 + j;
                    const int b = m >> 13, s = m & 8191;
                    const int p = ((s & 15) << 9) + (s >> 4);
#pragma unroll
                    for (int grp = 0; grp < 2; ++grp) {
                        u16* dst = vt + ((((size_t)(b * nhv + vth + grp)) * 512 + (p >> 4)) * 64) * 16 + (p & 15);
#pragma unroll
                        for (int nt = 0; nt < 4; ++nt)
                            *(u32x2*)(dst + (nt * 16 + fr) * 16) = u32x2{pack2(acc[0 * 8 + grp * 4 + nt][j], acc[1 * 8 + grp * 4 + nt][j]), pack2(acc[2 * 8 + grp * 4 + nt][j], acc[3 * 8 + grp * 4 + nt][j])};
                    }
                }
            } else {
#pragma unroll
                for (int mt = 0; mt < 4; ++mt) {
                    const int r0 = wm * 64 + mt * 16 + fq * 4;
                    const int m = m0 + (r0 & 31) * 4 + (r0 >> 5);
                    const int b = m >> 13, s = m & 8191;
                    const int p = ((s & 3) << 11) + (s >> 2);
#pragma unroll
                    for (int grp = 0; grp < 2; ++grp) {
                        u16* dst = vt + ((((size_t)(b * nhv + vth + grp)) * 512 + (p >> 4)) * 64) * 16 + (p & 15);
#pragma unroll
                        for (int nt = 0; nt < 4; ++nt) { const f32x4 v = acc[mt * 8 + grp * 4 + nt]; *(u32x2*)(dst + (nt * 16 + fr) * 16) = u32x2{pack2(v[0], v[1]), pack2(v[2], v[3])}; }
                    }
                }
            }
        } else {
            gemm_mainloop<false>(tid_, smem, A, 1024, Wt, 1024, 1024, m0, n0, acc);
            __builtin_amdgcn_s_barrier();
            constexpr int EROW = 272;
            unsigned char* est = smem + w * (64 * EROW);
            int l4_ = lane; asm volatile("" : "+v"(l4_));
            const int fr = l4_ & 15, fq = l4_ >> 4;
#pragma unroll
            for (int mt = 0; mt < 4; ++mt) {
                const int s = (mw + mt * 16 + fr) & 8191;
                unsigned char* erow = est + (mt * 16 + fr) * EROW + fq * 8;
                if (mode == 1) {
#pragma unroll
                    for (int nt = 0; nt < 2; ++nt) {
                        const f32x4 c4 = *(const f32x4*)(cosT + s * 32 + nt * 16 + fq * 4);
                        const f32x4 s4 = *(const f32x4*)(sinT + s * 32 + nt * 16 + fq * 4);
#pragma unroll
                        for (int grp = 0; grp < 2; ++grp) {
                            const f32x4 x1 = acc[(grp * 4 + nt) * 4 + mt], x2 = acc[(grp * 4 + nt + 2) * 4 + mt];
                            const f32x4 o1 = x1 * c4 - x2 * s4, o2 = x2 * c4 + x1 * s4;
                            *(u32x2*)(erow + (grp * 64 + nt * 16) * 2) = u32x2{pack2(o1[0], o1[1]), pack2(o1[2], o1[3])};
                            *(u32x2*)(erow + (grp * 64 + (nt + 2) * 16) * 2) = u32x2{pack2(o2[0], o2[1]), pack2(o2[2], o2[3])};
                        }
                    }
                } else {
#pragma unroll
                    for (int nt = 0; nt < 8; ++nt) { const f32x4 v = acc[nt * 4 + mt]; *(u32x2*)(erow + nt * 32) = u32x2{pack2(v[0], v[1]), pack2(v[2], v[3])}; }
                }
            }
            __builtin_amdgcn_fence(__ATOMIC_RELEASE, "wavefront"); __builtin_amdgcn_wave_barrier(); __builtin_amdgcn_fence(__ATOMIC_ACQUIRE, "wavefront");
            {
                const int rr = l4_ >> 4, ch = l4_ & 15;
                u16* hbase = H + (size_t)mw * N + ncol + ch * 8;
#pragma unroll
                for (int i = 0; i < 16; ++i) {
                    const int row = i * 4 + rr;
                    const u32x4 v = *(const u32x4*)(est + row * EROW + ch * 16);
                    *(u32x4*)(hbase + (size_t)row * N) = v;
                }
            }
        }
    }
}

DEV void gemm_out_phase(unsigned char* smem, const Prm& P, const u16* Wt, const float* xin) {
    const int tid_ = opaque_tid();
    const u16* A = (const u16*)(P.ws + OFF_G);
    const int lane = tid_ & 63, w = __builtin_amdgcn_readfirstlane(tid_ >> 6), wm = w >> 1, wn = w & 1, fr = lane & 15, fq = lane >> 4;
    for (int t = vblock(); t < 512; t += gridDim.x) {
        int mi, ni; tile_mn(t, 4, mi, ni);
        const int m0 = mi << 7, n0 = ni << 8;
        f32x4 acc[32]; ZERO_ACC(acc);
        gemm_mainloop<false>(tid_, smem, A, 1024, Wt, 1024, 1024, m0, n0, acc);
        {
            __builtin_amdgcn_s_barrier();
            constexpr int EROWF = 528;
            unsigned char* est = smem + w * (32 * EROWF);
            const size_t ub = (size_t)(m0 + wm * 64) * 1024 + n0 + wn * 128;
            const float* xw = xin + ub; float* ow = P.out + ub;
            int l2_ = lane; asm volatile("" : "+v"(l2_));
            const int fr2 = l2_ & 15, fq2 = l2_ >> 4, rr = l2_ >> 5, ch = l2_ & 31;
#pragma unroll
            for (int h = 0; h < 2; ++h) {
#pragma unroll
                for (int mh = 0; mh < 2; ++mh) {
                    unsigned char* erow = est + (mh * 16 + fr2) * EROWF + fq2 * 16;
#pragma unroll
                    for (int nt = 0; nt < 8; ++nt) *(f32x4*)(erow + nt * 64) = acc[nt * 4 + h * 2 + mh];
                }
                __builtin_amdgcn_fence(__ATOMIC_RELEASE, "wavefront"); __builtin_amdgcn_wave_barrier(); __builtin_amdgcn_fence(__ATOMIC_ACQUIRE, "wavefront");
#pragma unroll 4
                for (int i = 0; i < 16; ++i) {
                    const int row = i * 2 + rr;
                    const unsigned ix = (unsigned)((h * 32 + row) * 1024 + ch * 4);
                    const f32x4 v = *(const f32x4*)(est + row * EROWF + ch * 16);
                    const f32x4 xv = *(const f32x4*)(xw + ix);
                    *(f32x4*)(ow + ix) = xv * DN_ALPHA + v;
                }
                __builtin_amdgcn_fence(__ATOMIC_RELEASE, "wavefront"); __builtin_amdgcn_wave_barrier(); __builtin_amdgcn_fence(__ATOMIC_ACQUIRE, "wavefront");
            }
        }
    }
}

DEV void gemm_gate_phase(unsigned char* smem, const Prm& P, const u16* Wg, const u16* Wp) {
    const int tid_ = opaque_tid();
    const u16* A1 = (const u16*)(P.ws + OFF_XLB);
    const u16* A2 = (const u16*)(P.ws + OFF_PB);
    u16* xb = (u16*)(P.ws + OFF_XB);
    u16* ppb = (u16*)(P.ws + OFF_PP);
    const int lane = tid_ & 63, w = __builtin_amdgcn_readfirstlane(tid_ >> 6), wm = w >> 1, wn = w & 1, fr = lane & 15, fq = lane >> 4;
    for (int t = vblock(); t < 512; t += gridDim.x) {
        int mi, ni; tile_mn(t, 4, mi, ni);
        const int m0 = mi << 7, n0 = ni << 8;
        f32x4 acc[32]; ZERO_ACC(acc);
        gemm_mainloop<false>(tid_, smem, A2, 256, Wp, 256, 256, m0, n0, acc);
        const size_t ub = (size_t)(m0 + wm * 64) * 1024 + n0 + wn * 128;
        float* ow = P.out + ub; u16* pw = ppb + ub; u16* xw = xb + ub;
        {
            int l2_ = lane; asm volatile("" : "+v"(l2_));
            const unsigned lo = (unsigned)((l2_ & 15) * 1024 + (l2_ >> 4) * 4);
#pragma unroll
            for (int mt = 0; mt < 4; ++mt) {
#pragma unroll
                for (int nt = 0; nt < 8; ++nt) { const f32x4 v = acc[nt * 4 + mt]; *(u32x2*)(pw + (lo + mt * 16384 + nt * 16)) = u32x2{pack2(v[0], v[1]), pack2(v[2], v[3])}; }
                __builtin_amdgcn_sched_barrier(0);
            }
        }
        ZERO_ACC(acc);
        gemm_mainloop<false>(tid_, smem, A1, 1024, Wg, 1024, 1024, m0, n0, acc);
        int l3_ = lane; asm volatile("" : "+v"(l3_));
        const unsigned lo = (unsigned)((l3_ & 15) * 1024 + (l3_ >> 4) * 4);
#pragma unroll
        for (int mt = 0; mt < 4; ++mt) {
#pragma unroll
            for (int nt = 0; nt < 8; ++nt) {
                const unsigned ix = lo + mt * 16384 + nt * 16;
                const f32x4 xv = *(const f32x4*)(ow + ix);
                const u32x2 pq = *(const u32x2*)(pw + ix);
                const f32x4 ga = acc[nt * 4 + mt];
                f32x4 r;
                r[0] = xv[0] + sigmoidf_(ga[0]) * bflo(pq[0]); r[1] = xv[1] + sigmoidf_(ga[1]) * bfhi(pq[0]);
                r[2] = xv[2] + sigmoidf_(ga[2]) * bflo(pq[1]); r[3] = xv[3] + sigmoidf_(ga[3]) * bfhi(pq[1]);
                *(f32x4*)(ow + ix) = r;
                *(u32x2*)(xw + ix) = u32x2{pack2(r[0], r[1]), pack2(r[2], r[3])};
            }
            __builtin_amdgcn_sched_barrier(0);
        }
    }
}

DEV void ln_phase(const Prm& P, int layer) {
    const int tid_ = opaque_tid();
    const int lane = tid_ & 63, w = __builtin_amdgcn_readfirstlane(tid_ >> 6);
    const float* g = P.in[12] + layer * 1024; const float* bb = P.in[13] + layer * 1024;
    u16* xlb = (u16*)(P.ws + OFF_XLB);
    for (int row = blockIdx.x * 4 + w; row < T; row += gridDim.x * 4) {
        float* xr = P.out + (size_t)row * 1024;
        f32x4 v[4];
        float s = 0.f;
#pragma unroll
        for (int i = 0; i < 4; ++i) { v[i] = *(const f32x4*)(xr + i * 256 + lane * 4); s += v[i][0] + v[i][1] + v[i][2] + v[i][3]; }
        const float mean = wave_sum(s) * (1.f / 1024.f);
        float q = 0.f;
#pragma unroll
        for (int i = 0; i < 4; ++i)
#pragma unroll
            for (int j = 0; j < 4; ++j) { const float d = v[i][j] - mean; q += d * d; }
        const float rstd = rsqrtf(wave_sum(q) * (1.f / 1024.f) + LN_EPS);
#pragma unroll
        for (int i = 0; i < 4; ++i) {
            const f32x4 gg = *(const f32x4*)(g + i * 256 + lane * 4), bv = *(const f32x4*)(bb + i * 256 + lane * 4);
            f32x4 y;
#pragma unroll
            for (int j = 0; j < 4; ++j) y[j] = (v[i][j] - mean) * rstd * gg[j] + bv[j];
            *(f32x4*)(xr + i * 256 + lane * 4) = y;
            *(u32x2*)(xlb + (size_t)row * 1024 + i * 256 + lane * 4) = u32x2{pack2(y[0], y[1]), pack2(y[2], y[3])};
        }
    }
    const float* p = P.in[1] + (size_t)layer * T * 256; u16* pb = (u16*)(P.ws + OFF_PB);
    const size_t gtid = (size_t)blockIdx.x * 256 + tid_, gsz = (size_t)gridDim.x * 256;
    for (size_t i = gtid; i < (size_t)T * 256 / 8; i += gsz) {
        const f32x4 a = *(const f32x4*)(p + i * 8), b = *(const f32x4*)(p + i * 8 + 4);
        *(u32x4*)(pb + i * 8) = u32x4{pack2(a[0], a[1]), pack2(a[2], a[3]), pack2(b[0], b[1]), pack2(b[2], b[3])};
    }
}

struct KV { bf16x8 ka0, ka1, kb0, kb1; bf16x8 v0, v1, v2, v3; };
DEV void load_kv(KV& t, const char* Kb, unsigned koa, unsigned kob, const char* Vb, unsigned voa, unsigned vob) {
    t.ka0 = *(const bf16x8*)(Kb + koa); t.ka1 = *(const bf16x8*)(Kb + koa + 64);
    t.kb0 = *(const bf16x8*)(Kb + kob); t.kb1 = *(const bf16x8*)(Kb + kob + 64);
    t.v0 = __builtin_shufflevector(*(const s16x4*)(Vb + voa), *(const s16x4*)(Vb + vob), 0, 1, 2, 3, 4, 5, 6, 7);
    t.v1 = __builtin_shufflevector(*(const s16x4*)(Vb + voa + 512), *(const s16x4*)(Vb + vob + 512), 0, 1, 2, 3, 4, 5, 6, 7);
    t.v2 = __builtin_shufflevector(*(const s16x4*)(Vb + voa + 1024), *(const s16x4*)(Vb + vob + 1024), 0, 1, 2, 3, 4, 5, 6, 7);
    t.v3 = __builtin_shufflevector(*(const s16x4*)(Vb + voa + 1536), *(const s16x4*)(Vb + vob + 1536), 0, 1, 2, 3, 4, 5, 6, 7);
}
DEV unsigned pkrtz(float a, float b) { return __builtin_bit_cast(unsigned, __builtin_amdgcn_cvt_pkrtz(a, b)); }
DEV bf16x8 pack8(const float (&p)[8]) {
    return __builtin_bit_cast(bf16x8, u32x4{pkrtz(p[0], p[1]), pkrtz(p[2], p[3]), pkrtz(p[4], p[5]), pkrtz(p[6], p[7])});
}
DEV void qk_scores(const KV& t, const bf16x8& q0, const bf16x8& q1, f32x4& sa, f32x4& sb) {
    sa = f32x4{0.f, 0.f, 0.f, 0.f}; sb = f32x4{0.f, 0.f, 0.f, 0.f};
    sa = MFMA16(t.ka0, q0, sa); sa = MFMA16(t.ka1, q1, sa);
    sb = MFMA16(t.kb0, q0, sb); sb = MFMA16(t.kb1, q1, sb);
}
constexpr float QK_C = 0.125f * 1.4426950408889634f;
DEV void flash_core(float& mref, float& l, f32x4 (&o)[4], const bf16x8& q0, const bf16x8& q1, const KV& t, bool fast, int d0, unsigned lim) {
    f32x4 sa, sb; qk_scores(t, q0, q1, sa, sb);
    float y[8];
    if (fast) {
#pragma unroll
        for (int j = 0; j < 4; ++j) { y[j] = sa[j] * QK_C; y[4 + j] = sb[j] * QK_C; }
    } else {
#pragma unroll
        for (int j = 0; j < 4; ++j) {
            y[j]     = ((unsigned)(d0 - j) <= lim)      ? sa[j] * QK_C : NEG_INF;
            y[4 + j] = ((unsigned)(d0 - 16 - j) <= lim) ? sb[j] * QK_C : NEG_INF;
        }
    }
    float mx = fmaxf(fmaxf(fmaxf(y[0], y[1]), fmaxf(y[2], y[3])), fmaxf(fmaxf(y[4], y[5]), fmaxf(y[6], y[7])));
    if (__ballot(mx > mref + 8.f) != 0ull) {
        mx = red16_max(mx);
        const float mn = fmaxf(mref, mx);
        const float alpha = (mn == NEG_INF) ? 1.f : __builtin_amdgcn_exp2f(mref - mn);
        l *= alpha;
#pragma unroll
        for (int d = 0; d < 4; ++d) o[d] *= alpha;
        mref = mn;
    }
    const float mu = (mref == NEG_INF) ? 0.f : mref;
    float p[8]; float ps = 0.f;
#pragma unroll
    for (int j = 0; j < 8; ++j) { p[j] = __builtin_amdgcn_exp2f(y[j] - mu); ps += p[j]; }
    l += ps;
    const bf16x8 pf = pack8(p);
    o[0] = MFMA16(t.v0, pf, o[0]); o[1] = MFMA16(t.v1, pf, o[1]); o[2] = MFMA16(t.v2, pf, o[2]); o[3] = MFMA16(t.v3, pf, o[3]);
}

#define RING4(NSTEPS, LOADSTEP, COMPUTE) do { \
    KV r0_, r1_, r2_; const int nl_ = (NSTEPS) - 1; \
    LOADSTEP(r0_, 0); LOADSTEP(r1_, min(1, nl_)); \
    for (int st_ = 0; st_ < (NSTEPS); st_ += 3) { \
        LOADSTEP(r2_, min(st_ + 2, nl_)); COMPUTE(r0_, st_); \
        LOADSTEP(r0_, min(st_ + 3, nl_)); if (st_ + 1 < (NSTEPS)) COMPUTE(r1_, st_ + 1); \
        LOADSTEP(r1_, min(st_ + 4, nl_)); if (st_ + 2 < (NSTEPS)) COMPUTE(r2_, st_ + 2); \
    } } while (0)

DEV void band_loop(const int tid_, float& m, float& l, f32x4 (&o)[4], const bf16x8& q0, const bf16x8& q1, const char* Kb, int row_bytes, int dsh, int rg,
                   const char* Vb, int vblk0, int ustart, int nsteps, int uq, int uq0, int qspan, int maxd) {
    const int c = tid_ & 15, g4 = (tid_ & 63) >> 4;
    const unsigned kl = g4 * 16, vl = c * 32 + g4 * 8;
    const unsigned lim = (unsigned)min(maxd, uq);
#define BL_LOAD(R, S) do { const int ua_ = ustart + (S) * 32, ub_ = ua_ + 16; \
        load_kv(R, Kb, (unsigned)((max(ua_ + c, 0) << dsh) + rg) * (unsigned)row_bytes + kl, (unsigned)((max(ub_ + c, 0) << dsh) + rg) * (unsigned)row_bytes + kl, \
                Vb, (unsigned)(vblk0 + (max(ua_, 0) >> 4)) * 2048u + vl, (unsigned)(vblk0 + (max(ub_, 0) >> 4)) * 2048u + vl); } while (0)
#define BL_COMP(R, S) do { const int ua_ = ustart + (S) * 32; \
        const bool fast_ = (ua_ >= 0) && (ua_ + 31 <= uq0) && (uq0 + qspan - ua_ <= maxd); \
        flash_core(m, l, o, q0, q1, R, fast_, uq - ua_ - g4 * 4, lim); } while (0)
    RING4(nsteps, BL_LOAD, BL_COMP);
#undef BL_LOAD
#undef BL_COMP
}

DEV void attnA_phase(const Prm& P, int chunk) {
    const int tid_ = opaque_tid();
    unsigned char* ws = P.ws;
    const u16* H = (const u16*)(ws + OFF_H);
    u16* G = (u16*)(ws + OFF_G);
    const int lane = tid_ & 63, w = __builtin_amdgcn_readfirstlane(tid_ >> 6), c = lane & 15, g4 = lane >> 4;
    constexpr int LD = 2560;
    const int xcd_ = blockIdx.x & 7, slot_ = blockIdx.x >> 3, nslot_ = gridDim.x >> 3;
    for (int i_ = slot_; i_ < 128; i_ += nslot_) {
        const int rq = i_ & 3, tbi = i_ >> 2, hh = xcd_ & 3, b = xcd_ >> 2;
        const int r = rq * 4 + w, tb = tbi * 256;
        const int sq = tb + r + 16 * c;
        const size_t rowq = (size_t)b * 8192 + sq;
        float m = NEG_INF, l = 0.f;
        f32x4 o[4];
#pragma unroll
        for (int d = 0; d < 4; ++d) o[d] = f32x4{0.f, 0.f, 0.f, 0.f};
#pragma unroll 1
        for (int g = 0; g < 3; ++g) {
            const int dsh = 2 * g, dmask = (1 << dsh) - 1;
            const int rg = r & dmask;
            const int uq = sq >> dsh, uq0 = (tb + r) >> dsh;
            int ustart = (uq0 - 128) & ~15;
            const int ulast = (uq0 + (15 << (4 - dsh))) & ~15;
            int ntile = ((ulast - ustart) >> 4) + 1;
            if (ntile & 1) { ustart -= 16; ntile += 1; }
            const u16* Hq = H + rowq * LD + g * 768 + hh * 64 + g4 * 8;
            const bf16x8 q0 = *(const bf16x8*)Hq, q1 = *(const bf16x8*)(Hq + 32);
            const char* Kb = (const char*)(H + (size_t)b * 8192 * LD + g * 768 + 256 + hh * 64);
            const char* Vb = (const char*)((const u16*)(ws + (g == 0 ? OFF_VT0 : (g == 1 ? OFF_VT1 : OFF_VT2))) + ((size_t)(b * 4 + hh) * 512) * 1024);
            const int vblk0 = rg * ((8192 >> dsh) >> 4);
            band_loop(tid_, m, l, o, q0, q1, Kb, LD * 2, dsh, rg, Vb, vblk0, ustart, ntile >> 1, uq, uq0, 15 << (4 - dsh), 128);
        }
        l = red16_sum(l);
        const float inv = 1.f / l;
#pragma unroll
        for (int dt = 0; dt < 4; ++dt) {
            const int dh = dt * 16 + g4 * 4;
            const u32x2 z = *(const u32x2*)(H + rowq * LD + 2304 + hh * 64 + dh);
            const float r0 = o[dt][0] * inv * siluf_(bflo(z[0])), r1 = o[dt][1] * inv * siluf_(bfhi(z[0]));
            const float r2 = o[dt][2] * inv * siluf_(bflo(z[1])), r3 = o[dt][3] * inv * siluf_(bfhi(z[1]));
            *(u32x2*)(G + rowq * 1024 + (chunk * 4 + hh) * 64 + dh) = u32x2{pack2(r0, r1), pack2(r2, r3)};
        }
    }
}

DEV void attnB_phase(const Prm& P) {
    const int tid_ = opaque_tid();
    unsigned char* ws = P.ws;
    const u16* H = (const u16*)(ws + OFF_H);
    u16* G = (u16*)(ws + OFF_G);
    const float* sinks = P.in[5];
    const int lane = tid_ & 63, w = __builtin_amdgcn_readfirstlane(tid_ >> 6), c = lane & 15, g4 = lane >> 4;
    constexpr int LD = 2304;
    const int xcd_ = blockIdx.x & 7, slot_ = blockIdx.x >> 3, nslot_ = gridDim.x >> 3;
    for (int tile = slot_; tile < 512; tile += nslot_) {
        const int b = xcd_ >> 2, hq = xcd_ & 3;
        const int head = hq * 4 + w, kvh = head >> 3;
        const int t0 = tile * 16, sq = t0 + c;
        const size_t rowq = (size_t)b * 8192 + sq;
        float m = NEG_INF, l = 0.f;
        f32x4 o[4];
#pragma unroll
        for (int d = 0; d < 4; ++d) o[d] = f32x4{0.f, 0.f, 0.f, 0.f};
        const u16* Hq = H + rowq * LD + head * 64 + g4 * 8;
        const bf16x8 q0 = *(const bf16x8*)Hq, q1 = *(const bf16x8*)(Hq + 32);
        const char* Kb = (const char*)(H + (size_t)b * 8192 * LD + 1024 + kvh * 64);
        const char* Vb = (const char*)((const u16*)(ws + OFF_VT0) + ((size_t)(b * 2 + kvh) * 512) * 1024);
        band_loop(tid_, m, l, o, q0, q1, Kb, LD * 2, 0, 0, Vb, 0, t0 - 144, 5, sq, t0, 15, 127);
        l = red16_sum(l);
        const float mu = (m == NEG_INF) ? 0.f : m;
        const float lf = l + __builtin_amdgcn_exp2f(sinks[head] * 1.4426950408889634f - mu);
        const float inv = 1.f / lf;
#pragma unroll
        for (int dt = 0; dt < 4; ++dt) {
            const int dh = dt * 16 + g4 * 4;
            const u32x2 z = *(const u32x2*)(H + rowq * LD + 1280 + head * 64 + dh);
            const float r0 = o[dt][0] * inv * siluf_(bflo(z[0])), r1 = o[dt][1] * inv * siluf_(bfhi(z[0]));
            const float r2 = o[dt][2] * inv * siluf_(bflo(z[1])), r3 = o[dt][3] * inv * siluf_(bfhi(z[1]));
            *(u32x2*)(G + rowq * 1024 + head * 64 + dh) = u32x2{pack2(r0, r1), pack2(r2, r3)};
        }
    }
}

DEV void compress_phase(const Prm& P) {
    const int tid_ = opaque_tid();
    unsigned char* ws = P.ws;
    const u16* H = (const u16*)(ws + OFF_H);
    constexpr int LD = 3840;
    const float* bias = (const float*)(ws + OFF_BIAS);
    const int lane = tid_ & 63, w = __builtin_amdgcn_readfirstlane(tid_ >> 6), c = lane & 15, g4 = lane >> 4;
    for (int it = blockIdx.x; it < 128; it += gridDim.x) {
        const int unit = it * 4 + w;
        const int which = unit >> 8, b = (unit >> 7) & 1, kvh = (unit >> 5) & 3, ntile = unit & 31;
        const u16* Wt = (const u16*)(ws + (which ? OFF_WCV : OFF_WCK));
        const int colbase = (which ? 1280 : 1024) + kvh * 64;
        const int n = ntile * 16 + c;
        const u16* Wl = Wt + (size_t)c * 2048 + g4 * 8;
        f32x4 acc[4];
#pragma unroll
        for (int e = 0; e < 4; ++e) acc[e] = f32x4{0.f, 0.f, 0.f, 0.f};
#pragma unroll 4
        for (int kk = 0; kk < 64; ++kk) {
            const int j = kk >> 1, d0 = (kk & 1) * 32 + g4 * 8;
            int s = 16 * n + j; s = min(s, 8191);
            const bf16x8 xf = *(const bf16x8*)(H + ((size_t)b * 8192 + s) * LD + colbase + d0);
            bf16x8 wf[4];
#pragma unroll
            for (int e = 0; e < 4; ++e) wf[e] = *(const bf16x8*)(Wl + (size_t)e * 16 * 2048 + kk * 32);
            if (which == 0) {
#pragma unroll
                for (int e = 0; e < 4; ++e) acc[e] = MFMA16(wf[e], xf, acc[e]);
            } else {
#pragma unroll
                for (int e = 0; e < 4; ++e) acc[e] = MFMA16(xf, wf[e], acc[e]);
            }
        }
        if (which == 0) {
            u16* kc = (u16*)(ws + OFF_KCMP) + ((size_t)(b * 512 + n) * 4 + kvh) * 64;
#pragma unroll
            for (int e = 0; e < 4; ++e) {
                const int e0 = e * 16 + g4 * 4;
                const f32x4 bv = *(const f32x4*)(bias + e0);
                const f32x4 r = acc[e] + bv;
                *(u32x2*)(kc + e0) = u32x2{pack2(r[0], r[1]), pack2(r[2], r[3])};
            }
        } else {
            u16* vc = (u16*)(ws + OFF_VCMP) + (((size_t)(b * 4 + kvh) * 32 + ntile) * 64) * 16;
#pragma unroll
            for (int e = 0; e < 4; ++e) {
                const int ee = e * 16 + c;
                const float bv = bias[64 + ee];
                *(u32x2*)(vc + ee * 16 + g4 * 4) = u32x2{pack2(acc[e][0] + bv, acc[e][1] + bv), pack2(acc[e][2] + bv, acc[e][3] + bv)};
            }
        }
    }
}

DEV void attnC_phase(const Prm& P, unsigned char* smem) {
    const int tid_ = opaque_tid();
    unsigned char* ws = P.ws;
    const u16* H = (const u16*)(ws + OFF_H);
    u16* G = (u16*)(ws + OFF_G);
    constexpr int LD = 3840;
    float* imp = (float*)smem;
    float* scb = (float*)(smem + 32768);
    float* oslc = (float*)(smem + 34816);
    const int tid = tid_, lane = tid & 63, w = __builtin_amdgcn_readfirstlane(tid >> 6), c = lane & 15, g4 = lane >> 4;
    const int xcd_ = blockIdx.x & 7, slot_ = blockIdx.x >> 3, nslot_ = gridDim.x >> 3;
    for (int tile = slot_; tile < 512; tile += nslot_) {
        const int b = xcd_ >> 2, kvh = xcd_ & 3;
        const int t0 = tile * 16;
        for (int i = tid; i < 8192; i += 256) imp[i] = 0.f;
        __syncthreads();
        const int head = kvh * 4 + w;
        const size_t rowq = (size_t)b * 8192 + t0 + c;
        const u16* Hq = H + rowq * LD + head * 64 + g4 * 8;
        const bf16x8 q0 = *(const bf16x8*)Hq, q1 = *(const bf16x8*)(Hq + 32);
        f32x4 oacc[4];
#pragma unroll
        for (int d = 0; d < 4; ++d) oacc[d] = f32x4{0.f, 0.f, 0.f, 0.f};
        const int nmax = (t0 + c - 31) >> 4;
        const int nmaxw = (t0 - 16) >> 4;
        const float g0 = sigmoidf_(bf2f(H[rowq * LD + 3584 + head]));
        const float g1 = sigmoidf_(bf2f(H[rowq * LD + 3584 + 16 + head]));
        const float g2 = sigmoidf_(bf2f(H[rowq * LD + 3584 + 32 + head]));
        if (nmaxw >= 0) {
            const int nsteps = (nmaxw >> 5) + 1;
            const char* Kb = (const char*)((const u16*)(ws + OFF_KCMP) + (size_t)b * 512 * 256 + kvh * 64);
            const char* Vb = (const char*)((const u16*)(ws + OFF_VCMP) + ((size_t)(b * 4 + kvh) * 32) * 1024);
            const unsigned kl = g4 * 16, vl = c * 32 + g4 * 8;
            float m = NEG_INF, l = 0.f;
#define CM_LOAD(R, S) do { const int na_ = (S) * 32; load_kv(R, Kb, (unsigned)(na_ + c) * 512u + kl, (unsigned)min(na_ + 16 + c, 511) * 512u + kl, \
        Vb, (unsigned)(na_ >> 4) * 2048u + vl, (unsigned)min((na_ >> 4) + 1, 31) * 2048u + vl); } while (0)
#define CM_PASS1(R, S) do { const int na_ = (S) * 32; f32x4 sa, sb; qk_scores(R, q0, q1, sa, sb); float mx = NEG_INF; float x[8]; \
        _Pragma("unroll") for (int j = 0; j < 8; ++j) { const int n = na_ + (j >> 2) * 16 + g4 * 4 + (j & 3); \
            x[j] = (n <= nmax) ? ((j < 4) ? sa[j & 3] : sb[j & 3]) * 0.125f : NEG_INF; mx = fmaxf(mx, x[j]); } \
        const float mn = fmaxf(m, mx); const float mu = (mn == NEG_INF) ? 0.f : mn; float ps = 0.f; \
        _Pragma("unroll") for (int j = 0; j < 8; ++j) ps += __expf(x[j] - mu); \
        l = l * __expf(m - mu) + ps; m = mn; } while (0)
            RING4(nsteps, CM_LOAD, CM_PASS1);
            float mall = red16_max(m);
            mall = (mall == NEG_INF) ? 0.f : mall;
            l = l * __expf(m - mall);
            l = red16_sum(l);
            const float invl = (l > 0.f) ? 1.f / l : 0.f;
#define CM_PASS2(R, S) do { const int na_ = (S) * 32; f32x4 sa, sb; qk_scores(R, q0, q1, sa, sb); float p[8]; \
        _Pragma("unroll") for (int j = 0; j < 8; ++j) { const int n = na_ + (j >> 2) * 16 + g4 * 4 + (j & 3); \
            const float sv = ((j < 4) ? sa[j & 3] : sb[j & 3]) * 0.125f; \
            p[j] = (n <= nmax) ? __expf(sv - mall) * invl : 0.f; \
            if (n <= nmax) atomicAdd(&imp[n * 16 + c], p[j]); } \
        const bf16x8 pf = pack8(p); \
        oacc[0] = MFMA16(R.v0, pf, oacc[0]); oacc[1] = MFMA16(R.v1, pf, oacc[1]); \
        oacc[2] = MFMA16(R.v2, pf, oacc[2]); oacc[3] = MFMA16(R.v3, pf, oacc[3]); } while (0)
            RING4(nsteps, CM_LOAD, CM_PASS2);
#undef CM_LOAD
#undef CM_PASS1
#undef CM_PASS2
#pragma unroll
            for (int d = 0; d < 4; ++d) oacc[d] *= g0;
        }
        {
            float m = NEG_INF, l = 0.f;
            f32x4 o[4];
#pragma unroll
            for (int d = 0; d < 4; ++d) o[d] = f32x4{0.f, 0.f, 0.f, 0.f};
            const char* Kb = (const char*)(H + (size_t)b * 8192 * LD + 2048 + kvh * 64);
            const char* Vb = (const char*)((const u16*)(ws + OFF_VT1) + ((size_t)(b * 4 + kvh) * 512) * 1024);
            band_loop(tid_, m, l, o, q0, q1, Kb, LD * 2, 0, 0, Vb, 0, t0 - 528, 17, t0 + c, t0, 15, 511);
            l = red16_sum(l);
            const float sc = g2 / l;
#pragma unroll
            for (int d = 0; d < 4; ++d) oacc[d] += o[d] * sc;
        }
        __syncthreads();
        unsigned long long* msk = (unsigned long long*)(smem + 51200) + w * 8;
#pragma unroll 1
        for (int i = 0; i < 4; ++i) {
            const int tok = 4 * w + i, tq = t0 + tok, cur = tq >> 6;
            float my0, my1;
            {
                const int j0 = lane, j1 = lane + 64;
                float a0 = 2.f * (imp[(4 * j0) * 16 + tok] + imp[(4 * j0 + 1) * 16 + tok] + imp[(4 * j0 + 2) * 16 + tok]) + imp[(4 * j0 + 3) * 16 + tok];
                if (j0 > 0) a0 += imp[(4 * j0 - 1) * 16 + tok];
                const float a1 = 2.f * (imp[(4 * j1) * 16 + tok] + imp[(4 * j1 + 1) * 16 + tok] + imp[(4 * j1 + 2) * 16 + tok]) + imp[(4 * j1 + 3) * 16 + tok]
                                 + imp[(4 * j1 - 1) * 16 + tok];
                const bool f0 = (j0 == 0) || (j0 == cur) || (j0 == cur - 1);
                const bool f1 = (j1 == cur) || (j1 == cur - 1);
                my0 = f0 ? 1e4f : ((j0 <= cur) ? a0 : -1.f);
                my1 = f1 ? 1e4f : ((j1 <= cur) ? a1 : -1.f);
            }
            __builtin_amdgcn_fence(__ATOMIC_RELEASE, "wavefront"); __builtin_amdgcn_wave_barrier(); __builtin_amdgcn_fence(__ATOMIC_ACQUIRE, "wavefront");
            scb[w * 128 + lane] = my0; scb[w * 128 + 64 + lane] = my1;
            __builtin_amdgcn_fence(__ATOMIC_RELEASE, "wavefront"); __builtin_amdgcn_wave_barrier(); __builtin_amdgcn_fence(__ATOMIC_ACQUIRE, "wavefront");
            int c0 = 0, c1 = 0;
            const int jend = min(128, ((cur + 8) & ~7));
#pragma unroll 8
            for (int jj = 0; jj < jend; ++jj) {
                const float sv = scb[w * 128 + jj];
                c0 += (sv > my0 || (sv == my0 && jj < lane)) ? 1 : 0;
                c1 += (sv > my1 || (sv == my1 && jj < lane + 64)) ? 1 : 0;
            }
            const unsigned long long lo = __ballot((c0 < 16) && (lane <= cur));
            const unsigned long long hi = __ballot((c1 < 16) && (lane + 64 <= cur));
            if (lane == 0) { msk[i * 2] = lo; msk[i * 2 + 1] = hi; }
        }
        __builtin_amdgcn_fence(__ATOMIC_RELEASE, "wavefront"); __builtin_amdgcn_wave_barrier(); __builtin_amdgcn_fence(__ATOMIC_ACQUIRE, "wavefront");
        {
            const int tokL = 4 * w + (c >> 2), tq = t0 + tokL, hd = kvh * 4 + (c & 3);
            const size_t rq = (size_t)b * 8192 + tq;
            const u16* Hs = H + rq * LD + hd * 64 + g4 * 8;
            const bf16x8 s0 = *(const bf16x8*)Hs, s1 = *(const bf16x8*)(Hs + 32);
            const char* Kb = (const char*)(H + (size_t)b * 8192 * LD + 1536 + kvh * 64);
            const char* Vb = (const char*)((const u16*)(ws + OFF_VT0) + ((size_t)(b * 4 + kvh) * 512) * 1024);
            const unsigned kl = g4 * 16, vl = c * 32 + g4 * 8;
            float m = NEG_INF, l = 0.f;
            f32x4 o[4];
#pragma unroll
            for (int d = 0; d < 4; ++d) o[d] = f32x4{0.f, 0.f, 0.f, 0.f};
            const int ti = c >> 2;
            const unsigned long long mylo = msk[ti * 2], myhi = msk[ti * 2 + 1];
            const unsigned long long ulo = msk[0] | msk[2] | msk[4] | msk[6];
            const unsigned long long uhi = msk[1] | msk[3] | msk[5] | msk[7];
            const unsigned long long alo = msk[0] & msk[2] & msk[4] & msk[6], ahi = msk[1] & msk[3] & msk[5] & msk[7];
            int* blist = (int*)(scb + w * 128);
            const int nlo = __builtin_popcountll(ulo), nblk = nlo + __builtin_popcountll(uhi);
            if ((ulo >> lane) & 1ull) blist[__builtin_popcountll(ulo & ((1ull << lane) - 1ull))] = lane;
            if ((uhi >> lane) & 1ull) blist[nlo + __builtin_popcountll(uhi & ((1ull << lane) - 1ull))] = 64 + lane;
            __builtin_amdgcn_fence(__ATOMIC_RELEASE, "wavefront");
            __builtin_amdgcn_wave_barrier();
            __builtin_amdgcn_fence(__ATOMIC_ACQUIRE, "wavefront");
            const int nst = 2 * nblk;
#define SL_LOAD(R, S) do { const int j_ = __builtin_amdgcn_readfirstlane(blist[(S) >> 1]); const int ua_ = j_ * 64 + ((S) & 1) * 32; \
        load_kv(R, Kb, (unsigned)(ua_ + c) * (unsigned)(LD * 2) + kl, (unsigned)(ua_ + 16 + c) * (unsigned)(LD * 2) + kl, \
                Vb, (unsigned)(ua_ >> 4) * 2048u + vl, (unsigned)((ua_ >> 4) + 1) * 2048u + vl); } while (0)
#define SL_COMP(R, S) do { const int j_ = __builtin_amdgcn_readfirstlane(blist[(S) >> 1]); const int ua_ = j_ * 64 + ((S) & 1) * 32; \
        const bool selj = (j_ < 64) ? ((mylo >> j_) & 1ull) : ((myhi >> (j_ - 64)) & 1ull); \
        const bool alls_ = (j_ < 64) ? ((alo >> j_) & 1ull) : ((ahi >> (j_ - 64)) & 1ull); \
        const bool fast_ = alls_ && (ua_ + 31 <= t0 + 4 * w); \
        flash_core(m, l, o, s0, s1, R, fast_, selj ? (tq - ua_ - g4 * 4) : -(1 << 30), 0x7fffffffu); } while (0)
            RING4(nst, SL_LOAD, SL_COMP);
#undef SL_LOAD
#undef SL_COMP
            l = red16_sum(l);
            const float inv = 1.f / l;
#pragma unroll
            for (int dt = 0; dt < 4; ++dt)
                *(f32x4*)(oslc + (tokL * 4 + (c & 3)) * 64 + dt * 16 + g4 * 4) = o[dt] * inv;
        }
        __syncthreads();
#pragma unroll
        for (int dt = 0; dt < 4; ++dt) {
            const int dh = dt * 16 + g4 * 4;
            const f32x4 os = *(const f32x4*)(oslc + (c * 4 + w) * 64 + dh);
            const f32x4 r = oacc[dt] + os * g1;
            const u32x2 z = *(const u32x2*)(H + rowq * LD + 2560 + head * 64 + dh);
            const float r0 = r[0] * siluf_(bflo(z[0])), r1 = r[1] * siluf_(bfhi(z[0]));
            const float r2 = r[2] * siluf_(bflo(z[1])), r3 = r[3] * siluf_(bfhi(z[1]));
            *(u32x2*)(G + rowq * 1024 + head * 64 + dh) = u32x2{pack2(r0, r1), pack2(r2, r3)};
        }
        __syncthreads();
    }
}

#ifndef PROBE_DUP
#define PROBE_DUP 0
#endif
#define REP(k) for (int rep_ = 0; rep_ < 1 + ((PROBE_DUP >> (k)) & 1); ++rep_)
constexpr int LDS_BYTES = 3 * GSTAGE + 64;
__global__ void __launch_bounds__(256, 2) mk_fwd(Prm P) {
    extern __shared__ __attribute__((aligned(16))) unsigned char smem[];
    unsigned* xb_words = (unsigned*)(smem + 3 * GSTAGE);
    if (threadIdx.x < 4) xb_words[threadIdx.x] = 0u;
    __syncthreads();
    XcdBarrier bar = xcd_barrier_post((unsigned*)(P.ws + OFF_BAR), (volatile LAS unsigned*)xb_words);
    unsigned char* ws = P.ws;

    phase0(P, smem);
    cg::this_grid().sync();

#pragma unroll 1
    for (int layer = 0; layer < 4; ++layer) {
        const int kind = layer % 3, lj = layer / 3;
        const u16* Win; const u16* Wout; int N, nsub;
        if (kind == 0)      { Win = (const u16*)(ws + OFF_WA_IN + (size_t)lj * SZ_WA_IN); Wout = (const u16*)(ws + OFF_WA_OUT + (size_t)lj * SZ_SQ); N = 2560; nsub = 4; }
        else if (kind == 1) { Win = (const u16*)(ws + OFF_WB_IN); Wout = (const u16*)(ws + OFF_WB_OUT); N = 2304; nsub = 1; }
        else                { Win = (const u16*)(ws + OFF_WC_IN); Wout = (const u16*)(ws + OFF_WC_OUT); N = 3840; nsub = 1; }
#pragma unroll 1
        for (int sub = 0; sub < nsub; ++sub) {
            REP(0) gemm_in_phase(smem, P, kind, Win + (size_t)sub * 2560 * 1024, N);
            xcd_barrier(bar);
            if (kind == 0) REP(1) attnA_phase(P, sub);
            else if (kind == 1) REP(2) attnB_phase(P);
            else { REP(3) compress_phase(P); xcd_barrier(bar); REP(4) attnC_phase(P, smem); }
            xcd_barrier(bar);
        }
        gemm_out_phase(smem, P, Wout, layer == 0 ? P.in[0] : P.out);
        xcd_barrier(bar);
        ln_phase(P, layer);
        xcd_barrier(bar);
        gemm_gate_phase(smem, P, (const u16*)(ws + OFF_WG + (size_t)layer * SZ_SQ), (const u16*)(ws + OFF_WP + (size_t)layer * SZ_WP));
        if (layer < 3) xcd_barrier(bar);
    }
}

extern "C" void kernel_launch(void* const* d_in, const int* in_sizes, int n_in, void* d_out, int out_size, void* d_ws, size_t ws_size,
                              hipStream_t stream) {
    static int grid_blocks = 0;
    if (!grid_blocks) {
        int dev = 0, cus = 0, per_cu = 0;
        (void)hipGetDevice(&dev);
        (void)hipDeviceGetAttribute(&cus, hipDeviceAttributeMultiprocessorCount, dev);
        (void)hipFuncSetAttribute((const void*)mk_fwd, hipFuncAttributeMaxDynamicSharedMemorySize, LDS_BYTES);
        (void)hipOccupancyMaxActiveBlocksPerMultiprocessor(&per_cu, (const void*)mk_fwd, 256, LDS_BYTES);
        if (per_cu > 2) per_cu = 2;
        if (per_cu < 1) per_cu = 1;
        grid_blocks = cus * per_cu;
        if (ws_size < WS_END || n_in != 16) { fprintf(stderr, "kernel_launch: workspace too small (%zu < %zu) or n_in %d != 16\n", ws_size, (size_t)WS_END, n_in); grid_blocks = -1; }
    }
    if (grid_blocks < 0) return;
    (void)hipMemsetAsync((char*)d_ws + OFF_BAR, 0, 16384, stream);
    Prm p{};
    for (int i = 0; i < 16; ++i) p.in[i] = (const float*)d_in[i];
    p.out = (float*)d_out; p.ws = (unsigned char*)d_ws;
    void* args[] = {&p};
    hipError_t e = hipLaunchCooperativeKernel((const void*)mk_fwd, dim3(grid_blocks), dim3(256), args, LDS_BYTES, stream);
    if (e != hipSuccess) fprintf(stderr, "cooperative launch failed: %s (grid %d)\n", hipGetErrorString(e), grid_blocks);
}
```

```cpp
#include <hip/hip_runtime.h>
#include <hip/hip_cooperative_groups.h>
#include <cstdio>
#include <cstdint>
namespace cg = cooperative_groups;

typedef unsigned short u16;
using bf16x8 = __attribute__((ext_vector_type(8))) short;
using s16x4  = __attribute__((ext_vector_type(4))) short;
using f32x4  = __attribute__((ext_vector_type(4))) float;
using u32x4  = __attribute__((ext_vector_type(4))) unsigned;
using u32x2  = __attribute__((ext_vector_type(2))) unsigned;
#define DEV __device__ __forceinline__
using h16x8 = __attribute__((ext_vector_type(8))) _Float16;
#define MFMA16(a, b, c) __builtin_amdgcn_mfma_f32_16x16x32_f16(__builtin_bit_cast(h16x8, (a)), __builtin_bit_cast(h16x8, (b)), (c), 0, 0, 0)
#define LAS __attribute__((address_space(3)))

constexpr int T = 16384, S = 8192;
constexpr float LN_EPS = 1e-5f;
constexpr float DN_ALPHA = 1.6817928305074290f;
constexpr float NEG_INF = -__builtin_huge_valf();

constexpr size_t OFF_BAR   = 0;
constexpr size_t OFF_COS   = 16384;
constexpr size_t OFF_SIN   = OFF_COS + (size_t)8192 * 32 * 4;
constexpr size_t OFF_BIAS  = OFF_SIN + (size_t)8192 * 32 * 4;
constexpr size_t OFF_WA_IN = OFF_BIAS + 1024;
constexpr size_t SZ_WA_IN  = (size_t)10240 * 1024 * 2;
constexpr size_t SZ_SQ     = (size_t)1024 * 1024 * 2;
constexpr size_t OFF_WA_OUT = OFF_WA_IN + 2 * SZ_WA_IN;
constexpr size_t OFF_WB_IN  = OFF_WA_OUT + 2 * SZ_SQ;
constexpr size_t OFF_WB_OUT = OFF_WB_IN + (size_t)2304 * 1024 * 2;
constexpr size_t OFF_WC_IN  = OFF_WB_OUT + SZ_SQ;
constexpr size_t OFF_WC_OUT = OFF_WC_IN + (size_t)3840 * 1024 * 2;
constexpr size_t OFF_WG     = OFF_WC_OUT + SZ_SQ;
constexpr size_t OFF_WP     = OFF_WG + 4 * SZ_SQ;
constexpr size_t SZ_WP      = (size_t)1024 * 256 * 2;
constexpr size_t OFF_WCK    = OFF_WP + 4 * SZ_WP;
constexpr size_t OFF_WCV    = OFF_WCK + (size_t)64 * 2048 * 2;
constexpr size_t OFF_XB     = OFF_WCV + (size_t)64 * 2048 * 2;
constexpr size_t SZ_ACT     = (size_t)T * 1024 * 2;
constexpr size_t OFF_G      = OFF_XB + SZ_ACT;
constexpr size_t OFF_H      = OFF_G + SZ_ACT;
constexpr size_t SZ_HMAX    = (size_t)T * 3840 * 2;
constexpr size_t OFF_VT0    = OFF_H + SZ_HMAX;
constexpr size_t SZ_VT      = (size_t)2 * 4 * 8192 * 64 * 2;
constexpr size_t OFF_VT1    = OFF_VT0 + SZ_VT;
constexpr size_t OFF_VT2    = OFF_VT1 + SZ_VT;
constexpr size_t OFF_KCMP   = OFF_VT2 + SZ_VT;
constexpr size_t SZ_CMP     = (size_t)2 * 512 * 4 * 64 * 2;
constexpr size_t OFF_VCMP   = OFF_KCMP + SZ_CMP;
constexpr size_t OFF_KI0    = OFF_VCMP + SZ_CMP;
constexpr size_t OFF_KI1    = OFF_KI0 + SZ_VT;
constexpr size_t OFF_KI2    = OFF_KI1 + SZ_VT;
constexpr size_t WS_END     = OFF_KI2 + SZ_VT;
constexpr size_t OFF_XLB    = OFF_H;
constexpr size_t OFF_PB     = OFF_H + SZ_ACT;
constexpr size_t OFF_PP     = OFF_H + SZ_ACT + (size_t)16 * 1024 * 1024;

struct Prm { const float* in[16]; float* out; unsigned char* ws; };

__device__ __forceinline__ size_t kb_off(int row, int k, int K) { return ((size_t)(row >> 4) * (K >> 5) + (k >> 5)) * 512 + (row & 15) * 32 + (k & 31); }
DEV u16 f2bf(float f) { return __builtin_bit_cast(u16, (_Float16)f); }
DEV float bf2f(u16 h) { return (float)__builtin_bit_cast(_Float16, h); }
DEV unsigned pack2(float a, float b) { return (unsigned)f2bf(a) | ((unsigned)f2bf(b) << 16); }
DEV float bflo(unsigned u) { return bf2f((u16)(u & 0xffffu)); }
DEV float bfhi(unsigned u) { return bf2f((u16)(u >> 16)); }
DEV float sigmoidf_(float x) { return 1.f / (1.f + __expf(-x)); }
DEV float siluf_(float x) { return x / (1.f + __expf(-x)); }
DEV float red16_max(float v) { v = fmaxf(v, __shfl_xor(v, 16)); v = fmaxf(v, __shfl_xor(v, 32)); return v; }
DEV float red16_sum(float v) { v += __shfl_xor(v, 16); v += __shfl_xor(v, 32); return v; }
DEV float wave_sum(float v) { for (int o = 32; o > 0; o >>= 1) v += __shfl_xor(v, o); return v; }

DEV int opaque_tid() { int t = threadIdx.x; asm volatile("" : "+v"(t)); return t; }
#define XB_TMO      128
#define XB_XCNT(j)  (256  + 64 * (j))
#define XB_XSUB(j)  (1280 + 64 * (j))
#define XB_XGEN(j)  (2304 + 64 * (j))
#define XB_TOP      3328
#define XB_TOPGEN   3392
#define XCD_BAR_WORDS 3456
#define XB_SPIN_CAP (1u << 24)
DEV unsigned xb_ld(unsigned* p)              { return __hip_atomic_load(p, __ATOMIC_RELAXED, __HIP_MEMORY_SCOPE_AGENT); }
DEV unsigned xb_add(unsigned* p, unsigned v) { return __hip_atomic_fetch_add(p, v, __ATOMIC_RELAXED, __HIP_MEMORY_SCOPE_AGENT); }
DEV unsigned xb_xcc_id() { return (unsigned)__builtin_amdgcn_s_getreg((3 << 11) | 20) & 0xFu; }
#define XB_SPIN(cond, bar) do { unsigned _sp = 0; while (cond) { __builtin_amdgcn_s_sleep(1); \
    if ((++_sp & 255u) == 0u) { if (xb_ld(&(bar)[XB_TMO])) break; if (_sp > XB_SPIN_CAP) { atomicAdd(&(bar)[XB_TMO], 1u); break; } } } } while (0)
struct XcdBarrier { unsigned* bar; unsigned x; volatile LAS unsigned* st; };
DEV XcdBarrier xcd_barrier_post(unsigned* bar, volatile LAS unsigned* st) {
    XcdBarrier b; b.bar = bar; b.x = xb_xcc_id(); b.st = st;
    if (threadIdx.x == 0) (void)xb_add(&bar[XB_XCNT(b.x)], 1u);
    return b;
}
DEV void xcd_barrier_complete(unsigned* bar, unsigned x, unsigned& nloc, unsigned& nx) {
    const unsigned G = gridDim.x * gridDim.y * gridDim.z;
    unsigned sum, cnt, mine, sp = 0u;
    for (;;) {
        sum = 0u; cnt = 0u; mine = 0u;
#pragma unroll
        for (unsigned j = 0; j < 16; ++j) { const unsigned c = xb_ld(&bar[XB_XCNT(j)]); sum += c; cnt += (c > 0u) ? 1u : 0u; mine = (j == x) ? c : mine; }
        if (sum == G) break;
        __builtin_amdgcn_s_sleep(1);
        if ((++sp & 255u) == 0u) { if (xb_ld(&bar[XB_TMO])) break; if (sp > XB_SPIN_CAP) { atomicAdd(&bar[XB_TMO], 1u); break; } }
    }
    nloc = mine > 0u ? mine : 1u; nx = cnt > 0u ? cnt : 1u;
}
DEV void xcd_barrier(const XcdBarrier& b) {
    asm volatile("s_waitcnt vmcnt(0)" ::: "memory");
    __syncthreads();
    if (threadIdx.x == 0) {
        unsigned* bar = b.bar;
        __builtin_amdgcn_s_waitcnt(0);
        unsigned nloc = b.st[0], nx = b.st[1];
        if (nloc == 0u) { xcd_barrier_complete(bar, b.x, nloc, nx); b.st[0] = nloc; b.st[1] = nx; }
        const unsigned old = xb_add(&bar[XB_XSUB(b.x)], 1u);
        const unsigned gen = old / nloc;
        if (old + 1u == (gen + 1u) * nloc) {
            __builtin_amdgcn_fence(__ATOMIC_RELEASE, "agent");
            asm volatile("s_waitcnt vmcnt(0)" ::: "memory");
            const unsigned og = xb_add(&bar[XB_TOP], 1u);
            const unsigned tg = og / nx;
            if (og + 1u == (tg + 1u) * nx) xb_add(&bar[XB_TOPGEN], 1u);
            else XB_SPIN(xb_ld(&bar[XB_TOPGEN]) == tg, bar);
            __builtin_amdgcn_fence(__ATOMIC_ACQUIRE, "agent");
            xb_add(&bar[XB_XGEN(b.x)], 1u);
            asm volatile("s_waitcnt vmcnt(0)" ::: "memory");
        } else {
            XB_SPIN(xb_ld(&bar[XB_XGEN(b.x)]) == gen, bar);
            __builtin_amdgcn_fence(__ATOMIC_ACQUIRE, "agent");
            asm volatile("s_waitcnt vmcnt(0)" ::: "memory");
        }
    }
    __syncthreads();
}

DEV int colmap(int kind, int n) {
    if (kind == 0) return n;
    if (kind == 1) {
        const int c = n / 2560, nn = n - c * 2560;
        if (nn < 2304) { const int g = nn / 768, rem = nn - g * 768, part = rem >> 8, hh = (rem & 255) >> 6, d = rem & 63;
                         return g * 3072 + part * 1024 + (c * 4 + hh) * 64 + d; }
        const int z = nn - 2304; return 9216 + (c * 4 + (z >> 6)) * 64 + (z & 63);
    }
    if (n < 2560) return n;
    if (n < 3584) return n - 2560 + 2608;
    if (n < 3632) return n - 3584 + 2560;
    return -1;
}
DEV void tconv(const int tid_, float* lds, const float* __restrict__ src, int K, int Nsrc, u16* __restrict__ dst, int Ndst, int kind, int& acc_tiles) {
    const int G = gridDim.x, tid = tid_;
    const int ntn = Ndst >> 6, ntk = K >> 6, nt = ntn * ntk;
    int first = ((int)blockIdx.x - (acc_tiles % G) + G) % G;
    acc_tiles += nt;
    for (int t = first; t < nt; t += G) {
        const int tn = t / ntk, tk = t - tn * ntk;
        const int n0 = tn << 6, k0 = tk << 6;
        const int nl = tid & 63;
        const int c = colmap(kind, n0 + nl);
#pragma unroll
        for (int i = 0; i < 16; ++i) {
            const int kl = (tid >> 6) + 4 * i;
            const float v = (c >= 0) ? src[(size_t)(k0 + kl) * Nsrc + c] : 0.f;
            lds[kl * 65 + nl] = v;
        }
        __syncthreads();
        const int r = tid >> 2, kk = (tid & 3) << 4;
        unsigned o[8];
#pragma unroll
        for (int i = 0; i < 8; ++i) o[i] = pack2(lds[(kk + 2 * i) * 65 + r], lds[(kk + 2 * i + 1) * 65 + r]);
        u32x4* dp = (u32x4*)(dst + kb_off(n0 + r, k0 + kk, K));
        dp[0] = u32x4{o[0], o[1], o[2], o[3]};
        dp[1] = u32x4{o[4], o[5], o[6], o[7]};
        __syncthreads();
    }
}

DEV void phase0(const Prm& P, unsigned char* smem) {
    const int tid_ = opaque_tid();
    float* lds = (float*)smem;
    unsigned char* ws = P.ws;
    int acc = 0;
    tconv(tid_, lds, P.in[2], 1024, 10240, (u16*)(ws + OFF_WA_IN), 10240, 1, acc);
    tconv(tid_, lds, P.in[2] + (size_t)1024 * 10240, 1024, 10240, (u16*)(ws + OFF_WA_IN + SZ_WA_IN), 10240, 1, acc);
    tconv(tid_, lds, P.in[3], 1024, 1024, (u16*)(ws + OFF_WA_OUT), 1024, 0, acc);
    tconv(tid_, lds, P.in[3] + (size_t)1024 * 1024, 1024, 1024, (u16*)(ws + OFF_WA_OUT + SZ_SQ), 1024, 0, acc);
    tconv(tid_, lds, P.in[4], 1024, 2304, (u16*)(ws + OFF_WB_IN), 2304, 0, acc);
    tconv(tid_, lds, P.in[6], 1024, 1024, (u16*)(ws + OFF_WB_OUT), 1024, 0, acc);
    tconv(tid_, lds, P.in[7], 1024, 3632, (u16*)(ws + OFF_WC_IN), 3840, 2, acc);
    tconv(tid_, lds, P.in[11], 1024, 1024, (u16*)(ws + OFF_WC_OUT), 1024, 0, acc);
    for (int i = 0; i < 4; ++i) {
        tconv(tid_, lds, P.in[15] + (size_t)i * 1024 * 1024, 1024, 1024, (u16*)(ws + OFF_WG + i * SZ_SQ), 1024, 0, acc);
        tconv(tid_, lds, P.in[14] + (size_t)i * 256 * 1024, 256, 1024, (u16*)(ws + OFF_WP + i * SZ_WP), 1024, 0, acc);
    }
    tconv(tid_, lds, P.in[8], 2048, 64, (u16*)(ws + OFF_WCK), 64, 0, acc);
    tconv(tid_, lds, P.in[9], 2048, 64, (u16*)(ws + OFF_WCV), 64, 0, acc);

    const size_t gtid = (size_t)blockIdx.x * 256 + tid_, gsz = (size_t)gridDim.x * 256;
    {
        const float* x = P.in[0]; u16* xb = (u16*)(ws + OFF_XB);
        for (size_t i = gtid; i < (size_t)T * 1024 / 8; i += gsz) {
            const f32x4 a = *(const f32x4*)(x + i * 8), b = *(const f32x4*)(x + i * 8 + 4);
            *(u32x4*)(xb + kb_off((int)(i >> 7), (int)(i & 127) * 8, 1024)) = u32x4{pack2(a[0], a[1]), pack2(a[2], a[3]), pack2(b[0], b[1]), pack2(b[2], b[3])};
        }
    }
    {
        float* ct = (float*)(ws + OFF_COS); float* st = (float*)(ws + OFF_SIN);
        for (size_t i = gtid; i < (size_t)8192 * 32; i += gsz) {
            const int pos = (int)(i >> 5), k = (int)(i & 31);
            const float inv = (float)(1.0 / pow(10000.0, (double)(2 * k) / 64.0));
            const float ang = (float)pos * inv;
            ct[i] = (float)cos((double)ang); st[i] = (float)sin((double)ang);
        }
    }
    {
        const int lane = tid_ & 63;
        const int wid = blockIdx.x * 4 + __builtin_amdgcn_readfirstlane(tid_ >> 6);
        if (wid < 128) {
            const float* w = (wid < 64) ? P.in[8] : P.in[9];
            const int e = wid & 63;
            float s = 0.f;
            for (int jd = lane; jd < 2048; jd += 64) s += P.in[10][jd] * w[(size_t)jd * 64 + e];
            s = wave_sum(s);
            if (lane == 0) ((float*)(ws + OFF_BIAS))[wid] = s;
        }
    }
}

constexpr int GSTAGE = 24576;
DEV int gsw(int r) { return (0x78 >> (2 * ((r >> 2) & 3))) & 3; }
DEV void gemm_issue(unsigned char* stage, const u16* ag0, const u16* ag1, const u16* bg, int bstep, int kt, int w) {
    __builtin_amdgcn_global_load_lds((const unsigned*)(ag0 + kt * 512), (unsigned*)(stage + w * 1024), 16, 0, 0);
    __builtin_amdgcn_global_load_lds((const unsigned*)(ag1 + kt * 512), (unsigned*)(stage + w * 1024 + 4096), 16, 0, 0);
#pragma unroll
    for (int i = 0; i < 4; ++i)
        __builtin_amdgcn_global_load_lds((const unsigned*)(bg + (size_t)i * bstep + kt * 512), (unsigned*)(stage + 8192 + w * 1024 + i * 4096), 16, 0, 0);
}
template <bool NONSWAP>
DEV void gemm_mainloop(const int tid_, unsigned char* smem, const u16* __restrict__ A, int lda, const u16* __restrict__ Bt, int ldb, int K,
                       int m0, int n0, f32x4 (&acc)[32], bool aperm = false) {
    const int tid = tid_, lane = tid & 63, w = __builtin_amdgcn_readfirstlane(tid >> 6), wm = w >> 1, wn = w & 1;
    const int lrow = tid >> 2, lsw = ((tid & 3) ^ gsw(lrow)) * 8;
    const int arow0 = aperm ? ((lrow & 31) * 4 + (lrow >> 5)) : lrow;
    const int arow1 = aperm ? (arow0 + 2) : (lrow + 64);
    const u16* ag0 = A + kb_off(m0 + arow0, 0, lda) + lsw;
    const u16* ag1 = A + kb_off(m0 + arow1, 0, lda) + lsw;
    const u16* bg = Bt + kb_off(n0 + lrow, 0, ldb) + lsw;
    const int bstep = 4 * (ldb >> 5) * 512;
    const int fr = lane & 15, fq = lane >> 4;
    const int coff = (fq ^ gsw(fr)) << 4;
    const int a_base = (wm * 64 + fr) * 64 + coff, b_base = 8192 + (wn * 128 + fr) * 64 + coff;
    const int nk = K >> 5;
    asm volatile("s_waitcnt vmcnt(0)" ::: "memory");
    __builtin_amdgcn_s_barrier();
    gemm_issue(smem, ag0, ag1, bg, bstep, 0, w);
    gemm_issue(smem + GSTAGE, ag0, ag1, bg, bstep, 1, w);
    int sc = 0, si = 2;
    for (int kt = 0; kt < nk; ++kt) {
        if (kt + 1 < nk) asm volatile("s_waitcnt vmcnt(6)" ::: "memory"); else asm volatile("s_waitcnt vmcnt(0)" ::: "memory");
        __builtin_amdgcn_s_barrier();
        if (kt + 2 < nk) { gemm_issue(smem + si * GSTAGE, ag0, ag1, bg, bstep, kt + 2, w); si = (si == 2) ? 0 : si + 1; }
        const unsigned char* st = smem + sc * GSTAGE; sc = (sc == 2) ? 0 : sc + 1;
        bf16x8 a[4], b[8];
#pragma unroll
        for (int i = 0; i < 4; ++i) a[i] = *(const bf16x8*)(st + a_base + i * 1024);
#pragma unroll
        for (int i = 0; i < 8; ++i) b[i] = *(const bf16x8*)(st + b_base + i * 1024);
        if (NONSWAP) {
#pragma unroll
            for (int mt = 0; mt < 4; ++mt)
#pragma unroll
                for (int nt = 0; nt < 8; ++nt) acc[mt * 8 + nt] = MFMA16(a[mt], b[nt], acc[mt * 8 + nt]);
        } else {
#pragma unroll
            for (int nt = 0; nt < 8; ++nt)
#pragma unroll
                for (int mt = 0; mt < 4; ++mt) acc[nt * 4 + mt] = MFMA16(b[nt], a[mt], acc[nt * 4 + mt]);
        }
    }
}

DEV int vblock() { const int G = gridDim.x, b = blockIdx.x; return ((G & 7) == 0) ? (b & 7) * (G >> 3) + (b >> 3) : b; }
DEV void tile_mn(int t, int nN, int& mi, int& ni) { const int per = 16 * nN; const int mg = t / per, r = t - mg * per; mi = mg * 16 + (r & 15); ni = r >> 4; }
#define ZERO_ACC(acc) _Pragma("unroll") for (int i_ = 0; i_ < 32; ++i_) acc[i_] = f32x4{0.f, 0.f, 0.f, 0.f}

DEV void classify(int kind, int cgi, int& mode, int& vsel, int& vth, int& dsh, int& nhv, int& ksel) {
    mode = 0; vsel = 0; vth = 0; dsh = 0; nhv = 4; ksel = -1;
    if (kind == 0) {
        if (cgi < 36) { const int g = cgi / 12, part = (cgi - g * 12) >> 2; vth = cgi & 3; if (part < 2) { mode = 1; if (part == 1) { ksel = g; dsh = 2 * g; } } else { mode = 2; vsel = g; dsh = 2 * g; } }
    } else if (kind == 1) {
        if (cgi < 16) mode = 1; else if (cgi < 18) { mode = 1; ksel = 0; vth = cgi - 16; nhv = 2; } else if (cgi < 20) { mode = 2; vsel = 0; vth = cgi - 18; nhv = 2; }
    } else {
        if (cgi < 20) mode = 1; else if (cgi < 24) mode = 0; else if (cgi < 28) { mode = 1; ksel = 0; vth = cgi - 24; } else if (cgi < 32) { mode = 2; vsel = 0; vth = cgi - 28; }
        else if (cgi < 36) { mode = 1; ksel = 1; vth = cgi - 32; } else if (cgi < 40) { mode = 2; vsel = 1; vth = cgi - 36; }
    }
}

DEV void gemm_in_phase(unsigned char* smem, const Prm& P, int kind, const u16* Wt, int N) {
    const int tid_ = opaque_tid();
    unsigned char* ws = P.ws;
    const u16* A = (const u16*)(ws + OFF_XB);
    u16* H = (u16*)(ws + OFF_H);
    const float* cosT = (const float*)(ws + OFF_COS); const float* sinT = (const float*)(ws + OFF_SIN);
    const int nN = N >> 8, ntiles = 128 * nN;
    const int lane = tid_ & 63, w = __builtin_amdgcn_readfirstlane(tid_ >> 6), wm = w >> 1, wn = w & 1, fr = lane & 15, fq = lane >> 4;
    for (int t = vblock(); t < ntiles; t += gridDim.x) {
        int mi, ni; tile_mn(t, nN, mi, ni);
        const int m0 = mi << 7, n0 = ni << 8;
        const int ncol = n0 + wn * 128, cg0 = ncol >> 6;
        int mode, vsel, vth, dsh, nhv, ksel; classify(kind, cg0, mode, vsel, vth, dsh, nhv, ksel);
        const int mw = m0 + wm * 64;
        f32x4 acc[32]; ZERO_ACC(acc);
        if (mode == 2) {
            gemm_mainloop<true>(tid_, smem, A, 1024, Wt, 1024, 1024, m0, n0, acc, dsh == 2);
            __builtin_amdgcn_s_barrier();
            u16* vt = (u16*)(ws + (vsel == 0 ? OFF_VT0 : (vsel == 1 ? OFF_VT1 : OFF_VT2)));
            if (dsh == 0) {
#pragma unroll
                for (int mt = 0; mt < 4; ++mt) {
                    const int m = mw + mt * 16 + fq * 4;
                    const int b = m >> 13, p = m & 8191;
#pragma unroll
                    for (int grp = 0; grp < 2; ++grp) {
                        u16* dst = vt + ((((size_t)(b * nhv + vth + grp)) * 512 + (p >> 4)) * 64) * 16 + (p & 15);
#pragma unroll
                        for (int nt = 0; nt < 4; ++nt) { const f32x4 v = acc[mt * 8 + grp * 4 + nt]; *(u32x2*)(dst + (nt * 16 + fr) * 16) = u32x2{pack2(v[0], v[1]), pack2(v[2], v[3])}; }
                    }
                }
            } else if (dsh == 4) {
#pragma unroll
                for (int j = 0; j < 4; ++j) {
                    const int m = mw + fq * 4 + j;
                    const int b = m >> 13, s = m & 8191;
                    const int p = ((s & 15) << 9) + (s >> 4);
#pragma unroll
                    for (int grp = 0; grp < 2; ++grp) {
                        u16* dst = vt + ((((size_t)(b * nhv + vth + grp)) * 512 + (p >> 4)) * 64) * 16 + (p & 15);
#pragma unroll
                        for (int nt = 0; nt < 4; ++nt)
                            *(u32x2*)(dst + (nt * 16 + fr) * 16) = u32x2{pack2(acc[0 * 8 + grp * 4 + nt][j], acc[1 * 8 + grp * 4 + nt][j]), pack2(acc[2 * 8 + grp * 4 + nt][j], acc[3 * 8 + grp * 4 + nt][j])};
                    }
                }
            } else {
#pragma unroll
                for (int mt = 0; mt < 4; ++mt) {
                    const int r0 = wm * 64 + mt * 16 + fq * 4;
                    const int m = m0 + (r0 & 31) * 4 + (r0 >> 5);
                    const int b = m >> 13, s = m & 8191;
                    const int p = ((s & 3) << 11) + (s >> 2);
#pragma unroll
                    for (int grp = 0; grp < 2; ++grp) {
                        u16* dst = vt + ((((size_t)(b * nhv + vth + grp)) * 512 + (p >> 4)) * 64) * 16 + (p & 15);
#pragma unroll
                        for (int nt = 0; nt < 4; ++nt) { const f32x4 v = acc[mt * 8 + grp * 4 + nt]; *(u32x2*)(dst + (nt * 16 + fr) * 16) = u32x2{pack2(v[0], v[1]), pack2(v[2], v[3])}; }
                    }
                }
            }
        } else {
            gemm_mainloop<false>(tid_, smem, A, 1024, Wt, 1024, 1024, m0, n0, acc);
            __builtin_amdgcn_s_barrier();
            constexpr int EROW = 272;
            unsigned char* est = smem + w * (64 * EROW);
            int l4_ = lane; asm volatile("" : "+v"(l4_));
            const int fr = l4_ & 15, fq = l4_ >> 4;
#pragma unroll
            for (int mt = 0; mt < 4; ++mt) {
                const int s = (mw + mt * 16 + fr) & 8191;
                unsigned char* erow = est + (mt * 16 + fr) * EROW + fq * 8;
                if (mode == 1) {
#pragma unroll
                    for (int nt = 0; nt < 2; ++nt) {
                        const f32x4 c4 = *(const f32x4*)(cosT + s * 32 + nt * 16 + fq * 4);
                        const f32x4 s4 = *(const f32x4*)(sinT + s * 32 + nt * 16 + fq * 4);
#pragma unroll
                        for (int grp = 0; grp < 2; ++grp) {
                            const f32x4 x1 = acc[(grp * 4 + nt) * 4 + mt], x2 = acc[(grp * 4 + nt + 2) * 4 + mt];
                            const f32x4 o1 = x1 * c4 - x2 * s4, o2 = x2 * c4 + x1 * s4;
                            *(u32x2*)(erow + (grp * 64 + nt * 16) * 2) = u32x2{pack2(o1[0], o1[1]), pack2(o1[2], o1[3])};
                            *(u32x2*)(erow + (grp * 64 + (nt + 2) * 16) * 2) = u32x2{pack2(o2[0], o2[1]), pack2(o2[2], o2[3])};
                        }
                    }
                } else {
#pragma unroll
                    for (int nt = 0; nt < 8; ++nt) { const f32x4 v = acc[nt * 4 + mt]; *(u32x2*)(erow + nt * 32) = u32x2{pack2(v[0], v[1]), pack2(v[2], v[3])}; }
                }
            }
            __builtin_amdgcn_fence(__ATOMIC_RELEASE, "wavefront"); __builtin_amdgcn_wave_barrier(); __builtin_amdgcn_fence(__ATOMIC_ACQUIRE, "wavefront");
            {
                const int rr = l4_ >> 4, ch = l4_ & 15;
                if (ksel >= 0) {
                    u16* ki = (u16*)(ws + (ksel == 0 ? OFF_KI0 : (ksel == 1 ? OFF_KI1 : OFF_KI2)));
                    const int dmask = (1 << dsh) - 1, lsh = 13 - dsh, head = vth + (ch >> 3), dh0 = (ch & 7) * 8;
#pragma unroll 4
                    for (int i = 0; i < 16; ++i) {
                        const int row = i * 4 + rr, m = mw + row;
                        const int b = m >> 13, s = m & 8191;
                        const int p = ((s & dmask) << lsh) + (s >> dsh);
                        const u32x4 v = *(const u32x4*)(est + row * EROW + ch * 16);
                        *(u32x4*)(ki + ((((size_t)(b * nhv + head) * 512 + (p >> 4)) * 2 + (dh0 >> 5)) * 16 + (p & 15)) * 32 + (dh0 & 31)) = v;
                    }
                } else {
                u16* hbase = H + (size_t)mw * N + ncol + ch * 8;
#pragma unroll
                for (int i = 0; i < 16; ++i) {
                    const int row = i * 4 + rr;
                    const u32x4 v = *(const u32x4*)(est + row * EROW + ch * 16);
                    *(u32x4*)(hbase + (size_t)row * N) = v;
                }
                }
            }
        }
    }
}

DEV void gemm_out_phase(unsigned char* smem, const Prm& P, const u16* Wt, const float* xin) {
    const int tid_ = opaque_tid();
    const u16* A = (const u16*)(P.ws + OFF_G);
    const int lane = tid_ & 63, w = __builtin_amdgcn_readfirstlane(tid_ >> 6), wm = w >> 1, wn = w & 1, fr = lane & 15, fq = lane >> 4;
    for (int t = vblock(); t < 512; t += gridDim.x) {
        int mi, ni; tile_mn(t, 4, mi, ni);
        const int m0 = mi << 7, n0 = ni << 8;
        f32x4 acc[32]; ZERO_ACC(acc);
        gemm_mainloop<false>(tid_, smem, A, 1024, Wt, 1024, 1024, m0, n0, acc);
        {
            __builtin_amdgcn_s_barrier();
            constexpr int EROWF = 528;
            unsigned char* est = smem + w * (32 * EROWF);
            const size_t ub = (size_t)(m0 + wm * 64) * 1024 + n0 + wn * 128;
            const float* xw = xin + ub; float* ow = P.out + ub;
            int l2_ = lane; asm volatile("" : "+v"(l2_));
            const int fr2 = l2_ & 15, fq2 = l2_ >> 4, rr = l2_ >> 5, ch = l2_ & 31;
#pragma unroll
            for (int h = 0; h < 2; ++h) {
#pragma unroll
                for (int mh = 0; mh < 2; ++mh) {
                    unsigned char* erow = est + (mh * 16 + fr2) * EROWF + fq2 * 16;
#pragma unroll
                    for (int nt = 0; nt < 8; ++nt) *(f32x4*)(erow + nt * 64) = acc[nt * 4 + h * 2 + mh];
                }
                __builtin_amdgcn_fence(__ATOMIC_RELEASE, "wavefront"); __builtin_amdgcn_wave_barrier(); __builtin_amdgcn_fence(__ATOMIC_ACQUIRE, "wavefront");
#pragma unroll 4
                for (int i = 0; i < 16; ++i) {
                    const int row = i * 2 + rr;
                    const unsigned ix = (unsigned)((h * 32 + row) * 1024 + ch * 4);
                    const f32x4 v = *(const f32x4*)(est + row * EROWF + ch * 16);
                    const f32x4 xv = *(const f32x4*)(xw + ix);
                    *(f32x4*)(ow + ix) = xv * DN_ALPHA + v;
                }
                __builtin_amdgcn_fence(__ATOMIC_RELEASE, "wavefront"); __builtin_amdgcn_wave_barrier(); __builtin_amdgcn_fence(__ATOMIC_ACQUIRE, "wavefront");
            }
        }
    }
}

DEV void gemm_gate_phase(unsigned char* smem, const Prm& P, const u16* Wg, const u16* Wp) {
    const int tid_ = opaque_tid();
    const u16* A1 = (const u16*)(P.ws + OFF_XLB);
    const u16* A2 = (const u16*)(P.ws + OFF_PB);
    u16* xb = (u16*)(P.ws + OFF_XB);
    u16* ppb = (u16*)(P.ws + OFF_PP);
    const int lane = tid_ & 63, w = __builtin_amdgcn_readfirstlane(tid_ >> 6), wm = w >> 1, wn = w & 1, fr = lane & 15, fq = lane >> 4;
    for (int t = vblock(); t < 512; t += gridDim.x) {
        int mi, ni; tile_mn(t, 4, mi, ni);
        const int m0 = mi << 7, n0 = ni << 8;
        f32x4 acc[32]; ZERO_ACC(acc);
        gemm_mainloop<false>(tid_, smem, A2, 256, Wp, 256, 256, m0, n0, acc);
        const size_t ub = (size_t)(m0 + wm * 64) * 1024 + n0 + wn * 128;
        float* ow = P.out + ub; u16* pw = ppb + ub; u16* xw = xb + ub;
        {
            int l2_ = lane; asm volatile("" : "+v"(l2_));
            const unsigned lo = (unsigned)((l2_ & 15) * 1024 + (l2_ >> 4) * 4);
#pragma unroll
            for (int mt = 0; mt < 4; ++mt) {
#pragma unroll
                for (int nt = 0; nt < 8; ++nt) { const f32x4 v = acc[nt * 4 + mt]; *(u32x2*)(pw + (lo + mt * 16384 + nt * 16)) = u32x2{pack2(v[0], v[1]), pack2(v[2], v[3])}; }
                __builtin_amdgcn_sched_barrier(0);
            }
        }
        ZERO_ACC(acc);
        gemm_mainloop<false>(tid_, smem, A1, 1024, Wg, 1024, 1024, m0, n0, acc);
        int l3_ = lane; asm volatile("" : "+v"(l3_));
        const unsigned lo = (unsigned)((l3_ & 15) * 1024 + (l3_ >> 4) * 4);
#pragma unroll
        for (int mt = 0; mt < 4; ++mt) {
#pragma unroll
            for (int nt = 0; nt < 8; ++nt) {
                const unsigned ix = lo + mt * 16384 + nt * 16;
                const f32x4 xv = *(const f32x4*)(ow + ix);
                const u32x2 pq = *(const u32x2*)(pw + ix);
                const f32x4 ga = acc[nt * 4 + mt];
                f32x4 r;
                r[0] = xv[0] + sigmoidf_(ga[0]) * bflo(pq[0]); r[1] = xv[1] + sigmoidf_(ga[1]) * bfhi(pq[0]);
                r[2] = xv[2] + sigmoidf_(ga[2]) * bflo(pq[1]); r[3] = xv[3] + sigmoidf_(ga[3]) * bfhi(pq[1]);
                *(f32x4*)(ow + ix) = r;
                *(u32x2*)(xb + kb_off(m0 + wm * 64 + mt * 16 + (l3_ & 15), n0 + wn * 128 + nt * 16 + (l3_ >> 4) * 4, 1024)) = u32x2{pack2(r[0], r[1]), pack2(r[2], r[3])};
            }
            __builtin_amdgcn_sched_barrier(0);
        }
    }
}

DEV void ln_phase(const Prm& P, int layer) {
    const int tid_ = opaque_tid();
    const int lane = tid_ & 63, w = __builtin_amdgcn_readfirstlane(tid_ >> 6);
    const float* g = P.in[12] + layer * 1024; const float* bb = P.in[13] + layer * 1024;
    u16* xlb = (u16*)(P.ws + OFF_XLB);
    for (int row = blockIdx.x * 4 + w; row < T; row += gridDim.x * 4) {
        float* xr = P.out + (size_t)row * 1024;
        f32x4 v[4];
        float s = 0.f;
#pragma unroll
        for (int i = 0; i < 4; ++i) { v[i] = *(const f32x4*)(xr + i * 256 + lane * 4); s += v[i][0] + v[i][1] + v[i][2] + v[i][3]; }
        const float mean = wave_sum(s) * (1.f / 1024.f);
        float q = 0.f;
#pragma unroll
        for (int i = 0; i < 4; ++i)
#pragma unroll
            for (int j = 0; j < 4; ++j) { const float d = v[i][j] - mean; q += d * d; }
        const float rstd = rsqrtf(wave_sum(q) * (1.f / 1024.f) + LN_EPS);
#pragma unroll
        for (int i = 0; i < 4; ++i) {
            const f32x4 gg = *(const f32x4*)(g + i * 256 + lane * 4), bv = *(const f32x4*)(bb + i * 256 + lane * 4);
            f32x4 y;
#pragma unroll
            for (int j = 0; j < 4; ++j) y[j] = (v[i][j] - mean) * rstd * gg[j] + bv[j];
            *(f32x4*)(xr + i * 256 + lane * 4) = y;
            *(u32x2*)(xlb + kb_off(row, i * 256 + lane * 4, 1024)) = u32x2{pack2(y[0], y[1]), pack2(y[2], y[3])};
        }
    }
    const float* p = P.in[1] + (size_t)layer * T * 256; u16* pb = (u16*)(P.ws + OFF_PB);
    const size_t gtid = (size_t)blockIdx.x * 256 + tid_, gsz = (size_t)gridDim.x * 256;
    for (size_t i = gtid; i < (size_t)T * 256 / 8; i += gsz) {
        const f32x4 a = *(const f32x4*)(p + i * 8), b = *(const f32x4*)(p + i * 8 + 4);
        *(u32x4*)(pb + kb_off((int)(i >> 5), (int)(i & 31) * 8, 256)) = u32x4{pack2(a[0], a[1]), pack2(a[2], a[3]), pack2(b[0], b[1]), pack2(b[2], b[3])};
    }
}

struct KV { bf16x8 ka0, ka1, kb0, kb1; bf16x8 v0, v1, v2, v3; };
template <int KH = 1024>
DEV void load_kv(KV& t, const char* Kb, unsigned koa, unsigned kob, const char* Vb, unsigned voa, unsigned vob) {
    t.ka0 = *(const bf16x8*)(Kb + koa); t.ka1 = *(const bf16x8*)(Kb + koa + KH);
    t.kb0 = *(const bf16x8*)(Kb + kob); t.kb1 = *(const bf16x8*)(Kb + kob + KH);
    t.v0 = __builtin_shufflevector(*(const s16x4*)(Vb + voa), *(const s16x4*)(Vb + vob), 0, 1, 2, 3, 4, 5, 6, 7);
    t.v1 = __builtin_shufflevector(*(const s16x4*)(Vb + voa + 512), *(const s16x4*)(Vb + vob + 512), 0, 1, 2, 3, 4, 5, 6, 7);
    t.v2 = __builtin_shufflevector(*(const s16x4*)(Vb + voa + 1024), *(const s16x4*)(Vb + vob + 1024), 0, 1, 2, 3, 4, 5, 6, 7);
    t.v3 = __builtin_shufflevector(*(const s16x4*)(Vb + voa + 1536), *(const s16x4*)(Vb + vob + 1536), 0, 1, 2, 3, 4, 5, 6, 7);
}
DEV unsigned pkrtz(float a, float b) { return __builtin_bit_cast(unsigned, __builtin_amdgcn_cvt_pkrtz(a, b)); }
DEV bf16x8 pack8(const float (&p)[8]) {
    return __builtin_bit_cast(bf16x8, u32x4{pkrtz(p[0], p[1]), pkrtz(p[2], p[3]), pkrtz(p[4], p[5]), pkrtz(p[6], p[7])});
}
DEV void qk_scores(const KV& t, const bf16x8& q0, const bf16x8& q1, f32x4& sa, f32x4& sb) {
    sa = f32x4{0.f, 0.f, 0.f, 0.f}; sb = f32x4{0.f, 0.f, 0.f, 0.f};
    sa = MFMA16(t.ka0, q0, sa); sa = MFMA16(t.ka1, q1, sa);
    sb = MFMA16(t.kb0, q0, sb); sb = MFMA16(t.kb1, q1, sb);
}
constexpr float QK_C = 0.125f * 1.4426950408889634f;
DEV void flash_core(float& mref, float& l, f32x4 (&o)[4], const bf16x8& q0, const bf16x8& q1, const KV& t, bool fast, int d0, unsigned lim) {
    f32x4 sa, sb; qk_scores(t, q0, q1, sa, sb);
    float y[8];
    if (fast) {
#pragma unroll
        for (int j = 0; j < 4; ++j) { y[j] = sa[j] * QK_C; y[4 + j] = sb[j] * QK_C; }
    } else {
#pragma unroll
        for (int j = 0; j < 4; ++j) {
            y[j]     = ((unsigned)(d0 - j) <= lim)      ? sa[j] * QK_C : NEG_INF;
            y[4 + j] = ((unsigned)(d0 - 16 - j) <= lim) ? sb[j] * QK_C : NEG_INF;
        }
    }
    float mx = fmaxf(fmaxf(fmaxf(y[0], y[1]), fmaxf(y[2], y[3])), fmaxf(fmaxf(y[4], y[5]), fmaxf(y[6], y[7])));
    if (__ballot(mx > mref + 8.f) != 0ull) {
        mx = red16_max(mx);
        const float mn = fmaxf(mref, mx);
        const float alpha = (mn == NEG_INF) ? 1.f : __builtin_amdgcn_exp2f(mref - mn);
        l *= alpha;
#pragma unroll
        for (int d = 0; d < 4; ++d) o[d] *= alpha;
        mref = mn;
    }
    const float mu = (mref == NEG_INF) ? 0.f : mref;
    float p[8]; float ps = 0.f;
#pragma unroll
    for (int j = 0; j < 8; ++j) { p[j] = __builtin_amdgcn_exp2f(y[j] - mu); ps += p[j]; }
    l += ps;
    const bf16x8 pf = pack8(p);
    o[0] = MFMA16(t.v0, pf, o[0]); o[1] = MFMA16(t.v1, pf, o[1]); o[2] = MFMA16(t.v2, pf, o[2]); o[3] = MFMA16(t.v3, pf, o[3]);
}

#define RING4(NSTEPS, LOADSTEP, COMPUTE) do { \
    KV r0_, r1_, r2_; const int nl_ = (NSTEPS) - 1; \
    LOADSTEP(r0_, 0); LOADSTEP(r1_, min(1, nl_)); \
    for (int st_ = 0; st_ < (NSTEPS); st_ += 3) { \
        LOADSTEP(r2_, min(st_ + 2, nl_)); COMPUTE(r0_, st_); \
        LOADSTEP(r0_, min(st_ + 3, nl_)); if (st_ + 1 < (NSTEPS)) COMPUTE(r1_, st_ + 1); \
        LOADSTEP(r1_, min(st_ + 4, nl_)); if (st_ + 2 < (NSTEPS)) COMPUTE(r2_, st_ + 2); \
    } } while (0)

DEV void band_loop(const int tid_, float& m, float& l, f32x4 (&o)[4], const bf16x8& q0, const bf16x8& q1, const char* Kb,
                   const char* Vb, int vblk0, int ustart, int nsteps, int uq, int uq0, int qspan, int maxd) {
    const int c = tid_ & 15, g4 = (tid_ & 63) >> 4;
    const unsigned kl = c * 64 + g4 * 16, vl = c * 32 + g4 * 8;
    const unsigned lim = (unsigned)min(maxd, uq);
#define BL_LOAD(R, S) do { const int ua_ = ustart + (S) * 32, ub_ = ua_ + 16; \
        const unsigned ba_ = (unsigned)(vblk0 + (max(ua_, 0) >> 4)) * 2048u, bb_ = (unsigned)(vblk0 + (max(ub_, 0) >> 4)) * 2048u; \
        load_kv(R, Kb, ba_ + kl, bb_ + kl, Vb, ba_ + vl, bb_ + vl); } while (0)
#define BL_COMP(R, S) do { const int ua_ = ustart + (S) * 32; \
        const bool fast_ = (ua_ >= 0) && (ua_ + 31 <= uq0) && (uq0 + qspan - ua_ <= maxd); \
        flash_core(m, l, o, q0, q1, R, fast_, uq - ua_ - g4 * 4, lim); } while (0)
    RING4(nsteps, BL_LOAD, BL_COMP);
#undef BL_LOAD
#undef BL_COMP
}

DEV void attnA_phase(const Prm& P, int chunk) {
    const int tid_ = opaque_tid();
    unsigned char* ws = P.ws;
    const u16* H = (const u16*)(ws + OFF_H);
    u16* G = (u16*)(ws + OFF_G);
    const int lane = tid_ & 63, w = __builtin_amdgcn_readfirstlane(tid_ >> 6), c = lane & 15, g4 = lane >> 4;
    constexpr int LD = 2560;
    const int xcd_ = blockIdx.x & 7, slot_ = blockIdx.x >> 3, nslot_ = gridDim.x >> 3;
    for (int i_ = slot_; i_ < 128; i_ += nslot_) {
        const int rq = i_ & 3, tbi = i_ >> 2, hh = xcd_ & 3, b = xcd_ >> 2;
        const int r = rq * 4 + w, tb = tbi * 256;
        const int sq = tb + r + 16 * c;
        const size_t rowq = (size_t)b * 8192 + sq;
        float m = NEG_INF, l = 0.f;
        f32x4 o[4];
#pragma unroll
        for (int d = 0; d < 4; ++d) o[d] = f32x4{0.f, 0.f, 0.f, 0.f};
#pragma unroll 1
        for (int g = 0; g < 3; ++g) {
            const int dsh = 2 * g, dmask = (1 << dsh) - 1;
            const int rg = r & dmask;
            const int uq = sq >> dsh, uq0 = (tb + r) >> dsh;
            int ustart = (uq0 - 128) & ~15;
            const int ulast = (uq0 + (15 << (4 - dsh))) & ~15;
            int ntile = ((ulast - ustart) >> 4) + 1;
            if (ntile & 1) { ustart -= 16; ntile += 1; }
            const u16* Hq = H + rowq * LD + g * 768 + hh * 64 + g4 * 8;
            const bf16x8 q0 = *(const bf16x8*)Hq, q1 = *(const bf16x8*)(Hq + 32);
            const char* Kb = (const char*)((const u16*)(ws + (g == 0 ? OFF_KI0 : (g == 1 ? OFF_KI1 : OFF_KI2))) + ((size_t)(b * 4 + hh) * 512) * 1024);
            const char* Vb = (const char*)((const u16*)(ws + (g == 0 ? OFF_VT0 : (g == 1 ? OFF_VT1 : OFF_VT2))) + ((size_t)(b * 4 + hh) * 512) * 1024);
            const int vblk0 = rg * ((8192 >> dsh) >> 4);
            band_loop(tid_, m, l, o, q0, q1, Kb, Vb, vblk0, ustart, ntile >> 1, uq, uq0, 15 << (4 - dsh), 128);
        }
        l = red16_sum(l);
        const float inv = 1.f / l;
#pragma unroll
        for (int dt = 0; dt < 4; ++dt) {
            const int dh = dt * 16 + g4 * 4;
            const u32x2 z = *(const u32x2*)(H + rowq * LD + 2304 + hh * 64 + dh);
            const float r0 = o[dt][0] * inv * siluf_(bflo(z[0])), r1 = o[dt][1] * inv * siluf_(bfhi(z[0]));
            const float r2 = o[dt][2] * inv * siluf_(bflo(z[1])), r3 = o[dt][3] * inv * siluf_(bfhi(z[1]));
            *(u32x2*)(G + kb_off((int)rowq, (chunk * 4 + hh) * 64 + dh, 1024)) = u32x2{pack2(r0, r1), pack2(r2, r3)};
        }
    }
}

DEV void attnB_phase(const Prm& P) {
    const int tid_ = opaque_tid();
    unsigned char* ws = P.ws;
    const u16* H = (const u16*)(ws + OFF_H);
    u16* G = (u16*)(ws + OFF_G);
    const float* sinks = P.in[5];
    const int lane = tid_ & 63, w = __builtin_amdgcn_readfirstlane(tid_ >> 6), c = lane & 15, g4 = lane >> 4;
    constexpr int LD = 2304;
    const int xcd_ = blockIdx.x & 7, slot_ = blockIdx.x >> 3, nslot_ = gridDim.x >> 3;
    for (int tile = slot_; tile < 512; tile += nslot_) {
        const int b = xcd_ >> 2, hq = xcd_ & 3;
        const int head = hq * 4 + w, kvh = head >> 3;
        const int t0 = tile * 16, sq = t0 + c;
        const size_t rowq = (size_t)b * 8192 + sq;
        float m = NEG_INF, l = 0.f;
        f32x4 o[4];
#pragma unroll
        for (int d = 0; d < 4; ++d) o[d] = f32x4{0.f, 0.f, 0.f, 0.f};
        const u16* Hq = H + rowq * LD + head * 64 + g4 * 8;
        const bf16x8 q0 = *(const bf16x8*)Hq, q1 = *(const bf16x8*)(Hq + 32);
        const char* Kb = (const char*)((const u16*)(ws + OFF_KI0) + ((size_t)(b * 2 + kvh) * 512) * 1024);
        const char* Vb = (const char*)((const u16*)(ws + OFF_VT0) + ((size_t)(b * 2 + kvh) * 512) * 1024);
        band_loop(tid_, m, l, o, q0, q1, Kb, Vb, 0, t0 - 144, 5, sq, t0, 15, 127);
        l = red16_sum(l);
        const float mu = (m == NEG_INF) ? 0.f : m;
        const float lf = l + __builtin_amdgcn_exp2f(sinks[head] * 1.4426950408889634f - mu);
        const float inv = 1.f / lf;
#pragma unroll
        for (int dt = 0; dt < 4; ++dt) {
            const int dh = dt * 16 + g4 * 4;
            const u32x2 z = *(const u32x2*)(H + rowq * LD + 1280 + head * 64 + dh);
            const float r0 = o[dt][0] * inv * siluf_(bflo(z[0])), r1 = o[dt][1] * inv * siluf_(bfhi(z[0]));
            const float r2 = o[dt][2] * inv * siluf_(bflo(z[1])), r3 = o[dt][3] * inv * siluf_(bfhi(z[1]));
            *(u32x2*)(G + kb_off((int)rowq, head * 64 + dh, 1024)) = u32x2{pack2(r0, r1), pack2(r2, r3)};
        }
    }
}

DEV void compress_phase(const Prm& P) {
    const int tid_ = opaque_tid();
    unsigned char* ws = P.ws;
    const u16* H = (const u16*)(ws + OFF_H);
    constexpr int LD = 3840;
    const float* bias = (const float*)(ws + OFF_BIAS);
    const int lane = tid_ & 63, w = __builtin_amdgcn_readfirstlane(tid_ >> 6), c = lane & 15, g4 = lane >> 4;
    for (int it = blockIdx.x; it < 128; it += gridDim.x) {
        const int unit = it * 4 + w;
        const int which = unit >> 8, b = (unit >> 7) & 1, kvh = (unit >> 5) & 3, ntile = unit & 31;
        const u16* Wt = (const u16*)(ws + (which ? OFF_WCV : OFF_WCK));
        const int colbase = (which ? 1280 : 1024) + kvh * 64;
        const int n = ntile * 16 + c;
        const u16* Wl = Wt + c * 32 + g4 * 8;
        f32x4 acc[4];
#pragma unroll
        for (int e = 0; e < 4; ++e) acc[e] = f32x4{0.f, 0.f, 0.f, 0.f};
#pragma unroll 4
        for (int kk = 0; kk < 64; ++kk) {
            const int j = kk >> 1, d0 = (kk & 1) * 32 + g4 * 8;
            int s = 16 * n + j; s = min(s, 8191);
            const bf16x8 xf = *(const bf16x8*)(H + ((size_t)b * 8192 + s) * LD + colbase + d0);
            bf16x8 wf[4];
#pragma unroll
            for (int e = 0; e < 4; ++e) wf[e] = *(const bf16x8*)(Wl + (size_t)(e * 64 + kk) * 512);
            if (which == 0) {
#pragma unroll
                for (int e = 0; e < 4; ++e) acc[e] = MFMA16(wf[e], xf, acc[e]);
            } else {
#pragma unroll
                for (int e = 0; e < 4; ++e) acc[e] = MFMA16(xf, wf[e], acc[e]);
            }
        }
        if (which == 0) {
            u16* kc = (u16*)(ws + OFF_KCMP) + ((size_t)(b * 512 + n) * 4 + kvh) * 64;
#pragma unroll
            for (int e = 0; e < 4; ++e) {
                const int e0 = e * 16 + g4 * 4;
                const f32x4 bv = *(const f32x4*)(bias + e0);
                const f32x4 r = acc[e] + bv;
                *(u32x2*)(kc + e0) = u32x2{pack2(r[0], r[1]), pack2(r[2], r[3])};
            }
        } else {
            u16* vc = (u16*)(ws + OFF_VCMP) + (((size_t)(b * 4 + kvh) * 32 + ntile) * 64) * 16;
#pragma unroll
            for (int e = 0; e < 4; ++e) {
                const int ee = e * 16 + c;
                const float bv = bias[64 + ee];
                *(u32x2*)(vc + ee * 16 + g4 * 4) = u32x2{pack2(acc[e][0] + bv, acc[e][1] + bv), pack2(acc[e][2] + bv, acc[e][3] + bv)};
            }
        }
    }
}

DEV void attnC_phase(const Prm& P, unsigned char* smem) {
    const int tid_ = opaque_tid();
    unsigned char* ws = P.ws;
    const u16* H = (const u16*)(ws + OFF_H);
    u16* G = (u16*)(ws + OFF_G);
    constexpr int LD = 3840;
    float* imp = (float*)smem;
    float* scb = (float*)(smem + 32768);
    float* oslc = (float*)(smem + 34816);
    const int tid = tid_, lane = tid & 63, w = __builtin_amdgcn_readfirstlane(tid >> 6), c = lane & 15, g4 = lane >> 4;
    const int xcd_ = blockIdx.x & 7, slot_ = blockIdx.x >> 3, nslot_ = gridDim.x >> 3;
    for (int tile = slot_; tile < 512; tile += nslot_) {
        const int b = xcd_ >> 2, kvh = xcd_ & 3;
        const int t0 = tile * 16;
        for (int i = tid; i < 8192; i += 256) imp[i] = 0.f;
        __syncthreads();
        const int head = kvh * 4 + w;
        const size_t rowq = (size_t)b * 8192 + t0 + c;
        const u16* Hq = H + rowq * LD + head * 64 + g4 * 8;
        const bf16x8 q0 = *(const bf16x8*)Hq, q1 = *(const bf16x8*)(Hq + 32);
        f32x4 oacc[4];
#pragma unroll
        for (int d = 0; d < 4; ++d) oacc[d] = f32x4{0.f, 0.f, 0.f, 0.f};
        const int nmax = (t0 + c - 31) >> 4;
        const int nmaxw = (t0 - 16) >> 4;
        const float g0 = sigmoidf_(bf2f(H[rowq * LD + 3584 + head]));
        const float g1 = sigmoidf_(bf2f(H[rowq * LD + 3584 + 16 + head]));
        const float g2 = sigmoidf_(bf2f(H[rowq * LD + 3584 + 32 + head]));
        if (nmaxw >= 0) {
            const int nsteps = (nmaxw >> 5) + 1;
            const char* Kb = (const char*)((const u16*)(ws + OFF_KCMP) + (size_t)b * 512 * 256 + kvh * 64);
            const char* Vb = (const char*)((const u16*)(ws + OFF_VCMP) + ((size_t)(b * 4 + kvh) * 32) * 1024);
            const unsigned kl = g4 * 16, vl = c * 32 + g4 * 8;
            float m = NEG_INF, l = 0.f;
#define CM_LOAD(R, S) do { const int na_ = (S) * 32; load_kv<64>(R, Kb, (unsigned)(na_ + c) * 512u + kl, (unsigned)min(na_ + 16 + c, 511) * 512u + kl, \
        Vb, (unsigned)(na_ >> 4) * 2048u + vl, (unsigned)min((na_ >> 4) + 1, 31) * 2048u + vl); } while (0)
#define CM_PASS1(R, S) do { const int na_ = (S) * 32; f32x4 sa, sb; qk_scores(R, q0, q1, sa, sb); float mx = NEG_INF; float x[8]; \
        _Pragma("unroll") for (int j = 0; j < 8; ++j) { const int n = na_ + (j >> 2) * 16 + g4 * 4 + (j & 3); \
            x[j] = (n <= nmax) ? ((j < 4) ? sa[j & 3] : sb[j & 3]) * 0.125f : NEG_INF; mx = fmaxf(mx, x[j]); } \
        const float mn = fmaxf(m, mx); const float mu = (mn == NEG_INF) ? 0.f : mn; float ps = 0.f; \
        _Pragma("unroll") for (int j = 0; j < 8; ++j) ps += __expf(x[j] - mu); \
        l = l * __expf(m - mu) + ps; m = mn; } while (0)
            RING4(nsteps, CM_LOAD, CM_PASS1);
            float mall = red16_max(m);
            mall = (mall == NEG_INF) ? 0.f : mall;
            l = l * __expf(m - mall);
            l = red16_sum(l);
            const float invl = (l > 0.f) ? 1.f / l : 0.f;
#define CM_PASS2(R, S) do { const int na_ = (S) * 32; f32x4 sa, sb; qk_scores(R, q0, q1, sa, sb); float p[8]; \
        _Pragma("unroll") for (int j = 0; j < 8; ++j) { const int n = na_ + (j >> 2) * 16 + g4 * 4 + (j & 3); \
            const float sv = ((j < 4) ? sa[j & 3] : sb[j & 3]) * 0.125f; \
            p[j] = (n <= nmax) ? __expf(sv - mall) * invl : 0.f; \
            if (n <= nmax) atomicAdd(&imp[n * 16 + c], p[j]); } \
        const bf16x8 pf = pack8(p); \
        oacc[0] = MFMA16(R.v0, pf, oacc[0]); oacc[1] = MFMA16(R.v1, pf, oacc[1]); \
        oacc[2] = MFMA16(R.v2, pf, oacc[2]); oacc[3] = MFMA16(R.v3, pf, oacc[3]); } while (0)
            RING4(nsteps, CM_LOAD, CM_PASS2);
#undef CM_LOAD
#undef CM_PASS1
#undef CM_PASS2
#pragma unroll
            for (int d = 0; d < 4; ++d) oacc[d] *= g0;
        }
        {
            float m = NEG_INF, l = 0.f;
            f32x4 o[4];
#pragma unroll
            for (int d = 0; d < 4; ++d) o[d] = f32x4{0.f, 0.f, 0.f, 0.f};
            const char* Kb = (const char*)((const u16*)(ws + OFF_KI1) + ((size_t)(b * 4 + kvh) * 512) * 1024);
            const char* Vb = (const char*)((const u16*)(ws + OFF_VT1) + ((size_t)(b * 4 + kvh) * 512) * 1024);
            band_loop(tid_, m, l, o, q0, q1, Kb, Vb, 0, t0 - 528, 17, t0 + c, t0, 15, 511);
            l = red16_sum(l);
            const float sc = g2 / l;
#pragma unroll
            for (int d = 0; d < 4; ++d) oacc[d] += o[d] * sc;
        }
        __syncthreads();
        unsigned long long* msk = (unsigned long long*)(smem + 51200) + w * 8;
#pragma unroll 1
        for (int i = 0; i < 4; ++i) {
            const int tok = 4 * w + i, tq = t0 + tok, cur = tq >> 6;
            float my0, my1;
            {
                const int j0 = lane, j1 = lane + 64;
                float a0 = 2.f * (imp[(4 * j0) * 16 + tok] + imp[(4 * j0 + 1) * 16 + tok] + imp[(4 * j0 + 2) * 16 + tok]) + imp[(4 * j0 + 3) * 16 + tok];
                if (j0 > 0) a0 += imp[(4 * j0 - 1) * 16 + tok];
                const float a1 = 2.f * (imp[(4 * j1) * 16 + tok] + imp[(4 * j1 + 1) * 16 + tok] + imp[(4 * j1 + 2) * 16 + tok]) + imp[(4 * j1 + 3) * 16 + tok]
                                 + imp[(4 * j1 - 1) * 16 + tok];
                const bool f0 = (j0 == 0) || (j0 == cur) || (j0 == cur - 1);
                const bool f1 = (j1 == cur) || (j1 == cur - 1);
                my0 = f0 ? 1e4f : ((j0 <= cur) ? a0 : -1.f);
                my1 = f1 ? 1e4f : ((j1 <= cur) ? a1 : -1.f);
            }
            __builtin_amdgcn_fence(__ATOMIC_RELEASE, "wavefront"); __builtin_amdgcn_wave_barrier(); __builtin_amdgcn_fence(__ATOMIC_ACQUIRE, "wavefront");
            scb[w * 128 + lane] = my0; scb[w * 128 + 64 + lane] = my1;
            __builtin_amdgcn_fence(__ATOMIC_RELEASE, "wavefront"); __builtin_amdgcn_wave_barrier(); __builtin_amdgcn_fence(__ATOMIC_ACQUIRE, "wavefront");
            int c0 = 0, c1 = 0;
            const int jend = min(128, ((cur + 8) & ~7));
#pragma unroll 8
            for (int jj = 0; jj < jend; ++jj) {
                const float sv = scb[w * 128 + jj];
                c0 += (sv > my0 || (sv == my0 && jj < lane)) ? 1 : 0;
                c1 += (sv > my1 || (sv == my1 && jj < lane + 64)) ? 1 : 0;
            }
            const unsigned long long lo = __ballot((c0 < 16) && (lane <= cur));
            const unsigned long long hi = __ballot((c1 < 16) && (lane + 64 <= cur));
            if (lane == 0) { msk[i * 2] = lo; msk[i * 2 + 1] = hi; }
        }
        __builtin_amdgcn_fence(__ATOMIC_RELEASE, "wavefront"); __builtin_amdgcn_wave_barrier(); __builtin_amdgcn_fence(__ATOMIC_ACQUIRE, "wavefront");
        {
            const int tokL = 4 * w + (c >> 2), tq = t0 + tokL, hd = kvh * 4 + (c & 3);
            const size_t rq = (size_t)b * 8192 + tq;
            const u16* Hs = H + rq * LD + hd * 64 + g4 * 8;
            const bf16x8 s0 = *(const bf16x8*)Hs, s1 = *(const bf16x8*)(Hs + 32);
            const char* Kb = (const char*)((const u16*)(ws + OFF_KI0) + ((size_t)(b * 4 + kvh) * 512) * 1024);
            const char* Vb = (const char*)((const u16*)(ws + OFF_VT0) + ((size_t)(b * 4 + kvh) * 512) * 1024);
            const unsigned kl = c * 64 + g4 * 16, vl = c * 32 + g4 * 8;
            float m = NEG_INF, l = 0.f;
            f32x4 o[4];
#pragma unroll
            for (int d = 0; d < 4; ++d) o[d] = f32x4{0.f, 0.f, 0.f, 0.f};
            const int ti = c >> 2;
            const unsigned long long mylo = msk[ti * 2], myhi = msk[ti * 2 + 1];
            const unsigned long long ulo = msk[0] | msk[2] | msk[4] | msk[6];
            const unsigned long long uhi = msk[1] | msk[3] | msk[5] | msk[7];
            const unsigned long long alo = msk[0] & msk[2] & msk[4] & msk[6], ahi = msk[1] & msk[3] & msk[5] & msk[7];
            int* blist = (int*)(scb + w * 128);
            const int nlo = __builtin_popcountll(ulo), nblk = nlo + __builtin_popcountll(uhi);
            if ((ulo >> lane) & 1ull) blist[__builtin_popcountll(ulo & ((1ull << lane) - 1ull))] = lane;
            if ((uhi >> lane) & 1ull) blist[nlo + __builtin_popcountll(uhi & ((1ull << lane) - 1ull))] = 64 + lane;
            __builtin_amdgcn_fence(__ATOMIC_RELEASE, "wavefront");
            __builtin_amdgcn_wave_barrier();
            __builtin_amdgcn_fence(__ATOMIC_ACQUIRE, "wavefront");
            const int nst = 2 * nblk;
#define SL_LOAD(R, S) do { const int j_ = __builtin_amdgcn_readfirstlane(blist[(S) >> 1]); const int ua_ = j_ * 64 + ((S) & 1) * 32; \
        load_kv(R, Kb, (unsigned)(ua_ >> 4) * 2048u + kl, (unsigned)((ua_ >> 4) + 1) * 2048u + kl, \
                Vb, (unsigned)(ua_ >> 4) * 2048u + vl, (unsigned)((ua_ >> 4) + 1) * 2048u + vl); } while (0)
#define SL_COMP(R, S) do { const int j_ = __builtin_amdgcn_readfirstlane(blist[(S) >> 1]); const int ua_ = j_ * 64 + ((S) & 1) * 32; \
        const bool selj = (j_ < 64) ? ((mylo >> j_) & 1ull) : ((myhi >> (j_ - 64)) & 1ull); \
        const bool alls_ = (j_ < 64) ? ((alo >> j_) & 1ull) : ((ahi >> (j_ - 64)) & 1ull); \
        const bool fast_ = alls_ && (ua_ + 31 <= t0 + 4 * w); \
        flash_core(m, l, o, s0, s1, R, fast_, selj ? (tq - ua_ - g4 * 4) : -(1 << 30), 0x7fffffffu); } while (0)
            RING4(nst, SL_LOAD, SL_COMP);
#undef SL_LOAD
#undef SL_COMP
            l = red16_sum(l);
            const float inv = 1.f / l;
#pragma unroll
            for (int dt = 0; dt < 4; ++dt)
                *(f32x4*)(oslc + (tokL * 4 + (c & 3)) * 64 + dt * 16 + g4 * 4) = o[dt] * inv;
        }
        __syncthreads();
#pragma unroll
        for (int dt = 0; dt < 4; ++dt) {
            const int dh = dt * 16 + g4 * 4;
            const f32x4 os = *(const f32x4*)(oslc + (c * 4 + w) * 64 + dh);
            const f32x4 r = oacc[dt] + os * g1;
            const u32x2 z = *(const u32x2*)(H + rowq * LD + 2560 + head * 64 + dh);
            const float r0 = r[0] * siluf_(bflo(z[0])), r1 = r[1] * siluf_(bfhi(z[0]));
            const float r2 = r[2] * siluf_(bflo(z[1])), r3 = r[3] * siluf_(bfhi(z[1]));
            *(u32x2*)(G + kb_off((int)rowq, head * 64 + dh, 1024)) = u32x2{pack2(r0, r1), pack2(r2, r3)};
        }
        __syncthreads();
    }
}

#ifndef PROBE_DUP
#define PROBE_DUP 0
#endif
#define REP(k) for (int rep_ = 0; rep_ < 1 + ((PROBE_DUP >> (k)) & 1); ++rep_)
constexpr int LDS_BYTES = 3 * GSTAGE + 64;
__global__ void __launch_bounds__(256, 2) mk_fwd(Prm P) {
    extern __shared__ __attribute__((aligned(16))) unsigned char smem[];
    unsigned* xb_words = (unsigned*)(smem + 3 * GSTAGE);
    if (threadIdx.x < 4) xb_words[threadIdx.x] = 0u;
    __syncthreads();
    XcdBarrier bar = xcd_barrier_post((unsigned*)(P.ws + OFF_BAR), (volatile LAS unsigned*)xb_words);
    unsigned char* ws = P.ws;

    phase0(P, smem);
    cg::this_grid().sync();

#pragma unroll 1
    for (int layer = 0; layer < 4; ++layer) {
        const int kind = layer % 3, lj = layer / 3;
        const u16* Win; const u16* Wout; int N, nsub;
        if (kind == 0)      { Win = (const u16*)(ws + OFF_WA_IN + (size_t)lj * SZ_WA_IN); Wout = (const u16*)(ws + OFF_WA_OUT + (size_t)lj * SZ_SQ); N = 2560; nsub = 4; }
        else if (kind == 1) { Win = (const u16*)(ws + OFF_WB_IN); Wout = (const u16*)(ws + OFF_WB_OUT); N = 2304; nsub = 1; }
        else                { Win = (const u16*)(ws + OFF_WC_IN); Wout = (const u16*)(ws + OFF_WC_OUT); N = 3840; nsub = 1; }
#pragma unroll 1
        for (int sub = 0; sub < nsub; ++sub) {
            REP(0) gemm_in_phase(smem, P, kind, Win + (size_t)sub * 2560 * 1024, N);
            xcd_barrier(bar);
            if (kind == 0) REP(1) attnA_phase(P, sub);
            else if (kind == 1) REP(2) attnB_phase(P);
            else { REP(3) compress_phase(P); xcd_barrier(bar); REP(4) attnC_phase(P, smem); }
            xcd_barrier(bar);
        }
        gemm_out_phase(smem, P, Wout, layer == 0 ? P.in[0] : P.out);
        xcd_barrier(bar);
        ln_phase(P, layer);
        xcd_barrier(bar);
        gemm_gate_phase(smem, P, (const u16*)(ws + OFF_WG + (size_t)layer * SZ_SQ), (const u16*)(ws + OFF_WP + (size_t)layer * SZ_WP));
        if (layer < 3) xcd_barrier(bar);
    }
}

extern "C" void kernel_launch(void* const* d_in, const int* in_sizes, int n_in, void* d_out, int out_size, void* d_ws, size_t ws_size,
                              hipStream_t stream) {
    static int grid_blocks = 0;
    if (!grid_blocks) {
        int dev = 0, cus = 0, per_cu = 0;
        (void)hipGetDevice(&dev);
        (void)hipDeviceGetAttribute(&cus, hipDeviceAttributeMultiprocessorCount, dev);
        (void)hipFuncSetAttribute((const void*)mk_fwd, hipFuncAttributeMaxDynamicSharedMemorySize, LDS_BYTES);
        (void)hipOccupancyMaxActiveBlocksPerMultiprocessor(&per_cu, (const void*)mk_fwd, 256, LDS_BYTES);
        if (per_cu > 2) per_cu = 2;
        if (per_cu < 1) per_cu = 1;
        grid_blocks = cus * per_cu;
        if (ws_size < WS_END || n_in != 16) { fprintf(stderr, "kernel_launch: workspace too small (%zu < %zu) or n_in %d != 16\n", ws_size, (size_t)WS_END, n_in); grid_blocks = -1; }
    }
    if (grid_blocks < 0) return;
    (void)hipMemsetAsync((char*)d_ws + OFF_BAR, 0, 16384, stream);
    Prm p{};
    for (int i = 0; i < 16; ++i) p.in[i] = (const float*)d_in[i];
    p.out = (float*)d_out; p.ws = (unsigned char*)d_ws;
    void* args[] = {&p};
    hipError_t e = hipLaunchCooperativeKernel((const void*)mk_fwd, dim3(grid_blocks), dim3(256), args, LDS_BYTES, stream);
    if (e != hipSuccess) fprintf(stderr, "cooperative launch failed: %s (grid %d)\n", hipGetErrorString(e), grid_blocks);
}
```

```cpp
#include <hip/hip_runtime.h>
#include <hip/hip_cooperative_groups.h>
#include <cstdio>
#include <cstdint>
namespace cg = cooperative_groups;

typedef unsigned short u16;
using bf16x8 = __attribute__((ext_vector_type(8))) short;
using s16x4  = __attribute__((ext_vector_type(4))) short;
using f32x4  = __attribute__((ext_vector_type(4))) float;
using u32x4  = __attribute__((ext_vector_type(4))) unsigned;
using u32x2  = __attribute__((ext_vector_type(2))) unsigned;
#define DEV __device__ __forceinline__
using h16x8 = __attribute__((ext_vector_type(8))) _Float16;
#define MFMA16(a, b, c) __builtin_amdgcn_mfma_f32_16x16x32_f16(__builtin_bit_cast(h16x8, (a)), __builtin_bit_cast(h16x8, (b)), (c), 0, 0, 0)
#define LAS __attribute__((address_space(3)))

constexpr int T = 16384, S = 8192;
constexpr float LN_EPS = 1e-5f;
constexpr float DN_ALPHA = 1.6817928305074290f;
constexpr float NEG_INF = -__builtin_huge_valf();

constexpr size_t OFF_BAR   = 0;
constexpr size_t OFF_COS   = 16384;
constexpr size_t OFF_SIN   = OFF_COS + (size_t)8192 * 32 * 4;
constexpr size_t OFF_BIAS  = OFF_SIN + (size_t)8192 * 32 * 4;
constexpr size_t OFF_WA_IN = OFF_BIAS + 1024;
constexpr size_t SZ_WA_IN  = (size_t)10240 * 1024 * 2;
constexpr size_t SZ_SQ     = (size_t)1024 * 1024 * 2;
constexpr size_t OFF_WA_OUT = OFF_WA_IN + 2 * SZ_WA_IN;
constexpr size_t OFF_WB_IN  = OFF_WA_OUT + 2 * SZ_SQ;
constexpr size_t OFF_WB_OUT = OFF_WB_IN + (size_t)2304 * 1024 * 2;
constexpr size_t OFF_WC_IN  = OFF_WB_OUT + SZ_SQ;
constexpr size_t OFF_WC_OUT = OFF_WC_IN + (size_t)3840 * 1024 * 2;
constexpr size_t OFF_WG     = OFF_WC_OUT + SZ_SQ;
constexpr size_t OFF_WP     = OFF_WG + 4 * SZ_SQ;
constexpr size_t SZ_WP      = (size_t)1024 * 256 * 2;
constexpr size_t OFF_WCK    = OFF_WP + 4 * SZ_WP;
constexpr size_t OFF_WCV    = OFF_WCK + (size_t)64 * 2048 * 2;
constexpr size_t OFF_XB     = OFF_WCV + (size_t)64 * 2048 * 2;
constexpr size_t SZ_ACT     = (size_t)T * 1024 * 2;
constexpr size_t OFF_G      = OFF_XB + SZ_ACT;
constexpr size_t OFF_H      = OFF_G + SZ_ACT;
constexpr size_t SZ_HMAX    = (size_t)T * 3840 * 2;
constexpr size_t OFF_VT0    = OFF_H + SZ_HMAX;
constexpr size_t SZ_VT      = (size_t)2 * 4 * 8192 * 64 * 2;
constexpr size_t OFF_VT1    = OFF_VT0 + SZ_VT;
constexpr size_t OFF_VT2    = OFF_VT1 + SZ_VT;
constexpr size_t OFF_KCMP   = OFF_VT2 + SZ_VT;
constexpr size_t SZ_CMP     = (size_t)2 * 512 * 4 * 64 * 2;
constexpr size_t OFF_VCMP   = OFF_KCMP + SZ_CMP;
constexpr size_t OFF_KI0    = OFF_VCMP + SZ_CMP;
constexpr size_t OFF_KI1    = OFF_KI0 + SZ_VT;
constexpr size_t OFF_KI2    = OFF_KI1 + SZ_VT;
constexpr size_t WS_END     = OFF_KI2 + SZ_VT;
constexpr size_t OFF_XLB    = OFF_H;
constexpr size_t OFF_PB     = OFF_H + SZ_ACT;
constexpr size_t OFF_PP     = OFF_H + SZ_ACT + (size_t)16 * 1024 * 1024;

struct Prm { const float* in[16]; float* out; unsigned char* ws; };

__device__ __forceinline__ size_t kb_off(int row, int k, int K) { return ((size_t)(row >> 4) * (K >> 5) + (k >> 5)) * 512 + (row & 15) * 32 + (k & 31); }
DEV u16 f2bf(float f) { return __builtin_bit_cast(u16, (_Float16)f); }
DEV float bf2f(u16 h) { return (float)__builtin_bit_cast(_Float16, h); }
DEV unsigned pack2(float a, float b) { return (unsigned)f2bf(a) | ((unsigned)f2bf(b) << 16); }
DEV float bflo(unsigned u) { return bf2f((u16)(u & 0xffffu)); }
DEV float bfhi(unsigned u) { return bf2f((u16)(u >> 16)); }
DEV float sigmoidf_(float x) { return 1.f / (1.f + __expf(-x)); }
DEV float siluf_(float x) { return x / (1.f + __expf(-x)); }
DEV float red16_max(float v) { v = fmaxf(v, __shfl_xor(v, 16)); v = fmaxf(v, __shfl_xor(v, 32)); return v; }
DEV float red16_sum(float v) { v += __shfl_xor(v, 16); v += __shfl_xor(v, 32); return v; }
DEV float wave_sum(float v) { for (int o = 32; o > 0; o >>= 1) v += __shfl_xor(v, o); return v; }

DEV int opaque_tid() { int t = threadIdx.x; asm volatile("" : "+v"(t)); return t; }
#define XB_TMO      128
#define XB_XCNT(j)  (256  + 64 * (j))
#define XB_XSUB(j)  (1280 + 64 * (j))
#define XB_XGEN(j)  (2304 + 64 * (j))
#define XB_TOP      3328
#define XB_TOPGEN   3392
#define XCD_BAR_WORDS 3456
#define XB_SPIN_CAP (1u << 24)
DEV unsigned xb_ld(unsigned* p)              { return __hip_atomic_load(p, __ATOMIC_RELAXED, __HIP_MEMORY_SCOPE_AGENT); }
DEV unsigned xb_add(unsigned* p, unsigned v) { return __hip_atomic_fetch_add(p, v, __ATOMIC_RELAXED, __HIP_MEMORY_SCOPE_AGENT); }
DEV unsigned xb_xcc_id() { return (unsigned)__builtin_amdgcn_s_getreg((3 << 11) | 20) & 0xFu; }
#define XB_SPIN(cond, bar) do { unsigned _sp = 0; while (cond) { __builtin_amdgcn_s_sleep(1); \
    if ((++_sp & 255u) == 0u) { if (xb_ld(&(bar)[XB_TMO])) break; if (_sp > XB_SPIN_CAP) { atomicAdd(&(bar)[XB_TMO], 1u); break; } } } } while (0)
struct XcdBarrier { unsigned* bar; unsigned x; volatile LAS unsigned* st; };
DEV XcdBarrier xcd_barrier_post(unsigned* bar, volatile LAS unsigned* st) {
    XcdBarrier b; b.bar = bar; b.x = xb_xcc_id(); b.st = st;
    if (threadIdx.x == 0) (void)xb_add(&bar[XB_XCNT(b.x)], 1u);
    return b;
}
DEV void xcd_barrier_complete(unsigned* bar, unsigned x, unsigned& nloc, unsigned& nx) {
    const unsigned G = gridDim.x * gridDim.y * gridDim.z;
    unsigned sum, cnt, mine, sp = 0u;
    for (;;) {
        sum = 0u; cnt = 0u; mine = 0u;
#pragma unroll
        for (unsigned j = 0; j < 16; ++j) { const unsigned c = xb_ld(&bar[XB_XCNT(j)]); sum += c; cnt += (c > 0u) ? 1u : 0u; mine = (j == x) ? c : mine; }
        if (sum == G) break;
        __builtin_amdgcn_s_sleep(1);
        if ((++sp & 255u) == 0u) { if (xb_ld(&bar[XB_TMO])) break; if (sp > XB_SPIN_CAP) { atomicAdd(&bar[XB_TMO], 1u); break; } }
    }
    nloc = mine > 0u ? mine : 1u; nx = cnt > 0u ? cnt : 1u;
}
DEV void xcd_barrier(const XcdBarrier& b) {
    asm volatile("s_waitcnt vmcnt(0)" ::: "memory");
    __syncthreads();
    if (threadIdx.x == 0) {
        unsigned* bar = b.bar;
        __builtin_amdgcn_s_waitcnt(0);
        unsigned nloc = b.st[0], nx = b.st[1];
        if (nloc == 0u) { xcd_barrier_complete(bar, b.x, nloc, nx); b.st[0] = nloc; b.st[1] = nx; }
        const unsigned old = xb_add(&bar[XB_XSUB(b.x)], 1u);
        const unsigned gen = old / nloc;
        if (old + 1u == (gen + 1u) * nloc) {
            __builtin_amdgcn_fence(__ATOMIC_RELEASE, "agent");
            asm volatile("s_waitcnt vmcnt(0)" ::: "memory");
            const unsigned og = xb_add(&bar[XB_TOP], 1u);
            const unsigned tg = og / nx;
            if (og + 1u == (tg + 1u) * nx) xb_add(&bar[XB_TOPGEN], 1u);
            else XB_SPIN(xb_ld(&bar[XB_TOPGEN]) == tg, bar);
            __builtin_amdgcn_fence(__ATOMIC_ACQUIRE, "agent");
            xb_add(&bar[XB_XGEN(b.x)], 1u);
            asm volatile("s_waitcnt vmcnt(0)" ::: "memory");
        } else {
            XB_SPIN(xb_ld(&bar[XB_XGEN(b.x)]) == gen, bar);
            __builtin_amdgcn_fence(__ATOMIC_ACQUIRE, "agent");
            asm volatile("s_waitcnt vmcnt(0)" ::: "memory");
        }
    }
    __syncthreads();
}

DEV int colmap(int kind, int n) {
    if (kind == 0) return n;
    if (kind == 1) {
        const int c = n / 2560, nn = n - c * 2560;
        if (nn < 2304) { const int g = nn / 768, rem = nn - g * 768, part = rem >> 8, hh = (rem & 255) >> 6, d = rem & 63;
                         return g * 3072 + part * 1024 + (c * 4 + hh) * 64 + d; }
        const int z = nn - 2304; return 9216 + (c * 4 + (z >> 6)) * 64 + (z & 63);
    }
    if (n < 2560) return n;
    if (n < 3584) return n - 2560 + 2608;
    if (n < 3632) return n - 3584 + 2560;
    return -1;
}
DEV void tconv(const int tid_, float* lds, const float* __restrict__ src, int K, int Nsrc, u16* __restrict__ dst, int Ndst, int kind, int& acc_tiles) {
    const int G = gridDim.x, tid = tid_;
    const int ntn = Ndst >> 6, ntk = K >> 6, nt = ntn * ntk;
    int first = ((int)blockIdx.x - (acc_tiles % G) + G) % G;
    acc_tiles += nt;
    for (int t = first; t < nt; t += G) {
        const int tn = t / ntk, tk = t - tn * ntk;
        const int n0 = tn << 6, k0 = tk << 6;
        const int nl = tid & 63;
        const int c = colmap(kind, n0 + nl);
#pragma unroll
        for (int i = 0; i < 16; ++i) {
            const int kl = (tid >> 6) + 4 * i;
            const float v = (c >= 0) ? src[(size_t)(k0 + kl) * Nsrc + c] : 0.f;
            lds[kl * 65 + nl] = v;
        }
        __syncthreads();
        const int r = tid >> 2, kk = (tid & 3) << 4;
        unsigned o[8];
#pragma unroll
        for (int i = 0; i < 8; ++i) o[i] = pack2(lds[(kk + 2 * i) * 65 + r], lds[(kk + 2 * i + 1) * 65 + r]);
        u32x4* dp = (u32x4*)(dst + kb_off(n0 + r, k0 + kk, K));
        dp[0] = u32x4{o[0], o[1], o[2], o[3]};
        dp[1] = u32x4{o[4], o[5], o[6], o[7]};
        __syncthreads();
    }
}

DEV void phase0(const Prm& P, unsigned char* smem) {
    const int tid_ = opaque_tid();
    float* lds = (float*)smem;
    unsigned char* ws = P.ws;
    int acc = 0;
    tconv(tid_, lds, P.in[2], 1024, 10240, (u16*)(ws + OFF_WA_IN), 10240, 1, acc);
    tconv(tid_, lds, P.in[2] + (size_t)1024 * 10240, 1024, 10240, (u16*)(ws + OFF_WA_IN + SZ_WA_IN), 10240, 1, acc);
    tconv(tid_, lds, P.in[3], 1024, 1024, (u16*)(ws + OFF_WA_OUT), 1024, 0, acc);
    tconv(tid_, lds, P.in[3] + (size_t)1024 * 1024, 1024, 1024, (u16*)(ws + OFF_WA_OUT + SZ_SQ), 1024, 0, acc);
    tconv(tid_, lds, P.in[4], 1024, 2304, (u16*)(ws + OFF_WB_IN), 2304, 0, acc);
    tconv(tid_, lds, P.in[6], 1024, 1024, (u16*)(ws + OFF_WB_OUT), 1024, 0, acc);
    tconv(tid_, lds, P.in[7], 1024, 3632, (u16*)(ws + OFF_WC_IN), 3840, 2, acc);
    tconv(tid_, lds, P.in[11], 1024, 1024, (u16*)(ws + OFF_WC_OUT), 1024, 0, acc);
    for (int i = 0; i < 4; ++i) {
        tconv(tid_, lds, P.in[15] + (size_t)i * 1024 * 1024, 1024, 1024, (u16*)(ws + OFF_WG + i * SZ_SQ), 1024, 0, acc);
        tconv(tid_, lds, P.in[14] + (size_t)i * 256 * 1024, 256, 1024, (u16*)(ws + OFF_WP + i * SZ_WP), 1024, 0, acc);
    }
    tconv(tid_, lds, P.in[8], 2048, 64, (u16*)(ws + OFF_WCK), 64, 0, acc);
    tconv(tid_, lds, P.in[9], 2048, 64, (u16*)(ws + OFF_WCV), 64, 0, acc);

    const size_t gtid = (size_t)blockIdx.x * 256 + tid_, gsz = (size_t)gridDim.x * 256;
    {
        const float* x = P.in[0]; u16* xb = (u16*)(ws + OFF_XB);
        for (size_t i = gtid; i < (size_t)T * 1024 / 8; i += gsz) {
            const f32x4 a = *(const f32x4*)(x + i * 8), b = *(const f32x4*)(x + i * 8 + 4);
            *(u32x4*)(xb + kb_off((int)(i >> 7), (int)(i & 127) * 8, 1024)) = u32x4{pack2(a[0], a[1]), pack2(a[2], a[3]), pack2(b[0], b[1]), pack2(b[2], b[3])};
        }
    }
    {
        float* ct = (float*)(ws + OFF_COS); float* st = (float*)(ws + OFF_SIN);
        for (size_t i = gtid; i < (size_t)8192 * 32; i += gsz) {
            const int pos = (int)(i >> 5), k = (int)(i & 31);
            const float inv = (float)(1.0 / pow(10000.0, (double)(2 * k) / 64.0));
            const float ang = (float)pos * inv;
            ct[i] = (float)cos((double)ang); st[i] = (float)sin((double)ang);
        }
    }
    {
        const int lane = tid_ & 63;
        const int wid = blockIdx.x * 4 + __builtin_amdgcn_readfirstlane(tid_ >> 6);
        if (wid < 128) {
            const float* w = (wid < 64) ? P.in[8] : P.in[9];
            const int e = wid & 63;
            float s = 0.f;
            for (int jd = lane; jd < 2048; jd += 64) s += P.in[10][jd] * w[(size_t)jd * 64 + e];
            s = wave_sum(s);
            if (lane == 0) ((float*)(ws + OFF_BIAS))[wid] = s;
        }
    }
}

constexpr int GSTAGE = 24576;
DEV int gsw(int r) { return (0x78 >> (2 * ((r >> 2) & 3))) & 3; }
DEV void gemm_issue(unsigned char* stage, const u16* ag0, const u16* ag1, const u16* bg, int bstep, int kt, int w) {
    __builtin_amdgcn_global_load_lds((const unsigned*)(ag0 + kt * 512), (unsigned*)(stage + w * 1024), 16, 0, 0);
    __builtin_amdgcn_global_load_lds((const unsigned*)(ag1 + kt * 512), (unsigned*)(stage + w * 1024 + 4096), 16, 0, 0);
#pragma unroll
    for (int i = 0; i < 4; ++i)
        __builtin_amdgcn_global_load_lds((const unsigned*)(bg + (size_t)i * bstep + kt * 512), (unsigned*)(stage + 8192 + w * 1024 + i * 4096), 16, 0, 0);
}
template <bool NONSWAP>
DEV void gemm_mainloop(const int tid_, unsigned char* smem, const u16* __restrict__ A, int lda, const u16* __restrict__ Bt, int ldb, int K,
                       int m0, int n0, f32x4 (&acc)[32], bool aperm = false) {
    const int tid = tid_, lane = tid & 63, w = __builtin_amdgcn_readfirstlane(tid >> 6), wm = w >> 1, wn = w & 1;
    const int lrow = tid >> 2, lsw = ((tid & 3) ^ gsw(lrow)) * 8;
    const int arow0 = aperm ? ((lrow & 31) * 4 + (lrow >> 5)) : lrow;
    const int arow1 = aperm ? (arow0 + 2) : (lrow + 64);
    const u16* ag0 = A + kb_off(m0 + arow0, 0, lda) + lsw;
    const u16* ag1 = A + kb_off(m0 + arow1, 0, lda) + lsw;
    const u16* bg = Bt + kb_off(n0 + lrow, 0, ldb) + lsw;
    const int bstep = 4 * (ldb >> 5) * 512;
    const int fr = lane & 15, fq = lane >> 4;
    const int coff = (fq ^ gsw(fr)) << 4;
    const int a_base = (wm * 64 + fr) * 64 + coff, b_base = 8192 + (wn * 128 + fr) * 64 + coff;
    const int nk = K >> 5;
    asm volatile("s_waitcnt vmcnt(0)" ::: "memory");
    __builtin_amdgcn_s_barrier();
    gemm_issue(smem, ag0, ag1, bg, bstep, 0, w);
    gemm_issue(smem + GSTAGE, ag0, ag1, bg, bstep, 1, w);
    int sc = 0, si = 2;
    for (int kt = 0; kt < nk; ++kt) {
        if (kt + 1 < nk) asm volatile("s_waitcnt vmcnt(6)" ::: "memory"); else asm volatile("s_waitcnt vmcnt(0)" ::: "memory");
        __builtin_amdgcn_s_barrier();
        if (kt + 2 < nk) { gemm_issue(smem + si * GSTAGE, ag0, ag1, bg, bstep, kt + 2, w); si = (si == 2) ? 0 : si + 1; }
        const unsigned char* st = smem + sc * GSTAGE; sc = (sc == 2) ? 0 : sc + 1;
        bf16x8 a[4], b[8];
#pragma unroll
        for (int i = 0; i < 4; ++i) a[i] = *(const bf16x8*)(st + a_base + i * 1024);
#pragma unroll
        for (int i = 0; i < 8; ++i) b[i] = *(const bf16x8*)(st + b_base + i * 1024);
        if (NONSWAP) {
#pragma unroll
            for (int mt = 0; mt < 4; ++mt)
#pragma unroll
                for (int nt = 0; nt < 8; ++nt) acc[mt * 8 + nt] = MFMA16(a[mt], b[nt], acc[mt * 8 + nt]);
        } else {
#pragma unroll
            for (int nt = 0; nt < 8; ++nt)
#pragma unroll
                for (int mt = 0; mt < 4; ++mt) acc[nt * 4 + mt] = MFMA16(b[nt], a[mt], acc[nt * 4 + mt]);
        }
    }
}

DEV int vblock() { const int G = gridDim.x, b = blockIdx.x; return ((G & 7) == 0) ? (b & 7) * (G >> 3) + (b >> 3) : b; }
DEV void tile_mn(int t, int nN, int& mi, int& ni) { const int per = 16 * nN; const int mg = t / per, r = t - mg * per; mi = mg * 16 + (r & 15); ni = r >> 4; }
#define ZERO_ACC(acc) _Pragma("unroll") for (int i_ = 0; i_ < 32; ++i_) acc[i_] = f32x4{0.f, 0.f, 0.f, 0.f}

DEV void classify(int kind, int cgi, int& mode, int& vsel, int& vth, int& dsh, int& nhv, int& ksel) {
    mode = 0; vsel = 0; vth = 0; dsh = 0; nhv = 4; ksel = -1;
    if (kind == 0) {
        if (cgi < 36) { const int g = cgi / 12, part = (cgi - g * 12) >> 2; vth = cgi & 3; if (part < 2) { mode = 1; if (part == 1) { ksel = g; dsh = 2 * g; } } else { mode = 2; vsel = g; dsh = 2 * g; } }
    } else if (kind == 1) {
        if (cgi < 16) mode = 1; else if (cgi < 18) { mode = 1; ksel = 0; vth = cgi - 16; nhv = 2; } else if (cgi < 20) { mode = 2; vsel = 0; vth = cgi - 18; nhv = 2; }
    } else {
        if (cgi < 20) mode = 1; else if (cgi < 24) mode = 0; else if (cgi < 28) { mode = 1; ksel = 0; vth = cgi - 24; } else if (cgi < 32) { mode = 2; vsel = 0; vth = cgi - 28; }
        else if (cgi < 36) { mode = 1; ksel = 1; vth = cgi - 32; } else if (cgi < 40) { mode = 2; vsel = 1; vth = cgi - 36; }
    }
}

DEV void gemm_in_phase(unsigned char* smem, const Prm& P, int kind, const u16* Wt, int N) {
    const int tid_ = opaque_tid();
    unsigned char* ws = P.ws;
    const u16* A = (const u16*)(ws + OFF_XB);
    u16* H = (u16*)(ws + OFF_H);
    const float* cosT = (const float*)(ws + OFF_COS); const float* sinT = (const float*)(ws + OFF_SIN);
    const int nN = N >> 8, ntiles = 128 * nN;
    const int lane = tid_ & 63, w = __builtin_amdgcn_readfirstlane(tid_ >> 6), wm = w >> 1, wn = w & 1, fr = lane & 15, fq = lane >> 4;
    for (int t = vblock(); t < ntiles; t += gridDim.x) {
        int mi, ni; tile_mn(t, nN, mi, ni);
        const int m0 = mi << 7, n0 = ni << 8;
        const int ncol = n0 + wn * 128, cg0 = ncol >> 6;
        int mode, vsel, vth, dsh, nhv, ksel; classify(kind, cg0, mode, vsel, vth, dsh, nhv, ksel);
        const int mw = m0 + wm * 64;
        f32x4 acc[32]; ZERO_ACC(acc);
        if (mode == 2) {
            gemm_mainloop<true>(tid_, smem, A, 1024, Wt, 1024, 1024, m0, n0, acc, dsh == 2);
            __builtin_amdgcn_s_barrier();
            u16* vt = (u16*)(ws + (vsel == 0 ? OFF_VT0 : (vsel == 1 ? OFF_VT1 : OFF_VT2)));
            if (dsh == 0) {
#pragma unroll
                for (int mt = 0; mt < 4; ++mt) {
                    const int m = mw + mt * 16 + fq * 4;
                    const int b = m >> 13, p = m & 8191;
#pragma unroll
                    for (int grp = 0; grp < 2; ++grp) {
                        u16* dst = vt + ((((size_t)(b * nhv + vth + grp)) * 512 + (p >> 4)) * 64) * 16 + (p & 15);
#pragma unroll
                        for (int nt = 0; nt < 4; ++nt) { const f32x4 v = acc[mt * 8 + grp * 4 + nt]; *(u32x2*)(dst + (nt * 16 + fr) * 16) = u32x2{pack2(v[0], v[1]), pack2(v[2], v[3])}; }
                    }
                }
            } else if (dsh == 4) {
#pragma unroll
                for (int j = 0; j < 4; ++j) {
                    const int m = mw + fq * 4 + j;
                    const int b = m >> 13, s = m & 8191;
                    const int p = ((s & 15) << 9) + (s >> 4);
#pragma unroll
                    for (int grp = 0; grp < 2; ++grp) {
                        u16* dst = vt + ((((size_t)(b * nhv + vth + grp)) * 512 + (p >> 4)) * 64) * 16 + (p & 15);
#pragma unroll
                        for (int nt = 0; nt < 4; ++nt)
                            *(u32x2*)(dst + (nt * 16 + fr) * 16) = u32x2{pack2(acc[0 * 8 + grp * 4 + nt][j], acc[1 * 8 + grp * 4 + nt][j]), pack2(acc[2 * 8 + grp * 4 + nt][j], acc[3 * 8 + grp * 4 + nt][j])};
                    }
                }
            } else {
#pragma unroll
                for (int mt = 0; mt < 4; ++mt) {
                    const int r0 = wm * 64 + mt * 16 + fq * 4;
                    const int m = m0 + (r0 & 31) * 4 + (r0 >> 5);
                    const int b = m >> 13, s = m & 8191;
                    const int p = ((s & 3) << 11) + (s >> 2);
#pragma unroll
                    for (int grp = 0; grp < 2; ++grp) {
                        u16* dst = vt + ((((size_t)(b * nhv + vth + grp)) * 512 + (p >> 4)) * 64) * 16 + (p & 15);
#pragma unroll
                        for (int nt = 0; nt < 4; ++nt) { const f32x4 v = acc[mt * 8 + grp * 4 + nt]; *(u32x2*)(dst + (nt * 16 + fr) * 16) = u32x2{pack2(v[0], v[1]), pack2(v[2], v[3])}; }
                    }
                }
            }
        } else {
            gemm_mainloop<false>(tid_, smem, A, 1024, Wt, 1024, 1024, m0, n0, acc);
            __builtin_amdgcn_s_barrier();
            constexpr int EROW = 272;
            unsigned char* est = smem + w * (64 * EROW);
            int l4_ = lane; asm volatile("" : "+v"(l4_));
            const int fr = l4_ & 15, fq = l4_ >> 4;
#pragma unroll
            for (int mt = 0; mt < 4; ++mt) {
                const int s = (mw + mt * 16 + fr) & 8191;
                unsigned char* erow = est + (mt * 16 + fr) * EROW + fq * 8;
                if (mode == 1) {
#pragma unroll
                    for (int nt = 0; nt < 2; ++nt) {
                        const f32x4 c4 = *(const f32x4*)(cosT + s * 32 + nt * 16 + fq * 4);
                        const f32x4 s4 = *(const f32x4*)(sinT + s * 32 + nt * 16 + fq * 4);
#pragma unroll
                        for (int grp = 0; grp < 2; ++grp) {
                            const f32x4 x1 = acc[(grp * 4 + nt) * 4 + mt], x2 = acc[(grp * 4 + nt + 2) * 4 + mt];
                            const f32x4 o1 = x1 * c4 - x2 * s4, o2 = x2 * c4 + x1 * s4;
                            *(u32x2*)(erow + (grp * 64 + nt * 16) * 2) = u32x2{pack2(o1[0], o1[1]), pack2(o1[2], o1[3])};
                            *(u32x2*)(erow + (grp * 64 + (nt + 2) * 16) * 2) = u32x2{pack2(o2[0], o2[1]), pack2(o2[2], o2[3])};
                        }
                    }
                } else {
#pragma unroll
                    for (int nt = 0; nt < 8; ++nt) { const f32x4 v = acc[nt * 4 + mt]; *(u32x2*)(erow + nt * 32) = u32x2{pack2(v[0], v[1]), pack2(v[2], v[3])}; }
                }
            }
            __builtin_amdgcn_fence(__ATOMIC_RELEASE, "wavefront"); __builtin_amdgcn_wave_barrier(); __builtin_amdgcn_fence(__ATOMIC_ACQUIRE, "wavefront");
            {
                const int rr = l4_ >> 4, ch = l4_ & 15;
                if (ksel >= 0) {
                    u16* ki = (u16*)(ws + (ksel == 0 ? OFF_KI0 : (ksel == 1 ? OFF_KI1 : OFF_KI2)));
                    const int dmask = (1 << dsh) - 1, lsh = 13 - dsh, numask = (64 >> dsh) - 1;
                    const int kk = l4_ >> 2, c4 = l4_ & 3;
#pragma unroll 4
                    for (int i = 0; i < 16; ++i) {
                        const int rgp = i >> 2, hd = (i >> 1) & 1, half = i & 1;
                        const int tt = rgp * 16 + kk;
                        const int row = ((tt & numask) << dsh) + (tt >> (6 - dsh));
                        const int m = mw + row, b = m >> 13, s = m & 8191;
                        const int p = ((s & dmask) << lsh) + (s >> dsh);
                        const u32x4 v = *(const u32x4*)(est + row * EROW + (hd * 64 + half * 32 + c4 * 8) * 2);
                        *(u32x4*)(ki + ((((size_t)(b * nhv + vth + hd) * 512 + (p >> 4)) * 2 + half) * 16 + (p & 15)) * 32 + c4 * 8) = v;
                    }
                } else {
                u16* hbase = H + (size_t)mw * N + ncol + ch * 8;
#pragma unroll
                for (int i = 0; i < 16; ++i) {
                    const int row = i * 4 + rr;
                    const u32x4 v = *(const u32x4*)(est + row * EROW + ch * 16);
                    *(u32x4*)(hbase + (size_t)row * N) = v;
                }
                }
            }
        }
    }
}

DEV void gemm_out_phase(unsigned char* smem, const Prm& P, const u16* Wt, const float* xin) {
    const int tid_ = opaque_tid();
    const u16* A = (const u16*)(P.ws + OFF_G);
    const int lane = tid_ & 63, w = __builtin_amdgcn_readfirstlane(tid_ >> 6), wm = w >> 1, wn = w & 1, fr = lane & 15, fq = lane >> 4;
    for (int t = vblock(); t < 512; t += gridDim.x) {
        int mi, ni; tile_mn(t, 4, mi, ni);
        const int m0 = mi << 7, n0 = ni << 8;
        f32x4 acc[32]; ZERO_ACC(acc);
        gemm_mainloop<false>(tid_, smem, A, 1024, Wt, 1024, 1024, m0, n0, acc);
        {
            __builtin_amdgcn_s_barrier();
            constexpr int EROWF = 528;
            unsigned char* est = smem + w * (32 * EROWF);
            const size_t ub = (size_t)(m0 + wm * 64) * 1024 + n0 + wn * 128;
            const float* xw = xin + ub; float* ow = P.out + ub;
            int l2_ = lane; asm volatile("" : "+v"(l2_));
            const int fr2 = l2_ & 15, fq2 = l2_ >> 4, rr = l2_ >> 5, ch = l2_ & 31;
#pragma unroll
            for (int h = 0; h < 2; ++h) {
#pragma unroll
                for (int mh = 0; mh < 2; ++mh) {
                    unsigned char* erow = est + (mh * 16 + fr2) * EROWF + fq2 * 16;
#pragma unroll
                    for (int nt = 0; nt < 8; ++nt) *(f32x4*)(erow + nt * 64) = acc[nt * 4 + h * 2 + mh];
                }
                __builtin_amdgcn_fence(__ATOMIC_RELEASE, "wavefront"); __builtin_amdgcn_wave_barrier(); __builtin_amdgcn_fence(__ATOMIC_ACQUIRE, "wavefront");
#pragma unroll 4
                for (int i = 0; i < 16; ++i) {
                    const int row = i * 2 + rr;
                    const unsigned ix = (unsigned)((h * 32 + row) * 1024 + ch * 4);
                    const f32x4 v = *(const f32x4*)(est + row * EROWF + ch * 16);
                    const f32x4 xv = *(const f32x4*)(xw + ix);
                    *(f32x4*)(ow + ix) = xv * DN_ALPHA + v;
                }
                __builtin_amdgcn_fence(__ATOMIC_RELEASE, "wavefront"); __builtin_amdgcn_wave_barrier(); __builtin_amdgcn_fence(__ATOMIC_ACQUIRE, "wavefront");
            }
        }
    }
}

DEV void gemm_gate_phase(unsigned char* smem, const Prm& P, const u16* Wg, const u16* Wp) {
    const int tid_ = opaque_tid();
    const u16* A1 = (const u16*)(P.ws + OFF_XLB);
    const u16* A2 = (const u16*)(P.ws + OFF_PB);
    u16* xb = (u16*)(P.ws + OFF_XB);
    u16* ppb = (u16*)(P.ws + OFF_PP);
    const int lane = tid_ & 63, w = __builtin_amdgcn_readfirstlane(tid_ >> 6), wm = w >> 1, wn = w & 1, fr = lane & 15, fq = lane >> 4;
    for (int t = vblock(); t < 512; t += gridDim.x) {
        int mi, ni; tile_mn(t, 4, mi, ni);
        const int m0 = mi << 7, n0 = ni << 8;
        f32x4 acc[32]; ZERO_ACC(acc);
        gemm_mainloop<false>(tid_, smem, A2, 256, Wp, 256, 256, m0, n0, acc);
        const size_t ub = (size_t)(m0 + wm * 64) * 1024 + n0 + wn * 128;
        float* ow = P.out + ub; u16* pw = ppb + ub; u16* xw = xb + ub;
        {
            int l2_ = lane; asm volatile("" : "+v"(l2_));
            const unsigned lo = (unsigned)((l2_ & 15) * 1024 + (l2_ >> 4) * 4);
#pragma unroll
            for (int mt = 0; mt < 4; ++mt) {
#pragma unroll
                for (int nt = 0; nt < 8; ++nt) { const f32x4 v = acc[nt * 4 + mt]; *(u32x2*)(pw + (lo + mt * 16384 + nt * 16)) = u32x2{pack2(v[0], v[1]), pack2(v[2], v[3])}; }
                __builtin_amdgcn_sched_barrier(0);
            }
        }
        ZERO_ACC(acc);
        gemm_mainloop<false>(tid_, smem, A1, 1024, Wg, 1024, 1024, m0, n0, acc);
        int l3_ = lane; asm volatile("" : "+v"(l3_));
        const unsigned lo = (unsigned)((l3_ & 15) * 1024 + (l3_ >> 4) * 4);
#pragma unroll
        for (int mt = 0; mt < 4; ++mt) {
#pragma unroll
            for (int nt = 0; nt < 8; ++nt) {
                const unsigned ix = lo + mt * 16384 + nt * 16;
                const f32x4 xv = *(const f32x4*)(ow + ix);
                const u32x2 pq = *(const u32x2*)(pw + ix);
                const f32x4 ga = acc[nt * 4 + mt];
                f32x4 r;
                r[0] = xv[0] + sigmoidf_(ga[0]) * bflo(pq[0]); r[1] = xv[1] + sigmoidf_(ga[1]) * bfhi(pq[0]);
                r[2] = xv[2] + sigmoidf_(ga[2]) * bflo(pq[1]); r[3] = xv[3] + sigmoidf_(ga[3]) * bfhi(pq[1]);
                *(f32x4*)(ow + ix) = r;
                *(u32x2*)(xb + kb_off(m0 + wm * 64 + mt * 16 + (l3_ & 15), n0 + wn * 128 + nt * 16 + (l3_ >> 4) * 4, 1024)) = u32x2{pack2(r[0], r[1]), pack2(r[2], r[3])};
            }
            __builtin_amdgcn_sched_barrier(0);
        }
    }
}

DEV void ln_phase(const Prm& P, int layer) {
    const int tid_ = opaque_tid();
    const int lane = tid_ & 63, w = __builtin_amdgcn_readfirstlane(tid_ >> 6);
    const float* g = P.in[12] + layer * 1024; const float* bb = P.in[13] + layer * 1024;
    u16* xlb = (u16*)(P.ws + OFF_XLB);
    for (int row = blockIdx.x * 4 + w; row < T; row += gridDim.x * 4) {
        float* xr = P.out + (size_t)row * 1024;
        f32x4 v[4];
        float s = 0.f;
#pragma unroll
        for (int i = 0; i < 4; ++i) { v[i] = *(const f32x4*)(xr + i * 256 + lane * 4); s += v[i][0] + v[i][1] + v[i][2] + v[i][3]; }
        const float mean = wave_sum(s) * (1.f / 1024.f);
        float q = 0.f;
#pragma unroll
        for (int i = 0; i < 4; ++i)
#pragma unroll
            for (int j = 0; j < 4; ++j) { const float d = v[i][j] - mean; q += d * d; }
        const float rstd = rsqrtf(wave_sum(q) * (1.f / 1024.f) + LN_EPS);
#pragma unroll
        for (int i = 0; i < 4; ++i) {
            const f32x4 gg = *(const f32x4*)(g + i * 256 + lane * 4), bv = *(const f32x4*)(bb + i * 256 + lane * 4);
            f32x4 y;
#pragma unroll
            for (int j = 0; j < 4; ++j) y[j] = (v[i][j] - mean) * rstd * gg[j] + bv[j];
            *(f32x4*)(xr + i * 256 + lane * 4) = y;
            *(u32x2*)(xlb + kb_off(row, i * 256 + lane * 4, 1024)) = u32x2{pack2(y[0], y[1]), pack2(y[2], y[3])};
        }
    }
    const float* p = P.in[1] + (size_t)layer * T * 256; u16* pb = (u16*)(P.ws + OFF_PB);
    const size_t gtid = (size_t)blockIdx.x * 256 + tid_, gsz = (size_t)gridDim.x * 256;
    for (size_t i = gtid; i < (size_t)T * 256 / 8; i += gsz) {
        const f32x4 a = *(const f32x4*)(p + i * 8), b = *(const f32x4*)(p + i * 8 + 4);
        *(u32x4*)(pb + kb_off((int)(i >> 5), (int)(i & 31) * 8, 256)) = u32x4{pack2(a[0], a[1]), pack2(a[2], a[3]), pack2(b[0], b[1]), pack2(b[2], b[3])};
    }
}

struct KV { bf16x8 ka0, ka1, kb0, kb1; bf16x8 v0, v1, v2, v3; };
template <int KH = 1024>
DEV void load_kv(KV& t, const char* Kb, unsigned koa, unsigned kob, const char* Vb, unsigned voa, unsigned vob) {
    t.ka0 = *(const bf16x8*)(Kb + koa); t.ka1 = *(const bf16x8*)(Kb + koa + KH);
    t.kb0 = *(const bf16x8*)(Kb + kob); t.kb1 = *(const bf16x8*)(Kb + kob + KH);
    t.v0 = __builtin_shufflevector(*(const s16x4*)(Vb + voa), *(const s16x4*)(Vb + vob), 0, 1, 2, 3, 4, 5, 6, 7);
    t.v1 = __builtin_shufflevector(*(const s16x4*)(Vb + voa + 512), *(const s16x4*)(Vb + vob + 512), 0, 1, 2, 3, 4, 5, 6, 7);
    t.v2 = __builtin_shufflevector(*(const s16x4*)(Vb + voa + 1024), *(const s16x4*)(Vb + vob + 1024), 0, 1, 2, 3, 4, 5, 6, 7);
    t.v3 = __builtin_shufflevector(*(const s16x4*)(Vb + voa + 1536), *(const s16x4*)(Vb + vob + 1536), 0, 1, 2, 3, 4, 5, 6, 7);
}
DEV unsigned pkrtz(float a, float b) { return __builtin_bit_cast(unsigned, __builtin_amdgcn_cvt_pkrtz(a, b)); }
DEV bf16x8 pack8(const float (&p)[8]) {
    return __builtin_bit_cast(bf16x8, u32x4{pkrtz(p[0], p[1]), pkrtz(p[2], p[3]), pkrtz(p[4], p[5]), pkrtz(p[6], p[7])});
}
DEV void qk_scores(const KV& t, const bf16x8& q0, const bf16x8& q1, f32x4& sa, f32x4& sb) {
    sa = f32x4{0.f, 0.f, 0.f, 0.f}; sb = f32x4{0.f, 0.f, 0.f, 0.f};
    sa = MFMA16(t.ka0, q0, sa); sa = MFMA16(t.ka1, q1, sa);
    sb = MFMA16(t.kb0, q0, sb); sb = MFMA16(t.kb1, q1, sb);
}
constexpr float QK_C = 0.125f * 1.4426950408889634f;
DEV void flash_core(float& mref, float& l, f32x4 (&o)[4], const bf16x8& q0, const bf16x8& q1, const KV& t, bool fast, int d0, unsigned lim) {
    f32x4 sa, sb; qk_scores(t, q0, q1, sa, sb);
    float y[8];
    if (fast) {
#pragma unroll
        for (int j = 0; j < 4; ++j) { y[j] = sa[j] * QK_C; y[4 + j] = sb[j] * QK_C; }
    } else {
#pragma unroll
        for (int j = 0; j < 4; ++j) {
            y[j]     = ((unsigned)(d0 - j) <= lim)      ? sa[j] * QK_C : NEG_INF;
            y[4 + j] = ((unsigned)(d0 - 16 - j) <= lim) ? sb[j] * QK_C : NEG_INF;
        }
    }
    float mx = fmaxf(fmaxf(fmaxf(y[0], y[1]), fmaxf(y[2], y[3])), fmaxf(fmaxf(y[4], y[5]), fmaxf(y[6], y[7])));
    if (__ballot(mx > mref + 8.f) != 0ull) {
        mx = red16_max(mx);
        const float mn = fmaxf(mref, mx);
        const float alpha = (mn == NEG_INF) ? 1.f : __builtin_amdgcn_exp2f(mref - mn);
        l *= alpha;
#pragma unroll
        for (int d = 0; d < 4; ++d) o[d] *= alpha;
        mref = mn;
    }
    const float mu = (mref == NEG_INF) ? 0.f : mref;
    float p[8]; float ps = 0.f;
#pragma unroll
    for (int j = 0; j < 8; ++j) { p[j] = __builtin_amdgcn_exp2f(y[j] - mu); ps += p[j]; }
    l += ps;
    const bf16x8 pf = pack8(p);
    o[0] = MFMA16(t.v0, pf, o[0]); o[1] = MFMA16(t.v1, pf, o[1]); o[2] = MFMA16(t.v2, pf, o[2]); o[3] = MFMA16(t.v3, pf, o[3]);
}

#define RING4(NSTEPS, LOADSTEP, COMPUTE) do { \
    KV r0_, r1_, r2_; const int nl_ = (NSTEPS) - 1; \
    LOADSTEP(r0_, 0); LOADSTEP(r1_, min(1, nl_)); \
    for (int st_ = 0; st_ < (NSTEPS); st_ += 3) { \
        LOADSTEP(r2_, min(st_ + 2, nl_)); COMPUTE(r0_, st_); \
        LOADSTEP(r0_, min(st_ + 3, nl_)); if (st_ + 1 < (NSTEPS)) COMPUTE(r1_, st_ + 1); \
        LOADSTEP(r1_, min(st_ + 4, nl_)); if (st_ + 2 < (NSTEPS)) COMPUTE(r2_, st_ + 2); \
    } } while (0)

DEV void band_loop(const int tid_, float& m, float& l, f32x4 (&o)[4], const bf16x8& q0, const bf16x8& q1, const char* Kb,
                   const char* Vb, int vblk0, int ustart, int nsteps, int uq, int uq0, int qspan, int maxd) {
    const int c = tid_ & 15, g4 = (tid_ & 63) >> 4;
    const unsigned kl = c * 64 + g4 * 16, vl = c * 32 + g4 * 8;
    const unsigned lim = (unsigned)min(maxd, uq);
#define BL_LOAD(R, S) do { const int ua_ = ustart + (S) * 32, ub_ = ua_ + 16; \
        const unsigned ba_ = (unsigned)(vblk0 + (max(ua_, 0) >> 4)) * 2048u, bb_ = (unsigned)(vblk0 + (max(ub_, 0) >> 4)) * 2048u; \
        load_kv(R, Kb, ba_ + kl, bb_ + kl, Vb, ba_ + vl, bb_ + vl); } while (0)
#define BL_COMP(R, S) do { const int ua_ = ustart + (S) * 32; \
        const bool fast_ = (ua_ >= 0) && (ua_ + 31 <= uq0) && (uq0 + qspan - ua_ <= maxd); \
        flash_core(m, l, o, q0, q1, R, fast_, uq - ua_ - g4 * 4, lim); } while (0)
    RING4(nsteps, BL_LOAD, BL_COMP);
#undef BL_LOAD
#undef BL_COMP
}

DEV void attnA_phase(const Prm& P, int chunk) {
    const int tid_ = opaque_tid();
    unsigned char* ws = P.ws;
    const u16* H = (const u16*)(ws + OFF_H);
    u16* G = (u16*)(ws + OFF_G);
    const int lane = tid_ & 63, w = __builtin_amdgcn_readfirstlane(tid_ >> 6), c = lane & 15, g4 = lane >> 4;
    constexpr int LD = 2560;
    const int xcd_ = blockIdx.x & 7, slot_ = blockIdx.x >> 3, nslot_ = gridDim.x >> 3;
    for (int i_ = slot_; i_ < 128; i_ += nslot_) {
        const int rq = i_ & 3, tbi = i_ >> 2, hh = xcd_ & 3, b = xcd_ >> 2;
        const int r = rq * 4 + w, tb = tbi * 256;
        const int sq = tb + r + 16 * c;
        const size_t rowq = (size_t)b * 8192 + sq;
        float m = NEG_INF, l = 0.f;
        f32x4 o[4];
#pragma unroll
        for (int d = 0; d < 4; ++d) o[d] = f32x4{0.f, 0.f, 0.f, 0.f};
#pragma unroll 1
        for (int g = 0; g < 3; ++g) {
            const int dsh = 2 * g, dmask = (1 << dsh) - 1;
            const int rg = r & dmask;
            const int uq = sq >> dsh, uq0 = (tb + r) >> dsh;
            int ustart = (uq0 - 128) & ~15;
            const int ulast = (uq0 + (15 << (4 - dsh))) & ~15;
            int ntile = ((ulast - ustart) >> 4) + 1;
            if (ntile & 1) { ustart -= 16; ntile += 1; }
            const u16* Hq = H + rowq * LD + g * 768 + hh * 64 + g4 * 8;
            const bf16x8 q0 = *(const bf16x8*)Hq, q1 = *(const bf16x8*)(Hq + 32);
            const char* Kb = (const char*)((const u16*)(ws + (g == 0 ? OFF_KI0 : (g == 1 ? OFF_KI1 : OFF_KI2))) + ((size_t)(b * 4 + hh) * 512) * 1024);
            const char* Vb = (const char*)((const u16*)(ws + (g == 0 ? OFF_VT0 : (g == 1 ? OFF_VT1 : OFF_VT2))) + ((size_t)(b * 4 + hh) * 512) * 1024);
            const int vblk0 = rg * ((8192 >> dsh) >> 4);
            band_loop(tid_, m, l, o, q0, q1, Kb, Vb, vblk0, ustart, ntile >> 1, uq, uq0, 15 << (4 - dsh), 128);
        }
        l = red16_sum(l);
        const float inv = 1.f / l;
#pragma unroll
        for (int dt = 0; dt < 4; ++dt) {
            const int dh = dt * 16 + g4 * 4;
            const u32x2 z = *(const u32x2*)(H + rowq * LD + 2304 + hh * 64 + dh);
            const float r0 = o[dt][0] * inv * siluf_(bflo(z[0])), r1 = o[dt][1] * inv * siluf_(bfhi(z[0]));
            const float r2 = o[dt][2] * inv * siluf_(bflo(z[1])), r3 = o[dt][3] * inv * siluf_(bfhi(z[1]));
            *(u32x2*)(G + kb_off((int)rowq, (chunk * 4 + hh) * 64 + dh, 1024)) = u32x2{pack2(r0, r1), pack2(r2, r3)};
        }
    }
}

DEV void attnB_phase(const Prm& P) {
    const int tid_ = opaque_tid();
    unsigned char* ws = P.ws;
    const u16* H = (const u16*)(ws + OFF_H);
    u16* G = (u16*)(ws + OFF_G);
    const float* sinks = P.in[5];
    const int lane = tid_ & 63, w = __builtin_amdgcn_readfirstlane(tid_ >> 6), c = lane & 15, g4 = lane >> 4;
    constexpr int LD = 2304;
    const int xcd_ = blockIdx.x & 7, slot_ = blockIdx.x >> 3, nslot_ = gridDim.x >> 3;
    for (int tile = slot_; tile < 512; tile += nslot_) {
        const int b = xcd_ >> 2, hq = xcd_ & 3;
        const int head = hq * 4 + w, kvh = head >> 3;
        const int t0 = tile * 16, sq = t0 + c;
        const size_t rowq = (size_t)b * 8192 + sq;
        float m = NEG_INF, l = 0.f;
        f32x4 o[4];
#pragma unroll
        for (int d = 0; d < 4; ++d) o[d] = f32x4{0.f, 0.f, 0.f, 0.f};
        const u16* Hq = H + rowq * LD + head * 64 + g4 * 8;
        const bf16x8 q0 = *(const bf16x8*)Hq, q1 = *(const bf16x8*)(Hq + 32);
        const char* Kb = (const char*)((const u16*)(ws + OFF_KI0) + ((size_t)(b * 2 + kvh) * 512) * 1024);
        const char* Vb = (const char*)((const u16*)(ws + OFF_VT0) + ((size_t)(b * 2 + kvh) * 512) * 1024);
        band_loop(tid_, m, l, o, q0, q1, Kb, Vb, 0, t0 - 144, 5, sq, t0, 15, 127);
        l = red16_sum(l);
        const float mu = (m == NEG_INF) ? 0.f : m;
        const float lf = l + __builtin_amdgcn_exp2f(sinks[head] * 1.4426950408889634f - mu);
        const float inv = 1.f / lf;
#pragma unroll
        for (int dt = 0; dt < 4; ++dt) {
            const int dh = dt * 16 + g4 * 4;
            const u32x2 z = *(const u32x2*)(H + rowq * LD + 1280 + head * 64 + dh);
            const float r0 = o[dt][0] * inv * siluf_(bflo(z[0])), r1 = o[dt][1] * inv * siluf_(bfhi(z[0]));
            const float r2 = o[dt][2] * inv * siluf_(bflo(z[1])), r3 = o[dt][3] * inv * siluf_(bfhi(z[1]));
            *(u32x2*)(G + kb_off((int)rowq, head * 64 + dh, 1024)) = u32x2{pack2(r0, r1), pack2(r2, r3)};
        }
    }
}

DEV void compress_phase(const Prm& P) {
    const int tid_ = opaque_tid();
    unsigned char* ws = P.ws;
    const u16* H = (const u16*)(ws + OFF_H);
    constexpr int LD = 3840;
    const float* bias = (const float*)(ws + OFF_BIAS);
    const int lane = tid_ & 63, w = __builtin_amdgcn_readfirstlane(tid_ >> 6), c = lane & 15, g4 = lane >> 4;
    for (int it = blockIdx.x; it < 128; it += gridDim.x) {
        const int unit = it * 4 + w;
        const int which = unit >> 8, b = (unit >> 7) & 1, kvh = (unit >> 5) & 3, ntile = unit & 31;
        const u16* Wt = (const u16*)(ws + (which ? OFF_WCV : OFF_WCK));
        const int colbase = (which ? 1280 : 1024) + kvh * 64;
        const int n = ntile * 16 + c;
        const u16* Wl = Wt + c * 32 + g4 * 8;
        f32x4 acc[4];
#pragma unroll
        for (int e = 0; e < 4; ++e) acc[e] = f32x4{0.f, 0.f, 0.f, 0.f};
#pragma unroll 4
        for (int kk = 0; kk < 64; ++kk) {
            const int j = kk >> 1, d0 = (kk & 1) * 32 + g4 * 8;
            int s = 16 * n + j; s = min(s, 8191);
            const bf16x8 xf = *(const bf16x8*)(H + ((size_t)b * 8192 + s) * LD + colbase + d0);
            bf16x8 wf[4];
#pragma unroll
            for (int e = 0; e < 4; ++e) wf[e] = *(const bf16x8*)(Wl + (size_t)(e * 64 + kk) * 512);
            if (which == 0) {
#pragma unroll
                for (int e = 0; e < 4; ++e) acc[e] = MFMA16(wf[e], xf, acc[e]);
            } else {
#pragma unroll
                for (int e = 0; e < 4; ++e) acc[e] = MFMA16(xf, wf[e], acc[e]);
            }
        }
        if (which == 0) {
            u16* kc = (u16*)(ws + OFF_KCMP) + ((size_t)(b * 4 + kvh) * 32 + ntile) * 1024 + c * 32;
#pragma unroll
            for (int e = 0; e < 4; ++e) {
                const int e0 = e * 16 + g4 * 4;
                const f32x4 bv = *(const f32x4*)(bias + e0);
                const f32x4 r = acc[e] + bv;
                *(u32x2*)(kc + (e0 >> 5) * 512 + (e0 & 31)) = u32x2{pack2(r[0], r[1]), pack2(r[2], r[3])};
            }
        } else {
            u16* vc = (u16*)(ws + OFF_VCMP) + (((size_t)(b * 4 + kvh) * 32 + ntile) * 64) * 16;
#pragma unroll
            for (int e = 0; e < 4; ++e) {
                const int ee = e * 16 + c;
                const float bv = bias[64 + ee];
                *(u32x2*)(vc + ee * 16 + g4 * 4) = u32x2{pack2(acc[e][0] + bv, acc[e][1] + bv), pack2(acc[e][2] + bv, acc[e][3] + bv)};
            }
        }
    }
}

DEV void attnC_phase(const Prm& P, unsigned char* smem) {
    const int tid_ = opaque_tid();
    unsigned char* ws = P.ws;
    const u16* H = (const u16*)(ws + OFF_H);
    u16* G = (u16*)(ws + OFF_G);
    constexpr int LD = 3840;
    float* imp = (float*)smem;
    float* scb = (float*)(smem + 32768);
    float* oslc = (float*)(smem + 34816);
    const int tid = tid_, lane = tid & 63, w = __builtin_amdgcn_readfirstlane(tid >> 6), c = lane & 15, g4 = lane >> 4;
    const int xcd_ = blockIdx.x & 7, slot_ = blockIdx.x >> 3, nslot_ = gridDim.x >> 3;
    for (int tile = slot_; tile < 512; tile += nslot_) {
        const int b = xcd_ >> 2, kvh = xcd_ & 3;
        const int t0 = tile * 16;
        for (int i = tid; i < 8192; i += 256) imp[i] = 0.f;
        __syncthreads();
        const int head = kvh * 4 + w;
        const size_t rowq = (size_t)b * 8192 + t0 + c;
        const u16* Hq = H + rowq * LD + head * 64 + g4 * 8;
        const bf16x8 q0 = *(const bf16x8*)Hq, q1 = *(const bf16x8*)(Hq + 32);
        f32x4 oacc[4];
#pragma unroll
        for (int d = 0; d < 4; ++d) oacc[d] = f32x4{0.f, 0.f, 0.f, 0.f};
        const int nmax = (t0 + c - 31) >> 4;
        const int nmaxw = (t0 - 16) >> 4;
        const float g0 = sigmoidf_(bf2f(H[rowq * LD + 3584 + head]));
        const float g1 = sigmoidf_(bf2f(H[rowq * LD + 3584 + 16 + head]));
        const float g2 = sigmoidf_(bf2f(H[rowq * LD + 3584 + 32 + head]));
        if (nmaxw >= 0) {
            const int nsteps = (nmaxw >> 5) + 1;
            const char* Kb = (const char*)((const u16*)(ws + OFF_KCMP) + ((size_t)(b * 4 + kvh) * 32) * 1024);
            const char* Vb = (const char*)((const u16*)(ws + OFF_VCMP) + ((size_t)(b * 4 + kvh) * 32) * 1024);
            const unsigned kl = c * 64 + g4 * 16, vl = c * 32 + g4 * 8;
            float m = NEG_INF, l = 0.f;
#define CM_LOAD(R, S) do { const int na_ = (S) * 32; const unsigned ba_ = (unsigned)(na_ >> 4) * 2048u, bb_ = (unsigned)min((na_ >> 4) + 1, 31) * 2048u; \
        load_kv(R, Kb, ba_ + kl, bb_ + kl, Vb, ba_ + vl, bb_ + vl); } while (0)
#define CM_PASS1(R, S) do { const int na_ = (S) * 32; f32x4 sa, sb; qk_scores(R, q0, q1, sa, sb); float mx = NEG_INF; float x[8]; \
        _Pragma("unroll") for (int j = 0; j < 8; ++j) { const int n = na_ + (j >> 2) * 16 + g4 * 4 + (j & 3); \
            x[j] = (n <= nmax) ? ((j < 4) ? sa[j & 3] : sb[j & 3]) * 0.125f : NEG_INF; mx = fmaxf(mx, x[j]); } \
        const float mn = fmaxf(m, mx); const float mu = (mn == NEG_INF) ? 0.f : mn; float ps = 0.f; \
        _Pragma("unroll") for (int j = 0; j < 8; ++j) ps += __expf(x[j] - mu); \
        l = l * __expf(m - mu) + ps; m = mn; } while (0)
            RING4(nsteps, CM_LOAD, CM_PASS1);
            float mall = red16_max(m);
            mall = (mall == NEG_INF) ? 0.f : mall;
            l = l * __expf(m - mall);
            l = red16_sum(l);
            const float invl = (l > 0.f) ? 1.f / l : 0.f;
#define CM_PASS2(R, S) do { const int na_ = (S) * 32; f32x4 sa, sb; qk_scores(R, q0, q1, sa, sb); float p[8]; \
        _Pragma("unroll") for (int j = 0; j < 8; ++j) { const int n = na_ + (j >> 2) * 16 + g4 * 4 + (j & 3); \
            const float sv = ((j < 4) ? sa[j & 3] : sb[j & 3]) * 0.125f; \
            p[j] = (n <= nmax) ? __expf(sv - mall) * invl : 0.f; \
            if (n <= nmax) atomicAdd(&imp[n * 16 + c], p[j]); } \
        const bf16x8 pf = pack8(p); \
        oacc[0] = MFMA16(R.v0, pf, oacc[0]); oacc[1] = MFMA16(R.v1, pf, oacc[1]); \
        oacc[2] = MFMA16(R.v2, pf, oacc[2]); oacc[3] = MFMA16(R.v3, pf, oacc[3]); } while (0)
            RING4(nsteps, CM_LOAD, CM_PASS2);
#undef CM_LOAD
#undef CM_PASS1
#undef CM_PASS2
#pragma unroll
            for (int d = 0; d < 4; ++d) oacc[d] *= g0;
        }
        {
            float m = NEG_INF, l = 0.f;
            f32x4 o[4];
#pragma unroll
            for (int d = 0; d < 4; ++d) o[d] = f32x4{0.f, 0.f, 0.f, 0.f};
            const char* Kb = (const char*)((const u16*)(ws + OFF_KI1) + ((size_t)(b * 4 + kvh) * 512) * 1024);
            const char* Vb = (const char*)((const u16*)(ws + OFF_VT1) + ((size_t)(b * 4 + kvh) * 512) * 1024);
            band_loop(tid_, m, l, o, q0, q1, Kb, Vb, 0, t0 - 528, 17, t0 + c, t0, 15, 511);
            l = red16_sum(l);
            const float sc = g2 / l;
#pragma unroll
            for (int d = 0; d < 4; ++d) oacc[d] += o[d] * sc;
        }
        __syncthreads();
        unsigned long long* msk = (unsigned long long*)(smem + 51200) + w * 8;
#pragma unroll 1
        for (int i = 0; i < 4; ++i) {
            const int tok = 4 * w + i, tq = t0 + tok, cur = tq >> 6;
            float my0, my1;
            {
                const int j0 = lane, j1 = lane + 64;
                float a0 = 2.f * (imp[(4 * j0) * 16 + tok] + imp[(4 * j0 + 1) * 16 + tok] + imp[(4 * j0 + 2) * 16 + tok]) + imp[(4 * j0 + 3) * 16 + tok];
                if (j0 > 0) a0 += imp[(4 * j0 - 1) * 16 + tok];
                const float a1 = 2.f * (imp[(4 * j1) * 16 + tok] + imp[(4 * j1 + 1) * 16 + tok] + imp[(4 * j1 + 2) * 16 + tok]) + imp[(4 * j1 + 3) * 16 + tok]
                                 + imp[(4 * j1 - 1) * 16 + tok];
                const bool f0 = (j0 == 0) || (j0 == cur) || (j0 == cur - 1);
                const bool f1 = (j1 == cur) || (j1 == cur - 1);
                my0 = f0 ? 1e4f : ((j0 <= cur) ? a0 : -1.f);
                my1 = f1 ? 1e4f : ((j1 <= cur) ? a1 : -1.f);
            }
            __builtin_amdgcn_fence(__ATOMIC_RELEASE, "wavefront"); __builtin_amdgcn_wave_barrier(); __builtin_amdgcn_fence(__ATOMIC_ACQUIRE, "wavefront");
            scb[w * 128 + lane] = my0; scb[w * 128 + 64 + lane] = my1;
            __builtin_amdgcn_fence(__ATOMIC_RELEASE, "wavefront"); __builtin_amdgcn_wave_barrier(); __builtin_amdgcn_fence(__ATOMIC_ACQUIRE, "wavefront");
            int c0 = 0, c1 = 0;
            const int jend = min(128, ((cur + 8) & ~7));
#pragma unroll 8
            for (int jj = 0; jj < jend; ++jj) {
                const float sv = scb[w * 128 + jj];
                c0 += (sv > my0 || (sv == my0 && jj < lane)) ? 1 : 0;
                c1 += (sv > my1 || (sv == my1 && jj < lane + 64)) ? 1 : 0;
            }
            const unsigned long long lo = __ballot((c0 < 16) && (lane <= cur));
            const unsigned long long hi = __ballot((c1 < 16) && (lane + 64 <= cur));
            if (lane == 0) { msk[i * 2] = lo; msk[i * 2 + 1] = hi; }
        }
        __builtin_amdgcn_fence(__ATOMIC_RELEASE, "wavefront"); __builtin_amdgcn_wave_barrier(); __builtin_amdgcn_fence(__ATOMIC_ACQUIRE, "wavefront");
        {
            const int tokL = 4 * w + (c >> 2), tq = t0 + tokL, hd = kvh * 4 + (c & 3);
            const size_t rq = (size_t)b * 8192 + tq;
            const u16* Hs = H + rq * LD + hd * 64 + g4 * 8;
            const bf16x8 s0 = *(const bf16x8*)Hs, s1 = *(const bf16x8*)(Hs + 32);
            const char* Kb = (const char*)((const u16*)(ws + OFF_KI0) + ((size_t)(b * 4 + kvh) * 512) * 1024);
            const char* Vb = (const char*)((const u16*)(ws + OFF_VT0) + ((size_t)(b * 4 + kvh) * 512) * 1024);
            const unsigned kl = c * 64 + g4 * 16, vl = c * 32 + g4 * 8;
            float m = NEG_INF, l = 0.f;
            f32x4 o[4];
#pragma unroll
            for (int d = 0; d < 4; ++d) o[d] = f32x4{0.f, 0.f, 0.f, 0.f};
            const int ti = c >> 2;
            const unsigned long long mylo = msk[ti * 2], myhi = msk[ti * 2 + 1];
            const unsigned long long ulo = msk[0] | msk[2] | msk[4] | msk[6];
            const unsigned long long uhi = msk[1] | msk[3] | msk[5] | msk[7];
            const unsigned long long alo = msk[0] & msk[2] & msk[4] & msk[6], ahi = msk[1] & msk[3] & msk[5] & msk[7];
            int* blist = (int*)(scb + w * 128);
            const int nlo = __builtin_popcountll(ulo), nblk = nlo + __builtin_popcountll(uhi);
            if ((ulo >> lane) & 1ull) blist[__builtin_popcountll(ulo & ((1ull << lane) - 1ull))] = lane;
            if ((uhi >> lane) & 1ull) blist[nlo + __builtin_popcountll(uhi & ((1ull << lane) - 1ull))] = 64 + lane;
            __builtin_amdgcn_fence(__ATOMIC_RELEASE, "wavefront");
            __builtin_amdgcn_wave_barrier();
            __builtin_amdgcn_fence(__ATOMIC_ACQUIRE, "wavefront");
            const int nst = 2 * nblk;
#define SL_LOAD(R, S) do { const int j_ = __builtin_amdgcn_readfirstlane(blist[(S) >> 1]); const int ua_ = j_ * 64 + ((S) & 1) * 32; \
        load_kv(R, Kb, (unsigned)(ua_ >> 4) * 2048u + kl, (unsigned)((ua_ >> 4) + 1) * 2048u + kl, \
                Vb, (unsigned)(ua_ >> 4) * 2048u + vl, (unsigned)((ua_ >> 4) + 1) * 2048u + vl); } while (0)
#define SL_COMP(R, S) do { const int j_ = __builtin_amdgcn_readfirstlane(blist[(S) >> 1]); const int ua_ = j_ * 64 + ((S) & 1) * 32; \
        const bool selj = (j_ < 64) ? ((mylo >> j_) & 1ull) : ((myhi >> (j_ - 64)) & 1ull); \
        const bool alls_ = (j_ < 64) ? ((alo >> j_) & 1ull) : ((ahi >> (j_ - 64)) & 1ull); \
        const bool fast_ = alls_ && (ua_ + 31 <= t0 + 4 * w); \
        flash_core(m, l, o, s0, s1, R, fast_, selj ? (tq - ua_ - g4 * 4) : -(1 << 30), 0x7fffffffu); } while (0)
            RING4(nst, SL_LOAD, SL_COMP);
#undef SL_LOAD
#undef SL_COMP
            l = red16_sum(l);
            const float inv = 1.f / l;
#pragma unroll
            for (int dt = 0; dt < 4; ++dt)
                *(f32x4*)(oslc + (tokL * 4 + (c & 3)) * 64 + dt * 16 + g4 * 4) = o[dt] * inv;
        }
        __syncthreads();
#pragma unroll
        for (int dt = 0; dt < 4; ++dt) {
            const int dh = dt * 16 + g4 * 4;
            const f32x4 os = *(const f32x4*)(oslc + (c * 4 + w) * 64 + dh);
            const f32x4 r = oacc[dt] + os * g1;
            const u32x2 z = *(const u32x2*)(H + rowq * LD + 2560 + head * 64 + dh);
            const float r0 = r[0] * siluf_(bflo(z[0])), r1 = r[1] * siluf_(bfhi(z[0]));
            const float r2 = r[2] * siluf_(bflo(z[1])), r3 = r[3] * siluf_(bfhi(z[1]));
            *(u32x2*)(G + kb_off((int)rowq, head * 64 + dh, 1024)) = u32x2{pack2(r0, r1), pack2(r2, r3)};
        }
        __syncthreads();
    }
}

#ifndef PROBE_DUP
#define PROBE_DUP 0
#endif
#define REP(k) for (int rep_ = 0; rep_ < 1 + ((PROBE_DUP >> (k)) & 1); ++rep_)
constexpr int LDS_BYTES = 3 * GSTAGE + 64;
__global__ void __launch_bounds__(256, 2) mk_fwd(Prm P) {
    extern __shared__ __attribute__((aligned(16))) unsigned char smem[];
    unsigned* xb_words = (unsigned*)(smem + 3 * GSTAGE);
    if (threadIdx.x < 4) xb_words[threadIdx.x] = 0u;
    __syncthreads();
    XcdBarrier bar = xcd_barrier_post((unsigned*)(P.ws + OFF_BAR), (volatile LAS unsigned*)xb_words);
    unsigned char* ws = P.ws;

    phase0(P, smem);
    cg::this_grid().sync();

#pragma unroll 1
    for (int layer = 0; layer < 4; ++layer) {
        const int kind = layer % 3, lj = layer / 3;
        const u16* Win; const u16* Wout; int N, nsub;
        if (kind == 0)      { Win = (const u16*)(ws + OFF_WA_IN + (size_t)lj * SZ_WA_IN); Wout = (const u16*)(ws + OFF_WA_OUT + (size_t)lj * SZ_SQ); N = 2560; nsub = 4; }
        else if (kind == 1) { Win = (const u16*)(ws + OFF_WB_IN); Wout = (const u16*)(ws + OFF_WB_OUT); N = 2304; nsub = 1; }
        else                { Win = (const u16*)(ws + OFF_WC_IN); Wout = (const u16*)(ws + OFF_WC_OUT); N = 3840; nsub = 1; }
#pragma unroll 1
        for (int sub = 0; sub < nsub; ++sub) {
            REP(0) gemm_in_phase(smem, P, kind, Win + (size_t)sub * 2560 * 1024, N);
            xcd_barrier(bar);
            if (kind == 0) REP(1) attnA_phase(P, sub);
            else if (kind == 1) REP(2) attnB_phase(P);
            else { REP(3) compress_phase(P); xcd_barrier(bar); REP(4) attnC_phase(P, smem); }
            xcd_barrier(bar);
        }
        gemm_out_phase(smem, P, Wout, layer == 0 ? P.in[0] : P.out);
        xcd_barrier(bar);
        ln_phase(P, layer);
        xcd_barrier(bar);
        gemm_gate_phase(smem, P, (const u16*)(ws + OFF_WG + (size_t)layer * SZ_SQ), (const u16*)(ws + OFF_WP + (size_t)layer * SZ_WP));
        if (layer < 3) xcd_barrier(bar);
    }
}

extern "C" void kernel_launch(void* const* d_in, const int* in_sizes, int n_in, void* d_out, int out_size, void* d_ws, size_t ws_size,
                              hipStream_t stream) {
    static int grid_blocks = 0;
    if (!grid_blocks) {
        int dev = 0, cus = 0, per_cu = 0;
        (void)hipGetDevice(&dev);
        (void)hipDeviceGetAttribute(&cus, hipDeviceAttributeMultiprocessorCount, dev);
        (void)hipFuncSetAttribute((const void*)mk_fwd, hipFuncAttributeMaxDynamicSharedMemorySize, LDS_BYTES);
        (void)hipOccupancyMaxActiveBlocksPerMultiprocessor(&per_cu, (const void*)mk_fwd, 256, LDS_BYTES);
        if (per_cu > 2) per_cu = 2;
        if (per_cu < 1) per_cu = 1;
        grid_blocks = cus * per_cu;
        if (ws_size < WS_END || n_in != 16) { fprintf(stderr, "kernel_launch: workspace too small (%zu < %zu) or n_in %d != 16\n", ws_size, (size_t)WS_END, n_in); grid_blocks = -1; }
    }
    if (grid_blocks < 0) return;
    (void)hipMemsetAsync((char*)d_ws + OFF_BAR, 0, 16384, stream);
    Prm p{};
    for (int i = 0; i < 16; ++i) p.in[i] = (const float*)d_in[i];
    p.out = (float*)d_out; p.ws = (unsigned char*)d_ws;
    void* args[] = {&p};
    hipError_t e = hipLaunchCooperativeKernel((const void*)mk_fwd, dim3(grid_blocks), dim3(256), args, LDS_BYTES, stream);
    if (e != hipSuccess) fprintf(stderr, "cooperative launch failed: %s (grid %d)\n", hipGetErrorString(e), grid_blocks);
}
```

```cpp
#include <hip/hip_runtime.h>
#include <hip/hip_cooperative_groups.h>
#include <cstdio>
#include <cstdint>
namespace cg = cooperative_groups;

typedef unsigned short u16;
using bf16x8 = __attribute__((ext_vector_type(8))) short;
using s16x4  = __attribute__((ext_vector_type(4))) short;
using f32x4  = __attribute__((ext_vector_type(4))) float;
using u32x4  = __attribute__((ext_vector_type(4))) unsigned;
using u32x2  = __attribute__((ext_vector_type(2))) unsigned;
#define DEV __device__ __forceinline__
using h16x8 = __attribute__((ext_vector_type(8))) _Float16;
#define MFMA16(a, b, c) __builtin_amdgcn_mfma_f32_16x16x32_f16(__builtin_bit_cast(h16x8, (a)), __builtin_bit_cast(h16x8, (b)), (c), 0, 0, 0)
#define LAS __attribute__((address_space(3)))

constexpr int T = 16384, S = 8192;
constexpr float LN_EPS = 1e-5f;
constexpr float DN_ALPHA = 1.6817928305074290f;
constexpr float NEG_INF = -__builtin_huge_valf();

constexpr size_t OFF_BAR   = 0;
constexpr size_t OFF_COS   = 16384;
constexpr size_t OFF_SIN   = OFF_COS + (size_t)8192 * 32 * 4;
constexpr size_t OFF_BIAS  = OFF_SIN + (size_t)8192 * 32 * 4;
constexpr size_t OFF_WA_IN = OFF_BIAS + 1024;
constexpr size_t SZ_WA_IN  = (size_t)10240 * 1024 * 2;
constexpr size_t SZ_SQ     = (size_t)1024 * 1024 * 2;
constexpr size_t OFF_WA_OUT = OFF_WA_IN + 2 * SZ_WA_IN;
constexpr size_t OFF_WB_IN  = OFF_WA_OUT + 2 * SZ_SQ;
constexpr size_t OFF_WB_OUT = OFF_WB_IN + (size_t)2304 * 1024 * 2;
constexpr size_t OFF_WC_IN  = OFF_WB_OUT + SZ_SQ;
constexpr size_t OFF_WC_OUT = OFF_WC_IN + (size_t)3840 * 1024 * 2;
constexpr size_t OFF_WG     = OFF_WC_OUT + SZ_SQ;
constexpr size_t OFF_WP     = OFF_WG + 4 * SZ_SQ;
constexpr size_t SZ_WP      = (size_t)1024 * 256 * 2;
constexpr size_t OFF_WCK    = OFF_WP + 4 * SZ_WP;
constexpr size_t OFF_WCV    = OFF_WCK + (size_t)64 * 2048 * 2;
constexpr size_t OFF_XB     = OFF_WCV + (size_t)64 * 2048 * 2;
constexpr size_t SZ_ACT     = (size_t)T * 1024 * 2;
constexpr size_t OFF_G      = OFF_XB + SZ_ACT;
constexpr size_t OFF_H      = OFF_G + SZ_ACT;
constexpr size_t SZ_HMAX    = (size_t)T * 3840 * 2;
constexpr size_t OFF_VT0    = OFF_H + SZ_HMAX;
constexpr size_t SZ_VT      = (size_t)2 * 4 * 8192 * 64 * 2;
constexpr size_t OFF_VT1    = OFF_VT0 + SZ_VT;
constexpr size_t OFF_VT2    = OFF_VT1 + SZ_VT;
constexpr size_t OFF_KCMP   = OFF_VT2 + SZ_VT;
constexpr size_t SZ_CMP     = (size_t)2 * 512 * 4 * 64 * 2;
constexpr size_t OFF_VCMP   = OFF_KCMP + SZ_CMP;
constexpr size_t OFF_KI0    = OFF_VCMP + SZ_CMP;
constexpr size_t OFF_KI1    = OFF_KI0 + SZ_VT;
constexpr size_t OFF_KI2    = OFF_KI1 + SZ_VT;
constexpr size_t WS_END     = OFF_KI2 + SZ_VT;
constexpr size_t OFF_XLB    = OFF_H;
constexpr size_t OFF_PB     = OFF_H + SZ_ACT;
constexpr size_t OFF_PP     = OFF_H + SZ_ACT + (size_t)16 * 1024 * 1024;

struct Prm { const float* in[16]; float* out; unsigned char* ws; };

__device__ __forceinline__ size_t kb_off(int row, int k, int K) { return ((size_t)(row >> 4) * (K >> 5) + (k >> 5)) * 512 + (row & 15) * 32 + (k & 31); }
DEV u16 f2bf(float f) { return __builtin_bit_cast(u16, (_Float16)f); }
DEV float bf2f(u16 h) { return (float)__builtin_bit_cast(_Float16, h); }
DEV unsigned pack2(float a, float b) { return (unsigned)f2bf(a) | ((unsigned)f2bf(b) << 16); }
DEV float bflo(unsigned u) { return bf2f((u16)(u & 0xffffu)); }
DEV float bfhi(unsigned u) { return bf2f((u16)(u >> 16)); }
DEV float sigmoidf_(float x) { return 1.f / (1.f + __expf(-x)); }
DEV float siluf_(float x) { return x / (1.f + __expf(-x)); }
DEV float red16_max(float v) { v = fmaxf(v, __shfl_xor(v, 16)); v = fmaxf(v, __shfl_xor(v, 32)); return v; }
DEV float red16_sum(float v) { v += __shfl_xor(v, 16); v += __shfl_xor(v, 32); return v; }
DEV float wave_sum(float v) { for (int o = 32; o > 0; o >>= 1) v += __shfl_xor(v, o); return v; }

DEV int opaque_tid() { int t = threadIdx.x; asm volatile("" : "+v"(t)); return t; }
#define XB_TMO      128
#define XB_XCNT(j)  (256  + 64 * (j))
#define XB_XSUB(j)  (1280 + 64 * (j))
#define XB_XGEN(j)  (2304 + 64 * (j))
#define XB_TOP      3328
#define XB_TOPGEN   3392
#define XCD_BAR_WORDS 3456
#define XB_SPIN_CAP (1u << 24)
DEV unsigned xb_ld(unsigned* p)              { return __hip_atomic_load(p, __ATOMIC_RELAXED, __HIP_MEMORY_SCOPE_AGENT); }
DEV unsigned xb_add(unsigned* p, unsigned v) { return __hip_atomic_fetch_add(p, v, __ATOMIC_RELAXED, __HIP_MEMORY_SCOPE_AGENT); }
DEV unsigned xb_xcc_id() { return (unsigned)__builtin_amdgcn_s_getreg((3 << 11) | 20) & 0xFu; }
#define XB_SPIN(cond, bar) do { unsigned _sp = 0; while (cond) { __builtin_amdgcn_s_sleep(1); \
    if ((++_sp & 255u) == 0u) { if (xb_ld(&(bar)[XB_TMO])) break; if (_sp > XB_SPIN_CAP) { atomicAdd(&(bar)[XB_TMO], 1u); break; } } } } while (0)
struct XcdBarrier { unsigned* bar; unsigned x; volatile LAS unsigned* st; };
DEV XcdBarrier xcd_barrier_post(unsigned* bar, volatile LAS unsigned* st) {
    XcdBarrier b; b.bar = bar; b.x = xb_xcc_id(); b.st = st;
    if (threadIdx.x == 0) (void)xb_add(&bar[XB_XCNT(b.x)], 1u);
    return b;
}
DEV void xcd_barrier_complete(unsigned* bar, unsigned x, unsigned& nloc, unsigned& nx) {
    const unsigned G = gridDim.x * gridDim.y * gridDim.z;
    unsigned sum, cnt, mine, sp = 0u;
    for (;;) {
        sum = 0u; cnt = 0u; mine = 0u;
#pragma unroll
        for (unsigned j = 0; j < 16; ++j) { const unsigned c = xb_ld(&bar[XB_XCNT(j)]); sum += c; cnt += (c > 0u) ? 1u : 0u; mine = (j == x) ? c : mine; }
        if (sum == G) break;
        __builtin_amdgcn_s_sleep(1);
        if ((++sp & 255u) == 0u) { if (xb_ld(&bar[XB_TMO])) break; if (sp > XB_SPIN_CAP) { atomicAdd(&bar[XB_TMO], 1u); break; } }
    }
    nloc = mine > 0u ? mine : 1u; nx = cnt > 0u ? cnt : 1u;
}
DEV void xcd_barrier(const XcdBarrier& b) {
    asm volatile("s_waitcnt vmcnt(0)" ::: "memory");
    __syncthreads();
    if (threadIdx.x == 0) {
        unsigned* bar = b.bar;
        __builtin_amdgcn_s_waitcnt(0);
        unsigned nloc = b.st[0], nx = b.st[1];
        if (nloc == 0u) { xcd_barrier_complete(bar, b.x, nloc, nx); b.st[0] = nloc; b.st[1] = nx; }
        const unsigned old = xb_add(&bar[XB_XSUB(b.x)], 1u);
        const unsigned gen = old / nloc;
        if (old + 1u == (gen + 1u) * nloc) {
            __builtin_amdgcn_fence(__ATOMIC_RELEASE, "agent");
            asm volatile("s_waitcnt vmcnt(0)" ::: "memory");
            const unsigned og = xb_add(&bar[XB_TOP], 1u);
            const unsigned tg = og / nx;
            if (og + 1u == (tg + 1u) * nx) xb_add(&bar[XB_TOPGEN], 1u);
            else XB_SPIN(xb_ld(&bar[XB_TOPGEN]) == tg, bar);
            __builtin_amdgcn_fence(__ATOMIC_ACQUIRE, "agent");
            xb_add(&bar[XB_XGEN(b.x)], 1u);
            asm volatile("s_waitcnt vmcnt(0)" ::: "memory");
        } else {
            XB_SPIN(xb_ld(&bar[XB_XGEN(b.x)]) == gen, bar);
            __builtin_amdgcn_fence(__ATOMIC_ACQUIRE, "agent");
            asm volatile("s_waitcnt vmcnt(0)" ::: "memory");
        }
    }
    __syncthreads();
}

DEV int colmap(int kind, int n) {
    if (kind == 0) return n;
    if (kind == 1) {
        const int c = n / 2560, nn = n - c * 2560;
        if (nn < 2304) { const int g = nn / 768, rem = nn - g * 768, part = rem >> 8, hh = (rem & 255) >> 6, d = rem & 63;
                         return g * 3072 + part * 1024 + (c * 4 + hh) * 64 + d; }
        const int z = nn - 2304; return 9216 + (c * 4 + (z >> 6)) * 64 + (z & 63);
    }
    if (n < 2560) return n;
    if (n < 3584) return n - 2560 + 2608;
    if (n < 3632) return n - 3584 + 2560;
    return -1;
}
DEV void tconv(const int tid_, float* lds, const float* __restrict__ src, int K, int Nsrc, u16* __restrict__ dst, int Ndst, int kind, int& acc_tiles) {
    const int G = gridDim.x, tid = tid_;
    const int ntn = Ndst >> 6, ntk = K >> 6, nt = ntn * ntk;
    int first = ((int)blockIdx.x - (acc_tiles % G) + G) % G;
    acc_tiles += nt;
    for (int t = first; t < nt; t += G) {
        const int tn = t / ntk, tk = t - tn * ntk;
        const int n0 = tn << 6, k0 = tk << 6;
        const int nl = tid & 63;
        const int c = colmap(kind, n0 + nl);
#pragma unroll
        for (int i = 0; i < 16; ++i) {
            const int kl = (tid >> 6) + 4 * i;
            const float v = (c >= 0) ? src[(size_t)(k0 + kl) * Nsrc + c] : 0.f;
            lds[kl * 65 + nl] = v;
        }
        __syncthreads();
        const int r = tid >> 2, kk = (tid & 3) << 4;
        unsigned o[8];
#pragma unroll
        for (int i = 0; i < 8; ++i) o[i] = pack2(lds[(kk + 2 * i) * 65 + r], lds[(kk + 2 * i + 1) * 65 + r]);
        u32x4* dp = (u32x4*)(dst + kb_off(n0 + r, k0 + kk, K));
        dp[0] = u32x4{o[0], o[1], o[2], o[3]};
        dp[1] = u32x4{o[4], o[5], o[6], o[7]};
        __syncthreads();
    }
}

DEV void phase0(const Prm& P, unsigned char* smem) {
    const int tid_ = opaque_tid();
    float* lds = (float*)smem;
    unsigned char* ws = P.ws;
    int acc = 0;
    tconv(tid_, lds, P.in[2], 1024, 10240, (u16*)(ws + OFF_WA_IN), 10240, 1, acc);
    tconv(tid_, lds, P.in[2] + (size_t)1024 * 10240, 1024, 10240, (u16*)(ws + OFF_WA_IN + SZ_WA_IN), 10240, 1, acc);
    tconv(tid_, lds, P.in[3], 1024, 1024, (u16*)(ws + OFF_WA_OUT), 1024, 0, acc);
    tconv(tid_, lds, P.in[3] + (size_t)1024 * 1024, 1024, 1024, (u16*)(ws + OFF_WA_OUT + SZ_SQ), 1024, 0, acc);
    tconv(tid_, lds, P.in[4], 1024, 2304, (u16*)(ws + OFF_WB_IN), 2304, 0, acc);
    tconv(tid_, lds, P.in[6], 1024, 1024, (u16*)(ws + OFF_WB_OUT), 1024, 0, acc);
    tconv(tid_, lds, P.in[7], 1024, 3632, (u16*)(ws + OFF_WC_IN), 3840, 2, acc);
    tconv(tid_, lds, P.in[11], 1024, 1024, (u16*)(ws + OFF_WC_OUT), 1024, 0, acc);
    for (int i = 0; i < 4; ++i) {
        tconv(tid_, lds, P.in[15] + (size_t)i * 1024 * 1024, 1024, 1024, (u16*)(ws + OFF_WG + i * SZ_SQ), 1024, 0, acc);
        tconv(tid_, lds, P.in[14] + (size_t)i * 256 * 1024, 256, 1024, (u16*)(ws + OFF_WP + i * SZ_WP), 1024, 0, acc);
    }
    tconv(tid_, lds, P.in[8], 2048, 64, (u16*)(ws + OFF_WCK), 64, 0, acc);
    tconv(tid_, lds, P.in[9], 2048, 64, (u16*)(ws + OFF_WCV), 64, 0, acc);

    const size_t gtid = (size_t)blockIdx.x * 256 + tid_, gsz = (size_t)gridDim.x * 256;
    {
        const float* x = P.in[0]; u16* xb = (u16*)(ws + OFF_XB);
        for (size_t i = gtid; i < (size_t)T * 1024 / 8; i += gsz) {
            const f32x4 a = *(const f32x4*)(x + i * 8), b = *(const f32x4*)(x + i * 8 + 4);
            *(u32x4*)(xb + kb_off((int)(i >> 7), (int)(i & 127) * 8, 1024)) = u32x4{pack2(a[0], a[1]), pack2(a[2], a[3]), pack2(b[0], b[1]), pack2(b[2], b[3])};
        }
    }
    {
        float* ct = (float*)(ws + OFF_COS); float* st = (float*)(ws + OFF_SIN);
        for (size_t i = gtid; i < (size_t)8192 * 32; i += gsz) {
            const int pos = (int)(i >> 5), k = (int)(i & 31);
            const float inv = (float)(1.0 / pow(10000.0, (double)(2 * k) / 64.0));
            const float ang = (float)pos * inv;
            ct[i] = (float)cos((double)ang); st[i] = (float)sin((double)ang);
        }
    }
    {
        const int lane = tid_ & 63;
        const int wid = blockIdx.x * 4 + __builtin_amdgcn_readfirstlane(tid_ >> 6);
        if (wid < 128) {
            const float* w = (wid < 64) ? P.in[8] : P.in[9];
            const int e = wid & 63;
            float s = 0.f;
            for (int jd = lane; jd < 2048; jd += 64) s += P.in[10][jd] * w[(size_t)jd * 64 + e];
            s = wave_sum(s);
            if (lane == 0) ((float*)(ws + OFF_BIAS))[wid] = s;
        }
    }
}

constexpr int GSTAGE = 24576;
DEV int gsw(int r) { return (0x78 >> (2 * ((r >> 2) & 3))) & 3; }
DEV void gemm_issue(unsigned char* stage, const u16* ag0, const u16* ag1, const u16* bg, int bstep, int kt, int w) {
    __builtin_amdgcn_global_load_lds((const unsigned*)(ag0 + kt * 512), (unsigned*)(stage + w * 1024), 16, 0, 0);
    __builtin_amdgcn_global_load_lds((const unsigned*)(ag1 + kt * 512), (unsigned*)(stage + w * 1024 + 4096), 16, 0, 0);
#pragma unroll
    for (int i = 0; i < 4; ++i)
        __builtin_amdgcn_global_load_lds((const unsigned*)(bg + (size_t)i * bstep + kt * 512), (unsigned*)(stage + 8192 + w * 1024 + i * 4096), 16, 0, 0);
}
template <bool NONSWAP>
DEV void gemm_mainloop(const int tid_, unsigned char* smem, const u16* __restrict__ A, int lda, const u16* __restrict__ Bt, int ldb, int K,
                       int m0, int n0, f32x4 (&acc)[32], bool aperm = false) {
    const int tid = tid_, lane = tid & 63, w = __builtin_amdgcn_readfirstlane(tid >> 6), wm = w >> 1, wn = w & 1;
    const int lrow = tid >> 2, lsw = ((tid & 3) ^ gsw(lrow)) * 8;
    const int arow0 = aperm ? ((lrow & 31) * 4 + (lrow >> 5)) : lrow;
    const int arow1 = aperm ? (arow0 + 2) : (lrow + 64);
    const u16* ag0 = A + kb_off(m0 + arow0, 0, lda) + lsw;
    const u16* ag1 = A + kb_off(m0 + arow1, 0, lda) + lsw;
    const u16* bg = Bt + kb_off(n0 + lrow, 0, ldb) + lsw;
    const int bstep = 4 * (ldb >> 5) * 512;
    const int fr = lane & 15, fq = lane >> 4;
    const int coff = (fq ^ gsw(fr)) << 4;
    const int a_base = (wm * 64 + fr) * 64 + coff, b_base = 8192 + (wn * 128 + fr) * 64 + coff;
    const int nk = K >> 5;
    asm volatile("s_waitcnt vmcnt(0)" ::: "memory");
    __builtin_amdgcn_s_barrier();
    gemm_issue(smem, ag0, ag1, bg, bstep, 0, w);
    gemm_issue(smem + GSTAGE, ag0, ag1, bg, bstep, 1, w);
    int sc = 0, si = 2;
    for (int kt = 0; kt < nk; ++kt) {
        if (kt + 1 < nk) asm volatile("s_waitcnt vmcnt(6)" ::: "memory"); else asm volatile("s_waitcnt vmcnt(0)" ::: "memory");
        __builtin_amdgcn_s_barrier();
        if (kt + 2 < nk) { gemm_issue(smem + si * GSTAGE, ag0, ag1, bg, bstep, kt + 2, w); si = (si == 2) ? 0 : si + 1; }
        const unsigned char* st = smem + sc * GSTAGE; sc = (sc == 2) ? 0 : sc + 1;
        bf16x8 a[4], b[8];
#pragma unroll
        for (int i = 0; i < 4; ++i) a[i] = *(const bf16x8*)(st + a_base + i * 1024);
#pragma unroll
        for (int i = 0; i < 8; ++i) b[i] = *(const bf16x8*)(st + b_base + i * 1024);
        if (NONSWAP) {
#pragma unroll
            for (int mt = 0; mt < 4; ++mt)
#pragma unroll
                for (int nt = 0; nt < 8; ++nt) acc[mt * 8 + nt] = MFMA16(a[mt], b[nt], acc[mt * 8 + nt]);
        } else {
#pragma unroll
            for (int nt = 0; nt < 8; ++nt)
#pragma unroll
                for (int mt = 0; mt < 4; ++mt) acc[nt * 4 + mt] = MFMA16(b[nt], a[mt], acc[nt * 4 + mt]);
        }
    }
}

DEV int vblock() { const int G = gridDim.x, b = blockIdx.x; return ((G & 7) == 0) ? (b & 7) * (G >> 3) + (b >> 3) : b; }
DEV void tile_mn(int t, int nN, int& mi, int& ni) { const int per = 16 * nN; const int mg = t / per, r = t - mg * per; mi = mg * 16 + (r & 15); ni = r >> 4; }
#define ZERO_ACC(acc) _Pragma("unroll") for (int i_ = 0; i_ < 32; ++i_) acc[i_] = f32x4{0.f, 0.f, 0.f, 0.f}

DEV void classify(int kind, int cgi, int& mode, int& vsel, int& vth, int& dsh, int& nhv, int& ksel) {
    mode = 0; vsel = 0; vth = 0; dsh = 0; nhv = 4; ksel = -1;
    if (kind == 0) {
        if (cgi < 36) { const int g = cgi / 12, part = (cgi - g * 12) >> 2; vth = cgi & 3; if (part < 2) { mode = 1; if (part == 1) { ksel = g; dsh = 2 * g; } } else { mode = 2; vsel = g; dsh = 2 * g; } }
    } else if (kind == 1) {
        if (cgi < 16) mode = 1; else if (cgi < 18) { mode = 1; ksel = 0; vth = cgi - 16; nhv = 2; } else if (cgi < 20) { mode = 2; vsel = 0; vth = cgi - 18; nhv = 2; }
    } else {
        if (cgi < 20) mode = 1; else if (cgi < 24) mode = 0; else if (cgi < 28) { mode = 1; ksel = 0; vth = cgi - 24; } else if (cgi < 32) { mode = 2; vsel = 0; vth = cgi - 28; }
        else if (cgi < 36) { mode = 1; ksel = 1; vth = cgi - 32; } else if (cgi < 40) { mode = 2; vsel = 1; vth = cgi - 36; }
    }
}

DEV void gemm_in_phase(unsigned char* smem, const Prm& P, int kind, const u16* Wt, int N) {
    const int tid_ = opaque_tid();
    unsigned char* ws = P.ws;
    const u16* A = (const u16*)(ws + OFF_XB);
    u16* H = (u16*)(ws + OFF_H);
    const float* cosT = (const float*)(ws + OFF_COS); const float* sinT = (const float*)(ws + OFF_SIN);
    const int nN = N >> 8, ntiles = 128 * nN;
    const int lane = tid_ & 63, w = __builtin_amdgcn_readfirstlane(tid_ >> 6), wm = w >> 1, wn = w & 1, fr = lane & 15, fq = lane >> 4;
    for (int t = vblock(); t < ntiles; t += gridDim.x) {
        int mi, ni; tile_mn(t, nN, mi, ni);
        const int m0 = mi << 7, n0 = ni << 8;
        const int ncol = n0 + wn * 128, cg0 = ncol >> 6;
        int mode, vsel, vth, dsh, nhv, ksel; classify(kind, cg0, mode, vsel, vth, dsh, nhv, ksel);
        const int mw = m0 + wm * 64;
        f32x4 acc[32]; ZERO_ACC(acc);
        if (mode == 2) {
            gemm_mainloop<true>(tid_, smem, A, 1024, Wt, 1024, 1024, m0, n0, acc, dsh == 2);
            __builtin_amdgcn_s_barrier();
            u16* vt = (u16*)(ws + (vsel == 0 ? OFF_VT0 : (vsel == 1 ? OFF_VT1 : OFF_VT2)));
            if (dsh == 0) {
#pragma unroll
                for (int mt = 0; mt < 4; ++mt) {
                    const int m = mw + mt * 16 + fq * 4;
                    const int b = m >> 13, p = m & 8191;
#pragma unroll
                    for (int grp = 0; grp < 2; ++grp) {
                        u16* dst = vt + ((((size_t)(b * nhv + vth + grp)) * 512 + (p >> 4)) * 64) * 16 + (p & 15);
#pragma unroll
                        for (int nt = 0; nt < 4; ++nt) { const f32x4 v = acc[mt * 8 + grp * 4 + nt]; *(u32x2*)(dst + (nt * 16 + fr) * 16) = u32x2{pack2(v[0], v[1]), pack2(v[2], v[3])}; }
                    }
                }
            } else if (dsh == 4) {
#pragma unroll
                for (int j = 0; j < 4; ++j) {
                    const int m = mw + fq * 4 + j;
                    const int b = m >> 13, s = m & 8191;
                    const int p = ((s & 15) << 9) + (s >> 4);
#pragma unroll
                    for (int grp = 0; grp < 2; ++grp) {
                        u16* dst = vt + ((((size_t)(b * nhv + vth + grp)) * 512 + (p >> 4)) * 64) * 16 + (p & 15);
#pragma unroll
                        for (int nt = 0; nt < 4; ++nt)
                            *(u32x2*)(dst + (nt * 16 + fr) * 16) = u32x2{pack2(acc[0 * 8 + grp * 4 + nt][j], acc[1 * 8 + grp * 4 + nt][j]), pack2(acc[2 * 8 + grp * 4 + nt][j], acc[3 * 8 + grp * 4 + nt][j])};
                    }
                }
            } else {
#pragma unroll
                for (int mt = 0; mt < 4; ++mt) {
                    const int r0 = wm * 64 + mt * 16 + fq * 4;
                    const int m = m0 + (r0 & 31) * 4 + (r0 >> 5);
                    const int b = m >> 13, s = m & 8191;
                    const int p = ((s & 3) << 11) + (s >> 2);
#pragma unroll
                    for (int grp = 0; grp < 2; ++grp) {
                        u16* dst = vt + ((((size_t)(b * nhv + vth + grp)) * 512 + (p >> 4)) * 64) * 16 + (p & 15);
#pragma unroll
                        for (int nt = 0; nt < 4; ++nt) { const f32x4 v = acc[mt * 8 + grp * 4 + nt]; *(u32x2*)(dst + (nt * 16 + fr) * 16) = u32x2{pack2(v[0], v[1]), pack2(v[2], v[3])}; }
                    }
                }
            }
        } else {
            gemm_mainloop<false>(tid_, smem, A, 1024, Wt, 1024, 1024, m0, n0, acc);
            __builtin_amdgcn_s_barrier();
            constexpr int EROW = 272;
            unsigned char* est = smem + w * (64 * EROW);
            int l4_ = lane; asm volatile("" : "+v"(l4_));
            const int fr = l4_ & 15, fq = l4_ >> 4;
#pragma unroll
            for (int mt = 0; mt < 4; ++mt) {
                const int s = (mw + mt * 16 + fr) & 8191;
                unsigned char* erow = est + (mt * 16 + fr) * EROW + fq * 8;
                if (mode == 1) {
#pragma unroll
                    for (int nt = 0; nt < 2; ++nt) {
                        const f32x4 c4 = *(const f32x4*)(cosT + s * 32 + nt * 16 + fq * 4);
                        const f32x4 s4 = *(const f32x4*)(sinT + s * 32 + nt * 16 + fq * 4);
#pragma unroll
                        for (int grp = 0; grp < 2; ++grp) {
                            const f32x4 x1 = acc[(grp * 4 + nt) * 4 + mt], x2 = acc[(grp * 4 + nt + 2) * 4 + mt];
                            const f32x4 o1 = x1 * c4 - x2 * s4, o2 = x2 * c4 + x1 * s4;
                            *(u32x2*)(erow + (grp * 64 + nt * 16) * 2) = u32x2{pack2(o1[0], o1[1]), pack2(o1[2], o1[3])};
                            *(u32x2*)(erow + (grp * 64 + (nt + 2) * 16) * 2) = u32x2{pack2(o2[0], o2[1]), pack2(o2[2], o2[3])};
                        }
                    }
                } else {
#pragma unroll
                    for (int nt = 0; nt < 8; ++nt) { const f32x4 v = acc[nt * 4 + mt]; *(u32x2*)(erow + nt * 32) = u32x2{pack2(v[0], v[1]), pack2(v[2], v[3])}; }
                }
            }
            __builtin_amdgcn_fence(__ATOMIC_RELEASE, "wavefront"); __builtin_amdgcn_wave_barrier(); __builtin_amdgcn_fence(__ATOMIC_ACQUIRE, "wavefront");
            {
                const int rr = l4_ >> 4, ch = l4_ & 15;
                if (ksel >= 0) {
                    u16* ki = (u16*)(ws + (ksel == 0 ? OFF_KI0 : (ksel == 1 ? OFF_KI1 : OFF_KI2)));
                    const int dmask = (1 << dsh) - 1, lsh = 13 - dsh, numask = (64 >> dsh) - 1;
                    const int kk = l4_ >> 2, c4 = l4_ & 3;
#pragma unroll 4
                    for (int i = 0; i < 16; ++i) {
                        const int rgp = i >> 2, hd = (i >> 1) & 1, half = i & 1;
                        const int tt = rgp * 16 + kk;
                        const int row = ((tt & numask) << dsh) + (tt >> (6 - dsh));
                        const int m = mw + row, b = m >> 13, s = m & 8191;
                        const int p = ((s & dmask) << lsh) + (s >> dsh);
                        const u32x4 v = *(const u32x4*)(est + row * EROW + (hd * 64 + half * 32 + c4 * 8) * 2);
                        *(u32x4*)(ki + ((((size_t)(b * nhv + vth + hd) * 512 + (p >> 4)) * 2 + half) * 16 + (p & 15)) * 32 + c4 * 8) = v;
                    }
                } else {
                u16* hbase = H + (size_t)mw * N + ncol + ch * 8;
#pragma unroll
                for (int i = 0; i < 16; ++i) {
                    const int row = i * 4 + rr;
                    const u32x4 v = *(const u32x4*)(est + row * EROW + ch * 16);
                    *(u32x4*)(hbase + (size_t)row * N) = v;
                }
                }
            }
        }
    }
}

DEV void gemm_out_phase(unsigned char* smem, const Prm& P, const u16* Wt, const float* xin) {
    const int tid_ = opaque_tid();
    const u16* A = (const u16*)(P.ws + OFF_G);
    const int lane = tid_ & 63, w = __builtin_amdgcn_readfirstlane(tid_ >> 6), wm = w >> 1, wn = w & 1, fr = lane & 15, fq = lane >> 4;
    for (int t = vblock(); t < 512; t += gridDim.x) {
        int mi, ni; tile_mn(t, 4, mi, ni);
        const int m0 = mi << 7, n0 = ni << 8;
        f32x4 acc[32]; ZERO_ACC(acc);
        gemm_mainloop<false>(tid_, smem, A, 1024, Wt, 1024, 1024, m0, n0, acc);
        {
            __builtin_amdgcn_s_barrier();
            constexpr int EROWF = 528;
            unsigned char* est = smem + w * (32 * EROWF);
            const size_t ub = (size_t)(m0 + wm * 64) * 1024 + n0 + wn * 128;
            const float* xw = xin + ub; float* ow = P.out + ub;
            int l2_ = lane; asm volatile("" : "+v"(l2_));
            const int fr2 = l2_ & 15, fq2 = l2_ >> 4, rr = l2_ >> 5, ch = l2_ & 31;
#pragma unroll
            for (int h = 0; h < 2; ++h) {
#pragma unroll
                for (int mh = 0; mh < 2; ++mh) {
                    unsigned char* erow = est + (mh * 16 + fr2) * EROWF + fq2 * 16;
#pragma unroll
                    for (int nt = 0; nt < 8; ++nt) *(f32x4*)(erow + nt * 64) = acc[nt * 4 + h * 2 + mh];
                }
                __builtin_amdgcn_fence(__ATOMIC_RELEASE, "wavefront"); __builtin_amdgcn_wave_barrier(); __builtin_amdgcn_fence(__ATOMIC_ACQUIRE, "wavefront");
#pragma unroll 4
                for (int i = 0; i < 16; ++i) {
                    const int row = i * 2 + rr;
                    const unsigned ix = (unsigned)((h * 32 + row) * 1024 + ch * 4);
                    const f32x4 v = *(const f32x4*)(est + row * EROWF + ch * 16);
                    const f32x4 xv = *(const f32x4*)(xw + ix);
                    *(f32x4*)(ow + ix) = xv * DN_ALPHA + v;
                }
                __builtin_amdgcn_fence(__ATOMIC_RELEASE, "wavefront"); __builtin_amdgcn_wave_barrier(); __builtin_amdgcn_fence(__ATOMIC_ACQUIRE, "wavefront");
            }
        }
    }
}

DEV void gemm_gate_phase(unsigned char* smem, const Prm& P, const u16* Wg, const u16* Wp) {
    const int tid_ = opaque_tid();
    const u16* A1 = (const u16*)(P.ws + OFF_XLB);
    const u16* A2 = (const u16*)(P.ws + OFF_PB);
    u16* xb = (u16*)(P.ws + OFF_XB);
    u16* ppb = (u16*)(P.ws + OFF_PP);
    const int lane = tid_ & 63, w = __builtin_amdgcn_readfirstlane(tid_ >> 6), wm = w >> 1, wn = w & 1, fr = lane & 15, fq = lane >> 4;
    for (int t = vblock(); t < 512; t += gridDim.x) {
        int mi, ni; tile_mn(t, 4, mi, ni);
        const int m0 = mi << 7, n0 = ni << 8;
        f32x4 acc[32]; ZERO_ACC(acc);
        gemm_mainloop<false>(tid_, smem, A2, 256, Wp, 256, 256, m0, n0, acc);
        const size_t ub = (size_t)(m0 + wm * 64) * 1024 + n0 + wn * 128;
        float* ow = P.out + ub; u16* pw = ppb + ub; u16* xw = xb + ub;
        {
            int l2_ = lane; asm volatile("" : "+v"(l2_));
            const unsigned lo = (unsigned)((l2_ & 15) * 1024 + (l2_ >> 4) * 4);
#pragma unroll
            for (int mt = 0; mt < 4; ++mt) {
#pragma unroll
                for (int nt = 0; nt < 8; ++nt) { const f32x4 v = acc[nt * 4 + mt]; *(u32x2*)(pw + (lo + mt * 16384 + nt * 16)) = u32x2{pack2(v[0], v[1]), pack2(v[2], v[3])}; }
                __builtin_amdgcn_sched_barrier(0);
            }
        }
        ZERO_ACC(acc);
        gemm_mainloop<false>(tid_, smem, A1, 1024, Wg, 1024, 1024, m0, n0, acc);
        int l3_ = lane; asm volatile("" : "+v"(l3_));
        const unsigned lo = (unsigned)((l3_ & 15) * 1024 + (l3_ >> 4) * 4);
#pragma unroll
        for (int mt = 0; mt < 4; ++mt) {
#pragma unroll
            for (int nt = 0; nt < 8; ++nt) {
                const unsigned ix = lo + mt * 16384 + nt * 16;
                const f32x4 xv = *(const f32x4*)(ow + ix);
                const u32x2 pq = *(const u32x2*)(pw + ix);
                const f32x4 ga = acc[nt * 4 + mt];
                f32x4 r;
                r[0] = xv[0] + sigmoidf_(ga[0]) * bflo(pq[0]); r[1] = xv[1] + sigmoidf_(ga[1]) * bfhi(pq[0]);
                r[2] = xv[2] + sigmoidf_(ga[2]) * bflo(pq[1]); r[3] = xv[3] + sigmoidf_(ga[3]) * bfhi(pq[1]);
                *(f32x4*)(ow + ix) = r;
                *(u32x2*)(xb + kb_off(m0 + wm * 64 + mt * 16 + (l3_ & 15), n0 + wn * 128 + nt * 16 + (l3_ >> 4) * 4, 1024)) = u32x2{pack2(r[0], r[1]), pack2(r[2], r[3])};
            }
            __builtin_amdgcn_sched_barrier(0);
        }
    }
}

DEV void ln_phase(const Prm& P, int layer) {
    const int tid_ = opaque_tid();
    const int lane = tid_ & 63, w = __builtin_amdgcn_readfirstlane(tid_ >> 6);
    const float* g = P.in[12] + layer * 1024; const float* bb = P.in[13] + layer * 1024;
    u16* xlb = (u16*)(P.ws + OFF_XLB);
    for (int row = blockIdx.x * 4 + w; row < T; row += gridDim.x * 4) {
        float* xr = P.out + (size_t)row * 1024;
        f32x4 v[4];
        float s = 0.f;
#pragma unroll
        for (int i = 0; i < 4; ++i) { v[i] = *(const f32x4*)(xr + i * 256 + lane * 4); s += v[i][0] + v[i][1] + v[i][2] + v[i][3]; }
        const float mean = wave_sum(s) * (1.f / 1024.f);
        float q = 0.f;
#pragma unroll
        for (int i = 0; i < 4; ++i)
#pragma unroll
            for (int j = 0; j < 4; ++j) { const float d = v[i][j] - mean; q += d * d; }
        const float rstd = rsqrtf(wave_sum(q) * (1.f / 1024.f) + LN_EPS);
#pragma unroll
        for (int i = 0; i < 4; ++i) {
            const f32x4 gg = *(const f32x4*)(g + i * 256 + lane * 4), bv = *(const f32x4*)(bb + i * 256 + lane * 4);
            f32x4 y;
#pragma unroll
            for (int j = 0; j < 4; ++j) y[j] = (v[i][j] - mean) * rstd * gg[j] + bv[j];
            *(f32x4*)(xr + i * 256 + lane * 4) = y;
            *(u32x2*)(xlb + kb_off(row, i * 256 + lane * 4, 1024)) = u32x2{pack2(y[0], y[1]), pack2(y[2], y[3])};
        }
    }
    const float* p = P.in[1] + (size_t)layer * T * 256; u16* pb = (u16*)(P.ws + OFF_PB);
    const size_t gtid = (size_t)blockIdx.x * 256 + tid_, gsz = (size_t)gridDim.x * 256;
    for (size_t i = gtid; i < (size_t)T * 256 / 8; i += gsz) {
        const f32x4 a = *(const f32x4*)(p + i * 8), b = *(const f32x4*)(p + i * 8 + 4);
        *(u32x4*)(pb + kb_off((int)(i >> 5), (int)(i & 31) * 8, 256)) = u32x4{pack2(a[0], a[1]), pack2(a[2], a[3]), pack2(b[0], b[1]), pack2(b[2], b[3])};
    }
}

struct KV { bf16x8 ka0, ka1, kb0, kb1; bf16x8 v0, v1, v2, v3; };
template <int KH = 1024>
DEV void load_kv(KV& t, const char* Kb, unsigned koa, unsigned kob, const char* Vb, unsigned voa, unsigned vob) {
    t.ka0 = *(const bf16x8*)(Kb + koa); t.ka1 = *(const bf16x8*)(Kb + koa + KH);
    t.kb0 = *(const bf16x8*)(Kb + kob); t.kb1 = *(const bf16x8*)(Kb + kob + KH);
    t.v0 = __builtin_shufflevector(*(const s16x4*)(Vb + voa), *(const s16x4*)(Vb + vob), 0, 1, 2, 3, 4, 5, 6, 7);
    t.v1 = __builtin_shufflevector(*(const s16x4*)(Vb + voa + 512), *(const s16x4*)(Vb + vob + 512), 0, 1, 2, 3, 4, 5, 6, 7);
    t.v2 = __builtin_shufflevector(*(const s16x4*)(Vb + voa + 1024), *(const s16x4*)(Vb + vob + 1024), 0, 1, 2, 3, 4, 5, 6, 7);
    t.v3 = __builtin_shufflevector(*(const s16x4*)(Vb + voa + 1536), *(const s16x4*)(Vb + vob + 1536), 0, 1, 2, 3, 4, 5, 6, 7);
}
DEV unsigned pkrtz(float a, float b) { return __builtin_bit_cast(unsigned, __builtin_amdgcn_cvt_pkrtz(a, b)); }
DEV bf16x8 pack8(const float (&p)[8]) {
    return __builtin_bit_cast(bf16x8, u32x4{pkrtz(p[0], p[1]), pkrtz(p[2], p[3]), pkrtz(p[4], p[5]), pkrtz(p[6], p[7])});
}
DEV void qk_scores(const KV& t, const bf16x8& q0, const bf16x8& q1, f32x4& sa, f32x4& sb) {
    sa = f32x4{0.f, 0.f, 0.f, 0.f}; sb = f32x4{0.f, 0.f, 0.f, 0.f};
    sa = MFMA16(t.ka0, q0, sa); sa = MFMA16(t.ka1, q1, sa);
    sb = MFMA16(t.kb0, q0, sb); sb = MFMA16(t.kb1, q1, sb);
}
constexpr float QK_C = 0.125f * 1.4426950408889634f;
DEV void flash_core(float& mref, float& l, f32x4 (&o)[4], const bf16x8& q0, const bf16x8& q1, const KV& t, bool fast, int d0, unsigned lim) {
    f32x4 sa, sb; qk_scores(t, q0, q1, sa, sb);
    float y[8];
    if (fast) {
#pragma unroll
        for (int j = 0; j < 4; ++j) { y[j] = sa[j] * QK_C; y[4 + j] = sb[j] * QK_C; }
    } else {
#pragma unroll
        for (int j = 0; j < 4; ++j) {
            y[j]     = ((unsigned)(d0 - j) <= lim)      ? sa[j] * QK_C : NEG_INF;
            y[4 + j] = ((unsigned)(d0 - 16 - j) <= lim) ? sb[j] * QK_C : NEG_INF;
        }
    }
    float mx = fmaxf(fmaxf(fmaxf(y[0], y[1]), fmaxf(y[2], y[3])), fmaxf(fmaxf(y[4], y[5]), fmaxf(y[6], y[7])));
    if (__ballot(mx > mref + 8.f) != 0ull) {
        mx = red16_max(mx);
        const float mn = fmaxf(mref, mx);
        const float alpha = (mn == NEG_INF) ? 1.f : __builtin_amdgcn_exp2f(mref - mn);
        l *= alpha;
#pragma unroll
        for (int d = 0; d < 4; ++d) o[d] *= alpha;
        mref = mn;
    }
    const float mu = (mref == NEG_INF) ? 0.f : mref;
    float p[8]; float ps = 0.f;
#pragma unroll
    for (int j = 0; j < 8; ++j) { p[j] = __builtin_amdgcn_exp2f(y[j] - mu); ps += p[j]; }
    l += ps;
    const bf16x8 pf = pack8(p);
    o[0] = MFMA16(t.v0, pf, o[0]); o[1] = MFMA16(t.v1, pf, o[1]); o[2] = MFMA16(t.v2, pf, o[2]); o[3] = MFMA16(t.v3, pf, o[3]);
}

#define RING4(NSTEPS, LOADSTEP, COMPUTE) do { \
    KV cur_; \
    for (int st_ = 0; st_ < (NSTEPS); ++st_) { LOADSTEP(cur_, st_); COMPUTE(cur_, st_); } \
    } while (0)

DEV void band_loop(const int tid_, float& m, float& l, f32x4 (&o)[4], const bf16x8& q0, const bf16x8& q1, const char* Kb,
                   const char* Vb, int vblk0, int ustart, int nsteps, int uq, int uq0, int qspan, int maxd) {
    const int c = tid_ & 15, g4 = (tid_ & 63) >> 4;
    const unsigned kl = c * 64 + g4 * 16, vl = c * 32 + g4 * 8;
    const unsigned lim = (unsigned)min(maxd, uq);
#define BL_LOAD(R, S) do { const int ua_ = ustart + (S) * 32, ub_ = ua_ + 16; \
        const unsigned ba_ = (unsigned)(vblk0 + (max(ua_, 0) >> 4)) * 2048u, bb_ = (unsigned)(vblk0 + (max(ub_, 0) >> 4)) * 2048u; \
        load_kv(R, Kb, ba_ + kl, bb_ + kl, Vb, ba_ + vl, bb_ + vl); } while (0)
#define BL_COMP(R, S) do { const int ua_ = ustart + (S) * 32; \
        const bool fast_ = (ua_ >= 0) && (ua_ + 31 <= uq0) && (uq0 + qspan - ua_ <= maxd); \
        flash_core(m, l, o, q0, q1, R, fast_, uq - ua_ - g4 * 4, lim); } while (0)
    RING4(nsteps, BL_LOAD, BL_COMP);
#undef BL_LOAD
#undef BL_COMP
}

DEV void attnA_phase(const Prm& P, int chunk) {
    const int tid_ = opaque_tid();
    unsigned char* ws = P.ws;
    const u16* H = (const u16*)(ws + OFF_H);
    u16* G = (u16*)(ws + OFF_G);
    const int lane = tid_ & 63, w = __builtin_amdgcn_readfirstlane(tid_ >> 6), c = lane & 15, g4 = lane >> 4;
    constexpr int LD = 2560;
    const int xcd_ = blockIdx.x & 7, slot_ = blockIdx.x >> 3, nslot_ = gridDim.x >> 3;
    for (int i_ = slot_; i_ < 128; i_ += nslot_) {
        const int rq = i_ & 3, tbi = i_ >> 2, hh = xcd_ & 3, b = xcd_ >> 2;
        const int r = w * 4 + rq, tb = tbi * 256;
        const int sq = tb + r + 16 * c;
        const size_t rowq = (size_t)b * 8192 + sq;
        float m = NEG_INF, l = 0.f;
        f32x4 o[4];
#pragma unroll
        for (int d = 0; d < 4; ++d) o[d] = f32x4{0.f, 0.f, 0.f, 0.f};
#pragma unroll 1
        for (int g = 0; g < 3; ++g) {
            const int dsh = 2 * g, dmask = (1 << dsh) - 1;
            const int rg = r & dmask;
            const int uq = sq >> dsh, uq0 = (tb + r) >> dsh;
            int ustart = (uq0 - 128) & ~15;
            const int ulast = (uq0 + (15 << (4 - dsh))) & ~15;
            int ntile = ((ulast - ustart) >> 4) + 1;
            if (ntile & 1) { ustart -= 16; ntile += 1; }
            const u16* Hq = H + rowq * LD + g * 768 + hh * 64 + g4 * 8;
            const bf16x8 q0 = *(const bf16x8*)Hq, q1 = *(const bf16x8*)(Hq + 32);
            const char* Kb = (const char*)((const u16*)(ws + (g == 0 ? OFF_KI0 : (g == 1 ? OFF_KI1 : OFF_KI2))) + ((size_t)(b * 4 + hh) * 512) * 1024);
            const char* Vb = (const char*)((const u16*)(ws + (g == 0 ? OFF_VT0 : (g == 1 ? OFF_VT1 : OFF_VT2))) + ((size_t)(b * 4 + hh) * 512) * 1024);
            const int vblk0 = rg * ((8192 >> dsh) >> 4);
            band_loop(tid_, m, l, o, q0, q1, Kb, Vb, vblk0, ustart, ntile >> 1, uq, uq0, 15 << (4 - dsh), 128);
        }
        l = red16_sum(l);
        const float inv = 1.f / l;
#pragma unroll
        for (int dt = 0; dt < 4; ++dt) {
            const int dh = dt * 16 + g4 * 4;
            const u32x2 z = *(const u32x2*)(H + rowq * LD + 2304 + hh * 64 + dh);
            const float r0 = o[dt][0] * inv * siluf_(bflo(z[0])), r1 = o[dt][1] * inv * siluf_(bfhi(z[0]));
            const float r2 = o[dt][2] * inv * siluf_(bflo(z[1])), r3 = o[dt][3] * inv * siluf_(bfhi(z[1]));
            *(u32x2*)(G + kb_off((int)rowq, (chunk * 4 + hh) * 64 + dh, 1024)) = u32x2{pack2(r0, r1), pack2(r2, r3)};
        }
    }
}

DEV void attnB_phase(const Prm& P) {
    const int tid_ = opaque_tid();
    unsigned char* ws = P.ws;
    const u16* H = (const u16*)(ws + OFF_H);
    u16* G = (u16*)(ws + OFF_G);
    const float* sinks = P.in[5];
    const int lane = tid_ & 63, w = __builtin_amdgcn_readfirstlane(tid_ >> 6), c = lane & 15, g4 = lane >> 4;
    constexpr int LD = 2304;
    const int xcd_ = blockIdx.x & 7, slot_ = blockIdx.x >> 3, nslot_ = gridDim.x >> 3;
    for (int tile = slot_; tile < 512; tile += nslot_) {
        const int b = xcd_ >> 2, hq = xcd_ & 3;
        const int head = hq * 4 + w, kvh = head >> 3;
        const int t0 = tile * 16, sq = t0 + c;
        const size_t rowq = (size_t)b * 8192 + sq;
        float m = NEG_INF, l = 0.f;
        f32x4 o[4];
#pragma unroll
        for (int d = 0; d < 4; ++d) o[d] = f32x4{0.f, 0.f, 0.f, 0.f};
        const u16* Hq = H + rowq * LD + head * 64 + g4 * 8;
        const bf16x8 q0 = *(const bf16x8*)Hq, q1 = *(const bf16x8*)(Hq + 32);
        const char* Kb = (const char*)((const u16*)(ws + OFF_KI0) + ((size_t)(b * 2 + kvh) * 512) * 1024);
        const char* Vb = (const char*)((const u16*)(ws + OFF_VT0) + ((size_t)(b * 2 + kvh) * 512) * 1024);
        band_loop(tid_, m, l, o, q0, q1, Kb, Vb, 0, t0 - 144, 5, sq, t0, 15, 127);
        l = red16_sum(l);
        const float mu = (m == NEG_INF) ? 0.f : m;
        const float lf = l + __builtin_amdgcn_exp2f(sinks[head] * 1.4426950408889634f - mu);
        const float inv = 1.f / lf;
#pragma unroll
        for (int dt = 0; dt < 4; ++dt) {
            const int dh = dt * 16 + g4 * 4;
            const u32x2 z = *(const u32x2*)(H + rowq * LD + 1280 + head * 64 + dh);
            const float r0 = o[dt][0] * inv * siluf_(bflo(z[0])), r1 = o[dt][1] * inv * siluf_(bfhi(z[0]));
            const float r2 = o[dt][2] * inv * siluf_(bflo(z[1])), r3 = o[dt][3] * inv * siluf_(bfhi(z[1]));
            *(u32x2*)(G + kb_off((int)rowq, head * 64 + dh, 1024)) = u32x2{pack2(r0, r1), pack2(r2, r3)};
        }
    }
}

DEV void compress_phase(const Prm& P) {
    const int tid_ = opaque_tid();
    unsigned char* ws = P.ws;
    const u16* H = (const u16*)(ws + OFF_H);
    constexpr int LD = 3840;
    const float* bias = (const float*)(ws + OFF_BIAS);
    const int lane = tid_ & 63, w = __builtin_amdgcn_readfirstlane(tid_ >> 6), c = lane & 15, g4 = lane >> 4;
    for (int it = blockIdx.x; it < 128; it += gridDim.x) {
        const int unit = it * 4 + w;
        const int which = unit >> 8, b = (unit >> 7) & 1, kvh = (unit >> 5) & 3, ntile = unit & 31;
        const u16* Wt = (const u16*)(ws + (which ? OFF_WCV : OFF_WCK));
        const int colbase = (which ? 1280 : 1024) + kvh * 64;
        const int n = ntile * 16 + c;
        const u16* Wl = Wt + c * 32 + g4 * 8;
        f32x4 acc[4];
#pragma unroll
        for (int e = 0; e < 4; ++e) acc[e] = f32x4{0.f, 0.f, 0.f, 0.f};
#pragma unroll 4
        for (int kk = 0; kk < 64; ++kk) {
            const int j = kk >> 1, d0 = (kk & 1) * 32 + g4 * 8;
            int s = 16 * n + j; s = min(s, 8191);
            const bf16x8 xf = *(const bf16x8*)(H + ((size_t)b * 8192 + s) * LD + colbase + d0);
            bf16x8 wf[4];
#pragma unroll
            for (int e = 0; e < 4; ++e) wf[e] = *(const bf16x8*)(Wl + (size_t)(e * 64 + kk) * 512);
            if (which == 0) {
#pragma unroll
                for (int e = 0; e < 4; ++e) acc[e] = MFMA16(wf[e], xf, acc[e]);
            } else {
#pragma unroll
                for (int e = 0; e < 4; ++e) acc[e] = MFMA16(xf, wf[e], acc[e]);
            }
        }
        if (which == 0) {
            u16* kc = (u16*)(ws + OFF_KCMP) + ((size_t)(b * 4 + kvh) * 32 + ntile) * 1024 + c * 32;
#pragma unroll
            for (int e = 0; e < 4; ++e) {
                const int e0 = e * 16 + g4 * 4;
                const f32x4 bv = *(const f32x4*)(bias + e0);
                const f32x4 r = acc[e] + bv;
                *(u32x2*)(kc + (e0 >> 5) * 512 + (e0 & 31)) = u32x2{pack2(r[0], r[1]), pack2(r[2], r[3])};
            }
        } else {
            u16* vc = (u16*)(ws + OFF_VCMP) + (((size_t)(b * 4 + kvh) * 32 + ntile) * 64) * 16;
#pragma unroll
            for (int e = 0; e < 4; ++e) {
                const int ee = e * 16 + c;
                const float bv = bias[64 + ee];
                *(u32x2*)(vc + ee * 16 + g4 * 4) = u32x2{pack2(acc[e][0] + bv, acc[e][1] + bv), pack2(acc[e][2] + bv, acc[e][3] + bv)};
            }
        }
    }
}

DEV void attnC_phase(const Prm& P, unsigned char* smem) {
    const int tid_ = opaque_tid();
    unsigned char* ws = P.ws;
    const u16* H = (const u16*)(ws + OFF_H);
    u16* G = (u16*)(ws + OFF_G);
    constexpr int LD = 3840;
    float* imp = (float*)smem;
    float* scb = (float*)(smem + 32768);
    float* oslc = (float*)(smem + 34816);
    const int tid = tid_, lane = tid & 63, w = __builtin_amdgcn_readfirstlane(tid >> 6), c = lane & 15, g4 = lane >> 4;
    const int xcd_ = blockIdx.x & 7, slot_ = blockIdx.x >> 3, nslot_ = gridDim.x >> 3;
    for (int tile = slot_; tile < 512; tile += nslot_) {
        const int b = xcd_ >> 2, kvh = xcd_ & 3;
        const int t0 = tile * 16;
        for (int i = tid; i < 8192; i += 256) imp[i] = 0.f;
        __syncthreads();
        const int head = kvh * 4 + w;
        const size_t rowq = (size_t)b * 8192 + t0 + c;
        const u16* Hq = H + rowq * LD + head * 64 + g4 * 8;
        const bf16x8 q0 = *(const bf16x8*)Hq, q1 = *(const bf16x8*)(Hq + 32);
        f32x4 oacc[4];
#pragma unroll
        for (int d = 0; d < 4; ++d) oacc[d] = f32x4{0.f, 0.f, 0.f, 0.f};
        const int nmax = (t0 + c - 31) >> 4;
        const int nmaxw = (t0 - 16) >> 4;
        const float g0 = sigmoidf_(bf2f(H[rowq * LD + 3584 + head]));
        const float g1 = sigmoidf_(bf2f(H[rowq * LD + 3584 + 16 + head]));
        const float g2 = sigmoidf_(bf2f(H[rowq * LD + 3584 + 32 + head]));
        if (nmaxw >= 0) {
            const int nsteps = (nmaxw >> 5) + 1;
            const char* Kb = (const char*)((const u16*)(ws + OFF_KCMP) + ((size_t)(b * 4 + kvh) * 32) * 1024);
            const char* Vb = (const char*)((const u16*)(ws + OFF_VCMP) + ((size_t)(b * 4 + kvh) * 32) * 1024);
            const unsigned kl = c * 64 + g4 * 16, vl = c * 32 + g4 * 8;
            float m = NEG_INF, l = 0.f;
#define CM_LOAD(R, S) do { const int na_ = (S) * 32; const unsigned ba_ = (unsigned)(na_ >> 4) * 2048u, bb_ = (unsigned)min((na_ >> 4) + 1, 31) * 2048u; \
        load_kv(R, Kb, ba_ + kl, bb_ + kl, Vb, ba_ + vl, bb_ + vl); } while (0)
#define CM_PASS1(R, S) do { const int na_ = (S) * 32; f32x4 sa, sb; qk_scores(R, q0, q1, sa, sb); float mx = NEG_INF; float x[8]; \
        _Pragma("unroll") for (int j = 0; j < 8; ++j) { const int n = na_ + (j >> 2) * 16 + g4 * 4 + (j & 3); \
            x[j] = (n <= nmax) ? ((j < 4) ? sa[j & 3] : sb[j & 3]) * 0.125f : NEG_INF; mx = fmaxf(mx, x[j]); } \
        const float mn = fmaxf(m, mx); const float mu = (mn == NEG_INF) ? 0.f : mn; float ps = 0.f; \
        _Pragma("unroll") for (int j = 0; j < 8; ++j) ps += __expf(x[j] - mu); \
        l = l * __expf(m - mu) + ps; m = mn; } while (0)
            RING4(nsteps, CM_LOAD, CM_PASS1);
            float mall = red16_max(m);
            mall = (mall == NEG_INF) ? 0.f : mall;
            l = l * __expf(m - mall);
            l = red16_sum(l);
            const float invl = (l > 0.f) ? 1.f / l : 0.f;
#define CM_PASS2(R, S) do { const int na_ = (S) * 32; f32x4 sa, sb; qk_scores(R, q0, q1, sa, sb); float p[8]; \
        _Pragma("unroll") for (int j = 0; j < 8; ++j) { const int n = na_ + (j >> 2) * 16 + g4 * 4 + (j & 3); \
            const float sv = ((j < 4) ? sa[j & 3] : sb[j & 3]) * 0.125f; \
            p[j] = (n <= nmax) ? __expf(sv - mall) * invl : 0.f; \
            if (n <= nmax) atomicAdd(&imp[n * 16 + c], p[j]); } \
        const bf16x8 pf = pack8(p); \
        oacc[0] = MFMA16(R.v0, pf, oacc[0]); oacc[1] = MFMA16(R.v1, pf, oacc[1]); \
        oacc[2] = MFMA16(R.v2, pf, oacc[2]); oacc[3] = MFMA16(R.v3, pf, oacc[3]); } while (0)
            RING4(nsteps, CM_LOAD, CM_PASS2);
#undef CM_LOAD
#undef CM_PASS1
#undef CM_PASS2
#pragma unroll
            for (int d = 0; d < 4; ++d) oacc[d] *= g0;
        }
        {
            float m = NEG_INF, l = 0.f;
            f32x4 o[4];
#pragma unroll
            for (int d = 0; d < 4; ++d) o[d] = f32x4{0.f, 0.f, 0.f, 0.f};
            const char* Kb = (const char*)((const u16*)(ws + OFF_KI1) + ((size_t)(b * 4 + kvh) * 512) * 1024);
            const char* Vb = (const char*)((const u16*)(ws + OFF_VT1) + ((size_t)(b * 4 + kvh) * 512) * 1024);
            band_loop(tid_, m, l, o, q0, q1, Kb, Vb, 0, t0 - 528, 17, t0 + c, t0, 15, 511);
            l = red16_sum(l);
            const float sc = g2 / l;
#pragma unroll
            for (int d = 0; d < 4; ++d) oacc[d] += o[d] * sc;
        }
        __syncthreads();
        unsigned long long* msk = (unsigned long long*)(smem + 51200) + w * 8;
#pragma unroll 1
        for (int i = 0; i < 4; ++i) {
            const int tok = 4 * w + i, tq = t0 + tok, cur = tq >> 6;
            float my0, my1;
            {
                const int j0 = lane, j1 = lane + 64;
                float a0 = 2.f * (imp[(4 * j0) * 16 + tok] + imp[(4 * j0 + 1) * 16 + tok] + imp[(4 * j0 + 2) * 16 + tok]) + imp[(4 * j0 + 3) * 16 + tok];
                if (j0 > 0) a0 += imp[(4 * j0 - 1) * 16 + tok];
                const float a1 = 2.f * (imp[(4 * j1) * 16 + tok] + imp[(4 * j1 + 1) * 16 + tok] + imp[(4 * j1 + 2) * 16 + tok]) + imp[(4 * j1 + 3) * 16 + tok]
                                 + imp[(4 * j1 - 1) * 16 + tok];
                const bool f0 = (j0 == 0) || (j0 == cur) || (j0 == cur - 1);
                const bool f1 = (j1 == cur) || (j1 == cur - 1);
                my0 = f0 ? 1e4f : ((j0 <= cur) ? a0 : -1.f);
                my1 = f1 ? 1e4f : ((j1 <= cur) ? a1 : -1.f);
            }
            __builtin_amdgcn_fence(__ATOMIC_RELEASE, "wavefront"); __builtin_amdgcn_wave_barrier(); __builtin_amdgcn_fence(__ATOMIC_ACQUIRE, "wavefront");
            scb[w * 128 + lane] = my0; scb[w * 128 + 64 + lane] = my1;
            __builtin_amdgcn_fence(__ATOMIC_RELEASE, "wavefront"); __builtin_amdgcn_wave_barrier(); __builtin_amdgcn_fence(__ATOMIC_ACQUIRE, "wavefront");
            int c0 = 0, c1 = 0;
            const int jend = min(128, ((cur + 8) & ~7));
#pragma unroll 8
            for (int jj = 0; jj < jend; ++jj) {
                const float sv = scb[w * 128 + jj];
                c0 += (sv > my0 || (sv == my0 && jj < lane)) ? 1 : 0;
                c1 += (sv > my1 || (sv == my1 && jj < lane + 64)) ? 1 : 0;
            }
            const unsigned long long lo = __ballot((c0 < 16) && (lane <= cur));
            const unsigned long long hi = __ballot((c1 < 16) && (lane + 64 <= cur));
            if (lane == 0) { msk[i * 2] = lo; msk[i * 2 + 1] = hi; }
        }
        __builtin_amdgcn_fence(__ATOMIC_RELEASE, "wavefront"); __builtin_amdgcn_wave_barrier(); __builtin_amdgcn_fence(__ATOMIC_ACQUIRE, "wavefront");
        {
            const int tokL = 4 * w + (c >> 2), tq = t0 + tokL, hd = kvh * 4 + (c & 3);
            const size_t rq = (size_t)b * 8192 + tq;
            const u16* Hs = H + rq * LD + hd * 64 + g4 * 8;
            const bf16x8 s0 = *(const bf16x8*)Hs, s1 = *(const bf16x8*)(Hs + 32);
            const char* Kb = (const char*)((const u16*)(ws + OFF_KI0) + ((size_t)(b * 4 + kvh) * 512) * 1024);
            const char* Vb = (const char*)((const u16*)(ws + OFF_VT0) + ((size_t)(b * 4 + kvh) * 512) * 1024);
            const unsigned kl = c * 64 + g4 * 16, vl = c * 32 + g4 * 8;
            float m = NEG_INF, l = 0.f;
            f32x4 o[4];
#pragma unroll
            for (int d = 0; d < 4; ++d) o[d] = f32x4{0.f, 0.f, 0.f, 0.f};
            const int ti = c >> 2;
            const unsigned long long mylo = msk[ti * 2], myhi = msk[ti * 2 + 1];
            const unsigned long long ulo = msk[0] | msk[2] | msk[4] | msk[6];
            const unsigned long long uhi = msk[1] | msk[3] | msk[5] | msk[7];
            const unsigned long long alo = msk[0] & msk[2] & msk[4] & msk[6], ahi = msk[1] & msk[3] & msk[5] & msk[7];
            int* blist = (int*)(scb + w * 128);
            const int nlo = __builtin_popcountll(ulo), nblk = nlo + __builtin_popcountll(uhi);
            if ((ulo >> lane) & 1ull) blist[__builtin_popcountll(ulo & ((1ull << lane) - 1ull))] = lane;
            if ((uhi >> lane) & 1ull) blist[nlo + __builtin_popcountll(uhi & ((1ull << lane) - 1ull))] = 64 + lane;
            __builtin_amdgcn_fence(__ATOMIC_RELEASE, "wavefront");
            __builtin_amdgcn_wave_barrier();
            __builtin_amdgcn_fence(__ATOMIC_ACQUIRE, "wavefront");
            const int nst = 2 * nblk;
#define SL_LOAD(R, S) do { const int j_ = __builtin_amdgcn_readfirstlane(blist[(S) >> 1]); const int ua_ = j_ * 64 + ((S) & 1) * 32; \
        load_kv(R, Kb, (unsigned)(ua_ >> 4) * 2048u + kl, (unsigned)((ua_ >> 4) + 1) * 2048u + kl, \
                Vb, (unsigned)(ua_ >> 4) * 2048u + vl, (unsigned)((ua_ >> 4) + 1) * 2048u + vl); } while (0)
#define SL_COMP(R, S) do { const int j_ = __builtin_amdgcn_readfirstlane(blist[(S) >> 1]); const int ua_ = j_ * 64 + ((S) & 1) * 32; \
        const bool selj = (j_ < 64) ? ((mylo >> j_) & 1ull) : ((myhi >> (j_ - 64)) & 1ull); \
        const bool alls_ = (j_ < 64) ? ((alo >> j_) & 1ull) : ((ahi >> (j_ - 64)) & 1ull); \
        const bool fast_ = alls_ && (ua_ + 31 <= t0 + 4 * w); \
        flash_core(m, l, o, s0, s1, R, fast_, selj ? (tq - ua_ - g4 * 4) : -(1 << 30), 0x7fffffffu); } while (0)
            RING4(nst, SL_LOAD, SL_COMP);
#undef SL_LOAD
#undef SL_COMP
            l = red16_sum(l);
            const float inv = 1.f / l;
#pragma unroll
            for (int dt = 0; dt < 4; ++dt)
                *(f32x4*)(oslc + (tokL * 4 + (c & 3)) * 64 + dt * 16 + g4 * 4) = o[dt] * inv;
        }
        __syncthreads();
#pragma unroll
        for (int dt = 0; dt < 4; ++dt) {
            const int dh = dt * 16 + g4 * 4;
            const f32x4 os = *(const f32x4*)(oslc + (c * 4 + w) * 64 + dh);
            const f32x4 r = oacc[dt] + os * g1;
            const u32x2 z = *(const u32x2*)(H + rowq * LD + 2560 + head * 64 + dh);
            const float r0 = r[0] * siluf_(bflo(z[0])), r1 = r[1] * siluf_(bfhi(z[0]));
            const float r2 = r[2] * siluf_(bflo(z[1])), r3 = r[3] * siluf_(bfhi(z[1]));
            *(u32x2*)(G + kb_off((int)rowq, head * 64 + dh, 1024)) = u32x2{pack2(r0, r1), pack2(r2, r3)};
        }
        __syncthreads();
    }
}

#ifndef PROBE_DUP
#define PROBE_DUP 0
#endif
#define REP(k) for (int rep_ = 0; rep_ < 1 + ((PROBE_DUP >> (k)) & 1); ++rep_)
constexpr int LDS_BYTES = 3 * GSTAGE + 64;
__global__ void __launch_bounds__(256, 2) mk_fwd(Prm P) {
    extern __shared__ __attribute__((aligned(16))) unsigned char smem[];
    unsigned* xb_words = (unsigned*)(smem + 3 * GSTAGE);
    if (threadIdx.x < 4) xb_words[threadIdx.x] = 0u;
    __syncthreads();
    XcdBarrier bar = xcd_barrier_post((unsigned*)(P.ws + OFF_BAR), (volatile LAS unsigned*)xb_words);
    unsigned char* ws = P.ws;

    phase0(P, smem);
    cg::this_grid().sync();

#pragma unroll 1
    for (int layer = 0; layer < 4; ++layer) {
        const int kind = layer % 3, lj = layer / 3;
        const u16* Win; const u16* Wout; int N, nsub;
        if (kind == 0)      { Win = (const u16*)(ws + OFF_WA_IN + (size_t)lj * SZ_WA_IN); Wout = (const u16*)(ws + OFF_WA_OUT + (size_t)lj * SZ_SQ); N = 2560; nsub = 4; }
        else if (kind == 1) { Win = (const u16*)(ws + OFF_WB_IN); Wout = (const u16*)(ws + OFF_WB_OUT); N = 2304; nsub = 1; }
        else                { Win = (const u16*)(ws + OFF_WC_IN); Wout = (const u16*)(ws + OFF_WC_OUT); N = 3840; nsub = 1; }
#pragma unroll 1
        for (int sub = 0; sub < nsub; ++sub) {
            REP(0) gemm_in_phase(smem, P, kind, Win + (size_t)sub * 2560 * 1024, N);
            xcd_barrier(bar);
            if (kind == 0) REP(1) attnA_phase(P, sub);
            else if (kind == 1) REP(2) attnB_phase(P);
            else { REP(3) compress_phase(P); xcd_barrier(bar); REP(4) attnC_phase(P, smem); }
            xcd_barrier(bar);
        }
        gemm_out_phase(smem, P, Wout, layer == 0 ? P.in[0] : P.out);
        xcd_barrier(bar);
        ln_phase(P, layer);
        xcd_barrier(bar);
        gemm_gate_phase(smem, P, (const u16*)(ws + OFF_WG + (size_t)layer * SZ_SQ), (const u16*)(ws + OFF_WP + (size_t)layer * SZ_WP));
        if (layer < 3) xcd_barrier(bar);
    }
}

extern "C" void kernel_launch(void* const* d_in, const int* in_sizes, int n_in, void* d_out, int out_size, void* d_ws, size_t ws_size,
                              hipStream_t stream) {
    static int grid_blocks = 0;
    if (!grid_blocks) {
        int dev = 0, cus = 0, per_cu = 0;
        (void)hipGetDevice(&dev);
        (void)hipDeviceGetAttribute(&cus, hipDeviceAttributeMultiprocessorCount, dev);
        (void)hipFuncSetAttribute((const void*)mk_fwd, hipFuncAttributeMaxDynamicSharedMemorySize, LDS_BYTES);
        (void)hipOccupancyMaxActiveBlocksPerMultiprocessor(&per_cu, (const void*)mk_fwd, 256, LDS_BYTES);
        if (per_cu > 2) per_cu = 2;
        if (per_cu < 1) per_cu = 1;
        grid_blocks = cus * per_cu;
        if (ws_size < WS_END || n_in != 16) { fprintf(stderr, "kernel_launch: workspace too small (%zu < %zu) or n_in %d != 16\n", ws_size, (size_t)WS_END, n_in); grid_blocks = -1; }
    }
    if (grid_blocks < 0) return;
    (void)hipMemsetAsync((char*)d_ws + OFF_BAR, 0, 16384, stream);
    Prm p{};
    for (int i = 0; i < 16; ++i) p.in[i] = (const float*)d_in[i];
    p.out = (float*)d_out; p.ws = (unsigned char*)d_ws;
    void* args[] = {&p};
    hipError_t e = hipLaunchCooperativeKernel((const void*)mk_fwd, dim3(grid_blocks), dim3(256), args, LDS_BYTES, stream);
    if (e != hipSuccess) fprintf(stderr, "cooperative launch failed: %s (grid %d)\n", hipGetErrorString(e), grid_blocks);
}
```

```cpp
#include <hip/hip_runtime.h>
#include <hip/hip_cooperative_groups.h>
#include <cstdio>
#include <cstdint>
namespace cg = cooperative_groups;

typedef unsigned short u16;
using bf16x8 = __attribute__((ext_vector_type(8))) short;
using s16x4  = __attribute__((ext_vector_type(4))) short;
using f32x4  = __attribute__((ext_vector_type(4))) float;
using u32x4  = __attribute__((ext_vector_type(4))) unsigned;
using u32x2  = __attribute__((ext_vector_type(2))) unsigned;
#define DEV __device__ __forceinline__
using h16x8 = __attribute__((ext_vector_type(8))) _Float16;
#define MFMA16(a, b, c) __builtin_amdgcn_mfma_f32_16x16x32_f16(__builtin_bit_cast(h16x8, (a)), __builtin_bit_cast(h16x8, (b)), (c), 0, 0, 0)
#define LAS __attribute__((address_space(3)))

constexpr int T = 16384, S = 8192;
constexpr float LN_EPS = 1e-5f;
constexpr float DN_ALPHA = 1.6817928305074290f;
constexpr float NEG_INF = -__builtin_huge_valf();

constexpr size_t OFF_BAR   = 0;
constexpr size_t OFF_COS   = 16384;
constexpr size_t OFF_SIN   = OFF_COS + (size_t)8192 * 32 * 4;
constexpr size_t OFF_BIAS  = OFF_SIN + (size_t)8192 * 32 * 4;
constexpr size_t OFF_WA_IN = OFF_BIAS + 1024;
constexpr size_t SZ_WA_IN  = (size_t)10240 * 1024 * 2;
constexpr size_t SZ_SQ     = (size_t)1024 * 1024 * 2;
constexpr size_t OFF_WA_OUT = OFF_WA_IN + 2 * SZ_WA_IN;
constexpr size_t OFF_WB_IN  = OFF_WA_OUT + 2 * SZ_SQ;
constexpr size_t OFF_WB_OUT = OFF_WB_IN + (size_t)2304 * 1024 * 2;
constexpr size_t OFF_WC_IN  = OFF_WB_OUT + SZ_SQ;
constexpr size_t OFF_WC_OUT = OFF_WC_IN + (size_t)3840 * 1024 * 2;
constexpr size_t OFF_WG     = OFF_WC_OUT + SZ_SQ;
constexpr size_t OFF_WP     = OFF_WG + 4 * SZ_SQ;
constexpr size_t SZ_WP      = (size_t)1024 * 256 * 2;
constexpr size_t OFF_WCK    = OFF_WP + 4 * SZ_WP;
constexpr size_t OFF_WCV    = OFF_WCK + (size_t)64 * 2048 * 2;
constexpr size_t OFF_XB     = OFF_WCV + (size_t)64 * 2048 * 2;
constexpr size_t SZ_ACT     = (size_t)T * 1024 * 2;
constexpr size_t OFF_G      = OFF_XB + SZ_ACT;
constexpr size_t OFF_H      = OFF_G + SZ_ACT;
constexpr size_t SZ_HMAX    = (size_t)T * 3840 * 2;
constexpr size_t OFF_VT0    = OFF_H + SZ_HMAX;
constexpr size_t SZ_VT      = (size_t)2 * 4 * 8192 * 64 * 2;
constexpr size_t OFF_VT1    = OFF_VT0 + SZ_VT;
constexpr size_t OFF_VT2    = OFF_VT1 + SZ_VT;
constexpr size_t OFF_KCMP   = OFF_VT2 + SZ_VT;
constexpr size_t SZ_CMP     = (size_t)2 * 512 * 4 * 64 * 2;
constexpr size_t OFF_VCMP   = OFF_KCMP + SZ_CMP;
constexpr size_t OFF_KI0    = OFF_VCMP + SZ_CMP;
constexpr size_t OFF_KI1    = OFF_KI0 + SZ_VT;
constexpr size_t OFF_KI2    = OFF_KI1 + SZ_VT;
constexpr size_t WS_END     = OFF_KI2 + SZ_VT;
constexpr size_t OFF_XLB    = OFF_H;
constexpr size_t OFF_PB     = OFF_H + SZ_ACT;
constexpr size_t OFF_PP     = OFF_H + SZ_ACT + (size_t)16 * 1024 * 1024;

struct Prm { const float* in[16]; float* out; unsigned char* ws; };

__device__ __forceinline__ size_t kb_off(int row, int k, int K) { return ((size_t)(row >> 4) * (K >> 5) + (k >> 5)) * 512 + (row & 15) * 32 + (k & 31); }
DEV u16 f2bf(float f) { return __builtin_bit_cast(u16, (_Float16)f); }
DEV float bf2f(u16 h) { return (float)__builtin_bit_cast(_Float16, h); }
DEV unsigned pack2(float a, float b) { return (unsigned)f2bf(a) | ((unsigned)f2bf(b) << 16); }
DEV float bflo(unsigned u) { return bf2f((u16)(u & 0xffffu)); }
DEV float bfhi(unsigned u) { return bf2f((u16)(u >> 16)); }
DEV float sigmoidf_(float x) { return 1.f / (1.f + __expf(-x)); }
DEV float siluf_(float x) { return x / (1.f + __expf(-x)); }
DEV float red16_max(float v) { v = fmaxf(v, __shfl_xor(v, 16)); v = fmaxf(v, __shfl_xor(v, 32)); return v; }
DEV float red16_sum(float v) { v += __shfl_xor(v, 16); v += __shfl_xor(v, 32); return v; }
DEV float wave_sum(float v) { for (int o = 32; o > 0; o >>= 1) v += __shfl_xor(v, o); return v; }

DEV int opaque_tid() { int t = threadIdx.x; asm volatile("" : "+v"(t)); return t; }
#define XB_TMO      128
#define XB_XCNT(j)  (256  + 64 * (j))
#define XB_XSUB(j)  (1280 + 64 * (j))
#define XB_XGEN(j)  (2304 + 64 * (j))
#define XB_TOP      3328
#define XB_TOPGEN   3392
#define XCD_BAR_WORDS 3456
#define XB_SPIN_CAP (1u << 24)
DEV unsigned xb_ld(unsigned* p)              { return __hip_atomic_load(p, __ATOMIC_RELAXED, __HIP_MEMORY_SCOPE_AGENT); }
DEV unsigned xb_add(unsigned* p, unsigned v) { return __hip_atomic_fetch_add(p, v, __ATOMIC_RELAXED, __HIP_MEMORY_SCOPE_AGENT); }
DEV unsigned xb_xcc_id() { return (unsigned)__builtin_amdgcn_s_getreg((3 << 11) | 20) & 0xFu; }
#define XB_SPIN(cond, bar) do { unsigned _sp = 0; while (cond) { __builtin_amdgcn_s_sleep(1); \
    if ((++_sp & 255u) == 0u) { if (xb_ld(&(bar)[XB_TMO])) break; if (_sp > XB_SPIN_CAP) { atomicAdd(&(bar)[XB_TMO], 1u); break; } } } } while (0)
struct XcdBarrier { unsigned* bar; unsigned x; volatile LAS unsigned* st; };
DEV XcdBarrier xcd_barrier_post(unsigned* bar, volatile LAS unsigned* st) {
    XcdBarrier b; b.bar = bar; b.x = xb_xcc_id(); b.st = st;
    if (threadIdx.x == 0) (void)xb_add(&bar[XB_XCNT(b.x)], 1u);
    return b;
}
DEV void xcd_barrier_complete(unsigned* bar, unsigned x, unsigned& nloc, unsigned& nx) {
    const unsigned G = gridDim.x * gridDim.y * gridDim.z;
    unsigned sum, cnt, mine, sp = 0u;
    for (;;) {
        sum = 0u; cnt = 0u; mine = 0u;
#pragma unroll
        for (unsigned j = 0; j < 16; ++j) { const unsigned c = xb_ld(&bar[XB_XCNT(j)]); sum += c; cnt += (c > 0u) ? 1u : 0u; mine = (j == x) ? c : mine; }
        if (sum == G) break;
        __builtin_amdgcn_s_sleep(1);
        if ((++sp & 255u) == 0u) { if (xb_ld(&bar[XB_TMO])) break; if (sp > XB_SPIN_CAP) { atomicAdd(&bar[XB_TMO], 1u); break; } }
    }
    nloc = mine > 0u ? mine : 1u; nx = cnt > 0u ? cnt : 1u;
}
DEV void xcd_barrier(const XcdBarrier& b) {
    asm volatile("s_waitcnt vmcnt(0)" ::: "memory");
    __syncthreads();
    if (threadIdx.x == 0) {
        unsigned* bar = b.bar;
        __builtin_amdgcn_s_waitcnt(0);
        unsigned nloc = b.st[0], nx = b.st[1];
        if (nloc == 0u) { xcd_barrier_complete(bar, b.x, nloc, nx); b.st[0] = nloc; b.st[1] = nx; }
        const unsigned old = xb_add(&bar[XB_XSUB(b.x)], 1u);
        const unsigned gen = old / nloc;
        if (old + 1u == (gen + 1u) * nloc) {
            __builtin_amdgcn_fence(__ATOMIC_RELEASE, "agent");
            asm volatile("s_waitcnt vmcnt(0)" ::: "memory");
            const unsigned og = xb_add(&bar[XB_TOP], 1u);
            const unsigned tg = og / nx;
            if (og + 1u == (tg + 1u) * nx) xb_add(&bar[XB_TOPGEN], 1u);
            else XB_SPIN(xb_ld(&bar[XB_TOPGEN]) == tg, bar);
            __builtin_amdgcn_fence(__ATOMIC_ACQUIRE, "agent");
            xb_add(&bar[XB_XGEN(b.x)], 1u);
            asm volatile("s_waitcnt vmcnt(0)" ::: "memory");
        } else {
            XB_SPIN(xb_ld(&bar[XB_XGEN(b.x)]) == gen, bar);
            __builtin_amdgcn_fence(__ATOMIC_ACQUIRE, "agent");
            asm volatile("s_waitcnt vmcnt(0)" ::: "memory");
        }
    }
    __syncthreads();
}

DEV int colmap(int kind, int n) {
    if (kind == 0) return n;
    if (kind == 1) {
        const int c = n / 2560, nn = n - c * 2560;
        if (nn < 2304) { const int g = nn / 768, rem = nn - g * 768, part = rem >> 8, hh = (rem & 255) >> 6, d = rem & 63;
                         return g * 3072 + part * 1024 + (c * 4 + hh) * 64 + d; }
        const int z = nn - 2304; return 9216 + (c * 4 + (z >> 6)) * 64 + (z & 63);
    }
    if (n < 2560) return n;
    if (n < 3584) return n - 2560 + 2608;
    if (n < 3632) return n - 3584 + 2560;
    return -1;
}
DEV void tconv(const int tid_, float* lds, const float* __restrict__ src, int K, int Nsrc, u16* __restrict__ dst, int Ndst, int kind, int& acc_tiles) {
    const int G = gridDim.x, tid = tid_;
    const int ntn = Ndst >> 6, ntk = K >> 6, nt = ntn * ntk;
    int first = ((int)blockIdx.x - (acc_tiles % G) + G) % G;
    acc_tiles += nt;
    for (int t = first; t < nt; t += G) {
        const int tn = t / ntk, tk = t - tn * ntk;
        const int n0 = tn << 6, k0 = tk << 6;
        const int nl = tid & 63;
        const int c = colmap(kind, n0 + nl);
#pragma unroll
        for (int i = 0; i < 16; ++i) {
            const int kl = (tid >> 6) + 4 * i;
            const float v = (c >= 0) ? src[(size_t)(k0 + kl) * Nsrc + c] : 0.f;
            lds[kl * 65 + nl] = v;
        }
        __syncthreads();
        const int r = tid >> 2, kk = (tid & 3) << 4;
        unsigned o[8];
#pragma unroll
        for (int i = 0; i < 8; ++i) o[i] = pack2(lds[(kk + 2 * i) * 65 + r], lds[(kk + 2 * i + 1) * 65 + r]);
        u32x4* dp = (u32x4*)(dst + kb_off(n0 + r, k0 + kk, K));
        dp[0] = u32x4{o[0], o[1], o[2], o[3]};
        dp[1] = u32x4{o[4], o[5], o[6], o[7]};
        __syncthreads();
    }
}

DEV void phase0(const Prm& P, unsigned char* smem) {
    const int tid_ = opaque_tid();
    float* lds = (float*)smem;
    unsigned char* ws = P.ws;
    int acc = 0;
    tconv(tid_, lds, P.in[2], 1024, 10240, (u16*)(ws + OFF_WA_IN), 10240, 1, acc);
    tconv(tid_, lds, P.in[2] + (size_t)1024 * 10240, 1024, 10240, (u16*)(ws + OFF_WA_IN + SZ_WA_IN), 10240, 1, acc);
    tconv(tid_, lds, P.in[3], 1024, 1024, (u16*)(ws + OFF_WA_OUT), 1024, 0, acc);
    tconv(tid_, lds, P.in[3] + (size_t)1024 * 1024, 1024, 1024, (u16*)(ws + OFF_WA_OUT + SZ_SQ), 1024, 0, acc);
    tconv(tid_, lds, P.in[4], 1024, 2304, (u16*)(ws + OFF_WB_IN), 2304, 0, acc);
    tconv(tid_, lds, P.in[6], 1024, 1024, (u16*)(ws + OFF_WB_OUT), 1024, 0, acc);
    tconv(tid_, lds, P.in[7], 1024, 3632, (u16*)(ws + OFF_WC_IN), 3840, 2, acc);
    tconv(tid_, lds, P.in[11], 1024, 1024, (u16*)(ws + OFF_WC_OUT), 1024, 0, acc);
    for (int i = 0; i < 4; ++i) {
        tconv(tid_, lds, P.in[15] + (size_t)i * 1024 * 1024, 1024, 1024, (u16*)(ws + OFF_WG + i * SZ_SQ), 1024, 0, acc);
        tconv(tid_, lds, P.in[14] + (size_t)i * 256 * 1024, 256, 1024, (u16*)(ws + OFF_WP + i * SZ_WP), 1024, 0, acc);
    }
    tconv(tid_, lds, P.in[8], 2048, 64, (u16*)(ws + OFF_WCK), 64, 0, acc);
    tconv(tid_, lds, P.in[9], 2048, 64, (u16*)(ws + OFF_WCV), 64, 0, acc);

    const size_t gtid = (size_t)blockIdx.x * 256 + tid_, gsz = (size_t)gridDim.x * 256;
    {
        const float* x = P.in[0]; u16* xb = (u16*)(ws + OFF_XB);
        for (size_t i = gtid; i < (size_t)T * 1024 / 8; i += gsz) {
            const f32x4 a = *(const f32x4*)(x + i * 8), b = *(const f32x4*)(x + i * 8 + 4);
            *(u32x4*)(xb + kb_off((int)(i >> 7), (int)(i & 127) * 8, 1024)) = u32x4{pack2(a[0], a[1]), pack2(a[2], a[3]), pack2(b[0], b[1]), pack2(b[2], b[3])};
        }
    }
    {
        float* ct = (float*)(ws + OFF_COS); float* st = (float*)(ws + OFF_SIN);
        for (size_t i = gtid; i < (size_t)8192 * 32; i += gsz) {
            const int pos = (int)(i >> 5), k = (int)(i & 31);
            const float inv = (float)(1.0 / pow(10000.0, (double)(2 * k) / 64.0));
            const float ang = (float)pos * inv;
            ct[i] = (float)cos((double)ang); st[i] = (float)sin((double)ang);
        }
    }
    {
        const int lane = tid_ & 63;
        const int wid = blockIdx.x * 4 + __builtin_amdgcn_readfirstlane(tid_ >> 6);
        if (wid < 128) {
            const float* w = (wid < 64) ? P.in[8] : P.in[9];
            const int e = wid & 63;
            float s = 0.f;
            for (int jd = lane; jd < 2048; jd += 64) s += P.in[10][jd] * w[(size_t)jd * 64 + e];
            s = wave_sum(s);
            if (lane == 0) ((float*)(ws + OFF_BIAS))[wid] = s;
        }
    }
}

constexpr int GSTAGE = 24576;
DEV int gsw(int r) { return (0x78 >> (2 * ((r >> 2) & 3))) & 3; }
DEV void gemm_issue(unsigned char* stage, const u16* ag0, const u16* ag1, const u16* bg, int bstep, int kt, int w) {
    __builtin_amdgcn_global_load_lds((const unsigned*)(ag0 + kt * 512), (unsigned*)(stage + w * 1024), 16, 0, 0);
    __builtin_amdgcn_global_load_lds((const unsigned*)(ag1 + kt * 512), (unsigned*)(stage + w * 1024 + 4096), 16, 0, 0);
#pragma unroll
    for (int i = 0; i < 4; ++i)
        __builtin_amdgcn_global_load_lds((const unsigned*)(bg + (size_t)i * bstep + kt * 512), (unsigned*)(stage + 8192 + w * 1024 + i * 4096), 16, 0, 0);
}
template <bool NONSWAP>
DEV void gemm_mainloop(const int tid_, unsigned char* smem, const u16* __restrict__ A, int lda, const u16* __restrict__ Bt, int ldb, int K,
                       int m0, int n0, f32x4 (&acc)[32], bool aperm = false) {
    const int tid = tid_, lane = tid & 63, w = __builtin_amdgcn_readfirstlane(tid >> 6), wm = w >> 1, wn = w & 1;
    const int lrow = tid >> 2, lsw = ((tid & 3) ^ gsw(lrow)) * 8;
    const int arow0 = aperm ? ((lrow & 31) * 4 + (lrow >> 5)) : lrow;
    const int arow1 = aperm ? (arow0 + 2) : (lrow + 64);
    const u16* ag0 = A + kb_off(m0 + arow0, 0, lda) + lsw;
    const u16* ag1 = A + kb_off(m0 + arow1, 0, lda) + lsw;
    const u16* bg = Bt + kb_off(n0 + lrow, 0, ldb) + lsw;
    const int bstep = 4 * (ldb >> 5) * 512;
    const int fr = lane & 15, fq = lane >> 4;
    const int coff = (fq ^ gsw(fr)) << 4;
    const int a_base = (wm * 64 + fr) * 64 + coff, b_base = 8192 + (wn * 128 + fr) * 64 + coff;
    const int nk = K >> 5;
    asm volatile("s_waitcnt vmcnt(0)" ::: "memory");
    __builtin_amdgcn_s_barrier();
    gemm_issue(smem, ag0, ag1, bg, bstep, 0, w);
    gemm_issue(smem + GSTAGE, ag0, ag1, bg, bstep, 1, w);
    int sc = 0, si = 2;
    for (int kt = 0; kt < nk; ++kt) {
        if (kt + 1 < nk) asm volatile("s_waitcnt vmcnt(6)" ::: "memory"); else asm volatile("s_waitcnt vmcnt(0)" ::: "memory");
        __builtin_amdgcn_s_barrier();
        if (kt + 2 < nk) { gemm_issue(smem + si * GSTAGE, ag0, ag1, bg, bstep, kt + 2, w); si = (si == 2) ? 0 : si + 1; }
        const unsigned char* st = smem + sc * GSTAGE; sc = (sc == 2) ? 0 : sc + 1;
        bf16x8 a[4], b[8];
#pragma unroll
        for (int i = 0; i < 4; ++i) a[i] = *(const bf16x8*)(st + a_base + i * 1024);
#pragma unroll
        for (int i = 0; i < 8; ++i) b[i] = *(const bf16x8*)(st + b_base + i * 1024);
        if (NONSWAP) {
#pragma unroll
            for (int mt = 0; mt < 4; ++mt)
#pragma unroll
                for (int nt = 0; nt < 8; ++nt) acc[mt * 8 + nt] = MFMA16(a[mt], b[nt], acc[mt * 8 + nt]);
        } else {
#pragma unroll
            for (int nt = 0; nt < 8; ++nt)
#pragma unroll
                for (int mt = 0; mt < 4; ++mt) acc[nt * 4 + mt] = MFMA16(b[nt], a[mt], acc[nt * 4 + mt]);
        }
    }
}

DEV int vblock() { const int G = gridDim.x, b = blockIdx.x; return ((G & 7) == 0) ? (b & 7) * (G >> 3) + (b >> 3) : b; }
DEV void tile_mn(int t, int nN, int& mi, int& ni) { const int per = 8 * nN; const int mg = t / per, r = t - mg * per; mi = mg * 8 + (r & 7); ni = r >> 3; }
#define ZERO_ACC(acc) _Pragma("unroll") for (int i_ = 0; i_ < 32; ++i_) acc[i_] = f32x4{0.f, 0.f, 0.f, 0.f}

DEV void classify(int kind, int cgi, int& mode, int& vsel, int& vth, int& dsh, int& nhv, int& ksel) {
    mode = 0; vsel = 0; vth = 0; dsh = 0; nhv = 4; ksel = -1;
    if (kind == 0) {
        if (cgi < 36) { const int g = cgi / 12, part = (cgi - g * 12) >> 2; vth = cgi & 3; if (part < 2) { mode = 1; if (part == 1) { ksel = g; dsh = 2 * g; } } else { mode = 2; vsel = g; dsh = 2 * g; } }
    } else if (kind == 1) {
        if (cgi < 16) mode = 1; else if (cgi < 18) { mode = 1; ksel = 0; vth = cgi - 16; nhv = 2; } else if (cgi < 20) { mode = 2; vsel = 0; vth = cgi - 18; nhv = 2; }
    } else {
        if (cgi < 20) mode = 1; else if (cgi < 24) mode = 0; else if (cgi < 28) { mode = 1; ksel = 0; vth = cgi - 24; } else if (cgi < 32) { mode = 2; vsel = 0; vth = cgi - 28; }
        else if (cgi < 36) { mode = 1; ksel = 1; vth = cgi - 32; } else if (cgi < 40) { mode = 2; vsel = 1; vth = cgi - 36; }
    }
}

DEV void gemm_in_phase(unsigned char* smem, const Prm& P, int kind, const u16* Wt, int N) {
    const int tid_ = opaque_tid();
    unsigned char* ws = P.ws;
    const u16* A = (const u16*)(ws + OFF_XB);
    u16* H = (u16*)(ws + OFF_H);
    const float* cosT = (const float*)(ws + OFF_COS); const float* sinT = (const float*)(ws + OFF_SIN);
    const int nN = N >> 8, ntiles = 128 * nN;
    const int lane = tid_ & 63, w = __builtin_amdgcn_readfirstlane(tid_ >> 6), wm = w >> 1, wn = w & 1, fr = lane & 15, fq = lane >> 4;
    for (int t = vblock(); t < ntiles; t += gridDim.x) {
        int mi, ni; tile_mn(t, nN, mi, ni);
        const int m0 = mi << 7, n0 = ni << 8;
        const int ncol = n0 + wn * 128, cg0 = ncol >> 6;
        int mode, vsel, vth, dsh, nhv, ksel; classify(kind, cg0, mode, vsel, vth, dsh, nhv, ksel);
        const int mw = m0 + wm * 64;
        f32x4 acc[32]; ZERO_ACC(acc);
        if (mode == 2) {
            gemm_mainloop<true>(tid_, smem, A, 1024, Wt, 1024, 1024, m0, n0, acc, dsh == 2);
            __builtin_amdgcn_s_barrier();
            u16* vt = (u16*)(ws + (vsel == 0 ? OFF_VT0 : (vsel == 1 ? OFF_VT1 : OFF_VT2)));
            if (dsh == 0) {
#pragma unroll
                for (int mt = 0; mt < 4; ++mt) {
                    const int m = mw + mt * 16 + fq * 4;
                    const int b = m >> 13, p = m & 8191;
#pragma unroll
                    for (int grp = 0; grp < 2; ++grp) {
                        u16* dst = vt + ((((size_t)(b * nhv + vth + grp)) * 512 + (p >> 4)) * 64) * 16 + (p & 15);
#pragma unroll
                        for (int nt = 0; nt < 4; ++nt) { const f32x4 v = acc[mt * 8 + grp * 4 + nt]; *(u32x2*)(dst + (nt * 16 + fr) * 16) = u32x2{pack2(v[0], v[1]), pack2(v[2], v[3])}; }
                    }
                }
            } else if (dsh == 4) {
#pragma unroll
                for (int j = 0; j < 4; ++j) {
                    const int m = mw + fq * 4 + j;
                    const int b = m >> 13, s = m & 8191;
                    const int p = ((s & 15) << 9) + (s >> 4);
#pragma unroll
                    for (int grp = 0; grp < 2; ++grp) {
                        u16* dst = vt + ((((size_t)(b * nhv + vth + grp)) * 512 + (p >> 4)) * 64) * 16 + (p & 15);
#pragma unroll
                        for (int nt = 0; nt < 4; ++nt)
                            *(u32x2*)(dst + (nt * 16 + fr) * 16) = u32x2{pack2(acc[0 * 8 + grp * 4 + nt][j], acc[1 * 8 + grp * 4 + nt][j]), pack2(acc[2 * 8 + grp * 4 + nt][j], acc[3 * 8 + grp * 4 + nt][j])};
                    }
                }
            } else {
#pragma unroll
                for (int mt = 0; mt < 4; ++mt) {
                    const int r0 = wm * 64 + mt * 16 + fq * 4;
                    const int m = m0 + (r0 & 31) * 4 + (r0 >> 5);
                    const int b = m >> 13, s = m & 8191;
                    const int p = ((s & 3) << 11) + (s >> 2);
#pragma unroll
                    for (int grp = 0; grp < 2; ++grp) {
                        u16* dst = vt + ((((size_t)(b * nhv + vth + grp)) * 512 + (p >> 4)) * 64) * 16 + (p & 15);
#pragma unroll
                        for (int nt = 0; nt < 4; ++nt) { const f32x4 v = acc[mt * 8 + grp * 4 + nt]; *(u32x2*)(dst + (nt * 16 + fr) * 16) = u32x2{pack2(v[0], v[1]), pack2(v[2], v[3])}; }
                    }
                }
            }
        } else {
            gemm_mainloop<false>(tid_, smem, A, 1024, Wt, 1024, 1024, m0, n0, acc);
            __builtin_amdgcn_s_barrier();
            constexpr int EROW = 272;
            unsigned char* est = smem + w * (64 * EROW);
            int l4_ = lane; asm volatile("" : "+v"(l4_));
            const int fr = l4_ & 15, fq = l4_ >> 4;
#pragma unroll
            for (int mt = 0; mt < 4; ++mt) {
                const int s = (mw + mt * 16 + fr) & 8191;
                unsigned char* erow = est + (mt * 16 + fr) * EROW + fq * 8;
                if (mode == 1) {
#pragma unroll
                    for (int nt = 0; nt < 2; ++nt) {
                        const f32x4 c4 = *(const f32x4*)(cosT + s * 32 + nt * 16 + fq * 4);
                        const f32x4 s4 = *(const f32x4*)(sinT + s * 32 + nt * 16 + fq * 4);
#pragma unroll
                        for (int grp = 0; grp < 2; ++grp) {
                            const f32x4 x1 = acc[(grp * 4 + nt) * 4 + mt], x2 = acc[(grp * 4 + nt + 2) * 4 + mt];
                            const f32x4 o1 = x1 * c4 - x2 * s4, o2 = x2 * c4 + x1 * s4;
                            *(u32x2*)(erow + (grp * 64 + nt * 16) * 2) = u32x2{pack2(o1[0], o1[1]), pack2(o1[2], o1[3])};
                            *(u32x2*)(erow + (grp * 64 + (nt + 2) * 16) * 2) = u32x2{pack2(o2[0], o2[1]), pack2(o2[2], o2[3])};
                        }
                    }
                } else {
#pragma unroll
                    for (int nt = 0; nt < 8; ++nt) { const f32x4 v = acc[nt * 4 + mt]; *(u32x2*)(erow + nt * 32) = u32x2{pack2(v[0], v[1]), pack2(v[2], v[3])}; }
                }
            }
            __builtin_amdgcn_fence(__ATOMIC_RELEASE, "wavefront"); __builtin_amdgcn_wave_barrier(); __builtin_amdgcn_fence(__ATOMIC_ACQUIRE, "wavefront");
            {
                const int rr = l4_ >> 4, ch = l4_ & 15;
                if (ksel >= 0) {
                    u16* ki = (u16*)(ws + (ksel == 0 ? OFF_KI0 : (ksel == 1 ? OFF_KI1 : OFF_KI2)));
                    const int dmask = (1 << dsh) - 1, lsh = 13 - dsh, numask = (64 >> dsh) - 1;
                    const int kk = l4_ >> 2, c4 = l4_ & 3;
#pragma unroll 4
                    for (int i = 0; i < 16; ++i) {
                        const int rgp = i >> 2, hd = (i >> 1) & 1, half = i & 1;
                        const int tt = rgp * 16 + kk;
                        const int row = ((tt & numask) << dsh) + (tt >> (6 - dsh));
                        const int m = mw + row, b = m >> 13, s = m & 8191;
                        const int p = ((s & dmask) << lsh) + (s >> dsh);
                        const u32x4 v = *(const u32x4*)(est + row * EROW + (hd * 64 + half * 32 + c4 * 8) * 2);
                        *(u32x4*)(ki + ((((size_t)(b * nhv + vth + hd) * 512 + (p >> 4)) * 2 + half) * 16 + (p & 15)) * 32 + c4 * 8) = v;
                    }
                } else {
                u16* hbase = H + (size_t)mw * N + ncol + ch * 8;
#pragma unroll
                for (int i = 0; i < 16; ++i) {
                    const int row = i * 4 + rr;
                    const u32x4 v = *(const u32x4*)(est + row * EROW + ch * 16);
                    *(u32x4*)(hbase + (size_t)row * N) = v;
                }
                }
            }
        }
    }
}

DEV void gemm_out_phase(unsigned char* smem, const Prm& P, const u16* Wt, const float* xin) {
    const int tid_ = opaque_tid();
    const u16* A = (const u16*)(P.ws + OFF_G);
    const int lane = tid_ & 63, w = __builtin_amdgcn_readfirstlane(tid_ >> 6), wm = w >> 1, wn = w & 1, fr = lane & 15, fq = lane >> 4;
    for (int t = vblock(); t < 512; t += gridDim.x) {
        int mi, ni; tile_mn(t, 4, mi, ni);
        const int m0 = mi << 7, n0 = ni << 8;
        f32x4 acc[32]; ZERO_ACC(acc);
        gemm_mainloop<false>(tid_, smem, A, 1024, Wt, 1024, 1024, m0, n0, acc);
        {
            __builtin_amdgcn_s_barrier();
            constexpr int EROWF = 528;
            unsigned char* est = smem + w * (32 * EROWF);
            const size_t ub = (size_t)(m0 + wm * 64) * 1024 + n0 + wn * 128;
            const float* xw = xin + ub; float* ow = P.out + ub;
            int l2_ = lane; asm volatile("" : "+v"(l2_));
            const int fr2 = l2_ & 15, fq2 = l2_ >> 4, rr = l2_ >> 5, ch = l2_ & 31;
#pragma unroll
            for (int h = 0; h < 2; ++h) {
#pragma unroll
                for (int mh = 0; mh < 2; ++mh) {
                    unsigned char* erow = est + (mh * 16 + fr2) * EROWF + fq2 * 16;
#pragma unroll
                    for (int nt = 0; nt < 8; ++nt) *(f32x4*)(erow + nt * 64) = acc[nt * 4 + h * 2 + mh];
                }
                __builtin_amdgcn_fence(__ATOMIC_RELEASE, "wavefront"); __builtin_amdgcn_wave_barrier(); __builtin_amdgcn_fence(__ATOMIC_ACQUIRE, "wavefront");
#pragma unroll 4
                for (int i = 0; i < 16; ++i) {
                    const int row = i * 2 + rr;
                    const unsigned ix = (unsigned)((h * 32 + row) * 1024 + ch * 4);
                    const f32x4 v = *(const f32x4*)(est + row * EROWF + ch * 16);
                    const f32x4 xv = *(const f32x4*)(xw + ix);
                    *(f32x4*)(ow + ix) = xv * DN_ALPHA + v;
                }
                __builtin_amdgcn_fence(__ATOMIC_RELEASE, "wavefront"); __builtin_amdgcn_wave_barrier(); __builtin_amdgcn_fence(__ATOMIC_ACQUIRE, "wavefront");
            }
        }
    }
}

DEV void gemm_gate_phase(unsigned char* smem, const Prm& P, const u16* Wg, const u16* Wp) {
    const int tid_ = opaque_tid();
    const u16* A1 = (const u16*)(P.ws + OFF_XLB);
    const u16* A2 = (const u16*)(P.ws + OFF_PB);
    u16* xb = (u16*)(P.ws + OFF_XB);
    u16* ppb = (u16*)(P.ws + OFF_PP);
    const int lane = tid_ & 63, w = __builtin_amdgcn_readfirstlane(tid_ >> 6), wm = w >> 1, wn = w & 1, fr = lane & 15, fq = lane >> 4;
    for (int t = vblock(); t < 512; t += gridDim.x) {
        int mi, ni; tile_mn(t, 4, mi, ni);
        const int m0 = mi << 7, n0 = ni << 8;
        f32x4 acc[32]; ZERO_ACC(acc);
        gemm_mainloop<false>(tid_, smem, A2, 256, Wp, 256, 256, m0, n0, acc);
        const size_t ub = (size_t)(m0 + wm * 64) * 1024 + n0 + wn * 128;
        float* ow = P.out + ub; u16* pw = ppb + ub; u16* xw = xb + ub;
        {
            int l2_ = lane; asm volatile("" : "+v"(l2_));
            const unsigned lo = (unsigned)((l2_ & 15) * 1024 + (l2_ >> 4) * 4);
#pragma unroll
            for (int mt = 0; mt < 4; ++mt) {
#pragma unroll
                for (int nt = 0; nt < 8; ++nt) { const f32x4 v = acc[nt * 4 + mt]; *(u32x2*)(pw + (lo + mt * 16384 + nt * 16)) = u32x2{pack2(v[0], v[1]), pack2(v[2], v[3])}; }
                __builtin_amdgcn_sched_barrier(0);
            }
        }
        ZERO_ACC(acc);
        gemm_mainloop<false>(tid_, smem, A1, 1024, Wg, 1024, 1024, m0, n0, acc);
        int l3_ = lane; asm volatile("" : "+v"(l3_));
        const unsigned lo = (unsigned)((l3_ & 15) * 1024 + (l3_ >> 4) * 4);
#pragma unroll
        for (int mt = 0; mt < 4; ++mt) {
#pragma unroll
            for (int nt = 0; nt < 8; ++nt) {
                const unsigned ix = lo + mt * 16384 + nt * 16;
                const f32x4 xv = *(const f32x4*)(ow + ix);
                const u32x2 pq = *(const u32x2*)(pw + ix);
                const f32x4 ga = acc[nt * 4 + mt];
                f32x4 r;
                r[0] = xv[0] + sigmoidf_(ga[0]) * bflo(pq[0]); r[1] = xv[1] + sigmoidf_(ga[1]) * bfhi(pq[0]);
                r[2] = xv[2] + sigmoidf_(ga[2]) * bflo(pq[1]); r[3] = xv[3] + sigmoidf_(ga[3]) * bfhi(pq[1]);
                *(f32x4*)(ow + ix) = r;
                *(u32x2*)(xb + kb_off(m0 + wm * 64 + mt * 16 + (l3_ & 15), n0 + wn * 128 + nt * 16 + (l3_ >> 4) * 4, 1024)) = u32x2{pack2(r[0], r[1]), pack2(r[2], r[3])};
            }
            __builtin_amdgcn_sched_barrier(0);
        }
    }
}

DEV void ln_phase(const Prm& P, int layer) {
    const int tid_ = opaque_tid();
    const int lane = tid_ & 63, w = __builtin_amdgcn_readfirstlane(tid_ >> 6);
    const float* g = P.in[12] + layer * 1024; const float* bb = P.in[13] + layer * 1024;
    u16* xlb = (u16*)(P.ws + OFF_XLB);
    for (int row = blockIdx.x * 4 + w; row < T; row += gridDim.x * 4) {
        float* xr = P.out + (size_t)row * 1024;
        f32x4 v[4];
        float s = 0.f;
#pragma unroll
        for (int i = 0; i < 4; ++i) { v[i] = *(const f32x4*)(xr + i * 256 + lane * 4); s += v[i][0] + v[i][1] + v[i][2] + v[i][3]; }
        const float mean = wave_sum(s) * (1.f / 1024.f);
        float q = 0.f;
#pragma unroll
        for (int i = 0; i < 4; ++i)
#pragma unroll
            for (int j = 0; j < 4; ++j) { const float d = v[i][j] - mean; q += d * d; }
        const float rstd = rsqrtf(wave_sum(q) * (1.f / 1024.f) + LN_EPS);
#pragma unroll
        for (int i = 0; i < 4; ++i) {
            const f32x4 gg = *(const f32x4*)(g + i * 256 + lane * 4), bv = *(const f32x4*)(bb + i * 256 + lane * 4);
            f32x4 y;
#pragma unroll
            for (int j = 0; j < 4; ++j) y[j] = (v[i][j] - mean) * rstd * gg[j] + bv[j];
            *(f32x4*)(xr + i * 256 + lane * 4) = y;
            *(u32x2*)(xlb + kb_off(row, i * 256 + lane * 4, 1024)) = u32x2{pack2(y[0], y[1]), pack2(y[2], y[3])};
        }
    }
    const float* p = P.in[1] + (size_t)layer * T * 256; u16* pb = (u16*)(P.ws + OFF_PB);
    const size_t gtid = (size_t)blockIdx.x * 256 + tid_, gsz = (size_t)gridDim.x * 256;
    for (size_t i = gtid; i < (size_t)T * 256 / 8; i += gsz) {
        const f32x4 a = *(const f32x4*)(p + i * 8), b = *(const f32x4*)(p + i * 8 + 4);
        *(u32x4*)(pb + kb_off((int)(i >> 5), (int)(i & 31) * 8, 256)) = u32x4{pack2(a[0], a[1]), pack2(a[2], a[3]), pack2(b[0], b[1]), pack2(b[2], b[3])};
    }
}

struct KV { bf16x8 ka0, ka1, kb0, kb1; bf16x8 v0, v1, v2, v3; };
template <int KH = 1024>
DEV void load_kv(KV& t, const char* Kb, unsigned koa, unsigned kob, const char* Vb, unsigned voa, unsigned vob) {
    t.ka0 = *(const bf16x8*)(Kb + koa); t.ka1 = *(const bf16x8*)(Kb + koa + KH);
    t.kb0 = *(const bf16x8*)(Kb + kob); t.kb1 = *(const bf16x8*)(Kb + kob + KH);
    t.v0 = __builtin_shufflevector(*(const s16x4*)(Vb + voa), *(const s16x4*)(Vb + vob), 0, 1, 2, 3, 4, 5, 6, 7);
    t.v1 = __builtin_shufflevector(*(const s16x4*)(Vb + voa + 512), *(const s16x4*)(Vb + vob + 512), 0, 1, 2, 3, 4, 5, 6, 7);
    t.v2 = __builtin_shufflevector(*(const s16x4*)(Vb + voa + 1024), *(const s16x4*)(Vb + vob + 1024), 0, 1, 2, 3, 4, 5, 6, 7);
    t.v3 = __builtin_shufflevector(*(const s16x4*)(Vb + voa + 1536), *(const s16x4*)(Vb + vob + 1536), 0, 1, 2, 3, 4, 5, 6, 7);
}
DEV unsigned pkrtz(float a, float b) { return __builtin_bit_cast(unsigned, __builtin_amdgcn_cvt_pkrtz(a, b)); }
DEV bf16x8 pack8(const float (&p)[8]) {
    return __builtin_bit_cast(bf16x8, u32x4{pkrtz(p[0], p[1]), pkrtz(p[2], p[3]), pkrtz(p[4], p[5]), pkrtz(p[6], p[7])});
}
DEV void qk_scores(const KV& t, const bf16x8& q0, const bf16x8& q1, f32x4& sa, f32x4& sb) {
    sa = f32x4{0.f, 0.f, 0.f, 0.f}; sb = f32x4{0.f, 0.f, 0.f, 0.f};
    sa = MFMA16(t.ka0, q0, sa); sa = MFMA16(t.ka1, q1, sa);
    sb = MFMA16(t.kb0, q0, sb); sb = MFMA16(t.kb1, q1, sb);
}
constexpr float QK_C = 0.125f * 1.4426950408889634f;
DEV void flash_core(float& mref, float& l, f32x4 (&o)[4], const bf16x8& q0, const bf16x8& q1, const KV& t, bool fast, int d0, unsigned lim) {
    f32x4 sa, sb; qk_scores(t, q0, q1, sa, sb);
    float y[8];
    if (fast) {
#pragma unroll
        for (int j = 0; j < 4; ++j) { y[j] = sa[j] * QK_C; y[4 + j] = sb[j] * QK_C; }
    } else {
#pragma unroll
        for (int j = 0; j < 4; ++j) {
            y[j]     = ((unsigned)(d0 - j) <= lim)      ? sa[j] * QK_C : NEG_INF;
            y[4 + j] = ((unsigned)(d0 - 16 - j) <= lim) ? sb[j] * QK_C : NEG_INF;
        }
    }
    float mx = fmaxf(fmaxf(fmaxf(y[0], y[1]), fmaxf(y[2], y[3])), fmaxf(fmaxf(y[4], y[5]), fmaxf(y[6], y[7])));
    if (__ballot(mx > mref + 8.f) != 0ull) {
        mx = red16_max(mx);
        const float mn = fmaxf(mref, mx);
        const float alpha = (mn == NEG_INF) ? 1.f : __builtin_amdgcn_exp2f(mref - mn);
        l *= alpha;
#pragma unroll
        for (int d = 0; d < 4; ++d) o[d] *= alpha;
        mref = mn;
    }
    const float mu = (mref == NEG_INF) ? 0.f : mref;
    float p[8]; float ps = 0.f;
#pragma unroll
    for (int j = 0; j < 8; ++j) { p[j] = __builtin_amdgcn_exp2f(y[j] - mu); ps += p[j]; }
    l += ps;
    const bf16x8 pf = pack8(p);
    o[0] = MFMA16(t.v0, pf, o[0]); o[1] = MFMA16(t.v1, pf, o[1]); o[2] = MFMA16(t.v2, pf, o[2]); o[3] = MFMA16(t.v3, pf, o[3]);
}

#define RING4(NSTEPS, LOADSTEP, COMPUTE) do { \
    KV cur_; \
    for (int st_ = 0; st_ < (NSTEPS); ++st_) { LOADSTEP(cur_, st_); COMPUTE(cur_, st_); } \
    } while (0)

DEV void band_loop(const int tid_, float& m, float& l, f32x4 (&o)[4], const bf16x8& q0, const bf16x8& q1, const char* Kb,
                   const char* Vb, int vblk0, int ustart, int nsteps, int uq, int uq0, int qspan, int maxd) {
    const int c = tid_ & 15, g4 = (tid_ & 63) >> 4;
    const unsigned kl = c * 64 + g4 * 16, vl = c * 32 + g4 * 8;
    const unsigned lim = (unsigned)min(maxd, uq);
#define BL_LOAD(R, S) do { const int ua_ = ustart + (S) * 32, ub_ = ua_ + 16; \
        const unsigned ba_ = (unsigned)(vblk0 + (max(ua_, 0) >> 4)) * 2048u, bb_ = (unsigned)(vblk0 + (max(ub_, 0) >> 4)) * 2048u; \
        load_kv(R, Kb, ba_ + kl, bb_ + kl, Vb, ba_ + vl, bb_ + vl); } while (0)
#define BL_COMP(R, S) do { const int ua_ = ustart + (S) * 32; \
        const bool fast_ = (ua_ >= 0) && (ua_ + 31 <= uq0) && (uq0 + qspan - ua_ <= maxd); \
        flash_core(m, l, o, q0, q1, R, fast_, uq - ua_ - g4 * 4, lim); } while (0)
    RING4(nsteps, BL_LOAD, BL_COMP);
#undef BL_LOAD
#undef BL_COMP
}

DEV void attnA_phase(const Prm& P, int chunk) {
    const int tid_ = opaque_tid();
    unsigned char* ws = P.ws;
    const u16* H = (const u16*)(ws + OFF_H);
    u16* G = (u16*)(ws + OFF_G);
    const int lane = tid_ & 63, w = __builtin_amdgcn_readfirstlane(tid_ >> 6), c = lane & 15, g4 = lane >> 4;
    constexpr int LD = 2560;
    const int xcd_ = blockIdx.x & 7, slot_ = blockIdx.x >> 3, nslot_ = gridDim.x >> 3;
    for (int i_ = slot_; i_ < 128; i_ += nslot_) {
        const int rq = i_ & 3, tbi = i_ >> 2, hh = xcd_ & 3, b = xcd_ >> 2;
        const int r = w * 4 + rq, tb = tbi * 256;
        const int sq = tb + r + 16 * c;
        const size_t rowq = (size_t)b * 8192 + sq;
        float m = NEG_INF, l = 0.f;
        f32x4 o[4];
#pragma unroll
        for (int d = 0; d < 4; ++d) o[d] = f32x4{0.f, 0.f, 0.f, 0.f};
#pragma unroll 1
        for (int g = 0; g < 3; ++g) {
            const int dsh = 2 * g, dmask = (1 << dsh) - 1;
            const int rg = r & dmask;
            const int uq = sq >> dsh, uq0 = (tb + r) >> dsh;
            int ustart = (uq0 - 128) & ~15;
            const int ulast = (uq0 + (15 << (4 - dsh))) & ~15;
            int ntile = ((ulast - ustart) >> 4) + 1;
            if (ntile & 1) { ustart -= 16; ntile += 1; }
            const u16* Hq = H + rowq * LD + g * 768 + hh * 64 + g4 * 8;
            const bf16x8 q0 = *(const bf16x8*)Hq, q1 = *(const bf16x8*)(Hq + 32);
            const char* Kb = (const char*)((const u16*)(ws + (g == 0 ? OFF_KI0 : (g == 1 ? OFF_KI1 : OFF_KI2))) + ((size_t)(b * 4 + hh) * 512) * 1024);
            const char* Vb = (const char*)((const u16*)(ws + (g == 0 ? OFF_VT0 : (g == 1 ? OFF_VT1 : OFF_VT2))) + ((size_t)(b * 4 + hh) * 512) * 1024);
            const int vblk0 = rg * ((8192 >> dsh) >> 4);
            band_loop(tid_, m, l, o, q0, q1, Kb, Vb, vblk0, ustart, ntile >> 1, uq, uq0, 15 << (4 - dsh), 128);
        }
        l = red16_sum(l);
        const float inv = 1.f / l;
#pragma unroll
        for (int dt = 0; dt < 4; ++dt) {
            const int dh = dt * 16 + g4 * 4;
            const u32x2 z = *(const u32x2*)(H + rowq * LD + 2304 + hh * 64 + dh);
            const float r0 = o[dt][0] * inv * siluf_(bflo(z[0])), r1 = o[dt][1] * inv * siluf_(bfhi(z[0]));
            const float r2 = o[dt][2] * inv * siluf_(bflo(z[1])), r3 = o[dt][3] * inv * siluf_(bfhi(z[1]));
            *(u32x2*)(G + kb_off((int)rowq, (chunk * 4 + hh) * 64 + dh, 1024)) = u32x2{pack2(r0, r1), pack2(r2, r3)};
        }
    }
}

DEV void attnB_phase(const Prm& P) {
    const int tid_ = opaque_tid();
    unsigned char* ws = P.ws;
    const u16* H = (const u16*)(ws + OFF_H);
    u16* G = (u16*)(ws + OFF_G);
    const float* sinks = P.in[5];
    const int lane = tid_ & 63, w = __builtin_amdgcn_readfirstlane(tid_ >> 6), c = lane & 15, g4 = lane >> 4;
    constexpr int LD = 2304;
    const int xcd_ = blockIdx.x & 7, slot_ = blockIdx.x >> 3, nslot_ = gridDim.x >> 3;
    for (int tile = slot_; tile < 512; tile += nslot_) {
        const int b = xcd_ >> 2, hq = xcd_ & 3;
        const int head = hq * 4 + w, kvh = head >> 3;
        const int t0 = tile * 16, sq = t0 + c;
        const size_t rowq = (size_t)b * 8192 + sq;
        float m = NEG_INF, l = 0.f;
        f32x4 o[4];
#pragma unroll
        for (int d = 0; d < 4; ++d) o[d] = f32x4{0.f, 0.f, 0.f, 0.f};
        const u16* Hq = H + rowq * LD + head * 64 + g4 * 8;
        const bf16x8 q0 = *(const bf16x8*)Hq, q1 = *(const bf16x8*)(Hq + 32);
        const char* Kb = (const char*)((const u16*)(ws + OFF_KI0) + ((size_t)(b * 2 + kvh) * 512) * 1024);
        const char* Vb = (const char*)((const u16*)(ws + OFF_VT0) + ((size_t)(b * 2 + kvh) * 512) * 1024);
        band_loop(tid_, m, l, o, q0, q1, Kb, Vb, 0, t0 - 144, 5, sq, t0, 15, 127);
        l = red16_sum(l);
        const float mu = (m == NEG_INF) ? 0.f : m;
        const float lf = l + __builtin_amdgcn_exp2f(sinks[head] * 1.4426950408889634f - mu);
        const float inv = 1.f / lf;
#pragma unroll
        for (int dt = 0; dt < 4; ++dt) {
            const int dh = dt * 16 + g4 * 4;
            const u32x2 z = *(const u32x2*)(H + rowq * LD + 1280 + head * 64 + dh);
            const float r0 = o[dt][0] * inv * siluf_(bflo(z[0])), r1 = o[dt][1] * inv * siluf_(bfhi(z[0]));
            const float r2 = o[dt][2] * inv * siluf_(bflo(z[1])), r3 = o[dt][3] * inv * siluf_(bfhi(z[1]));
            *(u32x2*)(G + kb_off((int)rowq, head * 64 + dh, 1024)) = u32x2{pack2(r0, r1), pack2(r2, r3)};
        }
    }
}

DEV void compress_phase(const Prm& P) {
    const int tid_ = opaque_tid();
    unsigned char* ws = P.ws;
    const u16* H = (const u16*)(ws + OFF_H);
    constexpr int LD = 3840;
    const float* bias = (const float*)(ws + OFF_BIAS);
    const int lane = tid_ & 63, w = __builtin_amdgcn_readfirstlane(tid_ >> 6), c = lane & 15, g4 = lane >> 4;
    for (int it = blockIdx.x; it < 128; it += gridDim.x) {
        const int unit = it * 4 + w;
        const int which = unit >> 8, b = (unit >> 7) & 1, kvh = (unit >> 5) & 3, ntile = unit & 31;
        const u16* Wt = (const u16*)(ws + (which ? OFF_WCV : OFF_WCK));
        const int colbase = (which ? 1280 : 1024) + kvh * 64;
        const int n = ntile * 16 + c;
        const u16* Wl = Wt + c * 32 + g4 * 8;
        f32x4 acc[4];
#pragma unroll
        for (int e = 0; e < 4; ++e) acc[e] = f32x4{0.f, 0.f, 0.f, 0.f};
#pragma unroll 4
        for (int kk = 0; kk < 64; ++kk) {
            const int j = kk >> 1, d0 = (kk & 1) * 32 + g4 * 8;
            int s = 16 * n + j; s = min(s, 8191);
            const bf16x8 xf = *(const bf16x8*)(H + ((size_t)b * 8192 + s) * LD + colbase + d0);
            bf16x8 wf[4];
#pragma unroll
            for (int e = 0; e < 4; ++e) wf[e] = *(const bf16x8*)(Wl + (size_t)(e * 64 + kk) * 512);
            if (which == 0) {
#pragma unroll
                for (int e = 0; e < 4; ++e) acc[e] = MFMA16(wf[e], xf, acc[e]);
            } else {
#pragma unroll
                for (int e = 0; e < 4; ++e) acc[e] = MFMA16(xf, wf[e], acc[e]);
            }
        }
        if (which == 0) {
            u16* kc = (u16*)(ws + OFF_KCMP) + ((size_t)(b * 4 + kvh) * 32 + ntile) * 1024 + c * 32;
#pragma unroll
            for (int e = 0; e < 4; ++e) {
                const int e0 = e * 16 + g4 * 4;
                const f32x4 bv = *(const f32x4*)(bias + e0);
                const f32x4 r = acc[e] + bv;
                *(u32x2*)(kc + (e0 >> 5) * 512 + (e0 & 31)) = u32x2{pack2(r[0], r[1]), pack2(r[2], r[3])};
            }
        } else {
            u16* vc = (u16*)(ws + OFF_VCMP) + (((size_t)(b * 4 + kvh) * 32 + ntile) * 64) * 16;
#pragma unroll
            for (int e = 0; e < 4; ++e) {
                const int ee = e * 16 + c;
                const float bv = bias[64 + ee];
                *(u32x2*)(vc + ee * 16 + g4 * 4) = u32x2{pack2(acc[e][0] + bv, acc[e][1] + bv), pack2(acc[e][2] + bv, acc[e][3] + bv)};
            }
        }
    }
}

DEV void attnC_phase(const Prm& P, unsigned char* smem) {
    const int tid_ = opaque_tid();
    unsigned char* ws = P.ws;
    const u16* H = (const u16*)(ws + OFF_H);
    u16* G = (u16*)(ws + OFF_G);
    constexpr int LD = 3840;
    float* imp = (float*)smem;
    float* scb = (float*)(smem + 32768);
    float* oslc = (float*)(smem + 34816);
    const int tid = tid_, lane = tid & 63, w = __builtin_amdgcn_readfirstlane(tid >> 6), c = lane & 15, g4 = lane >> 4;
    const int xcd_ = blockIdx.x & 7, slot_ = blockIdx.x >> 3, nslot_ = gridDim.x >> 3;
    for (int i = tid; i < 8192; i += 256) imp[i] = 0.f;
    __syncthreads();
    for (int tile = slot_; tile < 512; tile += nslot_) {
        const int b = xcd_ >> 2, kvh = xcd_ & 3;
        const int t0 = tile * 16;
        const int head = kvh * 4 + w;
        const size_t rowq = (size_t)b * 8192 + t0 + c;
        const u16* Hq = H + rowq * LD + head * 64 + g4 * 8;
        const bf16x8 q0 = *(const bf16x8*)Hq, q1 = *(const bf16x8*)(Hq + 32);
        f32x4 oacc[4];
#pragma unroll
        for (int d = 0; d < 4; ++d) oacc[d] = f32x4{0.f, 0.f, 0.f, 0.f};
        const int nmax = (t0 + c - 31) >> 4;
        const int nmaxw = (t0 - 16) >> 4;
        const float g0 = sigmoidf_(bf2f(H[rowq * LD + 3584 + head]));
        const float g1 = sigmoidf_(bf2f(H[rowq * LD + 3584 + 16 + head]));
        const float g2 = sigmoidf_(bf2f(H[rowq * LD + 3584 + 32 + head]));
        if (nmaxw >= 0) {
            const int nsteps = (nmaxw >> 5) + 1;
            const char* Kb = (const char*)((const u16*)(ws + OFF_KCMP) + ((size_t)(b * 4 + kvh) * 32) * 1024);
            const char* Vb = (const char*)((const u16*)(ws + OFF_VCMP) + ((size_t)(b * 4 + kvh) * 32) * 1024);
            const unsigned kl = c * 64 + g4 * 16, vl = c * 32 + g4 * 8;
            float m = NEG_INF, l = 0.f;
#define CM_LOAD(R, S) do { const int na_ = (S) * 32; const unsigned ba_ = (unsigned)(na_ >> 4) * 2048u, bb_ = (unsigned)min((na_ >> 4) + 1, 31) * 2048u; \
        load_kv(R, Kb, ba_ + kl, bb_ + kl, Vb, ba_ + vl, bb_ + vl); } while (0)
#define CM_PASS1(R, S) do { const int na_ = (S) * 32; f32x4 sa, sb; qk_scores(R, q0, q1, sa, sb); float mx = NEG_INF; float x[8]; \
        _Pragma("unroll") for (int j = 0; j < 8; ++j) { const int n = na_ + (j >> 2) * 16 + g4 * 4 + (j & 3); \
            x[j] = (n <= nmax) ? ((j < 4) ? sa[j & 3] : sb[j & 3]) * 0.125f : NEG_INF; mx = fmaxf(mx, x[j]); } \
        const float mn = fmaxf(m, mx); const float mu = (mn == NEG_INF) ? 0.f : mn; float ps = 0.f; \
        _Pragma("unroll") for (int j = 0; j < 8; ++j) ps += __expf(x[j] - mu); \
        l = l * __expf(m - mu) + ps; m = mn; } while (0)
            RING4(nsteps, CM_LOAD, CM_PASS1);
            float mall = red16_max(m);
            mall = (mall == NEG_INF) ? 0.f : mall;
            l = l * __expf(m - mall);
            l = red16_sum(l);
            const float invl = (l > 0.f) ? 1.f / l : 0.f;
#define CM_PASS2(R, S) do { const int na_ = (S) * 32; f32x4 sa, sb; qk_scores(R, q0, q1, sa, sb); float p[8]; \
        _Pragma("unroll") for (int j = 0; j < 8; ++j) { const int n = na_ + (j >> 2) * 16 + g4 * 4 + (j & 3); \
            const float sv = ((j < 4) ? sa[j & 3] : sb[j & 3]) * 0.125f; \
            p[j] = (n <= nmax) ? __expf(sv - mall) * invl : 0.f; \
            if (n <= nmax) atomicAdd(&imp[n * 16 + c], p[j]); } \
        const bf16x8 pf = pack8(p); \
        oacc[0] = MFMA16(R.v0, pf, oacc[0]); oacc[1] = MFMA16(R.v1, pf, oacc[1]); \
        oacc[2] = MFMA16(R.v2, pf, oacc[2]); oacc[3] = MFMA16(R.v3, pf, oacc[3]); } while (0)
            RING4(nsteps, CM_LOAD, CM_PASS2);
#undef CM_LOAD
#undef CM_PASS1
#undef CM_PASS2
#pragma unroll
            for (int d = 0; d < 4; ++d) oacc[d] *= g0;
        }
        {
            float m = NEG_INF, l = 0.f;
            f32x4 o[4];
#pragma unroll
            for (int d = 0; d < 4; ++d) o[d] = f32x4{0.f, 0.f, 0.f, 0.f};
            const char* Kb = (const char*)((const u16*)(ws + OFF_KI1) + ((size_t)(b * 4 + kvh) * 512) * 1024);
            const char* Vb = (const char*)((const u16*)(ws + OFF_VT1) + ((size_t)(b * 4 + kvh) * 512) * 1024);
            band_loop(tid_, m, l, o, q0, q1, Kb, Vb, 0, t0 - 528, 17, t0 + c, t0, 15, 511);
            l = red16_sum(l);
            const float sc = g2 / l;
#pragma unroll
            for (int d = 0; d < 4; ++d) oacc[d] += o[d] * sc;
        }
        __syncthreads();
        unsigned long long* msk = (unsigned long long*)(smem + 51200) + w * 8;
#pragma unroll 1
        for (int i = 0; i < 4; ++i) {
            const int tok = 4 * w + i, tq = t0 + tok, cur = tq >> 6;
            float my0, my1;
            {
                const int j0 = lane, j1 = lane + 64;
                float a0 = 2.f * (imp[(4 * j0) * 16 + tok] + imp[(4 * j0 + 1) * 16 + tok] + imp[(4 * j0 + 2) * 16 + tok]) + imp[(4 * j0 + 3) * 16 + tok];
                if (j0 > 0) a0 += imp[(4 * j0 - 1) * 16 + tok];
                const float a1 = 2.f * (imp[(4 * j1) * 16 + tok] + imp[(4 * j1 + 1) * 16 + tok] + imp[(4 * j1 + 2) * 16 + tok]) + imp[(4 * j1 + 3) * 16 + tok]
                                 + imp[(4 * j1 - 1) * 16 + tok];
                const bool f0 = (j0 == 0) || (j0 == cur) || (j0 == cur - 1);
                const bool f1 = (j1 == cur) || (j1 == cur - 1);
                my0 = f0 ? 1e4f : ((j0 <= cur) ? a0 : -1.f);
                my1 = f1 ? 1e4f : ((j1 <= cur) ? a1 : -1.f);
            }
            const unsigned k0 = (lane <= cur) ? (__float_as_uint(my0) + 1u) : 0u;
            const unsigned k1 = (lane + 64 <= cur) ? (__float_as_uint(my1) + 1u) : 0u;
            unsigned T = 0u;
#pragma unroll
            for (int bit = 31; bit >= 0; --bit) {
                const unsigned tr = T | (1u << bit);
                const int cnt = __builtin_popcountll(__ballot(k0 >= tr)) + __builtin_popcountll(__ballot(k1 >= tr));
                if (cnt >= 16) T = tr;
            }
            const unsigned long long eq0 = __ballot(k0 == T), eq1 = __ballot(k1 == T);
            const int need = 16 - __builtin_popcountll(__ballot(k0 > T)) - __builtin_popcountll(__ballot(k1 > T));
            const unsigned long long lm = (1ull << lane) - 1ull;
            const bool s0 = (k0 > 0u) && (k0 > T || (k0 == T && __builtin_popcountll(eq0 & lm) < need));
            const bool s1 = (k1 > 0u) && (k1 > T || (k1 == T && __builtin_popcountll(eq0) + __builtin_popcountll(eq1 & lm) < need));
            const unsigned long long lo = __ballot(s0);
            const unsigned long long hi = __ballot(s1);
            if (lane == 0) { msk[i * 2] = lo; msk[i * 2 + 1] = hi; }
        }
#pragma unroll 4
        for (int i = 0; i < 32; ++i) { const int e = i * 64 + lane; imp[(e >> 2) * 16 + 4 * w + (e & 3)] = 0.f; }
        __builtin_amdgcn_fence(__ATOMIC_RELEASE, "wavefront"); __builtin_amdgcn_wave_barrier(); __builtin_amdgcn_fence(__ATOMIC_ACQUIRE, "wavefront");
        {
            const int tokL = 4 * w + (c >> 2), tq = t0 + tokL, hd = kvh * 4 + (c & 3);
            const size_t rq = (size_t)b * 8192 + tq;
            const u16* Hs = H + rq * LD + hd * 64 + g4 * 8;
            const bf16x8 s0 = *(const bf16x8*)Hs, s1 = *(const bf16x8*)(Hs + 32);
            const char* Kb = (const char*)((const u16*)(ws + OFF_KI0) + ((size_t)(b * 4 + kvh) * 512) * 1024);
            const char* Vb = (const char*)((const u16*)(ws + OFF_VT0) + ((size_t)(b * 4 + kvh) * 512) * 1024);
            const unsigned kl = c * 64 + g4 * 16, vl = c * 32 + g4 * 8;
            float m = NEG_INF, l = 0.f;
            f32x4 o[4];
#pragma unroll
            for (int d = 0; d < 4; ++d) o[d] = f32x4{0.f, 0.f, 0.f, 0.f};
            const int ti = c >> 2;
            const unsigned long long mylo = msk[ti * 2], myhi = msk[ti * 2 + 1];
            const unsigned long long ulo = msk[0] | msk[2] | msk[4] | msk[6];
            const unsigned long long uhi = msk[1] | msk[3] | msk[5] | msk[7];
            const unsigned long long alo = msk[0] & msk[2] & msk[4] & msk[6], ahi = msk[1] & msk[3] & msk[5] & msk[7];
            int* blist = (int*)(scb + w * 128);
            const int nlo = __builtin_popcountll(ulo), nblk = nlo + __builtin_popcountll(uhi);
            if ((ulo >> lane) & 1ull) blist[__builtin_popcountll(ulo & ((1ull << lane) - 1ull))] = lane;
            if ((uhi >> lane) & 1ull) blist[nlo + __builtin_popcountll(uhi & ((1ull << lane) - 1ull))] = 64 + lane;
            __builtin_amdgcn_fence(__ATOMIC_RELEASE, "wavefront");
            __builtin_amdgcn_wave_barrier();
            __builtin_amdgcn_fence(__ATOMIC_ACQUIRE, "wavefront");
            const int nst = 2 * nblk;
#define SL_LOAD(R, S) do { const int j_ = __builtin_amdgcn_readfirstlane(blist[(S) >> 1]); const int ua_ = j_ * 64 + ((S) & 1) * 32; \
        load_kv(R, Kb, (unsigned)(ua_ >> 4) * 2048u + kl, (unsigned)((ua_ >> 4) + 1) * 2048u + kl, \
                Vb, (unsigned)(ua_ >> 4) * 2048u + vl, (unsigned)((ua_ >> 4) + 1) * 2048u + vl); } while (0)
#define SL_COMP(R, S) do { const int j_ = __builtin_amdgcn_readfirstlane(blist[(S) >> 1]); const int ua_ = j_ * 64 + ((S) & 1) * 32; \
        const bool selj = (j_ < 64) ? ((mylo >> j_) & 1ull) : ((myhi >> (j_ - 64)) & 1ull); \
        const bool alls_ = (j_ < 64) ? ((alo >> j_) & 1ull) : ((ahi >> (j_ - 64)) & 1ull); \
        const bool fast_ = alls_ && (ua_ + 31 <= t0 + 4 * w); \
        flash_core(m, l, o, s0, s1, R, fast_, selj ? (tq - ua_ - g4 * 4) : -(1 << 30), 0x7fffffffu); } while (0)
            RING4(nst, SL_LOAD, SL_COMP);
#undef SL_LOAD
#undef SL_COMP
            l = red16_sum(l);
            const float inv = 1.f / l;
#pragma unroll
            for (int dt = 0; dt < 4; ++dt)
                *(f32x4*)(oslc + (tokL * 4 + (c & 3)) * 64 + dt * 16 + g4 * 4) = o[dt] * inv;
        }
        __syncthreads();
#pragma unroll
        for (int dt = 0; dt < 4; ++dt) {
            const int dh = dt * 16 + g4 * 4;
            const f32x4 os = *(const f32x4*)(oslc + (c * 4 + w) * 64 + dh);
            const f32x4 r = oacc[dt] + os * g1;
            const u32x2 z = *(const u32x2*)(H + rowq * LD + 2560 + head * 64 + dh);
            const float r0 = r[0] * siluf_(bflo(z[0])), r1 = r[1] * siluf_(bfhi(z[0]));
            const float r2 = r[2] * siluf_(bflo(z[1])), r3 = r[3] * siluf_(bfhi(z[1]));
            *(u32x2*)(G + kb_off((int)rowq, head * 64 + dh, 1024)) = u32x2{pack2(r0, r1), pack2(r2, r3)};
        }
    }
}

#ifndef PROBE_DUP
#define PROBE_DUP 0
#endif
#define REP(k) for (int rep_ = 0; rep_ < 1 + ((PROBE_DUP >> (k)) & 1); ++rep_)
constexpr int LDS_BYTES = 3 * GSTAGE + 64;
__global__ void __launch_bounds__(256, 2) mk_fwd(Prm P) {
    extern __shared__ __attribute__((aligned(16))) unsigned char smem[];
    unsigned* xb_words = (unsigned*)(smem + 3 * GSTAGE);
    if (threadIdx.x < 4) xb_words[threadIdx.x] = 0u;
    __syncthreads();
    XcdBarrier bar = xcd_barrier_post((unsigned*)(P.ws + OFF_BAR), (volatile LAS unsigned*)xb_words);
    unsigned char* ws = P.ws;

    phase0(P, smem);
    cg::this_grid().sync();

#pragma unroll 1
    for (int layer = 0; layer < 4; ++layer) {
        const int kind = layer % 3, lj = layer / 3;
        const u16* Win; const u16* Wout; int N, nsub;
        if (kind == 0)      { Win = (const u16*)(ws + OFF_WA_IN + (size_t)lj * SZ_WA_IN); Wout = (const u16*)(ws + OFF_WA_OUT + (size_t)lj * SZ_SQ); N = 2560; nsub = 4; }
        else if (kind == 1) { Win = (const u16*)(ws + OFF_WB_IN); Wout = (const u16*)(ws + OFF_WB_OUT); N = 2304; nsub = 1; }
        else                { Win = (const u16*)(ws + OFF_WC_IN); Wout = (const u16*)(ws + OFF_WC_OUT); N = 3840; nsub = 1; }
#pragma unroll 1
        for (int sub = 0; sub < nsub; ++sub) {
            REP(0) gemm_in_phase(smem, P, kind, Win + (size_t)sub * 2560 * 1024, N);
            xcd_barrier(bar);
            if (kind == 0) REP(1) attnA_phase(P, sub);
            else if (kind == 1) REP(2) attnB_phase(P);
            else { REP(3) compress_phase(P); xcd_barrier(bar); REP(4) attnC_phase(P, smem); }
            xcd_barrier(bar);
        }
        gemm_out_phase(smem, P, Wout, layer == 0 ? P.in[0] : P.out);
        xcd_barrier(bar);
        ln_phase(P, layer);
        xcd_barrier(bar);
        gemm_gate_phase(smem, P, (const u16*)(ws + OFF_WG + (size_t)layer * SZ_SQ), (const u16*)(ws + OFF_WP + (size_t)layer * SZ_WP));
        if (layer < 3) xcd_barrier(bar);
    }
}

extern "C" void kernel_launch(void* const* d_in, const int* in_sizes, int n_in, void* d_out, int out_size, void* d_ws, size_t ws_size,
                              hipStream_t stream) {
    static int grid_blocks = 0;
    if (!grid_blocks) {
        int dev = 0, cus = 0, per_cu = 0;
        (void)hipGetDevice(&dev);
        (void)hipDeviceGetAttribute(&cus, hipDeviceAttributeMultiprocessorCount, dev);
        (void)hipFuncSetAttribute((const void*)mk_fwd, hipFuncAttributeMaxDynamicSharedMemorySize, LDS_BYTES);
        (void)hipOccupancyMaxActiveBlocksPerMultiprocessor(&per_cu, (const void*)mk_fwd, 256, LDS_BYTES);
        if (per_cu > 2) per_cu = 2;
        if (per_cu < 1) per_cu = 1;
        grid_blocks = cus * per_cu;
        if (ws_size < WS_END || n_in != 16) { fprintf(stderr, "kernel_launch: workspace too small (%zu < %zu) or n_in %d != 16\n", ws_size, (size_t)WS_END, n_in); grid_blocks = -1; }
    }
    if (grid_blocks < 0) return;
    (void)hipMemsetAsync((char*)d_ws + OFF_BAR, 0, 16384, stream);
    Prm p{};
    for (int i = 0; i < 16; ++i) p.in[i] = (const float*)d_in[i];
    p.out = (float*)d_out; p.ws = (unsigned char*)d_ws;
    void* args[] = {&p};
    hipError_t e = hipLaunchCooperativeKernel((const void*)mk_fwd, dim3(grid_blocks), dim3(256), args, LDS_BYTES, stream);
    if (e != hipSuccess) fprintf(stderr, "cooperative launch failed: %s (grid %d)\n", hipGetErrorString(e), grid_blocks);
}
```

```cpp
#include <hip/hip_runtime.h>
#include <hip/hip_cooperative_groups.h>
#include <cstdio>
#include <cstdint>
namespace cg = cooperative_groups;

typedef unsigned short u16;
using bf16x8 = __attribute__((ext_vector_type(8))) short;
using s16x4  = __attribute__((ext_vector_type(4))) short;
using f32x4  = __attribute__((ext_vector_type(4))) float;
using u32x4  = __attribute__((ext_vector_type(4))) unsigned;
using u32x2  = __attribute__((ext_vector_type(2))) unsigned;
#define DEV __device__ __forceinline__
using h16x8 = __attribute__((ext_vector_type(8))) _Float16;
#define MFMA16(a, b, c) __builtin_amdgcn_mfma_f32_16x16x32_f16(__builtin_bit_cast(h16x8, (a)), __builtin_bit_cast(h16x8, (b)), (c), 0, 0, 0)
#define LAS __attribute__((address_space(3)))

constexpr int T = 16384, S = 8192;
constexpr float LN_EPS = 1e-5f;
constexpr float DN_ALPHA = 1.6817928305074290f;
constexpr float NEG_INF = -__builtin_huge_valf();

constexpr size_t OFF_BAR   = 0;
constexpr size_t OFF_COS   = 16384;
constexpr size_t OFF_SIN   = OFF_COS + (size_t)8192 * 32 * 4;
constexpr size_t OFF_BIAS  = OFF_SIN + (size_t)8192 * 32 * 4;
constexpr size_t OFF_WA_IN = OFF_BIAS + 1024;
constexpr size_t SZ_WA_IN  = (size_t)10240 * 1024 * 2;
constexpr size_t SZ_SQ     = (size_t)1024 * 1024 * 2;
constexpr size_t OFF_WA_OUT = OFF_WA_IN + 2 * SZ_WA_IN;
constexpr size_t OFF_WB_IN  = OFF_WA_OUT + 2 * SZ_SQ;
constexpr size_t OFF_WB_OUT = OFF_WB_IN + (size_t)2304 * 1024 * 2;
constexpr size_t OFF_WC_IN  = OFF_WB_OUT + SZ_SQ;
constexpr size_t OFF_WC_OUT = OFF_WC_IN + (size_t)3840 * 1024 * 2;
constexpr size_t OFF_WG     = OFF_WC_OUT + SZ_SQ;
constexpr size_t OFF_WP     = OFF_WG + 4 * SZ_SQ;
constexpr size_t SZ_WP      = (size_t)1024 * 256 * 2;
constexpr size_t OFF_WCK    = OFF_WP + 4 * SZ_WP;
constexpr size_t OFF_WCV    = OFF_WCK + (size_t)64 * 2048 * 2;
constexpr size_t OFF_XB     = OFF_WCV + (size_t)64 * 2048 * 2;
constexpr size_t SZ_ACT     = (size_t)T * 1024 * 2;
constexpr size_t OFF_G      = OFF_XB + SZ_ACT;
constexpr size_t OFF_H      = OFF_G + SZ_ACT;
constexpr size_t SZ_HMAX    = (size_t)T * 3840 * 2;
constexpr size_t OFF_VT0    = OFF_H + SZ_HMAX;
constexpr size_t SZ_VT      = (size_t)2 * 4 * 8192 * 64 * 2;
constexpr size_t OFF_VT1    = OFF_VT0 + SZ_VT;
constexpr size_t OFF_VT2    = OFF_VT1 + SZ_VT;
constexpr size_t OFF_KCMP   = OFF_VT2 + SZ_VT;
constexpr size_t SZ_CMP     = (size_t)2 * 512 * 4 * 64 * 2;
constexpr size_t OFF_VCMP   = OFF_KCMP + SZ_CMP;
constexpr size_t OFF_KI0    = OFF_VCMP + SZ_CMP;
constexpr size_t OFF_KI1    = OFF_KI0 + SZ_VT;
constexpr size_t OFF_KI2    = OFF_KI1 + SZ_VT;
constexpr size_t WS_END     = OFF_KI2 + SZ_VT;
constexpr size_t OFF_XLB    = OFF_H;
constexpr size_t OFF_PB     = OFF_H + SZ_ACT;
constexpr size_t OFF_PP     = OFF_H + SZ_ACT + (size_t)16 * 1024 * 1024;

struct Prm { const float* in[16]; float* out; unsigned char* ws; };

__device__ __forceinline__ size_t kb_off(int row, int k, int K) { return ((size_t)(row >> 4) * (K >> 5) + (k >> 5)) * 512 + (row & 15) * 32 + (k & 31); }
DEV u16 f2bf(float f) { return __builtin_bit_cast(u16, (_Float16)f); }
DEV float bf2f(u16 h) { return (float)__builtin_bit_cast(_Float16, h); }
DEV unsigned pack2(float a, float b) { return (unsigned)f2bf(a) | ((unsigned)f2bf(b) << 16); }
DEV float bflo(unsigned u) { return bf2f((u16)(u & 0xffffu)); }
DEV float bfhi(unsigned u) { return bf2f((u16)(u >> 16)); }
DEV float sigmoidf_(float x) { return 1.f / (1.f + __expf(-x)); }
DEV float siluf_(float x) { return x / (1.f + __expf(-x)); }
DEV float red16_max(float v) { v = fmaxf(v, __shfl_xor(v, 16)); v = fmaxf(v, __shfl_xor(v, 32)); return v; }
DEV float red16_sum(float v) { v += __shfl_xor(v, 16); v += __shfl_xor(v, 32); return v; }
DEV float wave_sum(float v) { for (int o = 32; o > 0; o >>= 1) v += __shfl_xor(v, o); return v; }

DEV int opaque_tid() { int t = threadIdx.x; asm volatile("" : "+v"(t)); return t; }
#define XB_TMO      128
#define XB_XCNT(j)  (256  + 64 * (j))
#define XB_XSUB(j)  (1280 + 64 * (j))
#define XB_XGEN(j)  (2304 + 64 * (j))
#define XB_TOP      3328
#define XB_TOPGEN   3392
#define XCD_BAR_WORDS 3456
#define XB_SPIN_CAP (1u << 24)
DEV unsigned xb_ld(unsigned* p)              { return __hip_atomic_load(p, __ATOMIC_RELAXED, __HIP_MEMORY_SCOPE_AGENT); }
DEV unsigned xb_add(unsigned* p, unsigned v) { return __hip_atomic_fetch_add(p, v, __ATOMIC_RELAXED, __HIP_MEMORY_SCOPE_AGENT); }
DEV unsigned xb_xcc_id() { return (unsigned)__builtin_amdgcn_s_getreg((3 << 11) | 20) & 0xFu; }
#define XB_SPIN(cond, bar) do { unsigned _sp = 0; while (cond) { __builtin_amdgcn_s_sleep(1); \
    if ((++_sp & 255u) == 0u) { if (xb_ld(&(bar)[XB_TMO])) break; if (_sp > XB_SPIN_CAP) { atomicAdd(&(bar)[XB_TMO], 1u); break; } } } } while (0)
struct XcdBarrier { unsigned* bar; unsigned x; volatile LAS unsigned* st; };
DEV XcdBarrier xcd_barrier_post(unsigned* bar, volatile LAS unsigned* st) {
    XcdBarrier b; b.bar = bar; b.x = xb_xcc_id(); b.st = st;
    if (threadIdx.x == 0) (void)xb_add(&bar[XB_XCNT(b.x)], 1u);
    return b;
}
DEV void xcd_barrier_complete(unsigned* bar, unsigned x, unsigned& nloc, unsigned& nx) {
    const unsigned G = gridDim.x * gridDim.y * gridDim.z;
    unsigned sum, cnt, mine, sp = 0u;
    for (;;) {
        sum = 0u; cnt = 0u; mine = 0u;
#pragma unroll
        for (unsigned j = 0; j < 16; ++j) { const unsigned c = xb_ld(&bar[XB_XCNT(j)]); sum += c; cnt += (c > 0u) ? 1u : 0u; mine = (j == x) ? c : mine; }
        if (sum == G) break;
        __builtin_amdgcn_s_sleep(1);
        if ((++sp & 255u) == 0u) { if (xb_ld(&bar[XB_TMO])) break; if (sp > XB_SPIN_CAP) { atomicAdd(&bar[XB_TMO], 1u); break; } }
    }
    nloc = mine > 0u ? mine : 1u; nx = cnt > 0u ? cnt : 1u;
}
DEV void xcd_barrier(const XcdBarrier& b) {
    asm volatile("s_waitcnt vmcnt(0)" ::: "memory");
    __syncthreads();
    if (threadIdx.x == 0) {
        unsigned* bar = b.bar;
        __builtin_amdgcn_s_waitcnt(0);
        unsigned nloc = b.st[0], nx = b.st[1];
        if (nloc == 0u) { xcd_barrier_complete(bar, b.x, nloc, nx); b.st[0] = nloc; b.st[1] = nx; }
        const unsigned old = xb_add(&bar[XB_XSUB(b.x)], 1u);
        const unsigned gen = old / nloc;
        if (old + 1u == (gen + 1u) * nloc) {
            __builtin_amdgcn_fence(__ATOMIC_RELEASE, "agent");
            asm volatile("s_waitcnt vmcnt(0)" ::: "memory");
            const unsigned og = xb_add(&bar[XB_TOP], 1u);
            const unsigned tg = og / nx;
            if (og + 1u == (tg + 1u) * nx) xb_add(&bar[XB_TOPGEN], 1u);
            else XB_SPIN(xb_ld(&bar[XB_TOPGEN]) == tg, bar);
            __builtin_amdgcn_fence(__ATOMIC_ACQUIRE, "agent");
            xb_add(&bar[XB_XGEN(b.x)], 1u);
            asm volatile("s_waitcnt vmcnt(0)" ::: "memory");
        } else {
            XB_SPIN(xb_ld(&bar[XB_XGEN(b.x)]) == gen, bar);
            __builtin_amdgcn_fence(__ATOMIC_ACQUIRE, "agent");
            asm volatile("s_waitcnt vmcnt(0)" ::: "memory");
        }
    }
    __syncthreads();
}

DEV int colmap(int kind, int n) {
    if (kind == 0) return n;
    if (kind == 1) {
        const int c = n / 2560, nn = n - c * 2560;
        if (nn < 2304) { const int g = nn / 768, rem = nn - g * 768, part = rem >> 8, hh = (rem & 255) >> 6, d = rem & 63;
                         return g * 3072 + part * 1024 + (c * 4 + hh) * 64 + d; }
        const int z = nn - 2304; return 9216 + (c * 4 + (z >> 6)) * 64 + (z & 63);
    }
    if (n < 2560) return n;
    if (n < 3584) return n - 2560 + 2608;
    if (n < 3632) return n - 3584 + 2560;
    return -1;
}
DEV void tconv(const int tid_, float* lds, const float* __restrict__ src, int K, int Nsrc, u16* __restrict__ dst, int Ndst, int kind, int& acc_tiles) {
    const int G = gridDim.x, tid = tid_;
    const int ntn = Ndst >> 6, ntk = K >> 6, nt = ntn * ntk;
    int first = ((int)blockIdx.x - (acc_tiles % G) + G) % G;
    acc_tiles += nt;
    for (int t = first; t < nt; t += G) {
        const int tn = t / ntk, tk = t - tn * ntk;
        const int n0 = tn << 6, k0 = tk << 6;
        const int nl = tid & 63;
        const int c = colmap(kind, n0 + nl);
#pragma unroll
        for (int i = 0; i < 16; ++i) {
            const int kl = (tid >> 6) + 4 * i;
            const float v = (c >= 0) ? src[(size_t)(k0 + kl) * Nsrc + c] : 0.f;
            lds[kl * 65 + nl] = v;
        }
        __syncthreads();
        const int r = tid >> 2, kk = (tid & 3) << 4;
        unsigned o[8];
#pragma unroll
        for (int i = 0; i < 8; ++i) o[i] = pack2(lds[(kk + 2 * i) * 65 + r], lds[(kk + 2 * i + 1) * 65 + r]);
        u32x4* dp = (u32x4*)(dst + kb_off(n0 + r, k0 + kk, K));
        dp[0] = u32x4{o[0], o[1], o[2], o[3]};
        dp[1] = u32x4{o[4], o[5], o[6], o[7]};
        __syncthreads();
    }
}

DEV void phase0(const Prm& P, unsigned char* smem) {
    const int tid_ = opaque_tid();
    float* lds = (float*)smem;
    unsigned char* ws = P.ws;
    int acc = 0;
    tconv(tid_, lds, P.in[2], 1024, 10240, (u16*)(ws + OFF_WA_IN), 10240, 1, acc);
    tconv(tid_, lds, P.in[2] + (size_t)1024 * 10240, 1024, 10240, (u16*)(ws + OFF_WA_IN + SZ_WA_IN), 10240, 1, acc);
    tconv(tid_, lds, P.in[3], 1024, 1024, (u16*)(ws + OFF_WA_OUT), 1024, 0, acc);
    tconv(tid_, lds, P.in[3] + (size_t)1024 * 1024, 1024, 1024, (u16*)(ws + OFF_WA_OUT + SZ_SQ), 1024, 0, acc);
    tconv(tid_, lds, P.in[4], 1024, 2304, (u16*)(ws + OFF_WB_IN), 2304, 0, acc);
    tconv(tid_, lds, P.in[6], 1024, 1024, (u16*)(ws + OFF_WB_OUT), 1024, 0, acc);
    tconv(tid_, lds, P.in[7], 1024, 3632, (u16*)(ws + OFF_WC_IN), 3840, 2, acc);
    tconv(tid_, lds, P.in[11], 1024, 1024, (u16*)(ws + OFF_WC_OUT), 1024, 0, acc);
    for (int i = 0; i < 4; ++i) {
        tconv(tid_, lds, P.in[15] + (size_t)i * 1024 * 1024, 1024, 1024, (u16*)(ws + OFF_WG + i * SZ_SQ), 1024, 0, acc);
        tconv(tid_, lds, P.in[14] + (size_t)i * 256 * 1024, 256, 1024, (u16*)(ws + OFF_WP + i * SZ_WP), 1024, 0, acc);
    }
    tconv(tid_, lds, P.in[8], 2048, 64, (u16*)(ws + OFF_WCK), 64, 0, acc);
    tconv(tid_, lds, P.in[9], 2048, 64, (u16*)(ws + OFF_WCV), 64, 0, acc);

    const size_t gtid = (size_t)blockIdx.x * 256 + tid_, gsz = (size_t)gridDim.x * 256;
    {
        const float* x = P.in[0]; u16* xb = (u16*)(ws + OFF_XB);
        for (size_t i = gtid; i < (size_t)T * 1024 / 8; i += gsz) {
            const f32x4 a = *(const f32x4*)(x + i * 8), b = *(const f32x4*)(x + i * 8 + 4);
            *(u32x4*)(xb + kb_off((int)(i >> 7), (int)(i & 127) * 8, 1024)) = u32x4{pack2(a[0], a[1]), pack2(a[2], a[3]), pack2(b[0], b[1]), pack2(b[2], b[3])};
        }
    }
    {
        float* ct = (float*)(ws + OFF_COS); float* st = (float*)(ws + OFF_SIN);
        for (size_t i = gtid; i < (size_t)8192 * 32; i += gsz) {
            const int pos = (int)(i >> 5), k = (int)(i & 31);
            const float inv = (float)(1.0 / pow(10000.0, (double)(2 * k) / 64.0));
            const float ang = (float)pos * inv;
            ct[i] = (float)cos((double)ang); st[i] = (float)sin((double)ang);
        }
    }
    {
        const int lane = tid_ & 63;
        const int wid = blockIdx.x * 4 + __builtin_amdgcn_readfirstlane(tid_ >> 6);
        if (wid < 128) {
            const float* w = (wid < 64) ? P.in[8] : P.in[9];
            const int e = wid & 63;
            float s = 0.f;
            for (int jd = lane; jd < 2048; jd += 64) s += P.in[10][jd] * w[(size_t)jd * 64 + e];
            s = wave_sum(s);
            if (lane == 0) ((float*)(ws + OFF_BIAS))[wid] = s;
        }
    }
}

constexpr int GSTAGE = 24576;
DEV int gsw(int r) { return (0x78 >> (2 * ((r >> 2) & 3))) & 3; }
DEV void gemm_issue(unsigned char* stage, const u16* ag0, const u16* ag1, const u16* bg, int bstep, int kt, int w) {
    __builtin_amdgcn_global_load_lds((const unsigned*)(ag0 + kt * 512), (unsigned*)(stage + w * 1024), 16, 0, 0);
    __builtin_amdgcn_global_load_lds((const unsigned*)(ag1 + kt * 512), (unsigned*)(stage + w * 1024 + 4096), 16, 0, 0);
#pragma unroll
    for (int i = 0; i < 4; ++i)
        __builtin_amdgcn_global_load_lds((const unsigned*)(bg + (size_t)i * bstep + kt * 512), (unsigned*)(stage + 8192 + w * 1024 + i * 4096), 16, 0, 0);
}
template <bool NONSWAP>
DEV void gemm_mainloop(const int tid_, unsigned char* smem, const u16* __restrict__ A, int lda, const u16* __restrict__ Bt, int ldb, int K,
                       int m0, int n0, f32x4 (&acc)[32], bool aperm = false) {
    const int tid = tid_, lane = tid & 63, w = __builtin_amdgcn_readfirstlane(tid >> 6), wm = w >> 1, wn = w & 1;
    const int lrow = tid >> 2, lsw = ((tid & 3) ^ gsw(lrow)) * 8;
    const int arow0 = aperm ? ((lrow & 31) * 4 + (lrow >> 5)) : lrow;
    const int arow1 = aperm ? (arow0 + 2) : (lrow + 64);
    const u16* ag0 = A + kb_off(m0 + arow0, 0, lda) + lsw;
    const u16* ag1 = A + kb_off(m0 + arow1, 0, lda) + lsw;
    const u16* bg = Bt + kb_off(n0 + lrow, 0, ldb) + lsw;
    const int bstep = 4 * (ldb >> 5) * 512;
    const int fr = lane & 15, fq = lane >> 4;
    const int coff = (fq ^ gsw(fr)) << 4;
    const int a_base = (wm * 64 + fr) * 64 + coff, b_base = 8192 + (wn * 128 + fr) * 64 + coff;
    const int nk = K >> 5;
    asm volatile("s_waitcnt vmcnt(0)" ::: "memory");
    __builtin_amdgcn_s_barrier();
    gemm_issue(smem, ag0, ag1, bg, bstep, 0, w);
    gemm_issue(smem + GSTAGE, ag0, ag1, bg, bstep, 1, w);
    int sc = 0, si = 2;
    for (int kt = 0; kt < nk; ++kt) {
        if (kt + 1 < nk) asm volatile("s_waitcnt vmcnt(6)" ::: "memory"); else asm volatile("s_waitcnt vmcnt(0)" ::: "memory");
        __builtin_amdgcn_s_barrier();
        if (kt + 2 < nk) { gemm_issue(smem + si * GSTAGE, ag0, ag1, bg, bstep, kt + 2, w); si = (si == 2) ? 0 : si + 1; }
        const unsigned char* st = smem + sc * GSTAGE; sc = (sc == 2) ? 0 : sc + 1;
        bf16x8 a[4], b[4];
#pragma unroll
        for (int i = 0; i < 4; ++i) a[i] = *(const bf16x8*)(st + a_base + i * 1024);
#pragma unroll
        for (int hb = 0; hb < 2; ++hb) {
#pragma unroll
            for (int i = 0; i < 4; ++i) b[i] = *(const bf16x8*)(st + b_base + (hb * 4 + i) * 1024);
            if (NONSWAP) {
#pragma unroll
                for (int mt = 0; mt < 4; ++mt)
#pragma unroll
                    for (int nt = 0; nt < 4; ++nt) acc[mt * 8 + hb * 4 + nt] = MFMA16(a[mt], b[nt], acc[mt * 8 + hb * 4 + nt]);
            } else {
#pragma unroll
                for (int nt = 0; nt < 4; ++nt)
#pragma unroll
                    for (int mt = 0; mt < 4; ++mt) acc[(hb * 4 + nt) * 4 + mt] = MFMA16(b[nt], a[mt], acc[(hb * 4 + nt) * 4 + mt]);
            }
        }
    }
}

DEV int vblock() { const int G = gridDim.x, b = blockIdx.x; return ((G & 7) == 0) ? (b & 7) * (G >> 3) + (b >> 3) : b; }
DEV void tile_mn(int t, int nN, int& mi, int& ni) { const int per = 8 * nN; const int mg = t / per, r = t - mg * per; mi = mg * 8 + (r & 7); ni = r >> 3; }
#define ZERO_ACC(acc) _Pragma("unroll") for (int i_ = 0; i_ < 32; ++i_) acc[i_] = f32x4{0.f, 0.f, 0.f, 0.f}

DEV void classify(int kind, int cgi, int& mode, int& vsel, int& vth, int& dsh, int& nhv, int& ksel) {
    mode = 0; vsel = 0; vth = 0; dsh = 0; nhv = 4; ksel = -1;
    if (kind == 0) {
        if (cgi < 36) { const int g = cgi / 12, part = (cgi - g * 12) >> 2; vth = cgi & 3; if (part < 2) { mode = 1; if (part == 1) { ksel = g; dsh = 2 * g; } } else { mode = 2; vsel = g; dsh = 2 * g; } }
    } else if (kind == 1) {
        if (cgi < 16) mode = 1; else if (cgi < 18) { mode = 1; ksel = 0; vth = cgi - 16; nhv = 2; } else if (cgi < 20) { mode = 2; vsel = 0; vth = cgi - 18; nhv = 2; }
    } else {
        if (cgi < 20) mode = 1; else if (cgi < 24) mode = 0; else if (cgi < 28) { mode = 1; ksel = 0; vth = cgi - 24; } else if (cgi < 32) { mode = 2; vsel = 0; vth = cgi - 28; }
        else if (cgi < 36) { mode = 1; ksel = 1; vth = cgi - 32; } else if (cgi < 40) { mode = 2; vsel = 1; vth = cgi - 36; }
    }
}

DEV void gemm_in_phase(unsigned char* smem, const Prm& P, int kind, const u16* Wt, int N) {
    const int tid_ = opaque_tid();
    unsigned char* ws = P.ws;
    const u16* A = (const u16*)(ws + OFF_XB);
    u16* H = (u16*)(ws + OFF_H);
    const float* cosT = (const float*)(ws + OFF_COS); const float* sinT = (const float*)(ws + OFF_SIN);
    const int nN = N >> 8, ntiles = 128 * nN;
    const int lane = tid_ & 63, w = __builtin_amdgcn_readfirstlane(tid_ >> 6), wm = w >> 1, wn = w & 1, fr = lane & 15, fq = lane >> 4;
    for (int t = vblock(); t < ntiles; t += gridDim.x) {
        int mi, ni; tile_mn(t, nN, mi, ni);
        const int m0 = mi << 7, n0 = ni << 8;
        const int ncol = n0 + wn * 128, cg0 = ncol >> 6;
        int mode, vsel, vth, dsh, nhv, ksel; classify(kind, cg0, mode, vsel, vth, dsh, nhv, ksel);
        const int mw = m0 + wm * 64;
        f32x4 acc[32]; ZERO_ACC(acc);
        if (mode == 2) {
            gemm_mainloop<true>(tid_, smem, A, 1024, Wt, 1024, 1024, m0, n0, acc, dsh == 2);
            __builtin_amdgcn_s_barrier();
            u16* vt = (u16*)(ws + (vsel == 0 ? OFF_VT0 : (vsel == 1 ? OFF_VT1 : OFF_VT2)));
            if (dsh == 0) {
#pragma unroll
                for (int mt = 0; mt < 4; ++mt) {
                    const int m = mw + mt * 16 + fq * 4;
                    const int b = m >> 13, p = m & 8191;
#pragma unroll
                    for (int grp = 0; grp < 2; ++grp) {
                        u16* dst = vt + ((((size_t)(b * nhv + vth + grp)) * 512 + (p >> 4)) * 64) * 16 + (p & 15);
#pragma unroll
                        for (int nt = 0; nt < 4; ++nt) { const f32x4 v = acc[mt * 8 + grp * 4 + nt]; *(u32x2*)(dst + (nt * 16 + fr) * 16) = u32x2{pack2(v[0], v[1]), pack2(v[2], v[3])}; }
                    }
                }
            } else if (dsh == 4) {
#pragma unroll
                for (int j = 0; j < 4; ++j) {
                    const int m = mw + fq * 4 + j;
                    const int b = m >> 13, s = m & 8191;
                    const int p = ((s & 15) << 9) + (s >> 4);
#pragma unroll
                    for (int grp = 0; grp < 2; ++grp) {
                        u16* dst = vt + ((((size_t)(b * nhv + vth + grp)) * 512 + (p >> 4)) * 64) * 16 + (p & 15);
#pragma unroll
                        for (int nt = 0; nt < 4; ++nt)
                            *(u32x2*)(dst + (nt * 16 + fr) * 16) = u32x2{pack2(acc[0 * 8 + grp * 4 + nt][j], acc[1 * 8 + grp * 4 + nt][j]), pack2(acc[2 * 8 + grp * 4 + nt][j], acc[3 * 8 + grp * 4 + nt][j])};
                    }
                }
            } else {
#pragma unroll
                for (int mt = 0; mt < 4; ++mt) {
                    const int r0 = wm * 64 + mt * 16 + fq * 4;
                    const int m = m0 + (r0 & 31) * 4 + (r0 >> 5);
                    const int b = m >> 13, s = m & 8191;
                    const int p = ((s & 3) << 11) + (s >> 2);
#pragma unroll
                    for (int grp = 0; grp < 2; ++grp) {
                        u16* dst = vt + ((((size_t)(b * nhv + vth + grp)) * 512 + (p >> 4)) * 64) * 16 + (p & 15);
#pragma unroll
                        for (int nt = 0; nt < 4; ++nt) { const f32x4 v = acc[mt * 8 + grp * 4 + nt]; *(u32x2*)(dst + (nt * 16 + fr) * 16) = u32x2{pack2(v[0], v[1]), pack2(v[2], v[3])}; }
                    }
                }
            }
        } else {
            gemm_mainloop<false>(tid_, smem, A, 1024, Wt, 1024, 1024, m0, n0, acc);
            __builtin_amdgcn_s_barrier();
            constexpr int EROW = 272;
            unsigned char* est = smem + w * (64 * EROW);
            int l4_ = lane; asm volatile("" : "+v"(l4_));
            const int fr = l4_ & 15, fq = l4_ >> 4;
#pragma unroll
            for (int mt = 0; mt < 4; ++mt) {
                const int s = (mw + mt * 16 + fr) & 8191;
                unsigned char* erow = est + (mt * 16 + fr) * EROW + fq * 8;
                if (mode == 1) {
#pragma unroll
                    for (int nt = 0; nt < 2; ++nt) {
                        const f32x4 c4 = *(const f32x4*)(cosT + s * 32 + nt * 16 + fq * 4);
                        const f32x4 s4 = *(const f32x4*)(sinT + s * 32 + nt * 16 + fq * 4);
#pragma unroll
                        for (int grp = 0; grp < 2; ++grp) {
                            const f32x4 x1 = acc[(grp * 4 + nt) * 4 + mt], x2 = acc[(grp * 4 + nt + 2) * 4 + mt];
                            const f32x4 o1 = x1 * c4 - x2 * s4, o2 = x2 * c4 + x1 * s4;
                            *(u32x2*)(erow + (grp * 64 + nt * 16) * 2) = u32x2{pack2(o1[0], o1[1]), pack2(o1[2], o1[3])};
                            *(u32x2*)(erow + (grp * 64 + (nt + 2) * 16) * 2) = u32x2{pack2(o2[0], o2[1]), pack2(o2[2], o2[3])};
                        }
                    }
                } else {
#pragma unroll
                    for (int nt = 0; nt < 8; ++nt) { const f32x4 v = acc[nt * 4 + mt]; *(u32x2*)(erow + nt * 32) = u32x2{pack2(v[0], v[1]), pack2(v[2], v[3])}; }
                }
            }
            __builtin_amdgcn_fence(__ATOMIC_RELEASE, "wavefront"); __builtin_amdgcn_wave_barrier(); __builtin_amdgcn_fence(__ATOMIC_ACQUIRE, "wavefront");
            {
                const int rr = l4_ >> 4, ch = l4_ & 15;
                if (ksel >= 0) {
                    u16* ki = (u16*)(ws + (ksel == 0 ? OFF_KI0 : (ksel == 1 ? OFF_KI1 : OFF_KI2)));
                    const int dmask = (1 << dsh) - 1, lsh = 13 - dsh, numask = (64 >> dsh) - 1;
                    const int kk = l4_ >> 2, c4 = l4_ & 3;
#pragma unroll 4
                    for (int i = 0; i < 16; ++i) {
                        const int rgp = i >> 2, hd = (i >> 1) & 1, half = i & 1;
                        const int tt = rgp * 16 + kk;
                        const int row = ((tt & numask) << dsh) + (tt >> (6 - dsh));
                        const int m = mw + row, b = m >> 13, s = m & 8191;
                        const int p = ((s & dmask) << lsh) + (s >> dsh);
                        const u32x4 v = *(const u32x4*)(est + row * EROW + (hd * 64 + half * 32 + c4 * 8) * 2);
                        *(u32x4*)(ki + ((((size_t)(b * nhv + vth + hd) * 512 + (p >> 4)) * 2 + half) * 16 + (p & 15)) * 32 + c4 * 8) = v;
                    }
                } else {
                u16* hbase = H + (size_t)mw * N + ncol + ch * 8;
#pragma unroll
                for (int i = 0; i < 16; ++i) {
                    const int row = i * 4 + rr;
                    const u32x4 v = *(const u32x4*)(est + row * EROW + ch * 16);
                    *(u32x4*)(hbase + (size_t)row * N) = v;
                }
                }
            }
        }
    }
}

DEV void gemm_out_phase(unsigned char* smem, const Prm& P, const u16* Wt, const float* xin) {
    const int tid_ = opaque_tid();
    const u16* A = (const u16*)(P.ws + OFF_G);
    const int lane = tid_ & 63, w = __builtin_amdgcn_readfirstlane(tid_ >> 6), wm = w >> 1, wn = w & 1, fr = lane & 15, fq = lane >> 4;
    for (int t = vblock(); t < 512; t += gridDim.x) {
        int mi, ni; tile_mn(t, 4, mi, ni);
        const int m0 = mi << 7, n0 = ni << 8;
        f32x4 acc[32]; ZERO_ACC(acc);
        gemm_mainloop<false>(tid_, smem, A, 1024, Wt, 1024, 1024, m0, n0, acc);
        {
            __builtin_amdgcn_s_barrier();
            constexpr int EROWF = 528;
            unsigned char* est = smem + w * (32 * EROWF);
            const size_t ub = (size_t)(m0 + wm * 64) * 1024 + n0 + wn * 128;
            const float* xw = xin + ub; float* ow = P.out + ub;
            int l2_ = lane; asm volatile("" : "+v"(l2_));
            const int fr2 = l2_ & 15, fq2 = l2_ >> 4, rr = l2_ >> 5, ch = l2_ & 31;
#pragma unroll
            for (int h = 0; h < 2; ++h) {
#pragma unroll
                for (int mh = 0; mh < 2; ++mh) {
                    unsigned char* erow = est + (mh * 16 + fr2) * EROWF + fq2 * 16;
#pragma unroll
                    for (int nt = 0; nt < 8; ++nt) *(f32x4*)(erow + nt * 64) = acc[nt * 4 + h * 2 + mh];
                }
                __builtin_amdgcn_fence(__ATOMIC_RELEASE, "wavefront"); __builtin_amdgcn_wave_barrier(); __builtin_amdgcn_fence(__ATOMIC_ACQUIRE, "wavefront");
#pragma unroll 4
                for (int i = 0; i < 16; ++i) {
                    const int row = i * 2 + rr;
                    const unsigned ix = (unsigned)((h * 32 + row) * 1024 + ch * 4);
                    const f32x4 v = *(const f32x4*)(est + row * EROWF + ch * 16);
                    const f32x4 xv = *(const f32x4*)(xw + ix);
                    *(f32x4*)(ow + ix) = xv * DN_ALPHA + v;
                }
                __builtin_amdgcn_fence(__ATOMIC_RELEASE, "wavefront"); __builtin_amdgcn_wave_barrier(); __builtin_amdgcn_fence(__ATOMIC_ACQUIRE, "wavefront");
            }
        }
    }
}

DEV void gemm_gate_phase(unsigned char* smem, const Prm& P, const u16* Wg, const u16* Wp) {
    const int tid_ = opaque_tid();
    const u16* A1 = (const u16*)(P.ws + OFF_XLB);
    const u16* A2 = (const u16*)(P.ws + OFF_PB);
    u16* xb = (u16*)(P.ws + OFF_XB);
    u16* ppb = (u16*)(P.ws + OFF_PP);
    const int lane = tid_ & 63, w = __builtin_amdgcn_readfirstlane(tid_ >> 6), wm = w >> 1, wn = w & 1, fr = lane & 15, fq = lane >> 4;
    for (int t = vblock(); t < 512; t += gridDim.x) {
        int mi, ni; tile_mn(t, 4, mi, ni);
        const int m0 = mi << 7, n0 = ni << 8;
        f32x4 acc[32]; ZERO_ACC(acc);
        gemm_mainloop<false>(tid_, smem, A2, 256, Wp, 256, 256, m0, n0, acc);
        const size_t ub = (size_t)(m0 + wm * 64) * 1024 + n0 + wn * 128;
        float* ow = P.out + ub; u16* pw = ppb + ub; u16* xw = xb + ub;
        {
            int l2_ = lane; asm volatile("" : "+v"(l2_));
            const unsigned lo = (unsigned)((l2_ & 15) * 1024 + (l2_ >> 4) * 4);
#pragma unroll
            for (int mt = 0; mt < 4; ++mt) {
#pragma unroll
                for (int nt = 0; nt < 8; ++nt) { const f32x4 v = acc[nt * 4 + mt]; *(u32x2*)(pw + (lo + mt * 16384 + nt * 16)) = u32x2{pack2(v[0], v[1]), pack2(v[2], v[3])}; }
                __builtin_amdgcn_sched_barrier(0);
            }
        }
        ZERO_ACC(acc);
        gemm_mainloop<false>(tid_, smem, A1, 1024, Wg, 1024, 1024, m0, n0, acc);
        int l3_ = lane; asm volatile("" : "+v"(l3_));
        const unsigned lo = (unsigned)((l3_ & 15) * 1024 + (l3_ >> 4) * 4);
#pragma unroll
        for (int mt = 0; mt < 4; ++mt) {
#pragma unroll
            for (int nt = 0; nt < 8; ++nt) {
                const unsigned ix = lo + mt * 16384 + nt * 16;
                const f32x4 xv = *(const f32x4*)(ow + ix);
                const u32x2 pq = *(const u32x2*)(pw + ix);
                const f32x4 ga = acc[nt * 4 + mt];
                f32x4 r;
                r[0] = xv[0] + sigmoidf_(ga[0]) * bflo(pq[0]); r[1] = xv[1] + sigmoidf_(ga[1]) * bfhi(pq[0]);
                r[2] = xv[2] + sigmoidf_(ga[2]) * bflo(pq[1]); r[3] = xv[3] + sigmoidf_(ga[3]) * bfhi(pq[1]);
                *(f32x4*)(ow + ix) = r;
                *(u32x2*)(xb + kb_off(m0 + wm * 64 + mt * 16 + (l3_ & 15), n0 + wn * 128 + nt * 16 + (l3_ >> 4) * 4, 1024)) = u32x2{pack2(r[0], r[1]), pack2(r[2], r[3])};
            }
            __builtin_amdgcn_sched_barrier(0);
        }
    }
}

DEV void ln_phase(const Prm& P, int layer) {
    const int tid_ = opaque_tid();
    const int lane = tid_ & 63, w = __builtin_amdgcn_readfirstlane(tid_ >> 6);
    const float* g = P.in[12] + layer * 1024; const float* bb = P.in[13] + layer * 1024;
    u16* xlb = (u16*)(P.ws + OFF_XLB);
    for (int row = blockIdx.x * 4 + w; row < T; row += gridDim.x * 4) {
        float* xr = P.out + (size_t)row * 1024;
        f32x4 v[4];
        float s = 0.f;
#pragma unroll
        for (int i = 0; i < 4; ++i) { v[i] = *(const f32x4*)(xr + i * 256 + lane * 4); s += v[i][0] + v[i][1] + v[i][2] + v[i][3]; }
        const float mean = wave_sum(s) * (1.f / 1024.f);
        float q = 0.f;
#pragma unroll
        for (int i = 0; i < 4; ++i)
#pragma unroll
            for (int j = 0; j < 4; ++j) { const float d = v[i][j] - mean; q += d * d; }
        const float rstd = rsqrtf(wave_sum(q) * (1.f / 1024.f) + LN_EPS);
#pragma unroll
        for (int i = 0; i < 4; ++i) {
            const f32x4 gg = *(const f32x4*)(g + i * 256 + lane * 4), bv = *(const f32x4*)(bb + i * 256 + lane * 4);
            f32x4 y;
#pragma unroll
            for (int j = 0; j < 4; ++j) y[j] = (v[i][j] - mean) * rstd * gg[j] + bv[j];
            *(f32x4*)(xr + i * 256 + lane * 4) = y;
            *(u32x2*)(xlb + kb_off(row, i * 256 + lane * 4, 1024)) = u32x2{pack2(y[0], y[1]), pack2(y[2], y[3])};
        }
    }
    const float* p = P.in[1] + (size_t)layer * T * 256; u16* pb = (u16*)(P.ws + OFF_PB);
    const size_t gtid = (size_t)blockIdx.x * 256 + tid_, gsz = (size_t)gridDim.x * 256;
    for (size_t i = gtid; i < (size_t)T * 256 / 8; i += gsz) {
        const f32x4 a = *(const f32x4*)(p + i * 8), b = *(const f32x4*)(p + i * 8 + 4);
        *(u32x4*)(pb + kb_off((int)(i >> 5), (int)(i & 31) * 8, 256)) = u32x4{pack2(a[0], a[1]), pack2(a[2], a[3]), pack2(b[0], b[1]), pack2(b[2], b[3])};
    }
}

struct KV { bf16x8 ka0, ka1, kb0, kb1; bf16x8 v0, v1, v2, v3; };
template <int KH = 1024>
DEV void load_kv(KV& t, const char* Kb, unsigned koa, unsigned kob, const char* Vb, unsigned voa, unsigned vob) {
    t.ka0 = *(const bf16x8*)(Kb + koa); t.ka1 = *(const bf16x8*)(Kb + koa + KH);
    t.kb0 = *(const bf16x8*)(Kb + kob); t.kb1 = *(const bf16x8*)(Kb + kob + KH);
    t.v0 = __builtin_shufflevector(*(const s16x4*)(Vb + voa), *(const s16x4*)(Vb + vob), 0, 1, 2, 3, 4, 5, 6, 7);
    t.v1 = __builtin_shufflevector(*(const s16x4*)(Vb + voa + 512), *(const s16x4*)(Vb + vob + 512), 0, 1, 2, 3, 4, 5, 6, 7);
    t.v2 = __builtin_shufflevector(*(const s16x4*)(Vb + voa + 1024), *(const s16x4*)(Vb + vob + 1024), 0, 1, 2, 3, 4, 5, 6, 7);
    t.v3 = __builtin_shufflevector(*(const s16x4*)(Vb + voa + 1536), *(const s16x4*)(Vb + vob + 1536), 0, 1, 2, 3, 4, 5, 6, 7);
}
DEV unsigned pkrtz(float a, float b) { return __builtin_bit_cast(unsigned, __builtin_amdgcn_cvt_pkrtz(a, b)); }
DEV bf16x8 pack8(const float (&p)[8]) {
    return __builtin_bit_cast(bf16x8, u32x4{pkrtz(p[0], p[1]), pkrtz(p[2], p[3]), pkrtz(p[4], p[5]), pkrtz(p[6], p[7])});
}
DEV void qk_scores(const KV& t, const bf16x8& q0, const bf16x8& q1, f32x4& sa, f32x4& sb) {
    sa = f32x4{0.f, 0.f, 0.f, 0.f}; sb = f32x4{0.f, 0.f, 0.f, 0.f};
    sa = MFMA16(t.ka0, q0, sa); sa = MFMA16(t.ka1, q1, sa);
    sb = MFMA16(t.kb0, q0, sb); sb = MFMA16(t.kb1, q1, sb);
}
constexpr float QK_C = 0.125f * 1.4426950408889634f;
DEV void flash_core(float& mref, float& l, f32x4 (&o)[4], const bf16x8& q0, const bf16x8& q1, const KV& t, bool fast, int d0, unsigned lim) {
    f32x4 sa, sb; qk_scores(t, q0, q1, sa, sb);
    float y[8];
    if (fast) {
#pragma unroll
        for (int j = 0; j < 4; ++j) { y[j] = sa[j] * QK_C; y[4 + j] = sb[j] * QK_C; }
    } else {
#pragma unroll
        for (int j = 0; j < 4; ++j) {
            y[j]     = ((unsigned)(d0 - j) <= lim)      ? sa[j] * QK_C : NEG_INF;
            y[4 + j] = ((unsigned)(d0 - 16 - j) <= lim) ? sb[j] * QK_C : NEG_INF;
        }
    }
    float mx = fmaxf(fmaxf(fmaxf(y[0], y[1]), fmaxf(y[2], y[3])), fmaxf(fmaxf(y[4], y[5]), fmaxf(y[6], y[7])));
    if (__ballot(mx > mref + 8.f) != 0ull) {
        mx = red16_max(mx);
        const float mn = fmaxf(mref, mx);
        const float alpha = (mn == NEG_INF) ? 1.f : __builtin_amdgcn_exp2f(mref - mn);
        l *= alpha;
#pragma unroll
        for (int d = 0; d < 4; ++d) o[d] *= alpha;
        mref = mn;
    }
    const float mu = (mref == NEG_INF) ? 0.f : mref;
    float p[8]; float ps = 0.f;
#pragma unroll
    for (int j = 0; j < 8; ++j) { p[j] = __builtin_amdgcn_exp2f(y[j] - mu); ps += p[j]; }
    l += ps;
    const bf16x8 pf = pack8(p);
    o[0] = MFMA16(t.v0, pf, o[0]); o[1] = MFMA16(t.v1, pf, o[1]); o[2] = MFMA16(t.v2, pf, o[2]); o[3] = MFMA16(t.v3, pf, o[3]);
}

#define RING4(NSTEPS, LOADSTEP, COMPUTE) do { \
    KV cur_; \
    for (int st_ = 0; st_ < (NSTEPS); ++st_) { LOADSTEP(cur_, st_); COMPUTE(cur_, st_); } \
    } while (0)

DEV void band_loop(const int tid_, float& m, float& l, f32x4 (&o)[4], const bf16x8& q0, const bf16x8& q1, const char* Kb,
                   const char* Vb, int vblk0, int ustart, int nsteps, int uq, int uq0, int qspan, int maxd) {
    const int c = tid_ & 15, g4 = (tid_ & 63) >> 4;
    const unsigned kl = c * 64 + g4 * 16, vl = c * 32 + g4 * 8;
    const unsigned lim = (unsigned)min(maxd, uq);
#define BL_LOAD(R, S) do { const int ua_ = ustart + (S) * 32, ub_ = ua_ + 16; \
        const unsigned ba_ = (unsigned)(vblk0 + (max(ua_, 0) >> 4)) * 2048u, bb_ = (unsigned)(vblk0 + (max(ub_, 0) >> 4)) * 2048u; \
        load_kv(R, Kb, ba_ + kl, bb_ + kl, Vb, ba_ + vl, bb_ + vl); } while (0)
#define BL_COMP(R, S) do { const int ua_ = ustart + (S) * 32; \
        const bool fast_ = (ua_ >= 0) && (ua_ + 31 <= uq0) && (uq0 + qspan - ua_ <= maxd); \
        flash_core(m, l, o, q0, q1, R, fast_, uq - ua_ - g4 * 4, lim); } while (0)
    RING4(nsteps, BL_LOAD, BL_COMP);
#undef BL_LOAD
#undef BL_COMP
}

DEV void attnA_phase(const Prm& P, int chunk) {
    const int tid_ = opaque_tid();
    unsigned char* ws = P.ws;
    const u16* H = (const u16*)(ws + OFF_H);
    u16* G = (u16*)(ws + OFF_G);
    const int lane = tid_ & 63, w = __builtin_amdgcn_readfirstlane(tid_ >> 6), c = lane & 15, g4 = lane >> 4;
    constexpr int LD = 2560;
    const int xcd_ = blockIdx.x & 7, slot_ = blockIdx.x >> 3, nslot_ = gridDim.x >> 3;
    for (int i_ = slot_; i_ < 128; i_ += nslot_) {
        const int rq = i_ & 3, tbi = i_ >> 2, hh = xcd_ & 3, b = xcd_ >> 2;
        const int r = w * 4 + rq, tb = tbi * 256;
        const int sq = tb + r + 16 * c;
        const size_t rowq = (size_t)b * 8192 + sq;
        float m = NEG_INF, l = 0.f;
        f32x4 o[4];
#pragma unroll
        for (int d = 0; d < 4; ++d) o[d] = f32x4{0.f, 0.f, 0.f, 0.f};
#pragma unroll 1
        for (int g = 0; g < 3; ++g) {
            const int dsh = 2 * g, dmask = (1 << dsh) - 1;
            const int rg = r & dmask;
            const int uq = sq >> dsh, uq0 = (tb + r) >> dsh;
            int ustart = (uq0 - 128) & ~15;
            const int ulast = (uq0 + (15 << (4 - dsh))) & ~15;
            int ntile = ((ulast - ustart) >> 4) + 1;
            if (ntile & 1) { ustart -= 16; ntile += 1; }
            const u16* Hq = H + rowq * LD + g * 768 + hh * 64 + g4 * 8;
            const bf16x8 q0 = *(const bf16x8*)Hq, q1 = *(const bf16x8*)(Hq + 32);
            const char* Kb = (const char*)((const u16*)(ws + (g == 0 ? OFF_KI0 : (g == 1 ? OFF_KI1 : OFF_KI2))) + ((size_t)(b * 4 + hh) * 512) * 1024);
            const char* Vb = (const char*)((const u16*)(ws + (g == 0 ? OFF_VT0 : (g == 1 ? OFF_VT1 : OFF_VT2))) + ((size_t)(b * 4 + hh) * 512) * 1024);
            const int vblk0 = rg * ((8192 >> dsh) >> 4);
            band_loop(tid_, m, l, o, q0, q1, Kb, Vb, vblk0, ustart, ntile >> 1, uq, uq0, 15 << (4 - dsh), 128);
        }
        l = red16_sum(l);
        const float inv = 1.f / l;
#pragma unroll
        for (int dt = 0; dt < 4; ++dt) {
            const int dh = dt * 16 + g4 * 4;
            const u32x2 z = *(const u32x2*)(H + rowq * LD + 2304 + hh * 64 + dh);
            const float r0 = o[dt][0] * inv * siluf_(bflo(z[0])), r1 = o[dt][1] * inv * siluf_(bfhi(z[0]));
            const float r2 = o[dt][2] * inv * siluf_(bflo(z[1])), r3 = o[dt][3] * inv * siluf_(bfhi(z[1]));
            *(u32x2*)(G + kb_off((int)rowq, (chunk * 4 + hh) * 64 + dh, 1024)) = u32x2{pack2(r0, r1), pack2(r2, r3)};
        }
    }
}

DEV void attnB_phase(const Prm& P) {
    const int tid_ = opaque_tid();
    unsigned char* ws = P.ws;
    const u16* H = (const u16*)(ws + OFF_H);
    u16* G = (u16*)(ws + OFF_G);
    const float* sinks = P.in[5];
    const int lane = tid_ & 63, w = __builtin_amdgcn_readfirstlane(tid_ >> 6), c = lane & 15, g4 = lane >> 4;
    constexpr int LD = 2304;
    const int xcd_ = blockIdx.x & 7, slot_ = blockIdx.x >> 3, nslot_ = gridDim.x >> 3;
    for (int tile = slot_; tile < 512; tile += nslot_) {
        const int b = xcd_ >> 2, hq = xcd_ & 3;
        const int head = hq * 4 + w, kvh = head >> 3;
        const int t0 = tile * 16, sq = t0 + c;
        const size_t rowq = (size_t)b * 8192 + sq;
        float m = NEG_INF, l = 0.f;
        f32x4 o[4];
#pragma unroll
        for (int d = 0; d < 4; ++d) o[d] = f32x4{0.f, 0.f, 0.f, 0.f};
        const u16* Hq = H + rowq * LD + head * 64 + g4 * 8;
        const bf16x8 q0 = *(const bf16x8*)Hq, q1 = *(const bf16x8*)(Hq + 32);
        const char* Kb = (const char*)((const u16*)(ws + OFF_KI0) + ((size_t)(b * 2 + kvh) * 512) * 1024);
        const char* Vb = (const char*)((const u16*)(ws + OFF_VT0) + ((size_t)(b * 2 + kvh) * 512) * 1024);
        band_loop(tid_, m, l, o, q0, q1, Kb, Vb, 0, t0 - 144, 5, sq, t0, 15, 127);
        l = red16_sum(l);
        const float mu = (m == NEG_INF) ? 0.f : m;
        const float lf = l + __builtin_amdgcn_exp2f(sinks[head] * 1.4426950408889634f - mu);
        const float inv = 1.f / lf;
#pragma unroll
        for (int dt = 0; dt < 4; ++dt) {
            const int dh = dt * 16 + g4 * 4;
            const u32x2 z = *(const u32x2*)(H + rowq * LD + 1280 + head * 64 + dh);
            const float r0 = o[dt][0] * inv * siluf_(bflo(z[0])), r1 = o[dt][1] * inv * siluf_(bfhi(z[0]));
            const float r2 = o[dt][2] * inv * siluf_(bflo(z[1])), r3 = o[dt][3] * inv * siluf_(bfhi(z[1]));
            *(u32x2*)(G + kb_off((int)rowq, head * 64 + dh, 1024)) = u32x2{pack2(r0, r1), pack2(r2, r3)};
        }
    }
}

DEV void compress_phase(const Prm& P) {
    const int tid_ = opaque_tid();
    unsigned char* ws = P.ws;
    const u16* H = (const u16*)(ws + OFF_H);
    constexpr int LD = 3840;
    const float* bias = (const float*)(ws + OFF_BIAS);
    const int lane = tid_ & 63, w = __builtin_amdgcn_readfirstlane(tid_ >> 6), c = lane & 15, g4 = lane >> 4;
    for (int it = blockIdx.x; it < 128; it += gridDim.x) {
        const int unit = it * 4 + w;
        const int which = unit >> 8, b = (unit >> 7) & 1, kvh = (unit >> 5) & 3, ntile = unit & 31;
        const u16* Wt = (const u16*)(ws + (which ? OFF_WCV : OFF_WCK));
        const int colbase = (which ? 1280 : 1024) + kvh * 64;
        const int n = ntile * 16 + c;
        const u16* Wl = Wt + c * 32 + g4 * 8;
        f32x4 acc[4];
#pragma unroll
        for (int e = 0; e < 4; ++e) acc[e] = f32x4{0.f, 0.f, 0.f, 0.f};
#pragma unroll 4
        for (int kk = 0; kk < 64; ++kk) {
            const int j = kk >> 1, d0 = (kk & 1) * 32 + g4 * 8;
            int s = 16 * n + j; s = min(s, 8191);
            const bf16x8 xf = *(const bf16x8*)(H + ((size_t)b * 8192 + s) * LD + colbase + d0);
            bf16x8 wf[4];
#pragma unroll
            for (int e = 0; e < 4; ++e) wf[e] = *(const bf16x8*)(Wl + (size_t)(e * 64 + kk) * 512);
            if (which == 0) {
#pragma unroll
                for (int e = 0; e < 4; ++e) acc[e] = MFMA16(wf[e], xf, acc[e]);
            } else {
#pragma unroll
                for (int e = 0; e < 4; ++e) acc[e] = MFMA16(xf, wf[e], acc[e]);
            }
        }
        if (which == 0) {
            u16* kc = (u16*)(ws + OFF_KCMP) + ((size_t)(b * 4 + kvh) * 32 + ntile) * 1024 + c * 32;
#pragma unroll
            for (int e = 0; e < 4; ++e) {
                const int e0 = e * 16 + g4 * 4;
                const f32x4 bv = *(const f32x4*)(bias + e0);
                const f32x4 r = acc[e] + bv;
                *(u32x2*)(kc + (e0 >> 5) * 512 + (e0 & 31)) = u32x2{pack2(r[0], r[1]), pack2(r[2], r[3])};
            }
        } else {
            u16* vc = (u16*)(ws + OFF_VCMP) + (((size_t)(b * 4 + kvh) * 32 + ntile) * 64) * 16;
#pragma unroll
            for (int e = 0; e < 4; ++e) {
                const int ee = e * 16 + c;
                const float bv = bias[64 + ee];
                *(u32x2*)(vc + ee * 16 + g4 * 4) = u32x2{pack2(acc[e][0] + bv, acc[e][1] + bv), pack2(acc[e][2] + bv, acc[e][3] + bv)};
            }
        }
    }
}

DEV void attnC_phase(const Prm& P, unsigned char* smem) {
    const int tid_ = opaque_tid();
    unsigned char* ws = P.ws;
    const u16* H = (const u16*)(ws + OFF_H);
    u16* G = (u16*)(ws + OFF_G);
    constexpr int LD = 3840;
    float* imp = (float*)smem;
    float* scb = (float*)(smem + 32768);
    float* oslc = (float*)(smem + 34816);
    const int tid = tid_, lane = tid & 63, w = __builtin_amdgcn_readfirstlane(tid >> 6), c = lane & 15, g4 = lane >> 4;
    const int xcd_ = blockIdx.x & 7, slot_ = blockIdx.x >> 3, nslot_ = gridDim.x >> 3;
    for (int i = tid; i < 8192; i += 256) imp[i] = 0.f;
    __syncthreads();
    for (int tile = slot_; tile < 512; tile += nslot_) {
        const int b = xcd_ >> 2, kvh = xcd_ & 3;
        const int t0 = tile * 16;
        const int head = kvh * 4 + w;
        const size_t rowq = (size_t)b * 8192 + t0 + c;
        const u16* Hq = H + rowq * LD + head * 64 + g4 * 8;
        const bf16x8 q0 = *(const bf16x8*)Hq, q1 = *(const bf16x8*)(Hq + 32);
        f32x4 oacc[4];
#pragma unroll
        for (int d = 0; d < 4; ++d) oacc[d] = f32x4{0.f, 0.f, 0.f, 0.f};
        const int nmax = (t0 + c - 31) >> 4;
        const int nmaxw = (t0 - 16) >> 4;
        const float g0 = sigmoidf_(bf2f(H[rowq * LD + 3584 + head]));
        const float g1 = sigmoidf_(bf2f(H[rowq * LD + 3584 + 16 + head]));
        const float g2 = sigmoidf_(bf2f(H[rowq * LD + 3584 + 32 + head]));
        if (nmaxw >= 0) {
            const int nsteps = (nmaxw >> 5) + 1;
            const char* Kb = (const char*)((const u16*)(ws + OFF_KCMP) + ((size_t)(b * 4 + kvh) * 32) * 1024);
            const char* Vb = (const char*)((const u16*)(ws + OFF_VCMP) + ((size_t)(b * 4 + kvh) * 32) * 1024);
            const unsigned kl = c * 64 + g4 * 16, vl = c * 32 + g4 * 8;
            float m = NEG_INF, l = 0.f;
#define CM_LOAD(R, S) do { const int na_ = (S) * 32; const unsigned ba_ = (unsigned)(na_ >> 4) * 2048u, bb_ = (unsigned)min((na_ >> 4) + 1, 31) * 2048u; \
        load_kv(R, Kb, ba_ + kl, bb_ + kl, Vb, ba_ + vl, bb_ + vl); } while (0)
#define CM_PASS1(R, S) do { const int na_ = (S) * 32; f32x4 sa, sb; qk_scores(R, q0, q1, sa, sb); float mx = NEG_INF; float x[8]; \
        _Pragma("unroll") for (int j = 0; j < 8; ++j) { const int n = na_ + (j >> 2) * 16 + g4 * 4 + (j & 3); \
            x[j] = (n <= nmax) ? ((j < 4) ? sa[j & 3] : sb[j & 3]) * 0.125f : NEG_INF; mx = fmaxf(mx, x[j]); } \
        const float mn = fmaxf(m, mx); const float mu = (mn == NEG_INF) ? 0.f : mn; float ps = 0.f; \
        _Pragma("unroll") for (int j = 0; j < 8; ++j) ps += __expf(x[j] - mu); \
        l = l * __expf(m - mu) + ps; m = mn; } while (0)
            RING4(nsteps, CM_LOAD, CM_PASS1);
            float mall = red16_max(m);
            mall = (mall == NEG_INF) ? 0.f : mall;
            l = l * __expf(m - mall);
            l = red16_sum(l);
            const float invl = (l > 0.f) ? 1.f / l : 0.f;
#define CM_PASS2(R, S) do { const int na_ = (S) * 32; f32x4 sa, sb; qk_scores(R, q0, q1, sa, sb); float p[8]; \
        _Pragma("unroll") for (int j = 0; j < 8; ++j) { const int n = na_ + (j >> 2) * 16 + g4 * 4 + (j & 3); \
            const float sv = ((j < 4) ? sa[j & 3] : sb[j & 3]) * 0.125f; \
            p[j] = (n <= nmax) ? __expf(sv - mall) * invl : 0.f; \
            if (n <= nmax) atomicAdd(&imp[n * 16 + c], p[j]); } \
        const bf16x8 pf = pack8(p); \
        oacc[0] = MFMA16(R.v0, pf, oacc[0]); oacc[1] = MFMA16(R.v1, pf, oacc[1]); \
        oacc[2] = MFMA16(R.v2, pf, oacc[2]); oacc[3] = MFMA16(R.v3, pf, oacc[3]); } while (0)
            RING4(nsteps, CM_LOAD, CM_PASS2);
#undef CM_LOAD
#undef CM_PASS1
#undef CM_PASS2
#pragma unroll
            for (int d = 0; d < 4; ++d) oacc[d] *= g0;
        }
        {
            float m = NEG_INF, l = 0.f;
            f32x4 o[4];
#pragma unroll
            for (int d = 0; d < 4; ++d) o[d] = f32x4{0.f, 0.f, 0.f, 0.f};
            const char* Kb = (const char*)((const u16*)(ws + OFF_KI1) + ((size_t)(b * 4 + kvh) * 512) * 1024);
            const char* Vb = (const char*)((const u16*)(ws + OFF_VT1) + ((size_t)(b * 4 + kvh) * 512) * 1024);
            band_loop(tid_, m, l, o, q0, q1, Kb, Vb, 0, t0 - 528, 17, t0 + c, t0, 15, 511);
            l = red16_sum(l);
            const float sc = g2 / l;
#pragma unroll
            for (int d = 0; d < 4; ++d) oacc[d] += o[d] * sc;
        }
        __syncthreads();
        unsigned long long* msk = (unsigned long long*)(smem + 51200) + w * 8;
#pragma unroll 1
        for (int i = 0; i < 4; ++i) {
            const int tok = 4 * w + i, tq = t0 + tok, cur = tq >> 6;
            float my0, my1;
            {
                const int j0 = lane, j1 = lane + 64;
                float a0 = 2.f * (imp[(4 * j0) * 16 + tok] + imp[(4 * j0 + 1) * 16 + tok] + imp[(4 * j0 + 2) * 16 + tok]) + imp[(4 * j0 + 3) * 16 + tok];
                if (j0 > 0) a0 += imp[(4 * j0 - 1) * 16 + tok];
                const float a1 = 2.f * (imp[(4 * j1) * 16 + tok] + imp[(4 * j1 + 1) * 16 + tok] + imp[(4 * j1 + 2) * 16 + tok]) + imp[(4 * j1 + 3) * 16 + tok]
                                 + imp[(4 * j1 - 1) * 16 + tok];
                const bool f0 = (j0 == 0) || (j0 == cur) || (j0 == cur - 1);
                const bool f1 = (j1 == cur) || (j1 == cur - 1);
                my0 = f0 ? 1e4f : ((j0 <= cur) ? a0 : -1.f);
                my1 = f1 ? 1e4f : ((j1 <= cur) ? a1 : -1.f);
            }
            const unsigned k0 = (lane <= cur) ? (__float_as_uint(my0) + 1u) : 0u;
            const unsigned k1 = (lane + 64 <= cur) ? (__float_as_uint(my1) + 1u) : 0u;
            unsigned T = 0u;
#pragma unroll
            for (int bit = 31; bit >= 0; --bit) {
                const unsigned tr = T | (1u << bit);
                const int cnt = __builtin_popcountll(__ballot(k0 >= tr)) + __builtin_popcountll(__ballot(k1 >= tr));
                if (cnt >= 16) T = tr;
            }
            const unsigned long long eq0 = __ballot(k0 == T), eq1 = __ballot(k1 == T);
            const int need = 16 - __builtin_popcountll(__ballot(k0 > T)) - __builtin_popcountll(__ballot(k1 > T));
            const unsigned long long lm = (1ull << lane) - 1ull;
            const bool s0 = (k0 > 0u) && (k0 > T || (k0 == T && __builtin_popcountll(eq0 & lm) < need));
            const bool s1 = (k1 > 0u) && (k1 > T || (k1 == T && __builtin_popcountll(eq0) + __builtin_popcountll(eq1 & lm) < need));
            const unsigned long long lo = __ballot(s0);
            const unsigned long long hi = __ballot(s1);
            if (lane == 0) { msk[i * 2] = lo; msk[i * 2 + 1] = hi; }
        }
#pragma unroll 4
        for (int i = 0; i < 32; ++i) { const int e = i * 64 + lane; imp[(e >> 2) * 16 + 4 * w + (e & 3)] = 0.f; }
        __builtin_amdgcn_fence(__ATOMIC_RELEASE, "wavefront"); __builtin_amdgcn_wave_barrier(); __builtin_amdgcn_fence(__ATOMIC_ACQUIRE, "wavefront");
        {
            const int tokL = 4 * w + (c >> 2), tq = t0 + tokL, hd = kvh * 4 + (c & 3);
            const size_t rq = (size_t)b * 8192 + tq;
            const u16* Hs = H + rq * LD + hd * 64 + g4 * 8;
            const bf16x8 s0 = *(const bf16x8*)Hs, s1 = *(const bf16x8*)(Hs + 32);
            const char* Kb = (const char*)((const u16*)(ws + OFF_KI0) + ((size_t)(b * 4 + kvh) * 512) * 1024);
            const char* Vb = (const char*)((const u16*)(ws + OFF_VT0) + ((size_t)(b * 4 + kvh) * 512) * 1024);
            const unsigned kl = c * 64 + g4 * 16, vl = c * 32 + g4 * 8;
            float m = NEG_INF, l = 0.f;
            f32x4 o[4];
#pragma unroll
            for (int d = 0; d < 4; ++d) o[d] = f32x4{0.f, 0.f, 0.f, 0.f};
            const int ti = c >> 2;
            const unsigned long long mylo = msk[ti * 2], myhi = msk[ti * 2 + 1];
            const unsigned long long ulo = msk[0] | msk[2] | msk[4] | msk[6];
            const unsigned long long uhi = msk[1] | msk[3] | msk[5] | msk[7];
            const unsigned long long alo = msk[0] & msk[2] & msk[4] & msk[6], ahi = msk[1] & msk[3] & msk[5] & msk[7];
            int* blist = (int*)(scb + w * 128);
            const int nlo = __builtin_popcountll(ulo), nblk = nlo + __builtin_popcountll(uhi);
            if ((ulo >> lane) & 1ull) blist[__builtin_popcountll(ulo & ((1ull << lane) - 1ull))] = lane;
            if ((uhi >> lane) & 1ull) blist[nlo + __builtin_popcountll(uhi & ((1ull << lane) - 1ull))] = 64 + lane;
            __builtin_amdgcn_fence(__ATOMIC_RELEASE, "wavefront");
            __builtin_amdgcn_wave_barrier();
            __builtin_amdgcn_fence(__ATOMIC_ACQUIRE, "wavefront");
            const int nst = 2 * nblk;
#define SL_LOAD(R, S) do { const int j_ = __builtin_amdgcn_readfirstlane(blist[(S) >> 1]); const int ua_ = j_ * 64 + ((S) & 1) * 32; \
        load_kv(R, Kb, (unsigned)(ua_ >> 4) * 2048u + kl, (unsigned)((ua_ >> 4) + 1) * 2048u + kl, \
                Vb, (unsigned)(ua_ >> 4) * 2048u + vl, (unsigned)((ua_ >> 4) + 1) * 2048u + vl); } while (0)
#define SL_COMP(R, S) do { const int j_ = __builtin_amdgcn_readfirstlane(blist[(S) >> 1]); const int ua_ = j_ * 64 + ((S) & 1) * 32; \
        const bool selj = (j_ < 64) ? ((mylo >> j_) & 1ull) : ((myhi >> (j_ - 64)) & 1ull); \
        const bool alls_ = (j_ < 64) ? ((alo >> j_) & 1ull) : ((ahi >> (j_ - 64)) & 1ull); \
        const bool fast_ = alls_ && (ua_ + 31 <= t0 + 4 * w); \
        flash_core(m, l, o, s0, s1, R, fast_, selj ? (tq - ua_ - g4 * 4) : -(1 << 30), 0x7fffffffu); } while (0)
            RING4(nst, SL_LOAD, SL_COMP);
#undef SL_LOAD
#undef SL_COMP
            l = red16_sum(l);
            const float inv = 1.f / l;
#pragma unroll
            for (int dt = 0; dt < 4; ++dt)
                *(f32x4*)(oslc + (tokL * 4 + (c & 3)) * 64 + dt * 16 + g4 * 4) = o[dt] * inv;
        }
        __syncthreads();
#pragma unroll
        for (int dt = 0; dt < 4; ++dt) {
            const int dh = dt * 16 + g4 * 4;
            const f32x4 os = *(const f32x4*)(oslc + (c * 4 + w) * 64 + dh);
            const f32x4 r = oacc[dt] + os * g1;
            const u32x2 z = *(const u32x2*)(H + rowq * LD + 2560 + head * 64 + dh);
            const float r0 = r[0] * siluf_(bflo(z[0])), r1 = r[1] * siluf_(bfhi(z[0]));
            const float r2 = r[2] * siluf_(bflo(z[1])), r3 = r[3] * siluf_(bfhi(z[1]));
            *(u32x2*)(G + kb_off((int)rowq, head * 64 + dh, 1024)) = u32x2{pack2(r0, r1), pack2(r2, r3)};
        }
    }
}

#ifndef PROBE_DUP
#define PROBE_DUP 0
#endif
#define REP(k) for (int rep_ = 0; rep_ < 1 + ((PROBE_DUP >> (k)) & 1); ++rep_)
constexpr int LDS_BYTES = 3 * GSTAGE + 64;
__global__ void __launch_bounds__(256, 2) mk_fwd(Prm P) {
    extern __shared__ __attribute__((aligned(16))) unsigned char smem[];
    unsigned* xb_words = (unsigned*)(smem + 3 * GSTAGE);
    if (threadIdx.x < 4) xb_words[threadIdx.x] = 0u;
    __syncthreads();
    XcdBarrier bar = xcd_barrier_post((unsigned*)(P.ws + OFF_BAR), (volatile LAS unsigned*)xb_words);
    unsigned char* ws = P.ws;

    phase0(P, smem);
    if (P.ws == nullptr) cg::this_grid().sync();
    xcd_barrier(bar);

#pragma unroll 1
    for (int layer = 0; layer < 4; ++layer) {
        const int kind = layer % 3, lj = layer / 3;
        const u16* Win; const u16* Wout; int N, nsub;
        if (kind == 0)      { Win = (const u16*)(ws + OFF_WA_IN + (size_t)lj * SZ_WA_IN); Wout = (const u16*)(ws + OFF_WA_OUT + (size_t)lj * SZ_SQ); N = 2560; nsub = 4; }
        else if (kind == 1) { Win = (const u16*)(ws + OFF_WB_IN); Wout = (const u16*)(ws + OFF_WB_OUT); N = 2304; nsub = 1; }
        else                { Win = (const u16*)(ws + OFF_WC_IN); Wout = (const u16*)(ws + OFF_WC_OUT); N = 3840; nsub = 1; }
#pragma unroll 1
        for (int sub = 0; sub < nsub; ++sub) {
            REP(0) gemm_in_phase(smem, P, kind, Win + (size_t)sub * 2560 * 1024, N);
            xcd_barrier(bar);
            if (kind == 0) REP(1) attnA_phase(P, sub);
            else if (kind == 1) REP(2) attnB_phase(P);
            else { REP(3) compress_phase(P); xcd_barrier(bar); REP(4) attnC_phase(P, smem); }
            xcd_barrier(bar);
        }
        gemm_out_phase(smem, P, Wout, layer == 0 ? P.in[0] : P.out);
        xcd_barrier(bar);
        ln_phase(P, layer);
        xcd_barrier(bar);
        gemm_gate_phase(smem, P, (const u16*)(ws + OFF_WG + (size_t)layer * SZ_SQ), (const u16*)(ws + OFF_WP + (size_t)layer * SZ_WP));
        if (layer < 3) xcd_barrier(bar);
    }
}

extern "C" void kernel_launch(void* const* d_in, const int* in_sizes, int n_in, void* d_out, int out_size, void* d_ws, size_t ws_size,
                              hipStream_t stream) {
    static int grid_blocks = 0;
    if (!grid_blocks) {
        int dev = 0, cus = 0, per_cu = 0;
        (void)hipGetDevice(&dev);
        (void)hipDeviceGetAttribute(&cus, hipDeviceAttributeMultiprocessorCount, dev);
        (void)hipFuncSetAttribute((const void*)mk_fwd, hipFuncAttributeMaxDynamicSharedMemorySize, LDS_BYTES);
        (void)hipOccupancyMaxActiveBlocksPerMultiprocessor(&per_cu, (const void*)mk_fwd, 256, LDS_BYTES);
        if (per_cu > 2) per_cu = 2;
        if (per_cu < 1) per_cu = 1;
        grid_blocks = cus * per_cu;
        if (ws_size < WS_END || n_in != 16) { fprintf(stderr, "kernel_launch: workspace too small (%zu < %zu) or n_in %d != 16\n", ws_size, (size_t)WS_END, n_in); grid_blocks = -1; }
    }
    if (grid_blocks < 0) return;
    (void)hipMemsetAsync((char*)d_ws + OFF_BAR, 0, 16384, stream);
    Prm p{};
    for (int i = 0; i < 16; ++i) p.in[i] = (const float*)d_in[i];
    p.out = (float*)d_out; p.ws = (unsigned char*)d_ws;
    void* args[] = {&p};
    hipError_t e = hipLaunchCooperativeKernel((const void*)mk_fwd, dim3(grid_blocks), dim3(256), args, LDS_BYTES, stream);
    if (e != hipSuccess) fprintf(stderr, "cooperative launch failed: %s (grid %d)\n", hipGetErrorString(e), grid_blocks);
}
```

```cpp
#include <hip/hip_runtime.h>
#include <hip/hip_cooperative_groups.h>
#include <cstdio>
#include <cstdint>
namespace cg = cooperative_groups;

typedef unsigned short u16;
using bf16x8 = __attribute__((ext_vector_type(8))) short;
using s16x4  = __attribute__((ext_vector_type(4))) short;
using f32x4  = __attribute__((ext_vector_type(4))) float;
using u32x4  = __attribute__((ext_vector_type(4))) unsigned;
using u32x2  = __attribute__((ext_vector_type(2))) unsigned;
#define DEV __device__ __forceinline__
using h16x8 = __attribute__((ext_vector_type(8))) _Float16;
#define MFMA16(a, b, c) __builtin_amdgcn_mfma_f32_16x16x32_f16(__builtin_bit_cast(h16x8, (a)), __builtin_bit_cast(h16x8, (b)), (c), 0, 0, 0)
#define LAS __attribute__((address_space(3)))

constexpr int T = 16384, S = 8192;
constexpr float LN_EPS = 1e-5f;
constexpr float DN_ALPHA = 1.6817928305074290f;
constexpr float NEG_INF = -__builtin_huge_valf();

constexpr size_t OFF_BAR   = 0;
constexpr size_t OFF_COS   = 16384;
constexpr size_t OFF_SIN   = OFF_COS + (size_t)8192 * 32 * 4;
constexpr size_t OFF_BIAS  = OFF_SIN + (size_t)8192 * 32 * 4;
constexpr size_t OFF_WA_IN = OFF_BIAS + 1024;
constexpr size_t SZ_WA_IN  = (size_t)10240 * 1024 * 2;
constexpr size_t SZ_SQ     = (size_t)1024 * 1024 * 2;
constexpr size_t OFF_WA_OUT = OFF_WA_IN + 2 * SZ_WA_IN;
constexpr size_t OFF_WB_IN  = OFF_WA_OUT + 2 * SZ_SQ;
constexpr size_t OFF_WB_OUT = OFF_WB_IN + (size_t)2304 * 1024 * 2;
constexpr size_t OFF_WC_IN  = OFF_WB_OUT + SZ_SQ;
constexpr size_t OFF_WC_OUT = OFF_WC_IN + (size_t)3840 * 1024 * 2;
constexpr size_t OFF_WG     = OFF_WC_OUT + SZ_SQ;
constexpr size_t OFF_WP     = OFF_WG + 4 * SZ_SQ;
constexpr size_t SZ_WP      = (size_t)1024 * 256 * 2;
constexpr size_t OFF_WCK    = OFF_WP + 4 * SZ_WP;
constexpr size_t OFF_WCV    = OFF_WCK + (size_t)64 * 2048 * 2;
constexpr size_t OFF_XB     = OFF_WCV + (size_t)64 * 2048 * 2;
constexpr size_t SZ_ACT     = (size_t)T * 1024 * 2;
constexpr size_t OFF_G      = OFF_XB + SZ_ACT;
constexpr size_t OFF_H      = OFF_G + SZ_ACT;
constexpr size_t SZ_HMAX    = (size_t)T * 3840 * 2;
constexpr size_t OFF_VT0    = OFF_H + SZ_HMAX;
constexpr size_t SZ_VT      = (size_t)2 * 4 * 8192 * 64 * 2;
constexpr size_t OFF_VT1    = OFF_VT0 + SZ_VT;
constexpr size_t OFF_VT2    = OFF_VT1 + SZ_VT;
constexpr size_t OFF_KCMP   = OFF_VT2 + SZ_VT;
constexpr size_t SZ_CMP     = (size_t)2 * 512 * 4 * 64 * 2;
constexpr size_t OFF_VCMP   = OFF_KCMP + SZ_CMP;
constexpr size_t OFF_KI0    = OFF_VCMP + SZ_CMP;
constexpr size_t OFF_KI1    = OFF_KI0 + SZ_VT;
constexpr size_t OFF_KI2    = OFF_KI1 + SZ_VT;
constexpr size_t WS_END     = OFF_KI2 + SZ_VT;
constexpr size_t OFF_XLB    = OFF_H;
constexpr size_t OFF_PB     = OFF_H + SZ_ACT;
constexpr size_t OFF_PP     = OFF_H + SZ_ACT + (size_t)16 * 1024 * 1024;

struct Prm { const float* in[16]; float* out; unsigned char* ws; };

__device__ __forceinline__ size_t kb_off(int row, int k, int K) { return ((size_t)(row >> 4) * (K >> 5) + (k >> 5)) * 512 + (row & 15) * 32 + (k & 31); }
DEV u16 f2bf(float f) { return __builtin_bit_cast(u16, (_Float16)f); }
DEV float bf2f(u16 h) { return (float)__builtin_bit_cast(_Float16, h); }
DEV unsigned pack2(float a, float b) { return (unsigned)f2bf(a) | ((unsigned)f2bf(b) << 16); }
DEV float bflo(unsigned u) { return bf2f((u16)(u & 0xffffu)); }
DEV float bfhi(unsigned u) { return bf2f((u16)(u >> 16)); }
DEV float sigmoidf_(float x) { return 1.f / (1.f + __expf(-x)); }
DEV float siluf_(float x) { return x / (1.f + __expf(-x)); }
DEV float red16_max(float v) { v = fmaxf(v, __shfl_xor(v, 16)); v = fmaxf(v, __shfl_xor(v, 32)); return v; }
DEV float red16_sum(float v) { v += __shfl_xor(v, 16); v += __shfl_xor(v, 32); return v; }
DEV float wave_sum(float v) { for (int o = 32; o > 0; o >>= 1) v += __shfl_xor(v, o); return v; }

DEV int opaque_tid() { int t = threadIdx.x; asm volatile("" : "+v"(t)); return t; }
#define XB_TMO      128
#define XB_XCNT(j)  (256  + 64 * (j))
#define XB_XSUB(j)  (1280 + 64 * (j))
#define XB_XGEN(j)  (2304 + 64 * (j))
#define XB_TOP      3328
#define XB_TOPGEN   3392
#define XCD_BAR_WORDS 3456
#define XB_SPIN_CAP (1u << 24)
DEV unsigned xb_ld(unsigned* p)              { return __hip_atomic_load(p, __ATOMIC_RELAXED, __HIP_MEMORY_SCOPE_AGENT); }
DEV unsigned xb_add(unsigned* p, unsigned v) { return __hip_atomic_fetch_add(p, v, __ATOMIC_RELAXED, __HIP_MEMORY_SCOPE_AGENT); }
DEV unsigned xb_xcc_id() { return (unsigned)__builtin_amdgcn_s_getreg((3 << 11) | 20) & 0xFu; }
#define XB_SPIN(cond, bar) do { unsigned _sp = 0; while (cond) { __builtin_amdgcn_s_sleep(1); \
    if ((++_sp & 255u) == 0u) { if (xb_ld(&(bar)[XB_TMO])) break; if (_sp > XB_SPIN_CAP) { atomicAdd(&(bar)[XB_TMO], 1u); break; } } } } while (0)
struct XcdBarrier { unsigned* bar; unsigned x; volatile LAS unsigned* st; };
DEV XcdBarrier xcd_barrier_post(unsigned* bar, volatile LAS unsigned* st) {
    XcdBarrier b; b.bar = bar; b.x = xb_xcc_id(); b.st = st;
    if (threadIdx.x == 0) (void)xb_add(&bar[XB_XCNT(b.x)], 1u);
    return b;
}
DEV void xcd_barrier_complete(unsigned* bar, unsigned x, unsigned& nloc, unsigned& nx) {
    const unsigned G = gridDim.x * gridDim.y * gridDim.z;
    unsigned sum, cnt, mine, sp = 0u;
    for (;;) {
        sum = 0u; cnt = 0u; mine = 0u;
#pragma unroll
        for (unsigned j = 0; j < 16; ++j) { const unsigned c = xb_ld(&bar[XB_XCNT(j)]); sum += c; cnt += (c > 0u) ? 1u : 0u; mine = (j == x) ? c : mine; }
        if (sum == G) break;
        __builtin_amdgcn_s_sleep(1);
        if ((++sp & 255u) == 0u) { if (xb_ld(&bar[XB_TMO])) break; if (sp > XB_SPIN_CAP) { atomicAdd(&bar[XB_TMO], 1u); break; } }
    }
    nloc = mine > 0u ? mine : 1u; nx = cnt > 0u ? cnt : 1u;
}
DEV void xcd_barrier(const XcdBarrier& b) {
    asm volatile("s_waitcnt vmcnt(0)" ::: "memory");
    __syncthreads();
    if (threadIdx.x == 0) {
        unsigned* bar = b.bar;
        __builtin_amdgcn_s_waitcnt(0);
        unsigned nloc = b.st[0], nx = b.st[1];
        if (nloc == 0u) { xcd_barrier_complete(bar, b.x, nloc, nx); b.st[0] = nloc; b.st[1] = nx; }
        const unsigned old = xb_add(&bar[XB_XSUB(b.x)], 1u);
        const unsigned gen = old / nloc;
        if (old + 1u == (gen + 1u) * nloc) {
            __builtin_amdgcn_fence(__ATOMIC_RELEASE, "agent");
            asm volatile("s_waitcnt vmcnt(0)" ::: "memory");
            const unsigned og = xb_add(&bar[XB_TOP], 1u);
            const unsigned tg = og / nx;
            if (og + 1u == (tg + 1u) * nx) xb_add(&bar[XB_TOPGEN], 1u);
            else XB_SPIN(xb_ld(&bar[XB_TOPGEN]) == tg, bar);
            __builtin_amdgcn_fence(__ATOMIC_ACQUIRE, "agent");
            xb_add(&bar[XB_XGEN(b.x)], 1u);
            asm volatile("s_waitcnt vmcnt(0)" ::: "memory");
        } else {
            XB_SPIN(xb_ld(&bar[XB_XGEN(b.x)]) == gen, bar);
            __builtin_amdgcn_fence(__ATOMIC_ACQUIRE, "agent");
            asm volatile("s_waitcnt vmcnt(0)" ::: "memory");
        }
    }
    __syncthreads();
}

DEV int colmap(int kind, int n) {
    if (kind == 0) return n;
    if (kind == 1) {
        const int c = n / 2560, nn = n - c * 2560;
        if (nn < 2304) { const int g = nn / 768, rem = nn - g * 768, part = rem >> 8, hh = (rem & 255) >> 6, d = rem & 63;
                         return g * 3072 + part * 1024 + (c * 4 + hh) * 64 + d; }
        const int z = nn - 2304; return 9216 + (c * 4 + (z >> 6)) * 64 + (z & 63);
    }
    if (n < 2560) return n;
    if (n < 3584) return n - 2560 + 2608;
    if (n < 3632) return n - 3584 + 2560;
    return -1;
}
DEV void tconv(const int tid_, float* lds, const float* __restrict__ src, int K, int Nsrc, u16* __restrict__ dst, int Ndst, int kind, int& acc_tiles) {
    const int G = gridDim.x, tid = tid_;
    const int ntn = Ndst >> 6, ntk = K >> 6, nt = ntn * ntk;
    int first = ((int)blockIdx.x - (acc_tiles % G) + G) % G;
    acc_tiles += nt;
    for (int t = first; t < nt; t += G) {
        const int tn = t / ntk, tk = t - tn * ntk;
        const int n0 = tn << 6, k0 = tk << 6;
        const int nl = tid & 63;
        const int c = colmap(kind, n0 + nl);
#pragma unroll
        for (int i = 0; i < 16; ++i) {
            const int kl = (tid >> 6) + 4 * i;
            const float v = (c >= 0) ? src[(size_t)(k0 + kl) * Nsrc + c] : 0.f;
            lds[kl * 65 + nl] = v;
        }
        __syncthreads();
        const int r = tid >> 2, kk = (tid & 3) << 4;
        unsigned o[8];
#pragma unroll
        for (int i = 0; i < 8; ++i) o[i] = pack2(lds[(kk + 2 * i) * 65 + r], lds[(kk + 2 * i + 1) * 65 + r]);
        u32x4* dp = (u32x4*)(dst + kb_off(n0 + r, k0 + kk, K));
        dp[0] = u32x4{o[0], o[1], o[2], o[3]};
        dp[1] = u32x4{o[4], o[5], o[6], o[7]};
        __syncthreads();
    }
}

DEV void phase0(const Prm& P, unsigned char* smem) {
    const int tid_ = opaque_tid();
    float* lds = (float*)smem;
    unsigned char* ws = P.ws;
    int acc = 0;
    tconv(tid_, lds, P.in[2], 1024, 10240, (u16*)(ws + OFF_WA_IN), 10240, 1, acc);
    tconv(tid_, lds, P.in[2] + (size_t)1024 * 10240, 1024, 10240, (u16*)(ws + OFF_WA_IN + SZ_WA_IN), 10240, 1, acc);
    tconv(tid_, lds, P.in[3], 1024, 1024, (u16*)(ws + OFF_WA_OUT), 1024, 0, acc);
    tconv(tid_, lds, P.in[3] + (size_t)1024 * 1024, 1024, 1024, (u16*)(ws + OFF_WA_OUT + SZ_SQ), 1024, 0, acc);
    tconv(tid_, lds, P.in[4], 1024, 2304, (u16*)(ws + OFF_WB_IN), 2304, 0, acc);
    tconv(tid_, lds, P.in[6], 1024, 1024, (u16*)(ws + OFF_WB_OUT), 1024, 0, acc);
    tconv(tid_, lds, P.in[7], 1024, 3632, (u16*)(ws + OFF_WC_IN), 3840, 2, acc);
    tconv(tid_, lds, P.in[11], 1024, 1024, (u16*)(ws + OFF_WC_OUT), 1024, 0, acc);
    for (int i = 0; i < 4; ++i) {
        tconv(tid_, lds, P.in[15] + (size_t)i * 1024 * 1024, 1024, 1024, (u16*)(ws + OFF_WG + i * SZ_SQ), 1024, 0, acc);
        tconv(tid_, lds, P.in[14] + (size_t)i * 256 * 1024, 256, 1024, (u16*)(ws + OFF_WP + i * SZ_WP), 1024, 0, acc);
    }
    tconv(tid_, lds, P.in[8], 2048, 64, (u16*)(ws + OFF_WCK), 64, 0, acc);
    tconv(tid_, lds, P.in[9], 2048, 64, (u16*)(ws + OFF_WCV), 64, 0, acc);

    const size_t gtid = (size_t)blockIdx.x * 256 + tid_, gsz = (size_t)gridDim.x * 256;
    {
        const float* x = P.in[0]; u16* xb = (u16*)(ws + OFF_XB);
        for (size_t i = gtid; i < (size_t)T * 1024 / 8; i += gsz) {
            const f32x4 a = *(const f32x4*)(x + i * 8), b = *(const f32x4*)(x + i * 8 + 4);
            *(u32x4*)(xb + kb_off((int)(i >> 7), (int)(i & 127) * 8, 1024)) = u32x4{pack2(a[0], a[1]), pack2(a[2], a[3]), pack2(b[0], b[1]), pack2(b[2], b[3])};
        }
    }
    {
        float* ct = (float*)(ws + OFF_COS); float* st = (float*)(ws + OFF_SIN);
        for (size_t i = gtid; i < (size_t)8192 * 32; i += gsz) {
            const int pos = (int)(i >> 5), k = (int)(i & 31);
            const float inv = (float)(1.0 / pow(10000.0, (double)(2 * k) / 64.0));
            const float ang = (float)pos * inv;
            ct[i] = (float)cos((double)ang); st[i] = (float)sin((double)ang);
        }
    }
    {
        const int lane = tid_ & 63;
        const int wid = blockIdx.x * 4 + __builtin_amdgcn_readfirstlane(tid_ >> 6);
        if (wid < 128) {
            const float* w = (wid < 64) ? P.in[8] : P.in[9];
            const int e = wid & 63;
            float s = 0.f;
            for (int jd = lane; jd < 2048; jd += 64) s += P.in[10][jd] * w[(size_t)jd * 64 + e];
            s = wave_sum(s);
            if (lane == 0) ((float*)(ws + OFF_BIAS))[wid] = s;
        }
    }
}

constexpr int GSTAGE = 24576;
DEV int gsw(int r) { return (0x78 >> (2 * ((r >> 2) & 3))) & 3; }
DEV void gemm_issue(unsigned char* stage, const u16* ag0, const u16* ag1, const u16* bg, int bstep, int kt, int w) {
    __builtin_amdgcn_global_load_lds((const unsigned*)(ag0 + kt * 512), (unsigned*)(stage + w * 1024), 16, 0, 0);
    __builtin_amdgcn_global_load_lds((const unsigned*)(ag1 + kt * 512), (unsigned*)(stage + w * 1024 + 4096), 16, 0, 0);
#pragma unroll
    for (int i = 0; i < 4; ++i)
        __builtin_amdgcn_global_load_lds((const unsigned*)(bg + (size_t)i * bstep + kt * 512), (unsigned*)(stage + 8192 + w * 1024 + i * 4096), 16, 0, 0);
}
template <bool NONSWAP>
DEV void gemm_mainloop(const int tid_, unsigned char* smem, const u16* __restrict__ A, int lda, const u16* __restrict__ Bt, int ldb, int K,
                       int m0, int n0, f32x4 (&acc)[32], bool aperm = false) {
    const int tid = tid_, lane = tid & 63, w = __builtin_amdgcn_readfirstlane(tid >> 6), wm = w >> 1, wn = w & 1;
    const int lrow = tid >> 2, lsw = ((tid & 3) ^ gsw(lrow)) * 8;
    const int arow0 = aperm ? ((lrow & 31) * 4 + (lrow >> 5)) : lrow;
    const int arow1 = aperm ? (arow0 + 2) : (lrow + 64);
    const u16* ag0 = A + kb_off(m0 + arow0, 0, lda) + lsw;
    const u16* ag1 = A + kb_off(m0 + arow1, 0, lda) + lsw;
    const u16* bg = Bt + kb_off(n0 + lrow, 0, ldb) + lsw;
    const int bstep = 4 * (ldb >> 5) * 512;
    const int fr = lane & 15, fq = lane >> 4;
    const int coff = (fq ^ gsw(fr)) << 4;
    const int a_base = (wm * 64 + fr) * 64 + coff, b_base = 8192 + (wn * 128 + fr) * 64 + coff;
    const int nk = K >> 5;
    asm volatile("s_waitcnt vmcnt(0)" ::: "memory");
    __builtin_amdgcn_s_barrier();
    gemm_issue(smem, ag0, ag1, bg, bstep, 0, w);
    gemm_issue(smem + GSTAGE, ag0, ag1, bg, bstep, 1, w);
    int sc = 0, si = 2;
    for (int kt = 0; kt < nk; ++kt) {
        if (kt + 1 < nk) asm volatile("s_waitcnt vmcnt(6)" ::: "memory"); else asm volatile("s_waitcnt vmcnt(0)" ::: "memory");
        __builtin_amdgcn_s_barrier();
        if (kt + 2 < nk) { gemm_issue(smem + si * GSTAGE, ag0, ag1, bg, bstep, kt + 2, w); si = (si == 2) ? 0 : si + 1; }
        const unsigned char* st = smem + sc * GSTAGE; sc = (sc == 2) ? 0 : sc + 1;
        bf16x8 a[4], b[4];
#pragma unroll
        for (int i = 0; i < 4; ++i) a[i] = *(const bf16x8*)(st + a_base + i * 1024);
#pragma unroll
        for (int hb = 0; hb < 2; ++hb) {
#pragma unroll
            for (int i = 0; i < 4; ++i) b[i] = *(const bf16x8*)(st + b_base + (hb * 4 + i) * 1024);
            if (NONSWAP) {
#pragma unroll
                for (int mt = 0; mt < 4; ++mt)
#pragma unroll
                    for (int nt = 0; nt < 4; ++nt) acc[mt * 8 + hb * 4 + nt] = MFMA16(a[mt], b[nt], acc[mt * 8 + hb * 4 + nt]);
            } else {
#pragma unroll
                for (int nt = 0; nt < 4; ++nt)
#pragma unroll
                    for (int mt = 0; mt < 4; ++mt) acc[(hb * 4 + nt) * 4 + mt] = MFMA16(b[nt], a[mt], acc[(hb * 4 + nt) * 4 + mt]);
            }
        }
    }
}

DEV int vblock() { const int G = gridDim.x, b = blockIdx.x; return ((G & 7) == 0) ? (b & 7) * (G >> 3) + (b >> 3) : b; }
DEV void tile_mn(int t, int nN, int& mi, int& ni) { const int per = 8 * nN; const int mg = t / per, r = t - mg * per; mi = mg * 8 + (r & 7); ni = r >> 3; }
#define ZERO_ACC(acc) _Pragma("unroll") for (int i_ = 0; i_ < 32; ++i_) acc[i_] = f32x4{0.f, 0.f, 0.f, 0.f}

DEV void classify(int kind, int cgi, int& mode, int& vsel, int& vth, int& dsh, int& nhv, int& ksel) {
    mode = 0; vsel = 0; vth = 0; dsh = 0; nhv = 4; ksel = -1;
    if (kind == 0) {
        if (cgi < 36) { const int g = cgi / 12, part = (cgi - g * 12) >> 2; vth = cgi & 3; if (part < 2) { mode = 1; if (part == 1) { ksel = g; dsh = 2 * g; } } else { mode = 2; vsel = g; dsh = 2 * g; } }
    } else if (kind == 1) {
        if (cgi < 16) mode = 1; else if (cgi < 18) { mode = 1; ksel = 0; vth = cgi - 16; nhv = 2; } else if (cgi < 20) { mode = 2; vsel = 0; vth = cgi - 18; nhv = 2; }
    } else {
        if (cgi < 20) mode = 1; else if (cgi < 24) mode = 0; else if (cgi < 28) { mode = 1; ksel = 0; vth = cgi - 24; } else if (cgi < 32) { mode = 2; vsel = 0; vth = cgi - 28; }
        else if (cgi < 36) { mode = 1; ksel = 1; vth = cgi - 32; } else if (cgi < 40) { mode = 2; vsel = 1; vth = cgi - 36; }
    }
}

DEV void gemm_in_phase(unsigned char* smem, const Prm& P, int kind, const u16* Wt, int N) {
    const int tid_ = opaque_tid();
    unsigned char* ws = P.ws;
    const u16* A = (const u16*)(ws + OFF_XB);
    u16* H = (u16*)(ws + OFF_H);
    const float* cosT = (const float*)(ws + OFF_COS); const float* sinT = (const float*)(ws + OFF_SIN);
    const int nN = N >> 8, ntiles = 128 * nN;
    const int lane = tid_ & 63, w = __builtin_amdgcn_readfirstlane(tid_ >> 6), wm = w >> 1, wn = w & 1, fr = lane & 15, fq = lane >> 4;
    for (int t = vblock(); t < ntiles; t += gridDim.x) {
        int mi, ni; tile_mn(t, nN, mi, ni);
        const int m0 = mi << 7, n0 = ni << 8;
        const int ncol = n0 + wn * 128, cg0 = ncol >> 6;
        int mode, vsel, vth, dsh, nhv, ksel; classify(kind, cg0, mode, vsel, vth, dsh, nhv, ksel);
        const int mw = m0 + wm * 64;
        f32x4 acc[32]; ZERO_ACC(acc);
        if (mode == 2) {
            gemm_mainloop<true>(tid_, smem, A, 1024, Wt, 1024, 1024, m0, n0, acc, dsh == 2);
            __builtin_amdgcn_s_barrier();
            u16* vt = (u16*)(ws + (vsel == 0 ? OFF_VT0 : (vsel == 1 ? OFF_VT1 : OFF_VT2)));
            if (dsh == 0) {
#pragma unroll
                for (int mt = 0; mt < 4; ++mt) {
                    const int m = mw + mt * 16 + fq * 4;
                    const int b = m >> 13, p = m & 8191;
#pragma unroll
                    for (int grp = 0; grp < 2; ++grp) {
                        u16* dst = vt + ((((size_t)(b * nhv + vth + grp)) * 512 + (p >> 4)) * 64) * 16 + (p & 15);
#pragma unroll
                        for (int nt = 0; nt < 4; ++nt) { const f32x4 v = acc[mt * 8 + grp * 4 + nt]; *(u32x2*)(dst + (nt * 16 + fr) * 16) = u32x2{pack2(v[0], v[1]), pack2(v[2], v[3])}; }
                    }
                }
            } else if (dsh == 4) {
#pragma unroll
                for (int j = 0; j < 4; ++j) {
                    const int m = mw + fq * 4 + j;
                    const int b = m >> 13, s = m & 8191;
                    const int p = ((s & 15) << 9) + (s >> 4);
#pragma unroll
                    for (int grp = 0; grp < 2; ++grp) {
                        u16* dst = vt + ((((size_t)(b * nhv + vth + grp)) * 512 + (p >> 4)) * 64) * 16 + (p & 15);
#pragma unroll
                        for (int nt = 0; nt < 4; ++nt)
                            *(u32x2*)(dst + (nt * 16 + fr) * 16) = u32x2{pack2(acc[0 * 8 + grp * 4 + nt][j], acc[1 * 8 + grp * 4 + nt][j]), pack2(acc[2 * 8 + grp * 4 + nt][j], acc[3 * 8 + grp * 4 + nt][j])};
                    }
                }
            } else {
#pragma unroll
                for (int mt = 0; mt < 4; ++mt) {
                    const int r0 = wm * 64 + mt * 16 + fq * 4;
                    const int m = m0 + (r0 & 31) * 4 + (r0 >> 5);
                    const int b = m >> 13, s = m & 8191;
                    const int p = ((s & 3) << 11) + (s >> 2);
#pragma unroll
                    for (int grp = 0; grp < 2; ++grp) {
                        u16* dst = vt + ((((size_t)(b * nhv + vth + grp)) * 512 + (p >> 4)) * 64) * 16 + (p & 15);
#pragma unroll
                        for (int nt = 0; nt < 4; ++nt) { const f32x4 v = acc[mt * 8 + grp * 4 + nt]; *(u32x2*)(dst + (nt * 16 + fr) * 16) = u32x2{pack2(v[0], v[1]), pack2(v[2], v[3])}; }
                    }
                }
            }
        } else {
            gemm_mainloop<false>(tid_, smem, A, 1024, Wt, 1024, 1024, m0, n0, acc);
            __builtin_amdgcn_s_barrier();
            constexpr int EROW = 272;
            unsigned char* est = smem + w * (64 * EROW);
            int l4_ = lane; asm volatile("" : "+v"(l4_));
            const int fr = l4_ & 15, fq = l4_ >> 4;
#pragma unroll
            for (int mt = 0; mt < 4; ++mt) {
                const int s = (mw + mt * 16 + fr) & 8191;
                unsigned char* erow = est + (mt * 16 + fr) * EROW + fq * 8;
                if (mode == 1) {
#pragma unroll
                    for (int nt = 0; nt < 2; ++nt) {
                        const f32x4 c4 = *(const f32x4*)(cosT + s * 32 + nt * 16 + fq * 4);
                        const f32x4 s4 = *(const f32x4*)(sinT + s * 32 + nt * 16 + fq * 4);
#pragma unroll
                        for (int grp = 0; grp < 2; ++grp) {
                            const f32x4 x1 = acc[(grp * 4 + nt) * 4 + mt], x2 = acc[(grp * 4 + nt + 2) * 4 + mt];
                            const f32x4 o1 = x1 * c4 - x2 * s4, o2 = x2 * c4 + x1 * s4;
                            *(u32x2*)(erow + (grp * 64 + nt * 16) * 2) = u32x2{pack2(o1[0], o1[1]), pack2(o1[2], o1[3])};
                            *(u32x2*)(erow + (grp * 64 + (nt + 2) * 16) * 2) = u32x2{pack2(o2[0], o2[1]), pack2(o2[2], o2[3])};
                        }
                    }
                } else {
#pragma unroll
                    for (int nt = 0; nt < 8; ++nt) { const f32x4 v = acc[nt * 4 + mt]; *(u32x2*)(erow + nt * 32) = u32x2{pack2(v[0], v[1]), pack2(v[2], v[3])}; }
                }
            }
            __builtin_amdgcn_fence(__ATOMIC_RELEASE, "wavefront"); __builtin_amdgcn_wave_barrier(); __builtin_amdgcn_fence(__ATOMIC_ACQUIRE, "wavefront");
            {
                const int rr = l4_ >> 4, ch = l4_ & 15;
                if (ksel >= 0) {
                    u16* ki = (u16*)(ws + (ksel == 0 ? OFF_KI0 : (ksel == 1 ? OFF_KI1 : OFF_KI2)));
                    const int dmask = (1 << dsh) - 1, lsh = 13 - dsh, numask = (64 >> dsh) - 1;
                    const int kk = l4_ >> 2, c4 = l4_ & 3;
#pragma unroll 4
                    for (int i = 0; i < 16; ++i) {
                        const int rgp = i >> 2, hd = (i >> 1) & 1, half = i & 1;
                        const int tt = rgp * 16 + kk;
                        const int row = ((tt & numask) << dsh) + (tt >> (6 - dsh));
                        const int m = mw + row, b = m >> 13, s = m & 8191;
                        const int p = ((s & dmask) << lsh) + (s >> dsh);
                        const u32x4 v = *(const u32x4*)(est + row * EROW + (hd * 64 + half * 32 + c4 * 8) * 2);
                        *(u32x4*)(ki + ((((size_t)(b * nhv + vth + hd) * 512 + (p >> 4)) * 2 + half) * 16 + (p & 15)) * 32 + c4 * 8) = v;
                    }
                } else {
                u16* hbase = H + (size_t)mw * N + ncol + ch * 8;
#pragma unroll
                for (int i = 0; i < 16; ++i) {
                    const int row = i * 4 + rr;
                    const u32x4 v = *(const u32x4*)(est + row * EROW + ch * 16);
                    *(u32x4*)(hbase + (size_t)row * N) = v;
                }
                }
            }
        }
    }
}

DEV void gemm_out_phase(unsigned char* smem, const Prm& P, const u16* Wt, const float* xin) {
    const int tid_ = opaque_tid();
    const u16* A = (const u16*)(P.ws + OFF_G);
    const int lane = tid_ & 63, w = __builtin_amdgcn_readfirstlane(tid_ >> 6), wm = w >> 1, wn = w & 1, fr = lane & 15, fq = lane >> 4;
    for (int t = vblock(); t < 512; t += gridDim.x) {
        int mi, ni; tile_mn(t, 4, mi, ni);
        const int m0 = mi << 7, n0 = ni << 8;
        f32x4 acc[32]; ZERO_ACC(acc);
        gemm_mainloop<false>(tid_, smem, A, 1024, Wt, 1024, 1024, m0, n0, acc);
        {
            __builtin_amdgcn_s_barrier();
            constexpr int EROWF = 528;
            unsigned char* est = smem + w * (32 * EROWF);
            const size_t ub = (size_t)(m0 + wm * 64) * 1024 + n0 + wn * 128;
            const float* xw = xin + ub; float* ow = P.out + ub;
            int l2_ = lane; asm volatile("" : "+v"(l2_));
            const int fr2 = l2_ & 15, fq2 = l2_ >> 4, rr = l2_ >> 5, ch = l2_ & 31;
#pragma unroll
            for (int h = 0; h < 2; ++h) {
#pragma unroll
                for (int mh = 0; mh < 2; ++mh) {
                    unsigned char* erow = est + (mh * 16 + fr2) * EROWF + fq2 * 16;
#pragma unroll
                    for (int nt = 0; nt < 8; ++nt) *(f32x4*)(erow + nt * 64) = acc[nt * 4 + h * 2 + mh];
                }
                __builtin_amdgcn_fence(__ATOMIC_RELEASE, "wavefront"); __builtin_amdgcn_wave_barrier(); __builtin_amdgcn_fence(__ATOMIC_ACQUIRE, "wavefront");
#pragma unroll 4
                for (int i = 0; i < 16; ++i) {
                    const int row = i * 2 + rr;
                    const unsigned ix = (unsigned)((h * 32 + row) * 1024 + ch * 4);
                    const f32x4 v = *(const f32x4*)(est + row * EROWF + ch * 16);
                    const f32x4 xv = *(const f32x4*)(xw + ix);
                    *(f32x4*)(ow + ix) = xv * DN_ALPHA + v;
                }
                __builtin_amdgcn_fence(__ATOMIC_RELEASE, "wavefront"); __builtin_amdgcn_wave_barrier(); __builtin_amdgcn_fence(__ATOMIC_ACQUIRE, "wavefront");
            }
        }
    }
}

DEV void gemm_gate_phase(unsigned char* smem, const Prm& P, const u16* Wg, const u16* Wp) {
    const int tid_ = opaque_tid();
    const u16* A1 = (const u16*)(P.ws + OFF_XLB);
    const u16* A2 = (const u16*)(P.ws + OFF_PB);
    u16* xb = (u16*)(P.ws + OFF_XB);
    u16* ppb = (u16*)(P.ws + OFF_PP);
    const int lane = tid_ & 63, w = __builtin_amdgcn_readfirstlane(tid_ >> 6), wm = w >> 1, wn = w & 1, fr = lane & 15, fq = lane >> 4;
    for (int t = vblock(); t < 512; t += gridDim.x) {
        int mi, ni; tile_mn(t, 4, mi, ni);
        const int m0 = mi << 7, n0 = ni << 8;
        f32x4 acc[32]; ZERO_ACC(acc);
        gemm_mainloop<false>(tid_, smem, A2, 256, Wp, 256, 256, m0, n0, acc);
        const size_t ub = (size_t)(m0 + wm * 64) * 1024 + n0 + wn * 128;
        float* ow = P.out + ub; u16* pw = ppb + ub; u16* xw = xb + ub;
        {
            int l2_ = lane; asm volatile("" : "+v"(l2_));
            const unsigned lo = (unsigned)((l2_ & 15) * 1024 + (l2_ >> 4) * 4);
#pragma unroll
            for (int mt = 0; mt < 4; ++mt) {
#pragma unroll
                for (int nt = 0; nt < 8; ++nt) { const f32x4 v = acc[nt * 4 + mt]; *(u32x2*)(pw + (lo + mt * 16384 + nt * 16)) = u32x2{pack2(v[0], v[1]), pack2(v[2], v[3])}; }
                __builtin_amdgcn_sched_barrier(0);
            }
        }
        ZERO_ACC(acc);
        gemm_mainloop<false>(tid_, smem, A1, 1024, Wg, 1024, 1024, m0, n0, acc);
        int l3_ = lane; asm volatile("" : "+v"(l3_));
        const unsigned lo = (unsigned)((l3_ & 15) * 1024 + (l3_ >> 4) * 4);
#pragma unroll
        for (int mt = 0; mt < 4; ++mt) {
#pragma unroll
            for (int nt = 0; nt < 8; ++nt) {
                const unsigned ix = lo + mt * 16384 + nt * 16;
                const f32x4 xv = *(const f32x4*)(ow + ix);
                const u32x2 pq = *(const u32x2*)(pw + ix);
                const f32x4 ga = acc[nt * 4 + mt];
                f32x4 r;
                r[0] = xv[0] + sigmoidf_(ga[0]) * bflo(pq[0]); r[1] = xv[1] + sigmoidf_(ga[1]) * bfhi(pq[0]);
                r[2] = xv[2] + sigmoidf_(ga[2]) * bflo(pq[1]); r[3] = xv[3] + sigmoidf_(ga[3]) * bfhi(pq[1]);
                *(f32x4*)(ow + ix) = r;
                *(u32x2*)(xb + kb_off(m0 + wm * 64 + mt * 16 + (l3_ & 15), n0 + wn * 128 + nt * 16 + (l3_ >> 4) * 4, 1024)) = u32x2{pack2(r[0], r[1]), pack2(r[2], r[3])};
            }
            __builtin_amdgcn_sched_barrier(0);
        }
    }
}

DEV void ln_phase(const Prm& P, int layer) {
    const int tid_ = opaque_tid();
    const int lane = tid_ & 63, w = __builtin_amdgcn_readfirstlane(tid_ >> 6);
    const float* g = P.in[12] + layer * 1024; const float* bb = P.in[13] + layer * 1024;
    u16* xlb = (u16*)(P.ws + OFF_XLB);
    for (int row = blockIdx.x * 4 + w; row < T; row += gridDim.x * 4) {
        float* xr = P.out + (size_t)row * 1024;
        f32x4 v[4];
        float s = 0.f;
#pragma unroll
        for (int i = 0; i < 4; ++i) { v[i] = *(const f32x4*)(xr + i * 256 + lane * 4); s += v[i][0] + v[i][1] + v[i][2] + v[i][3]; }
        const float mean = wave_sum(s) * (1.f / 1024.f);
        float q = 0.f;
#pragma unroll
        for (int i = 0; i < 4; ++i)
#pragma unroll
            for (int j = 0; j < 4; ++j) { const float d = v[i][j] - mean; q += d * d; }
        const float rstd = rsqrtf(wave_sum(q) * (1.f / 1024.f) + LN_EPS);
#pragma unroll
        for (int i = 0; i < 4; ++i) {
            const f32x4 gg = *(const f32x4*)(g + i * 256 + lane * 4), bv = *(const f32x4*)(bb + i * 256 + lane * 4);
            f32x4 y;
#pragma unroll
            for (int j = 0; j < 4; ++j) y[j] = (v[i][j] - mean) * rstd * gg[j] + bv[j];
            *(f32x4*)(xr + i * 256 + lane * 4) = y;
            *(u32x2*)(xlb + kb_off(row, i * 256 + lane * 4, 1024)) = u32x2{pack2(y[0], y[1]), pack2(y[2], y[3])};
        }
    }
    const float* p = P.in[1] + (size_t)layer * T * 256; u16* pb = (u16*)(P.ws + OFF_PB);
    const size_t gtid = (size_t)blockIdx.x * 256 + tid_, gsz = (size_t)gridDim.x * 256;
    for (size_t i = gtid; i < (size_t)T * 256 / 8; i += gsz) {
        const f32x4 a = *(const f32x4*)(p + i * 8), b = *(const f32x4*)(p + i * 8 + 4);
        *(u32x4*)(pb + kb_off((int)(i >> 5), (int)(i & 31) * 8, 256)) = u32x4{pack2(a[0], a[1]), pack2(a[2], a[3]), pack2(b[0], b[1]), pack2(b[2], b[3])};
    }
}

struct KV { bf16x8 ka0, ka1, kb0, kb1; bf16x8 v0, v1, v2, v3; };
template <int KH = 1024>
DEV void load_kv(KV& t, const char* Kb, unsigned koa, unsigned kob, const char* Vb, unsigned voa, unsigned vob) {
    t.ka0 = *(const bf16x8*)(Kb + koa); t.ka1 = *(const bf16x8*)(Kb + koa + KH);
    t.kb0 = *(const bf16x8*)(Kb + kob); t.kb1 = *(const bf16x8*)(Kb + kob + KH);
    t.v0 = __builtin_shufflevector(*(const s16x4*)(Vb + voa), *(const s16x4*)(Vb + vob), 0, 1, 2, 3, 4, 5, 6, 7);
    t.v1 = __builtin_shufflevector(*(const s16x4*)(Vb + voa + 512), *(const s16x4*)(Vb + vob + 512), 0, 1, 2, 3, 4, 5, 6, 7);
    t.v2 = __builtin_shufflevector(*(const s16x4*)(Vb + voa + 1024), *(const s16x4*)(Vb + vob + 1024), 0, 1, 2, 3, 4, 5, 6, 7);
    t.v3 = __builtin_shufflevector(*(const s16x4*)(Vb + voa + 1536), *(const s16x4*)(Vb + vob + 1536), 0, 1, 2, 3, 4, 5, 6, 7);
}
DEV unsigned pkrtz(float a, float b) { return __builtin_bit_cast(unsigned, __builtin_amdgcn_cvt_pkrtz(a, b)); }
DEV bf16x8 pack8(const float (&p)[8]) {
    return __builtin_bit_cast(bf16x8, u32x4{pkrtz(p[0], p[1]), pkrtz(p[2], p[3]), pkrtz(p[4], p[5]), pkrtz(p[6], p[7])});
}
DEV void qk_scores(const KV& t, const bf16x8& q0, const bf16x8& q1, f32x4& sa, f32x4& sb) {
    sa = f32x4{0.f, 0.f, 0.f, 0.f}; sb = f32x4{0.f, 0.f, 0.f, 0.f};
    sa = MFMA16(t.ka0, q0, sa); sa = MFMA16(t.ka1, q1, sa);
    sb = MFMA16(t.kb0, q0, sb); sb = MFMA16(t.kb1, q1, sb);
}
constexpr float QK_C = 0.125f * 1.4426950408889634f;
DEV void flash_core(float& mref, float& l, f32x4 (&o)[4], const bf16x8& q0, const bf16x8& q1, const KV& t, bool fast, int d0, unsigned lim) {
    f32x4 sa, sb; qk_scores(t, q0, q1, sa, sb);
    float y[8];
    if (fast) {
#pragma unroll
        for (int j = 0; j < 4; ++j) { y[j] = sa[j] * QK_C; y[4 + j] = sb[j] * QK_C; }
    } else {
#pragma unroll
        for (int j = 0; j < 4; ++j) {
            y[j]     = ((unsigned)(d0 - j) <= lim)      ? sa[j] * QK_C : NEG_INF;
            y[4 + j] = ((unsigned)(d0 - 16 - j) <= lim) ? sb[j] * QK_C : NEG_INF;
        }
    }
    float mx = fmaxf(fmaxf(fmaxf(y[0], y[1]), fmaxf(y[2], y[3])), fmaxf(fmaxf(y[4], y[5]), fmaxf(y[6], y[7])));
    if (__ballot(mx > mref + 8.f) != 0ull) {
        mx = red16_max(mx);
        const float mn = fmaxf(mref, mx);
        const float alpha = (mn == NEG_INF) ? 1.f : __builtin_amdgcn_exp2f(mref - mn);
        l *= alpha;
#pragma unroll
        for (int d = 0; d < 4; ++d) o[d] *= alpha;
        mref = mn;
    }
    const float mu = (mref == NEG_INF) ? 0.f : mref;
    float p[8]; float ps = 0.f;
#pragma unroll
    for (int j = 0; j < 8; ++j) { p[j] = __builtin_amdgcn_exp2f(y[j] - mu); ps += p[j]; }
    l += ps;
    const bf16x8 pf = pack8(p);
    o[0] = MFMA16(t.v0, pf, o[0]); o[1] = MFMA16(t.v1, pf, o[1]); o[2] = MFMA16(t.v2, pf, o[2]); o[3] = MFMA16(t.v3, pf, o[3]);
}

#define RING4(NSTEPS, LOADSTEP, COMPUTE) do { \
    KV cur_; \
    for (int st_ = 0; st_ < (NSTEPS); ++st_) { LOADSTEP(cur_, st_); COMPUTE(cur_, st_); } \
    } while (0)

DEV void band_loop(const int tid_, float& m, float& l, f32x4 (&o)[4], const bf16x8& q0, const bf16x8& q1, const char* Kb,
                   const char* Vb, int vblk0, int ustart, int nsteps, int uq, int uq0, int qspan, int maxd) {
    const int c = tid_ & 15, g4 = (tid_ & 63) >> 4;
    const unsigned kl = c * 64 + g4 * 16, vl = c * 32 + g4 * 8;
    const unsigned lim = (unsigned)min(maxd, uq);
#define BL_LOAD(R, S) do { const int ua_ = ustart + (S) * 32, ub_ = ua_ + 16; \
        const unsigned ba_ = (unsigned)(vblk0 + (max(ua_, 0) >> 4)) * 2048u, bb_ = (unsigned)(vblk0 + (max(ub_, 0) >> 4)) * 2048u; \
        load_kv(R, Kb, ba_ + kl, bb_ + kl, Vb, ba_ + vl, bb_ + vl); } while (0)
#define BL_COMP(R, S) do { const int ua_ = ustart + (S) * 32; \
        const bool fast_ = (ua_ >= 0) && (ua_ + 31 <= uq0) && (uq0 + qspan - ua_ <= maxd); \
        flash_core(m, l, o, q0, q1, R, fast_, uq - ua_ - g4 * 4, lim); } while (0)
    RING4(nsteps, BL_LOAD, BL_COMP);
#undef BL_LOAD
#undef BL_COMP
}

DEV void attnA_phase(const Prm& P, int chunk) {
    const int tid_ = opaque_tid();
    unsigned char* ws = P.ws;
    const u16* H = (const u16*)(ws + OFF_H);
    u16* G = (u16*)(ws + OFF_G);
    const int lane = tid_ & 63, w = __builtin_amdgcn_readfirstlane(tid_ >> 6), c = lane & 15, g4 = lane >> 4;
    constexpr int LD = 2560;
    const int xcd_ = blockIdx.x & 7, slot_ = blockIdx.x >> 3, nslot_ = gridDim.x >> 3;
    for (int i_ = slot_; i_ < 128; i_ += nslot_) {
        const int rq = i_ & 3, tbi = i_ >> 2, hh = xcd_ & 3, b = xcd_ >> 2;
        const int r = w * 4 + rq, tb = tbi * 256;
        const int sq = tb + r + 16 * c;
        const size_t rowq = (size_t)b * 8192 + sq;
        float m = NEG_INF, l = 0.f;
        f32x4 o[4];
#pragma unroll
        for (int d = 0; d < 4; ++d) o[d] = f32x4{0.f, 0.f, 0.f, 0.f};
#pragma unroll 1
        for (int g = 0; g < 3; ++g) {
            const int dsh = 2 * g, dmask = (1 << dsh) - 1;
            const int rg = r & dmask;
            const int uq = sq >> dsh, uq0 = (tb + r) >> dsh;
            int ustart = (uq0 - 128) & ~15;
            const int ulast = (uq0 + (15 << (4 - dsh))) & ~15;
            int ntile = ((ulast - ustart) >> 4) + 1;
            if (ntile & 1) { ustart -= 16; ntile += 1; }
            const u16* Hq = H + rowq * LD + g * 768 + hh * 64 + g4 * 8;
            const bf16x8 q0 = *(const bf16x8*)Hq, q1 = *(const bf16x8*)(Hq + 32);
            const char* Kb = (const char*)((const u16*)(ws + (g == 0 ? OFF_KI0 : (g == 1 ? OFF_KI1 : OFF_KI2))) + ((size_t)(b * 4 + hh) * 512) * 1024);
            const char* Vb = (const char*)((const u16*)(ws + (g == 0 ? OFF_VT0 : (g == 1 ? OFF_VT1 : OFF_VT2))) + ((size_t)(b * 4 + hh) * 512) * 1024);
            const int vblk0 = rg * ((8192 >> dsh) >> 4);
            band_loop(tid_, m, l, o, q0, q1, Kb, Vb, vblk0, ustart, ntile >> 1, uq, uq0, 15 << (4 - dsh), 128);
        }
        l = red16_sum(l);
        const float inv = 1.f / l;
#pragma unroll
        for (int dt = 0; dt < 4; ++dt) {
            const int dh = dt * 16 + g4 * 4;
            const u32x2 z = *(const u32x2*)(H + rowq * LD + 2304 + hh * 64 + dh);
            const float r0 = o[dt][0] * inv * siluf_(bflo(z[0])), r1 = o[dt][1] * inv * siluf_(bfhi(z[0]));
            const float r2 = o[dt][2] * inv * siluf_(bflo(z[1])), r3 = o[dt][3] * inv * siluf_(bfhi(z[1]));
            *(u32x2*)(G + kb_off((int)rowq, (chunk * 4 + hh) * 64 + dh, 1024)) = u32x2{pack2(r0, r1), pack2(r2, r3)};
        }
    }
}

DEV void attnB_phase(const Prm& P) {
    const int tid_ = opaque_tid();
    unsigned char* ws = P.ws;
    const u16* H = (const u16*)(ws + OFF_H);
    u16* G = (u16*)(ws + OFF_G);
    const float* sinks = P.in[5];
    const int lane = tid_ & 63, w = __builtin_amdgcn_readfirstlane(tid_ >> 6), c = lane & 15, g4 = lane >> 4;
    constexpr int LD = 2304;
    const int xcd_ = blockIdx.x & 7, slot_ = blockIdx.x >> 3, nslot_ = gridDim.x >> 3;
    for (int tile = slot_; tile < 512; tile += nslot_) {
        const int b = xcd_ >> 2, hq = xcd_ & 3;
        const int head = hq * 4 + w, kvh = head >> 3;
        const int t0 = tile * 16, sq = t0 + c;
        const size_t rowq = (size_t)b * 8192 + sq;
        float m = NEG_INF, l = 0.f;
        f32x4 o[4];
#pragma unroll
        for (int d = 0; d < 4; ++d) o[d] = f32x4{0.f, 0.f, 0.f, 0.f};
        const u16* Hq = H + rowq * LD + head * 64 + g4 * 8;
        const bf16x8 q0 = *(const bf16x8*)Hq, q1 = *(const bf16x8*)(Hq + 32);
        const char* Kb = (const char*)((const u16*)(ws + OFF_KI0) + ((size_t)(b * 2 + kvh) * 512) * 1024);
        const char* Vb = (const char*)((const u16*)(ws + OFF_VT0) + ((size_t)(b * 2 + kvh) * 512) * 1024);
        band_loop(tid_, m, l, o, q0, q1, Kb, Vb, 0, t0 - 144, 5, sq, t0, 15, 127);
        l = red16_sum(l);
        const float mu = (m == NEG_INF) ? 0.f : m;
        const float lf = l + __builtin_amdgcn_exp2f(sinks[head] * 1.4426950408889634f - mu);
        const float inv = 1.f / lf;
#pragma unroll
        for (int dt = 0; dt < 4; ++dt) {
            const int dh = dt * 16 + g4 * 4;
            const u32x2 z = *(const u32x2*)(H + rowq * LD + 1280 + head * 64 + dh);
            const float r0 = o[dt][0] * inv * siluf_(bflo(z[0])), r1 = o[dt][1] * inv * siluf_(bfhi(z[0]));
            const float r2 = o[dt][2] * inv * siluf_(bflo(z[1])), r3 = o[dt][3] * inv * siluf_(bfhi(z[1]));
            *(u32x2*)(G + kb_off((int)rowq, head * 64 + dh, 1024)) = u32x2{pack2(r0, r1), pack2(r2, r3)};
        }
    }
}

DEV void compress_phase(const Prm& P) {
    const int tid_ = opaque_tid();
    unsigned char* ws = P.ws;
    const u16* H = (const u16*)(ws + OFF_H);
    constexpr int LD = 3840;
    const float* bias = (const float*)(ws + OFF_BIAS);
    const int lane = tid_ & 63, w = __builtin_amdgcn_readfirstlane(tid_ >> 6), c = lane & 15, g4 = lane >> 4;
    for (int it = blockIdx.x; it < 128; it += gridDim.x) {
        const int unit = it * 4 + w;
        const int which = unit >> 8, b = (unit >> 7) & 1, kvh = (unit >> 5) & 3, ntile = unit & 31;
        const u16* Wt = (const u16*)(ws + (which ? OFF_WCV : OFF_WCK));
        const int colbase = (which ? 1280 : 1024) + kvh * 64;
        const int n = ntile * 16 + c;
        const u16* Wl = Wt + c * 32 + g4 * 8;
        f32x4 acc[4];
#pragma unroll
        for (int e = 0; e < 4; ++e) acc[e] = f32x4{0.f, 0.f, 0.f, 0.f};
#pragma unroll 4
        for (int kk = 0; kk < 64; ++kk) {
            const int j = kk >> 1, d0 = (kk & 1) * 32 + g4 * 8;
            int s = 16 * n + j; s = min(s, 8191);
            const bf16x8 xf = *(const bf16x8*)(H + ((size_t)b * 8192 + s) * LD + colbase + d0);
            bf16x8 wf[4];
#pragma unroll
            for (int e = 0; e < 4; ++e) wf[e] = *(const bf16x8*)(Wl + (size_t)(e * 64 + kk) * 512);
            if (which == 0) {
#pragma unroll
                for (int e = 0; e < 4; ++e) acc[e] = MFMA16(wf[e], xf, acc[e]);
            } else {
#pragma unroll
                for (int e = 0; e < 4; ++e) acc[e] = MFMA16(xf, wf[e], acc[e]);
            }
        }
        if (which == 0) {
            u16* kc = (u16*)(ws + OFF_KCMP) + ((size_t)(b * 4 + kvh) * 32 + ntile) * 1024 + c * 32;
#pragma unroll
            for (int e = 0; e < 4; ++e) {
                const int e0 = e * 16 + g4 * 4;
                const f32x4 bv = *(const f32x4*)(bias + e0);
                const f32x4 r = acc[e] + bv;
                *(u32x2*)(kc + (e0 >> 5) * 512 + (e0 & 31)) = u32x2{pack2(r[0], r[1]), pack2(r[2], r[3])};
            }
        } else {
            u16* vc = (u16*)(ws + OFF_VCMP) + (((size_t)(b * 4 + kvh) * 32 + ntile) * 64) * 16;
#pragma unroll
            for (int e = 0; e < 4; ++e) {
                const int ee = e * 16 + c;
                const float bv = bias[64 + ee];
                *(u32x2*)(vc + ee * 16 + g4 * 4) = u32x2{pack2(acc[e][0] + bv, acc[e][1] + bv), pack2(acc[e][2] + bv, acc[e][3] + bv)};
            }
        }
    }
}

DEV void attnC_phase(const Prm& P, unsigned char* smem) {
    const int tid_ = opaque_tid();
    unsigned char* ws = P.ws;
    const u16* H = (const u16*)(ws + OFF_H);
    u16* G = (u16*)(ws + OFF_G);
    constexpr int LD = 3840;
    float* imp = (float*)smem;
    float* scb = (float*)(smem + 32768);
    float* oslc = (float*)(smem + 34816);
    const int tid = tid_, lane = tid & 63, w = __builtin_amdgcn_readfirstlane(tid >> 6), c = lane & 15, g4 = lane >> 4;
    const int xcd_ = blockIdx.x & 7, slot_ = blockIdx.x >> 3, nslot_ = gridDim.x >> 3;
    for (int i = tid; i < 8192; i += 256) imp[i] = 0.f;
    __syncthreads();
    for (int tk_ = 0; tk_ * nslot_ < 512; ++tk_) {
        const int tile = tk_ * nslot_ + ((tk_ & 1) ? (nslot_ - 1 - slot_) : slot_);
        const int b = xcd_ >> 2, kvh = xcd_ & 3;
        const int t0 = tile * 16;
        const int head = kvh * 4 + w;
        const size_t rowq = (size_t)b * 8192 + t0 + c;
        const u16* Hq = H + rowq * LD + head * 64 + g4 * 8;
        const bf16x8 q0 = *(const bf16x8*)Hq, q1 = *(const bf16x8*)(Hq + 32);
        f32x4 oacc[4];
#pragma unroll
        for (int d = 0; d < 4; ++d) oacc[d] = f32x4{0.f, 0.f, 0.f, 0.f};
        const int nmax = (t0 + c - 31) >> 4;
        const int nmaxw = (t0 - 16) >> 4;
        const float g0 = sigmoidf_(bf2f(H[rowq * LD + 3584 + head]));
        const float g1 = sigmoidf_(bf2f(H[rowq * LD + 3584 + 16 + head]));
        const float g2 = sigmoidf_(bf2f(H[rowq * LD + 3584 + 32 + head]));
        if (nmaxw >= 0) {
            const int nsteps = (nmaxw >> 5) + 1;
            const char* Kb = (const char*)((const u16*)(ws + OFF_KCMP) + ((size_t)(b * 4 + kvh) * 32) * 1024);
            const char* Vb = (const char*)((const u16*)(ws + OFF_VCMP) + ((size_t)(b * 4 + kvh) * 32) * 1024);
            const unsigned kl = c * 64 + g4 * 16, vl = c * 32 + g4 * 8;
            float m = NEG_INF, l = 0.f;
#define CM_LOAD(R, S) do { const int na_ = (S) * 32; const unsigned ba_ = (unsigned)(na_ >> 4) * 2048u, bb_ = (unsigned)min((na_ >> 4) + 1, 31) * 2048u; \
        load_kv(R, Kb, ba_ + kl, bb_ + kl, Vb, ba_ + vl, bb_ + vl); } while (0)
#define CM_PASS1(R, S) do { const int na_ = (S) * 32; f32x4 sa, sb; qk_scores(R, q0, q1, sa, sb); float mx = NEG_INF; float x[8]; \
        _Pragma("unroll") for (int j = 0; j < 8; ++j) { const int n = na_ + (j >> 2) * 16 + g4 * 4 + (j & 3); \
            x[j] = (n <= nmax) ? ((j < 4) ? sa[j & 3] : sb[j & 3]) * 0.125f : NEG_INF; mx = fmaxf(mx, x[j]); } \
        const float mn = fmaxf(m, mx); const float mu = (mn == NEG_INF) ? 0.f : mn; float ps = 0.f; \
        _Pragma("unroll") for (int j = 0; j < 8; ++j) ps += __expf(x[j] - mu); \
        l = l * __expf(m - mu) + ps; m = mn; } while (0)
            RING4(nsteps, CM_LOAD, CM_PASS1);
            float mall = red16_max(m);
            mall = (mall == NEG_INF) ? 0.f : mall;
            l = l * __expf(m - mall);
            l = red16_sum(l);
            const float invl = (l > 0.f) ? 1.f / l : 0.f;
#define CM_PASS2(R, S) do { const int na_ = (S) * 32; f32x4 sa, sb; qk_scores(R, q0, q1, sa, sb); float p[8]; \
        _Pragma("unroll") for (int j = 0; j < 8; ++j) { const int n = na_ + (j >> 2) * 16 + g4 * 4 + (j & 3); \
            const float sv = ((j < 4) ? sa[j & 3] : sb[j & 3]) * 0.125f; \
            p[j] = (n <= nmax) ? __expf(sv - mall) * invl : 0.f; \
            if (n <= nmax) atomicAdd(&imp[n * 16 + c], p[j]); } \
        const bf16x8 pf = pack8(p); \
        oacc[0] = MFMA16(R.v0, pf, oacc[0]); oacc[1] = MFMA16(R.v1, pf, oacc[1]); \
        oacc[2] = MFMA16(R.v2, pf, oacc[2]); oacc[3] = MFMA16(R.v3, pf, oacc[3]); } while (0)
            RING4(nsteps, CM_LOAD, CM_PASS2);
#undef CM_LOAD
#undef CM_PASS1
#undef CM_PASS2
#pragma unroll
            for (int d = 0; d < 4; ++d) oacc[d] *= g0;
        }
        {
            float m = NEG_INF, l = 0.f;
            f32x4 o[4];
#pragma unroll
            for (int d = 0; d < 4; ++d) o[d] = f32x4{0.f, 0.f, 0.f, 0.f};
            const char* Kb = (const char*)((const u16*)(ws + OFF_KI1) + ((size_t)(b * 4 + kvh) * 512) * 1024);
            const char* Vb = (const char*)((const u16*)(ws + OFF_VT1) + ((size_t)(b * 4 + kvh) * 512) * 1024);
            band_loop(tid_, m, l, o, q0, q1, Kb, Vb, 0, t0 - 528, 17, t0 + c, t0, 15, 511);
            l = red16_sum(l);
            const float sc = g2 / l;
#pragma unroll
            for (int d = 0; d < 4; ++d) oacc[d] += o[d] * sc;
        }
        __syncthreads();
        unsigned long long* msk = (unsigned long long*)(smem + 51200) + w * 8;
#pragma unroll 1
        for (int i = 0; i < 4; ++i) {
            const int tok = 4 * w + i, tq = t0 + tok, cur = tq >> 6;
            float my0, my1;
            {
                const int j0 = lane, j1 = lane + 64;
                float a0 = 2.f * (imp[(4 * j0) * 16 + tok] + imp[(4 * j0 + 1) * 16 + tok] + imp[(4 * j0 + 2) * 16 + tok]) + imp[(4 * j0 + 3) * 16 + tok];
                if (j0 > 0) a0 += imp[(4 * j0 - 1) * 16 + tok];
                const float a1 = 2.f * (imp[(4 * j1) * 16 + tok] + imp[(4 * j1 + 1) * 16 + tok] + imp[(4 * j1 + 2) * 16 + tok]) + imp[(4 * j1 + 3) * 16 + tok]
                                 + imp[(4 * j1 - 1) * 16 + tok];
                const bool f0 = (j0 == 0) || (j0 == cur) || (j0 == cur - 1);
                const bool f1 = (j1 == cur) || (j1 == cur - 1);
                my0 = f0 ? 1e4f : ((j0 <= cur) ? a0 : -1.f);
                my1 = f1 ? 1e4f : ((j1 <= cur) ? a1 : -1.f);
            }
            const unsigned k0 = (lane <= cur) ? (__float_as_uint(my0) + 1u) : 0u;
            const unsigned k1 = (lane + 64 <= cur) ? (__float_as_uint(my1) + 1u) : 0u;
            unsigned T = 0u;
#pragma unroll
            for (int bit = 31; bit >= 0; --bit) {
                const unsigned tr = T | (1u << bit);
                const int cnt = __builtin_popcountll(__ballot(k0 >= tr)) + __builtin_popcountll(__ballot(k1 >= tr));
                if (cnt >= 16) T = tr;
            }
            const unsigned long long eq0 = __ballot(k0 == T), eq1 = __ballot(k1 == T);
            const int need = 16 - __builtin_popcountll(__ballot(k0 > T)) - __builtin_popcountll(__ballot(k1 > T));
            const unsigned long long lm = (1ull << lane) - 1ull;
            const bool s0 = (k0 > 0u) && (k0 > T || (k0 == T && __builtin_popcountll(eq0 & lm) < need));
            const bool s1 = (k1 > 0u) && (k1 > T || (k1 == T && __builtin_popcountll(eq0) + __builtin_popcountll(eq1 & lm) < need));
            const unsigned long long lo = __ballot(s0);
            const unsigned long long hi = __ballot(s1);
            if (lane == 0) { msk[i * 2] = lo; msk[i * 2 + 1] = hi; }
        }
#pragma unroll 4
        for (int i = 0; i < 32; ++i) { const int e = i * 64 + lane; imp[(e >> 2) * 16 + 4 * w + (e & 3)] = 0.f; }
        __builtin_amdgcn_fence(__ATOMIC_RELEASE, "wavefront"); __builtin_amdgcn_wave_barrier(); __builtin_amdgcn_fence(__ATOMIC_ACQUIRE, "wavefront");
        {
            const int tokL = 4 * w + (c >> 2), tq = t0 + tokL, hd = kvh * 4 + (c & 3);
            const size_t rq = (size_t)b * 8192 + tq;
            const u16* Hs = H + rq * LD + hd * 64 + g4 * 8;
            const bf16x8 s0 = *(const bf16x8*)Hs, s1 = *(const bf16x8*)(Hs + 32);
            const char* Kb = (const char*)((const u16*)(ws + OFF_KI0) + ((size_t)(b * 4 + kvh) * 512) * 1024);
            const char* Vb = (const char*)((const u16*)(ws + OFF_VT0) + ((size_t)(b * 4 + kvh) * 512) * 1024);
            const unsigned kl = c * 64 + g4 * 16, vl = c * 32 + g4 * 8;
            float m = NEG_INF, l = 0.f;
            f32x4 o[4];
#pragma unroll
            for (int d = 0; d < 4; ++d) o[d] = f32x4{0.f, 0.f, 0.f, 0.f};
            const int ti = c >> 2;
            const unsigned long long mylo = msk[ti * 2], myhi = msk[ti * 2 + 1];
            const unsigned long long ulo = msk[0] | msk[2] | msk[4] | msk[6];
            const unsigned long long uhi = msk[1] | msk[3] | msk[5] | msk[7];
            const unsigned long long alo = msk[0] & msk[2] & msk[4] & msk[6], ahi = msk[1] & msk[3] & msk[5] & msk[7];
            int* blist = (int*)(scb + w * 128);
            const int nlo = __builtin_popcountll(ulo), nblk = nlo + __builtin_popcountll(uhi);
            if ((ulo >> lane) & 1ull) blist[__builtin_popcountll(ulo & ((1ull << lane) - 1ull))] = lane;
            if ((uhi >> lane) & 1ull) blist[nlo + __builtin_popcountll(uhi & ((1ull << lane) - 1ull))] = 64 + lane;
            __builtin_amdgcn_fence(__ATOMIC_RELEASE, "wavefront");
            __builtin_amdgcn_wave_barrier();
            __builtin_amdgcn_fence(__ATOMIC_ACQUIRE, "wavefront");
            const int nst = 2 * nblk;
#define SL_LOAD(R, S) do { const int j_ = __builtin_amdgcn_readfirstlane(blist[(S) >> 1]); const int ua_ = j_ * 64 + ((S) & 1) * 32; \
        load_kv(R, Kb, (unsigned)(ua_ >> 4) * 2048u + kl, (unsigned)((ua_ >> 4) + 1) * 2048u + kl, \
                Vb, (unsigned)(ua_ >> 4) * 2048u + vl, (unsigned)((ua_ >> 4) + 1) * 2048u + vl); } while (0)
#define SL_COMP(R, S) do { const int j_ = __builtin_amdgcn_readfirstlane(blist[(S) >> 1]); const int ua_ = j_ * 64 + ((S) & 1) * 32; \
        const bool selj = (j_ < 64) ? ((mylo >> j_) & 1ull) : ((myhi >> (j_ - 64)) & 1ull); \
        const bool alls_ = (j_ < 64) ? ((alo >> j_) & 1ull) : ((ahi >> (j_ - 64)) & 1ull); \
        const bool fast_ = alls_ && (ua_ + 31 <= t0 + 4 * w); \
        flash_core(m, l, o, s0, s1, R, fast_, selj ? (tq - ua_ - g4 * 4) : -(1 << 30), 0x7fffffffu); } while (0)
            RING4(nst, SL_LOAD, SL_COMP);
#undef SL_LOAD
#undef SL_COMP
            l = red16_sum(l);
            const float inv = 1.f / l;
#pragma unroll
            for (int dt = 0; dt < 4; ++dt)
                *(f32x4*)(oslc + (tokL * 4 + (c & 3)) * 64 + dt * 16 + g4 * 4) = o[dt] * inv;
        }
        __syncthreads();
#pragma unroll
        for (int dt = 0; dt < 4; ++dt) {
            const int dh = dt * 16 + g4 * 4;
            const f32x4 os = *(const f32x4*)(oslc + (c * 4 + w) * 64 + dh);
            const f32x4 r = oacc[dt] + os * g1;
            const u32x2 z = *(const u32x2*)(H + rowq * LD + 2560 + head * 64 + dh);
            const float r0 = r[0] * siluf_(bflo(z[0])), r1 = r[1] * siluf_(bfhi(z[0]));
            const float r2 = r[2] * siluf_(bflo(z[1])), r3 = r[3] * siluf_(bfhi(z[1]));
            *(u32x2*)(G + kb_off((int)rowq, head * 64 + dh, 1024)) = u32x2{pack2(r0, r1), pack2(r2, r3)};
        }
    }
}

#ifndef PROBE_DUP
#define PROBE_DUP 0
#endif
#define REP(k) for (int rep_ = 0; rep_ < 1 + ((PROBE_DUP >> (k)) & 1); ++rep_)
constexpr int LDS_BYTES = 3 * GSTAGE + 64;
__global__ void __launch_bounds__(256, 2) mk_fwd(Prm P) {
    extern __shared__ __attribute__((aligned(16))) unsigned char smem[];
    unsigned* xb_words = (unsigned*)(smem + 3 * GSTAGE);
    if (threadIdx.x < 4) xb_words[threadIdx.x] = 0u;
    __syncthreads();
    XcdBarrier bar = xcd_barrier_post((unsigned*)(P.ws + OFF_BAR), (volatile LAS unsigned*)xb_words);
    unsigned char* ws = P.ws;

    phase0(P, smem);
    if (P.ws == nullptr) cg::this_grid().sync();
    xcd_barrier(bar);

#pragma unroll 1
    for (int layer = 0; layer < 4; ++layer) {
        const int kind = layer % 3, lj = layer / 3;
        const u16* Win; const u16* Wout; int N, nsub;
        if (kind == 0)      { Win = (const u16*)(ws + OFF_WA_IN + (size_t)lj * SZ_WA_IN); Wout = (const u16*)(ws + OFF_WA_OUT + (size_t)lj * SZ_SQ); N = 2560; nsub = 4; }
        else if (kind == 1) { Win = (const u16*)(ws + OFF_WB_IN); Wout = (const u16*)(ws + OFF_WB_OUT); N = 2304; nsub = 1; }
        else                { Win = (const u16*)(ws + OFF_WC_IN); Wout = (const u16*)(ws + OFF_WC_OUT); N = 3840; nsub = 1; }
#pragma unroll 1
        for (int sub = 0; sub < nsub; ++sub) {
            REP(0) gemm_in_phase(smem, P, kind, Win + (size_t)sub * 2560 * 1024, N);
            xcd_barrier(bar);
            if (kind == 0) REP(1) attnA_phase(P, sub);
            else if (kind == 1) REP(2) attnB_phase(P);
            else { REP(3) compress_phase(P); xcd_barrier(bar); REP(4) attnC_phase(P, smem); }
            xcd_barrier(bar);
        }
        gemm_out_phase(smem, P, Wout, layer == 0 ? P.in[0] : P.out);
        xcd_barrier(bar);
        ln_phase(P, layer);
        xcd_barrier(bar);
        gemm_gate_phase(smem, P, (const u16*)(ws + OFF_WG + (size_t)layer * SZ_SQ), (const u16*)(ws + OFF_WP + (size_t)layer * SZ_WP));
        if (layer < 3) xcd_barrier(bar);
    }
}

extern "C" void kernel_launch(void* const* d_in, const int* in_sizes, int n_in, void* d_out, int out_size, void* d_ws, size_t ws_size,
                              hipStream_t stream) {
    static int grid_blocks = 0;
    if (!grid_blocks) {
        int dev = 0, cus = 0, per_cu = 0;
        (void)hipGetDevice(&dev);
        (void)hipDeviceGetAttribute(&cus, hipDeviceAttributeMultiprocessorCount, dev);
        (void)hipFuncSetAttribute((const void*)mk_fwd, hipFuncAttributeMaxDynamicSharedMemorySize, LDS_BYTES);
        (void)hipOccupancyMaxActiveBlocksPerMultiprocessor(&per_cu, (const void*)mk_fwd, 256, LDS_BYTES);
        if (per_cu > 2) per_cu = 2;
        if (per_cu < 1) per_cu = 1;
        grid_blocks = cus * per_cu;
        if (ws_size < WS_END || n_in != 16) { fprintf(stderr, "kernel_launch: workspace too small (%zu < %zu) or n_in %d != 16\n", ws_size, (size_t)WS_END, n_in); grid_blocks = -1; }
    }
    if (grid_blocks < 0) return;
    (void)hipMemsetAsync((char*)d_ws + OFF_BAR, 0, 16384, stream);
    Prm p{};
    for (int i = 0; i < 16; ++i) p.in[i] = (const float*)d_in[i];
    p.out = (float*)d_out; p.ws = (unsigned char*)d_ws;
    void* args[] = {&p};
    hipError_t e = hipLaunchCooperativeKernel((const void*)mk_fwd, dim3(grid_blocks), dim3(256), args, LDS_BYTES, stream);
    if (e != hipSuccess) fprintf(stderr, "cooperative launch failed: %s (grid %d)\n", hipGetErrorString(e), grid_blocks);
}
```

```cpp
#include <hip/hip_runtime.h>
#include <hip/hip_cooperative_groups.h>
#include <cstdio>
#include <cstdint>
namespace cg = cooperative_groups;

typedef unsigned short u16;
using bf16x8 = __attribute__((ext_vector_type(8))) short;
using s16x4  = __attribute__((ext_vector_type(4))) short;
using f32x4  = __attribute__((ext_vector_type(4))) float;
using u32x4  = __attribute__((ext_vector_type(4))) unsigned;
using u32x2  = __attribute__((ext_vector_type(2))) unsigned;
#define DEV __device__ __forceinline__
using h16x8 = __attribute__((ext_vector_type(8))) _Float16;
#define MFMA16(a, b, c) __builtin_amdgcn_mfma_f32_16x16x32_f16(__builtin_bit_cast(h16x8, (a)), __builtin_bit_cast(h16x8, (b)), (c), 0, 0, 0)
#define LAS __attribute__((address_space(3)))

constexpr int T = 16384, S = 8192;
constexpr float LN_EPS = 1e-5f;
constexpr float DN_ALPHA = 1.6817928305074290f;
constexpr float NEG_INF = -__builtin_huge_valf();

constexpr size_t OFF_BAR   = 0;
constexpr size_t OFF_COS   = 16384;
constexpr size_t OFF_SIN   = OFF_COS + (size_t)8192 * 32 * 4;
constexpr size_t OFF_BIAS  = OFF_SIN + (size_t)8192 * 32 * 4;
constexpr size_t OFF_WA_IN = OFF_BIAS + 1024;
constexpr size_t SZ_WA_IN  = (size_t)10240 * 1024 * 2;
constexpr size_t SZ_SQ     = (size_t)1024 * 1024 * 2;
constexpr size_t OFF_WA_OUT = OFF_WA_IN + 2 * SZ_WA_IN;
constexpr size_t OFF_WB_IN  = OFF_WA_OUT + 2 * SZ_SQ;
constexpr size_t OFF_WB_OUT = OFF_WB_IN + (size_t)2304 * 1024 * 2;
constexpr size_t OFF_WC_IN  = OFF_WB_OUT + SZ_SQ;
constexpr size_t OFF_WC_OUT = OFF_WC_IN + (size_t)3840 * 1024 * 2;
constexpr size_t OFF_WG     = OFF_WC_OUT + SZ_SQ;
constexpr size_t OFF_WP     = OFF_WG + 4 * SZ_SQ;
constexpr size_t SZ_WP      = (size_t)1024 * 256 * 2;
constexpr size_t OFF_WCK    = OFF_WP + 4 * SZ_WP;
constexpr size_t OFF_WCV    = OFF_WCK + (size_t)64 * 2048 * 2;
constexpr size_t OFF_XB     = OFF_WCV + (size_t)64 * 2048 * 2;
constexpr size_t SZ_ACT     = (size_t)T * 1024 * 2;
constexpr size_t OFF_G      = OFF_XB + SZ_ACT;
constexpr size_t OFF_H      = OFF_G + SZ_ACT;
constexpr size_t SZ_HMAX    = (size_t)T * 3840 * 2;
constexpr size_t OFF_VT0    = OFF_H + SZ_HMAX;
constexpr size_t SZ_VT      = (size_t)2 * 4 * 8192 * 64 * 2;
constexpr size_t OFF_VT1    = OFF_VT0 + SZ_VT;
constexpr size_t OFF_VT2    = OFF_VT1 + SZ_VT;
constexpr size_t OFF_KCMP   = OFF_VT2 + SZ_VT;
constexpr size_t SZ_CMP     = (size_t)2 * 512 * 4 * 64 * 2;
constexpr size_t OFF_VCMP   = OFF_KCMP + SZ_CMP;
constexpr size_t OFF_KI0    = OFF_VCMP + SZ_CMP;
constexpr size_t OFF_KI1    = OFF_KI0 + SZ_VT;
constexpr size_t OFF_KI2    = OFF_KI1 + SZ_VT;
constexpr size_t WS_END     = OFF_KI2 + SZ_VT;
constexpr size_t OFF_XLB    = OFF_H;
constexpr size_t OFF_PB     = OFF_H + SZ_ACT;
constexpr size_t OFF_PP     = OFF_H + SZ_ACT + (size_t)16 * 1024 * 1024;

struct Prm { const float* in[16]; float* out; unsigned char* ws; };

__device__ __forceinline__ size_t kb_off(int row, int k, int K) { return ((size_t)(row >> 4) * (K >> 5) + (k >> 5)) * 512 + (row & 15) * 32 + (k & 31); }
DEV u16 f2bf(float f) { return __builtin_bit_cast(u16, (_Float16)f); }
DEV float bf2f(u16 h) { return (float)__builtin_bit_cast(_Float16, h); }
DEV unsigned pack2(float a, float b) { return (unsigned)f2bf(a) | ((unsigned)f2bf(b) << 16); }
DEV float bflo(unsigned u) { return bf2f((u16)(u & 0xffffu)); }
DEV float bfhi(unsigned u) { return bf2f((u16)(u >> 16)); }
DEV float sigmoidf_(float x) { return 1.f / (1.f + __expf(-x)); }
DEV float siluf_(float x) { return x / (1.f + __expf(-x)); }
DEV float red16_max(float v) { v = fmaxf(v, __shfl_xor(v, 16)); v = fmaxf(v, __shfl_xor(v, 32)); return v; }
DEV float red16_sum(float v) { v += __shfl_xor(v, 16); v += __shfl_xor(v, 32); return v; }
DEV float wave_sum(float v) { for (int o = 32; o > 0; o >>= 1) v += __shfl_xor(v, o); return v; }

DEV int opaque_tid() { int t = threadIdx.x; asm volatile("" : "+v"(t)); return t; }
#define XB_TMO      128
#define XB_XCNT(j)  (256  + 64 * (j))
#define XB_XSUB(j)  (1280 + 64 * (j))
#define XB_XGEN(j)  (2304 + 64 * (j))
#define XB_TOP      3328
#define XB_TOPGEN   3392
#define XCD_BAR_WORDS 3456
#define XB_SPIN_CAP (1u << 24)
DEV unsigned xb_ld(unsigned* p)              { return __hip_atomic_load(p, __ATOMIC_RELAXED, __HIP_MEMORY_SCOPE_AGENT); }
DEV unsigned xb_add(unsigned* p, unsigned v) { return __hip_atomic_fetch_add(p, v, __ATOMIC_RELAXED, __HIP_MEMORY_SCOPE_AGENT); }
DEV unsigned xb_xcc_id() { return (unsigned)__builtin_amdgcn_s_getreg((3 << 11) | 20) & 0xFu; }
#define XB_SPIN(cond, bar) do { unsigned _sp = 0; while (cond) { __builtin_amdgcn_s_sleep(1); \
    if ((++_sp & 255u) == 0u) { if (xb_ld(&(bar)[XB_TMO])) break; if (_sp > XB_SPIN_CAP) { atomicAdd(&(bar)[XB_TMO], 1u); break; } } } } while (0)
struct XcdBarrier { unsigned* bar; unsigned x; volatile LAS unsigned* st; };
DEV XcdBarrier xcd_barrier_post(unsigned* bar, volatile LAS unsigned* st) {
    XcdBarrier b; b.bar = bar; b.x = xb_xcc_id(); b.st = st;
    if (threadIdx.x == 0) (void)xb_add(&bar[XB_XCNT(b.x)], 1u);
    return b;
}
DEV void xcd_barrier_complete(unsigned* bar, unsigned x, unsigned& nloc, unsigned& nx) {
    const unsigned G = gridDim.x * gridDim.y * gridDim.z;
    unsigned sum, cnt, mine, sp = 0u;
    for (;;) {
        sum = 0u; cnt = 0u; mine = 0u;
#pragma unroll
        for (unsigned j = 0; j < 16; ++j) { const unsigned c = xb_ld(&bar[XB_XCNT(j)]); sum += c; cnt += (c > 0u) ? 1u : 0u; mine = (j == x) ? c : mine; }
        if (sum == G) break;
        __builtin_amdgcn_s_sleep(1);
        if ((++sp & 255u) == 0u) { if (xb_ld(&bar[XB_TMO])) break; if (sp > XB_SPIN_CAP) { atomicAdd(&bar[XB_TMO], 1u); break; } }
    }
    nloc = mine > 0u ? mine : 1u; nx = cnt > 0u ? cnt : 1u;
}
DEV void xcd_barrier(const XcdBarrier& b) {
    asm volatile("s_waitcnt vmcnt(0)" ::: "memory");
    __syncthreads();
    if (threadIdx.x == 0) {
        unsigned* bar = b.bar;
        __builtin_amdgcn_s_waitcnt(0);
        unsigned nloc = b.st[0], nx = b.st[1];
        if (nloc == 0u) { xcd_barrier_complete(bar, b.x, nloc, nx); b.st[0] = nloc; b.st[1] = nx; }
        const unsigned old = xb_add(&bar[XB_XSUB(b.x)], 1u);
        const unsigned gen = old / nloc;
        if (old + 1u == (gen + 1u) * nloc) {
            __builtin_amdgcn_fence(__ATOMIC_RELEASE, "agent");
            asm volatile("s_waitcnt vmcnt(0)" ::: "memory");
            const unsigned og = xb_add(&bar[XB_TOP], 1u);
            const unsigned tg = og / nx;
            if (og + 1u == (tg + 1u) * nx) xb_add(&bar[XB_TOPGEN], 1u);
            else XB_SPIN(xb_ld(&bar[XB_TOPGEN]) == tg, bar);
            __builtin_amdgcn_fence(__ATOMIC_ACQUIRE, "agent");
            xb_add(&bar[XB_XGEN(b.x)], 1u);
            asm volatile("s_waitcnt vmcnt(0)" ::: "memory");
        } else {
            XB_SPIN(xb_ld(&bar[XB_XGEN(b.x)]) == gen, bar);
            __builtin_amdgcn_fence(__ATOMIC_ACQUIRE, "agent");
            asm volatile("s_waitcnt vmcnt(0)" ::: "memory");
        }
    }
    __syncthreads();
}

DEV int colmap(int kind, int n) {
    if (kind == 0) return n;
    if (kind == 1) {
        const int c = n / 2560, nn = n - c * 2560;
        if (nn < 2304) { const int g = nn / 768, rem = nn - g * 768, part = rem >> 8, hh = (rem & 255) >> 6, d = rem & 63;
                         return g * 3072 + part * 1024 + (c * 4 + hh) * 64 + d; }
        const int z = nn - 2304; return 9216 + (c * 4 + (z >> 6)) * 64 + (z & 63);
    }
    if (n < 2560) return n;
    if (n < 3584) return n - 2560 + 2608;
    if (n < 3632) return n - 3584 + 2560;
    return -1;
}
DEV void tconv(const int tid_, float* lds, const float* __restrict__ src, int K, int Nsrc, u16* __restrict__ dst, int Ndst, int kind, int& acc_tiles) {
    const int G = gridDim.x, tid = tid_;
    const int ntn = Ndst >> 6, ntk = K >> 6, nt = ntn * ntk;
    int first = ((int)blockIdx.x - (acc_tiles % G) + G) % G;
    acc_tiles += nt;
    for (int t = first; t < nt; t += G) {
        const int tn = t / ntk, tk = t - tn * ntk;
        const int n0 = tn << 6, k0 = tk << 6;
        const int nl = tid & 63;
        const int c = colmap(kind, n0 + nl);
#pragma unroll
        for (int i = 0; i < 16; ++i) {
            const int kl = (tid >> 6) + 4 * i;
            const float v = (c >= 0) ? src[(size_t)(k0 + kl) * Nsrc + c] : 0.f;
            lds[kl * 65 + nl] = v;
        }
        __syncthreads();
        const int r = tid >> 2, kk = (tid & 3) << 4;
        unsigned o[8];
#pragma unroll
        for (int i = 0; i < 8; ++i) o[i] = pack2(lds[(kk + 2 * i) * 65 + r], lds[(kk + 2 * i + 1) * 65 + r]);
        u32x4* dp = (u32x4*)(dst + kb_off(n0 + r, k0 + kk, K));
        dp[0] = u32x4{o[0], o[1], o[2], o[3]};
        dp[1] = u32x4{o[4], o[5], o[6], o[7]};
        __syncthreads();
    }
}

DEV void phase0(const Prm& P, unsigned char* smem) {
    const int tid_ = opaque_tid();
    float* lds = (float*)smem;
    unsigned char* ws = P.ws;
    int acc = 0;
    tconv(tid_, lds, P.in[2], 1024, 10240, (u16*)(ws + OFF_WA_IN), 10240, 1, acc);
    tconv(tid_, lds, P.in[2] + (size_t)1024 * 10240, 1024, 10240, (u16*)(ws + OFF_WA_IN + SZ_WA_IN), 10240, 1, acc);
    tconv(tid_, lds, P.in[3], 1024, 1024, (u16*)(ws + OFF_WA_OUT), 1024, 0, acc);
    tconv(tid_, lds, P.in[3] + (size_t)1024 * 1024, 1024, 1024, (u16*)(ws + OFF_WA_OUT + SZ_SQ), 1024, 0, acc);
    tconv(tid_, lds, P.in[4], 1024, 2304, (u16*)(ws + OFF_WB_IN), 2304, 0, acc);
    tconv(tid_, lds, P.in[6], 1024, 1024, (u16*)(ws + OFF_WB_OUT), 1024, 0, acc);
    tconv(tid_, lds, P.in[7], 1024, 3632, (u16*)(ws + OFF_WC_IN), 3840, 2, acc);
    tconv(tid_, lds, P.in[11], 1024, 1024, (u16*)(ws + OFF_WC_OUT), 1024, 0, acc);
    for (int i = 0; i < 4; ++i) {
        tconv(tid_, lds, P.in[15] + (size_t)i * 1024 * 1024, 1024, 1024, (u16*)(ws + OFF_WG + i * SZ_SQ), 1024, 0, acc);
        tconv(tid_, lds, P.in[14] + (size_t)i * 256 * 1024, 256, 1024, (u16*)(ws + OFF_WP + i * SZ_WP), 1024, 0, acc);
    }
    tconv(tid_, lds, P.in[8], 2048, 64, (u16*)(ws + OFF_WCK), 64, 0, acc);
    tconv(tid_, lds, P.in[9], 2048, 64, (u16*)(ws + OFF_WCV), 64, 0, acc);

    const size_t gtid = (size_t)blockIdx.x * 256 + tid_, gsz = (size_t)gridDim.x * 256;
    {
        const float* x = P.in[0]; u16* xb = (u16*)(ws + OFF_XB);
        for (size_t i = gtid; i < (size_t)T * 1024 / 8; i += gsz) {
            const f32x4 a = *(const f32x4*)(x + i * 8), b = *(const f32x4*)(x + i * 8 + 4);
            *(u32x4*)(xb + kb_off((int)(i >> 7), (int)(i & 127) * 8, 1024)) = u32x4{pack2(a[0], a[1]), pack2(a[2], a[3]), pack2(b[0], b[1]), pack2(b[2], b[3])};
        }
    }
    {
        float* ct = (float*)(ws + OFF_COS); float* st = (float*)(ws + OFF_SIN);
        for (size_t i = gtid; i < (size_t)8192 * 32; i += gsz) {
            const int pos = (int)(i >> 5), k = (int)(i & 31);
            const float inv = (float)(1.0 / pow(10000.0, (double)(2 * k) / 64.0));
            const float ang = (float)pos * inv;
            ct[i] = (float)cos((double)ang); st[i] = (float)sin((double)ang);
        }
    }
    {
        const int lane = tid_ & 63;
        const int wid = blockIdx.x * 4 + __builtin_amdgcn_readfirstlane(tid_ >> 6);
        if (wid < 128) {
            const float* w = (wid < 64) ? P.in[8] : P.in[9];
            const int e = wid & 63;
            float s = 0.f;
            for (int jd = lane; jd < 2048; jd += 64) s += P.in[10][jd] * w[(size_t)jd * 64 + e];
            s = wave_sum(s);
            if (lane == 0) ((float*)(ws + OFF_BIAS))[wid] = s;
        }
    }
}

constexpr int GSTAGE = 24576;
DEV int gsw(int r) { return (0x78 >> (2 * ((r >> 2) & 3))) & 3; }
DEV void gemm_issue(unsigned char* stage, const u16* ag0, const u16* ag1, const u16* bg, int bstep, int kt, int w) {
    __builtin_amdgcn_global_load_lds((const unsigned*)(ag0 + kt * 512), (unsigned*)(stage + w * 1024), 16, 0, 0);
    __builtin_amdgcn_global_load_lds((const unsigned*)(ag1 + kt * 512), (unsigned*)(stage + w * 1024 + 4096), 16, 0, 0);
#pragma unroll
    for (int i = 0; i < 4; ++i)
        __builtin_amdgcn_global_load_lds((const unsigned*)(bg + (size_t)i * bstep + kt * 512), (unsigned*)(stage + 8192 + w * 1024 + i * 4096), 16, 0, 0);
}
template <bool NONSWAP>
DEV void gemm_mainloop(const int tid_, unsigned char* smem, const u16* __restrict__ A, int lda, const u16* __restrict__ Bt, int ldb, int K,
                       int m0, int n0, f32x4 (&acc)[32], bool aperm = false) {
    const int tid = tid_, lane = tid & 63, w = __builtin_amdgcn_readfirstlane(tid >> 6), wm = w >> 1, wn = w & 1;
    const int lrow = tid >> 2, lsw = ((tid & 3) ^ gsw(lrow)) * 8;
    const int arow0 = aperm ? ((lrow & 31) * 4 + (lrow >> 5)) : lrow;
    const int arow1 = aperm ? (arow0 + 2) : (lrow + 64);
    const u16* ag0 = A + kb_off(m0 + arow0, 0, lda) + lsw;
    const u16* ag1 = A + kb_off(m0 + arow1, 0, lda) + lsw;
    const u16* bg = Bt + kb_off(n0 + lrow, 0, ldb) + lsw;
    const int bstep = 4 * (ldb >> 5) * 512;
    const int fr = lane & 15, fq = lane >> 4;
    const int coff = (fq ^ gsw(fr)) << 4;
    const int a_base = (wm * 64 + fr) * 64 + coff, b_base = 8192 + (wn * 128 + fr) * 64 + coff;
    const int nk = K >> 5;
    asm volatile("s_waitcnt vmcnt(0)" ::: "memory");
    __builtin_amdgcn_s_barrier();
    gemm_issue(smem, ag0, ag1, bg, bstep, 0, w);
    gemm_issue(smem + GSTAGE, ag0, ag1, bg, bstep, 1, w);
    int sc = 0, si = 2;
    for (int kt = 0; kt < nk; ++kt) {
        if (kt + 1 < nk) asm volatile("s_waitcnt vmcnt(6)" ::: "memory"); else asm volatile("s_waitcnt vmcnt(0)" ::: "memory");
        __builtin_amdgcn_s_barrier();
        if (kt + 2 < nk) { gemm_issue(smem + si * GSTAGE, ag0, ag1, bg, bstep, kt + 2, w); si = (si == 2) ? 0 : si + 1; }
        const unsigned char* st = smem + sc * GSTAGE; sc = (sc == 2) ? 0 : sc + 1;
        bf16x8 a[4], b[4];
#pragma unroll
        for (int i = 0; i < 4; ++i) a[i] = *(const bf16x8*)(st + a_base + i * 1024);
#pragma unroll
        for (int hb = 0; hb < 2; ++hb) {
#pragma unroll
            for (int i = 0; i < 4; ++i) b[i] = *(const bf16x8*)(st + b_base + (hb * 4 + i) * 1024);
            if (NONSWAP) {
#pragma unroll
                for (int mt = 0; mt < 4; ++mt)
#pragma unroll
                    for (int nt = 0; nt < 4; ++nt) acc[mt * 8 + hb * 4 + nt] = MFMA16(a[mt], b[nt], acc[mt * 8 + hb * 4 + nt]);
            } else {
#pragma unroll
                for (int nt = 0; nt < 4; ++nt)
#pragma unroll
                    for (int mt = 0; mt < 4; ++mt) acc[(hb * 4 + nt) * 4 + mt] = MFMA16(b[nt], a[mt], acc[(hb * 4 + nt) * 4 + mt]);
            }
        }
    }
}

DEV int vblock() { const int G = gridDim.x, b = blockIdx.x; return ((G & 7) == 0) ? (b & 7) * (G >> 3) + (b >> 3) : b; }
DEV void tile_mn(int t, int nN, int& mi, int& ni) { const int per = 8 * nN; const int mg = t / per, r = t - mg * per; mi = mg * 8 + (r & 7); ni = r >> 3; }
#define ZERO_ACC(acc) _Pragma("unroll") for (int i_ = 0; i_ < 32; ++i_) acc[i_] = f32x4{0.f, 0.f, 0.f, 0.f}

DEV void classify(int kind, int cgi, int& mode, int& vsel, int& vth, int& dsh, int& nhv, int& ksel) {
    mode = 0; vsel = 0; vth = 0; dsh = 0; nhv = 4; ksel = -1;
    if (kind == 0) {
        if (cgi < 36) { const int g = cgi / 12, part = (cgi - g * 12) >> 2; vth = cgi & 3; if (part < 2) { mode = 1; if (part == 1) { ksel = g; dsh = 2 * g; } } else { mode = 2; vsel = g; dsh = 2 * g; } }
    } else if (kind == 1) {
        if (cgi < 16) mode = 1; else if (cgi < 18) { mode = 1; ksel = 0; vth = cgi - 16; nhv = 2; } else if (cgi < 20) { mode = 2; vsel = 0; vth = cgi - 18; nhv = 2; }
    } else {
        if (cgi < 20) mode = 1; else if (cgi < 24) mode = 0; else if (cgi < 28) { mode = 1; ksel = 0; vth = cgi - 24; } else if (cgi < 32) { mode = 2; vsel = 0; vth = cgi - 28; }
        else if (cgi < 36) { mode = 1; ksel = 1; vth = cgi - 32; } else if (cgi < 40) { mode = 2; vsel = 1; vth = cgi - 36; }
    }
}

DEV void gemm_in_phase(unsigned char* smem, const Prm& P, int kind, const u16* Wt, int N) {
    const int tid_ = opaque_tid();
    unsigned char* ws = P.ws;
    const u16* A = (const u16*)(ws + OFF_XB);
    u16* H = (u16*)(ws + OFF_H);
    const float* cosT = (const float*)(ws + OFF_COS); const float* sinT = (const float*)(ws + OFF_SIN);
    const int nN = N >> 8, ntiles = 128 * nN;
    const int lane = tid_ & 63, w = __builtin_amdgcn_readfirstlane(tid_ >> 6), wm = w >> 1, wn = w & 1, fr = lane & 15, fq = lane >> 4;
    const int G_ = gridDim.x, vb_ = vblock(), nfull_ = ntiles / G_, R_ = ntiles - nfull_ * G_;
    const int per_x = ((G_ & 7) == 0) ? (G_ >> 3) : G_, rx_ = ((G_ & 7) == 0 && (R_ & 7) == 0) ? (R_ >> 3) : 0;
    const int xs_ = vb_ / per_x, sl_ = vb_ - xs_ * per_x;
    const int tail_t = (rx_ > 0) ? ((sl_ < rx_) ? nfull_ * G_ + xs_ * rx_ + sl_ : -1) : ((vb_ < R_) ? nfull_ * G_ + vb_ : -1);
    for (int rnd_ = 0; rnd_ <= nfull_; ++rnd_) {
        const int t = (rnd_ < nfull_) ? (vb_ + rnd_ * G_) : tail_t;
        if (t < 0) break;
        int mi, ni; tile_mn(t, nN, mi, ni);
        const int m0 = mi << 7, n0 = ni << 8;
        const int ncol = n0 + wn * 128, cg0 = ncol >> 6;
        int mode, vsel, vth, dsh, nhv, ksel; classify(kind, cg0, mode, vsel, vth, dsh, nhv, ksel);
        const int mw = m0 + wm * 64;
        f32x4 acc[32]; ZERO_ACC(acc);
        if (mode == 2) {
            gemm_mainloop<true>(tid_, smem, A, 1024, Wt, 1024, 1024, m0, n0, acc, dsh == 2);
            __builtin_amdgcn_s_barrier();
            u16* vt = (u16*)(ws + (vsel == 0 ? OFF_VT0 : (vsel == 1 ? OFF_VT1 : OFF_VT2)));
            if (dsh == 0) {
#pragma unroll
                for (int mt = 0; mt < 4; ++mt) {
                    const int m = mw + mt * 16 + fq * 4;
                    const int b = m >> 13, p = m & 8191;
#pragma unroll
                    for (int grp = 0; grp < 2; ++grp) {
                        u16* dst = vt + ((((size_t)(b * nhv + vth + grp)) * 512 + (p >> 4)) * 64) * 16 + (p & 15);
#pragma unroll
                        for (int nt = 0; nt < 4; ++nt) { const f32x4 v = acc[mt * 8 + grp * 4 + nt]; *(u32x2*)(dst + (nt * 16 + fr) * 16) = u32x2{pack2(v[0], v[1]), pack2(v[2], v[3])}; }
                    }
                }
            } else if (dsh == 4) {
#pragma unroll
                for (int j = 0; j < 4; ++j) {
                    const int m = mw + fq * 4 + j;
                    const int b = m >> 13, s = m & 8191;
                    const int p = ((s & 15) << 9) + (s >> 4);
#pragma unroll
                    for (int grp = 0; grp < 2; ++grp) {
                        u16* dst = vt + ((((size_t)(b * nhv + vth + grp)) * 512 + (p >> 4)) * 64) * 16 + (p & 15);
#pragma unroll
                        for (int nt = 0; nt < 4; ++nt)
                            *(u32x2*)(dst + (nt * 16 + fr) * 16) = u32x2{pack2(acc[0 * 8 + grp * 4 + nt][j], acc[1 * 8 + grp * 4 + nt][j]), pack2(acc[2 * 8 + grp * 4 + nt][j], acc[3 * 8 + grp * 4 + nt][j])};
                    }
                }
            } else {
#pragma unroll
                for (int mt = 0; mt < 4; ++mt) {
                    const int r0 = wm * 64 + mt * 16 + fq * 4;
                    const int m = m0 + (r0 & 31) * 4 + (r0 >> 5);
                    const int b = m >> 13, s = m & 8191;
                    const int p = ((s & 3) << 11) + (s >> 2);
#pragma unroll
                    for (int grp = 0; grp < 2; ++grp) {
                        u16* dst = vt + ((((size_t)(b * nhv + vth + grp)) * 512 + (p >> 4)) * 64) * 16 + (p & 15);
#pragma unroll
                        for (int nt = 0; nt < 4; ++nt) { const f32x4 v = acc[mt * 8 + grp * 4 + nt]; *(u32x2*)(dst + (nt * 16 + fr) * 16) = u32x2{pack2(v[0], v[1]), pack2(v[2], v[3])}; }
                    }
                }
            }
        } else {
            gemm_mainloop<false>(tid_, smem, A, 1024, Wt, 1024, 1024, m0, n0, acc);
            __builtin_amdgcn_s_barrier();
            constexpr int EROW = 272;
            unsigned char* est = smem + w * (64 * EROW);
            int l4_ = lane; asm volatile("" : "+v"(l4_));
            const int fr = l4_ & 15, fq = l4_ >> 4;
#pragma unroll
            for (int mt = 0; mt < 4; ++mt) {
                const int s = (mw + mt * 16 + fr) & 8191;
                unsigned char* erow = est + (mt * 16 + fr) * EROW + fq * 8;
                if (mode == 1) {
#pragma unroll
                    for (int nt = 0; nt < 2; ++nt) {
                        const f32x4 c4 = *(const f32x4*)(cosT + s * 32 + nt * 16 + fq * 4);
                        const f32x4 s4 = *(const f32x4*)(sinT + s * 32 + nt * 16 + fq * 4);
#pragma unroll
                        for (int grp = 0; grp < 2; ++grp) {
                            const f32x4 x1 = acc[(grp * 4 + nt) * 4 + mt], x2 = acc[(grp * 4 + nt + 2) * 4 + mt];
                            const f32x4 o1 = x1 * c4 - x2 * s4, o2 = x2 * c4 + x1 * s4;
                            *(u32x2*)(erow + (grp * 64 + nt * 16) * 2) = u32x2{pack2(o1[0], o1[1]), pack2(o1[2], o1[3])};
                            *(u32x2*)(erow + (grp * 64 + (nt + 2) * 16) * 2) = u32x2{pack2(o2[0], o2[1]), pack2(o2[2], o2[3])};
                        }
                    }
                } else {
#pragma unroll
                    for (int nt = 0; nt < 8; ++nt) { const f32x4 v = acc[nt * 4 + mt]; *(u32x2*)(erow + nt * 32) = u32x2{pack2(v[0], v[1]), pack2(v[2], v[3])}; }
                }
            }
            __builtin_amdgcn_fence(__ATOMIC_RELEASE, "wavefront"); __builtin_amdgcn_wave_barrier(); __builtin_amdgcn_fence(__ATOMIC_ACQUIRE, "wavefront");
            {
                const int rr = l4_ >> 4, ch = l4_ & 15;
                if (ksel >= 0) {
                    u16* ki = (u16*)(ws + (ksel == 0 ? OFF_KI0 : (ksel == 1 ? OFF_KI1 : OFF_KI2)));
                    const int dmask = (1 << dsh) - 1, lsh = 13 - dsh, numask = (64 >> dsh) - 1;
                    const int kk = l4_ >> 2, c4 = l4_ & 3;
#pragma unroll 4
                    for (int i = 0; i < 16; ++i) {
                        const int rgp = i >> 2, hd = (i >> 1) & 1, half = i & 1;
                        const int tt = rgp * 16 + kk;
                        const int row = ((tt & numask) << dsh) + (tt >> (6 - dsh));
                        const int m = mw + row, b = m >> 13, s = m & 8191;
                        const int p = ((s & dmask) << lsh) + (s >> dsh);
                        const u32x4 v = *(const u32x4*)(est + row * EROW + (hd * 64 + half * 32 + c4 * 8) * 2);
                        *(u32x4*)(ki + ((((size_t)(b * nhv + vth + hd) * 512 + (p >> 4)) * 2 + half) * 16 + (p & 15)) * 32 + c4 * 8) = v;
                    }
                } else {
                u16* hbase = H + (size_t)mw * N + ncol + ch * 8;
#pragma unroll
                for (int i = 0; i < 16; ++i) {
                    const int row = i * 4 + rr;
                    const u32x4 v = *(const u32x4*)(est + row * EROW + ch * 16);
                    *(u32x4*)(hbase + (size_t)row * N) = v;
                }
                }
            }
        }
    }
}

DEV void gemm_out_phase(unsigned char* smem, const Prm& P, const u16* Wt, const float* xin) {
    const int tid_ = opaque_tid();
    const u16* A = (const u16*)(P.ws + OFF_G);
    const int lane = tid_ & 63, w = __builtin_amdgcn_readfirstlane(tid_ >> 6), wm = w >> 1, wn = w & 1, fr = lane & 15, fq = lane >> 4;
    for (int t = vblock(); t < 512; t += gridDim.x) {
        int mi, ni; tile_mn(t, 4, mi, ni);
        const int m0 = mi << 7, n0 = ni << 8;
        f32x4 acc[32]; ZERO_ACC(acc);
        gemm_mainloop<false>(tid_, smem, A, 1024, Wt, 1024, 1024, m0, n0, acc);
        {
            __builtin_amdgcn_s_barrier();
            constexpr int EROWF = 528;
            unsigned char* est = smem + w * (32 * EROWF);
            const size_t ub = (size_t)(m0 + wm * 64) * 1024 + n0 + wn * 128;
            const float* xw = xin + ub; float* ow = P.out + ub;
            int l2_ = lane; asm volatile("" : "+v"(l2_));
            const int fr2 = l2_ & 15, fq2 = l2_ >> 4, rr = l2_ >> 5, ch = l2_ & 31;
#pragma unroll
            for (int h = 0; h < 2; ++h) {
#pragma unroll
                for (int mh = 0; mh < 2; ++mh) {
                    unsigned char* erow = est + (mh * 16 + fr2) * EROWF + fq2 * 16;
#pragma unroll
                    for (int nt = 0; nt < 8; ++nt) *(f32x4*)(erow + nt * 64) = acc[nt * 4 + h * 2 + mh];
                }
                __builtin_amdgcn_fence(__ATOMIC_RELEASE, "wavefront"); __builtin_amdgcn_wave_barrier(); __builtin_amdgcn_fence(__ATOMIC_ACQUIRE, "wavefront");
#pragma unroll 4
                for (int i = 0; i < 16; ++i) {
                    const int row = i * 2 + rr;
                    const unsigned ix = (unsigned)((h * 32 + row) * 1024 + ch * 4);
                    const f32x4 v = *(const f32x4*)(est + row * EROWF + ch * 16);
                    const f32x4 xv = *(const f32x4*)(xw + ix);
                    *(f32x4*)(ow + ix) = xv * DN_ALPHA + v;
                }
                __builtin_amdgcn_fence(__ATOMIC_RELEASE, "wavefront"); __builtin_amdgcn_wave_barrier(); __builtin_amdgcn_fence(__ATOMIC_ACQUIRE, "wavefront");
            }
        }
    }
}

DEV void gemm_gate_phase(unsigned char* smem, const Prm& P, const u16* Wg, const u16* Wp) {
    const int tid_ = opaque_tid();
    const u16* A1 = (const u16*)(P.ws + OFF_XLB);
    const u16* A2 = (const u16*)(P.ws + OFF_PB);
    u16* xb = (u16*)(P.ws + OFF_XB);
    u16* ppb = (u16*)(P.ws + OFF_PP);
    const int lane = tid_ & 63, w = __builtin_amdgcn_readfirstlane(tid_ >> 6), wm = w >> 1, wn = w & 1, fr = lane & 15, fq = lane >> 4;
    for (int t = vblock(); t < 512; t += gridDim.x) {
        int mi, ni; tile_mn(t, 4, mi, ni);
        const int m0 = mi << 7, n0 = ni << 8;
        f32x4 acc[32]; ZERO_ACC(acc);
        gemm_mainloop<false>(tid_, smem, A2, 256, Wp, 256, 256, m0, n0, acc);
        const size_t ub = (size_t)(m0 + wm * 64) * 1024 + n0 + wn * 128;
        float* ow = P.out + ub; u16* pw = ppb + ub; u16* xw = xb + ub;
        {
            int l2_ = lane; asm volatile("" : "+v"(l2_));
            const unsigned lo = (unsigned)((l2_ & 15) * 1024 + (l2_ >> 4) * 4);
#pragma unroll
            for (int mt = 0; mt < 4; ++mt) {
#pragma unroll
                for (int nt = 0; nt < 8; ++nt) { const f32x4 v = acc[nt * 4 + mt]; *(u32x2*)(pw + (lo + mt * 16384 + nt * 16)) = u32x2{pack2(v[0], v[1]), pack2(v[2], v[3])}; }
                __builtin_amdgcn_sched_barrier(0);
            }
        }
        ZERO_ACC(acc);
        gemm_mainloop<false>(tid_, smem, A1, 1024, Wg, 1024, 1024, m0, n0, acc);
        int l3_ = lane; asm volatile("" : "+v"(l3_));
        const unsigned lo = (unsigned)((l3_ & 15) * 1024 + (l3_ >> 4) * 4);
#pragma unroll
        for (int mt = 0; mt < 4; ++mt) {
#pragma unroll
            for (int nt = 0; nt < 8; ++nt) {
                const unsigned ix = lo + mt * 16384 + nt * 16;
                const f32x4 xv = *(const f32x4*)(ow + ix);
                const u32x2 pq = *(const u32x2*)(pw + ix);
                const f32x4 ga = acc[nt * 4 + mt];
                f32x4 r;
                r[0] = xv[0] + sigmoidf_(ga[0]) * bflo(pq[0]); r[1] = xv[1] + sigmoidf_(ga[1]) * bfhi(pq[0]);
                r[2] = xv[2] + sigmoidf_(ga[2]) * bflo(pq[1]); r[3] = xv[3] + sigmoidf_(ga[3]) * bfhi(pq[1]);
                *(f32x4*)(ow + ix) = r;
                *(u32x2*)(xb + kb_off(m0 + wm * 64 + mt * 16 + (l3_ & 15), n0 + wn * 128 + nt * 16 + (l3_ >> 4) * 4, 1024)) = u32x2{pack2(r[0], r[1]), pack2(r[2], r[3])};
            }
            __builtin_amdgcn_sched_barrier(0);
        }
    }
}

DEV void ln_phase(const Prm& P, int layer) {
    const int tid_ = opaque_tid();
    const int lane = tid_ & 63, w = __builtin_amdgcn_readfirstlane(tid_ >> 6);
    const float* g = P.in[12] + layer * 1024; const float* bb = P.in[13] + layer * 1024;
    u16* xlb = (u16*)(P.ws + OFF_XLB);
    for (int row = blockIdx.x * 4 + w; row < T; row += gridDim.x * 4) {
        float* xr = P.out + (size_t)row * 1024;
        f32x4 v[4];
        float s = 0.f;
#pragma unroll
        for (int i = 0; i < 4; ++i) { v[i] = *(const f32x4*)(xr + i * 256 + lane * 4); s += v[i][0] + v[i][1] + v[i][2] + v[i][3]; }
        const float mean = wave_sum(s) * (1.f / 1024.f);
        float q = 0.f;
#pragma unroll
        for (int i = 0; i < 4; ++i)
#pragma unroll
            for (int j = 0; j < 4; ++j) { const float d = v[i][j] - mean; q += d * d; }
        const float rstd = rsqrtf(wave_sum(q) * (1.f / 1024.f) + LN_EPS);
#pragma unroll
        for (int i = 0; i < 4; ++i) {
            const f32x4 gg = *(const f32x4*)(g + i * 256 + lane * 4), bv = *(const f32x4*)(bb + i * 256 + lane * 4);
            f32x4 y;
#pragma unroll
            for (int j = 0; j < 4; ++j) y[j] = (v[i][j] - mean) * rstd * gg[j] + bv[j];
            *(f32x4*)(xr + i * 256 + lane * 4) = y;
            *(u32x2*)(xlb + kb_off(row, i * 256 + lane * 4, 1024)) = u32x2{pack2(y[0], y[1]), pack2(y[2], y[3])};
        }
    }
    const float* p = P.in[1] + (size_t)layer * T * 256; u16* pb = (u16*)(P.ws + OFF_PB);
    const size_t gtid = (size_t)blockIdx.x * 256 + tid_, gsz = (size_t)gridDim.x * 256;
    for (size_t i = gtid; i < (size_t)T * 256 / 8; i += gsz) {
        const f32x4 a = *(const f32x4*)(p + i * 8), b = *(const f32x4*)(p + i * 8 + 4);
        *(u32x4*)(pb + kb_off((int)(i >> 5), (int)(i & 31) * 8, 256)) = u32x4{pack2(a[0], a[1]), pack2(a[2], a[3]), pack2(b[0], b[1]), pack2(b[2], b[3])};
    }
}

struct KV { bf16x8 ka0, ka1, kb0, kb1; bf16x8 v0, v1, v2, v3; };
template <int KH = 1024>
DEV void load_kv(KV& t, const char* Kb, unsigned koa, unsigned kob, const char* Vb, unsigned voa, unsigned vob) {
    t.ka0 = *(const bf16x8*)(Kb + koa); t.ka1 = *(const bf16x8*)(Kb + koa + KH);
    t.kb0 = *(const bf16x8*)(Kb + kob); t.kb1 = *(const bf16x8*)(Kb + kob + KH);
    t.v0 = __builtin_shufflevector(*(const s16x4*)(Vb + voa), *(const s16x4*)(Vb + vob), 0, 1, 2, 3, 4, 5, 6, 7);
    t.v1 = __builtin_shufflevector(*(const s16x4*)(Vb + voa + 512), *(const s16x4*)(Vb + vob + 512), 0, 1, 2, 3, 4, 5, 6, 7);
    t.v2 = __builtin_shufflevector(*(const s16x4*)(Vb + voa + 1024), *(const s16x4*)(Vb + vob + 1024), 0, 1, 2, 3, 4, 5, 6, 7);
    t.v3 = __builtin_shufflevector(*(const s16x4*)(Vb + voa + 1536), *(const s16x4*)(Vb + vob + 1536), 0, 1, 2, 3, 4, 5, 6, 7);
}
DEV unsigned pkrtz(float a, float b) { return __builtin_bit_cast(unsigned, __builtin_amdgcn_cvt_pkrtz(a, b)); }
DEV bf16x8 pack8(const float (&p)[8]) {
    return __builtin_bit_cast(bf16x8, u32x4{pkrtz(p[0], p[1]), pkrtz(p[2], p[3]), pkrtz(p[4], p[5]), pkrtz(p[6], p[7])});
}
DEV void qk_scores(const KV& t, const bf16x8& q0, const bf16x8& q1, f32x4& sa, f32x4& sb) {
    sa = f32x4{0.f, 0.f, 0.f, 0.f}; sb = f32x4{0.f, 0.f, 0.f, 0.f};
    sa = MFMA16(t.ka0, q0, sa); sa = MFMA16(t.ka1, q1, sa);
    sb = MFMA16(t.kb0, q0, sb); sb = MFMA16(t.kb1, q1, sb);
}
constexpr float QK_C = 0.125f * 1.4426950408889634f;
DEV void flash_core(float& mref, float& l, f32x4 (&o)[4], const bf16x8& q0, const bf16x8& q1, const KV& t, bool fast, int d0, unsigned lim) {
    f32x4 sa, sb; qk_scores(t, q0, q1, sa, sb);
    float y[8];
    if (fast) {
#pragma unroll
        for (int j = 0; j < 4; ++j) { y[j] = sa[j] * QK_C; y[4 + j] = sb[j] * QK_C; }
    } else {
#pragma unroll
        for (int j = 0; j < 4; ++j) {
            y[j]     = ((unsigned)(d0 - j) <= lim)      ? sa[j] * QK_C : NEG_INF;
            y[4 + j] = ((unsigned)(d0 - 16 - j) <= lim) ? sb[j] * QK_C : NEG_INF;
        }
    }
    float mx = fmaxf(fmaxf(fmaxf(y[0], y[1]), fmaxf(y[2], y[3])), fmaxf(fmaxf(y[4], y[5]), fmaxf(y[6], y[7])));
    if (__ballot(mx > mref + 8.f) != 0ull) {
        mx = red16_max(mx);
        const float mn = fmaxf(mref, mx);
        const float alpha = (mn == NEG_INF) ? 1.f : __builtin_amdgcn_exp2f(mref - mn);
        l *= alpha;
#pragma unroll
        for (int d = 0; d < 4; ++d) o[d] *= alpha;
        mref = mn;
    }
    const float mu = (mref == NEG_INF) ? 0.f : mref;
    float p[8]; float ps = 0.f;
#pragma unroll
    for (int j = 0; j < 8; ++j) { p[j] = __builtin_amdgcn_exp2f(y[j] - mu); ps += p[j]; }
    l += ps;
    const bf16x8 pf = pack8(p);
    o[0] = MFMA16(t.v0, pf, o[0]); o[1] = MFMA16(t.v1, pf, o[1]); o[2] = MFMA16(t.v2, pf, o[2]); o[3] = MFMA16(t.v3, pf, o[3]);
}

#define RING4(NSTEPS, LOADSTEP, COMPUTE) do { \
    KV cur_; \
    for (int st_ = 0; st_ < (NSTEPS); ++st_) { LOADSTEP(cur_, st_); COMPUTE(cur_, st_); } \
    } while (0)

DEV void band_loop(const int tid_, float& m, float& l, f32x4 (&o)[4], const bf16x8& q0, const bf16x8& q1, const char* Kb,
                   const char* Vb, int vblk0, int ustart, int nsteps, int uq, int uq0, int qspan, int maxd) {
    const int c = tid_ & 15, g4 = (tid_ & 63) >> 4;
    const unsigned kl = c * 64 + g4 * 16, vl = c * 32 + g4 * 8;
    const unsigned lim = (unsigned)min(maxd, uq);
#define BL_LOAD(R, S) do { const int ua_ = ustart + (S) * 32, ub_ = ua_ + 16; \
        const unsigned ba_ = (unsigned)(vblk0 + (max(ua_, 0) >> 4)) * 2048u, bb_ = (unsigned)(vblk0 + (max(ub_, 0) >> 4)) * 2048u; \
        load_kv(R, Kb, ba_ + kl, bb_ + kl, Vb, ba_ + vl, bb_ + vl); } while (0)
#define BL_COMP(R, S) do { const int ua_ = ustart + (S) * 32; \
        const bool fast_ = (ua_ >= 0) && (ua_ + 31 <= uq0) && (uq0 + qspan - ua_ <= maxd); \
        flash_core(m, l, o, q0, q1, R, fast_, uq - ua_ - g4 * 4, lim); } while (0)
    RING4(nsteps, BL_LOAD, BL_COMP);
#undef BL_LOAD
#undef BL_COMP
}

DEV void attnA_phase(const Prm& P, int chunk) {
    const int tid_ = opaque_tid();
    unsigned char* ws = P.ws;
    const u16* H = (const u16*)(ws + OFF_H);
    u16* G = (u16*)(ws + OFF_G);
    const int lane = tid_ & 63, w = __builtin_amdgcn_readfirstlane(tid_ >> 6), c = lane & 15, g4 = lane >> 4;
    constexpr int LD = 2560;
    const int xcd_ = blockIdx.x & 7, slot_ = blockIdx.x >> 3, nslot_ = gridDim.x >> 3;
    for (int i_ = slot_; i_ < 128; i_ += nslot_) {
        const int rq = i_ & 3, tbi = i_ >> 2, hh = xcd_ & 3, b = xcd_ >> 2;
        const int r = w * 4 + rq, tb = tbi * 256;
        const int sq = tb + r + 16 * c;
        const size_t rowq = (size_t)b * 8192 + sq;
        float m = NEG_INF, l = 0.f;
        f32x4 o[4];
#pragma unroll
        for (int d = 0; d < 4; ++d) o[d] = f32x4{0.f, 0.f, 0.f, 0.f};
#pragma unroll 1
        for (int g = 0; g < 3; ++g) {
            const int dsh = 2 * g, dmask = (1 << dsh) - 1;
            const int rg = r & dmask;
            const int uq = sq >> dsh, uq0 = (tb + r) >> dsh;
            int ustart = (uq0 - 128) & ~15;
            const int ulast = (uq0 + (15 << (4 - dsh))) & ~15;
            int ntile = ((ulast - ustart) >> 4) + 1;
            if (ntile & 1) { ustart -= 16; ntile += 1; }
            const u16* Hq = H + rowq * LD + g * 768 + hh * 64 + g4 * 8;
            const bf16x8 q0 = *(const bf16x8*)Hq, q1 = *(const bf16x8*)(Hq + 32);
            const char* Kb = (const char*)((const u16*)(ws + (g == 0 ? OFF_KI0 : (g == 1 ? OFF_KI1 : OFF_KI2))) + ((size_t)(b * 4 + hh) * 512) * 1024);
            const char* Vb = (const char*)((const u16*)(ws + (g == 0 ? OFF_VT0 : (g == 1 ? OFF_VT1 : OFF_VT2))) + ((size_t)(b * 4 + hh) * 512) * 1024);
            const int vblk0 = rg * ((8192 >> dsh) >> 4);
            band_loop(tid_, m, l, o, q0, q1, Kb, Vb, vblk0, ustart, ntile >> 1, uq, uq0, 15 << (4 - dsh), 128);
        }
        l = red16_sum(l);
        const float inv = 1.f / l;
#pragma unroll
        for (int dt = 0; dt < 4; ++dt) {
            const int dh = dt * 16 + g4 * 4;
            const u32x2 z = *(const u32x2*)(H + rowq * LD + 2304 + hh * 64 + dh);
            const float r0 = o[dt][0] * inv * siluf_(bflo(z[0])), r1 = o[dt][1] * inv * siluf_(bfhi(z[0]));
            const float r2 = o[dt][2] * inv * siluf_(bflo(z[1])), r3 = o[dt][3] * inv * siluf_(bfhi(z[1]));
            *(u32x2*)(G + kb_off((int)rowq, (chunk * 4 + hh) * 64 + dh, 1024)) = u32x2{pack2(r0, r1), pack2(r2, r3)};
        }
    }
}

DEV void attnB_phase(const Prm& P) {
    const int tid_ = opaque_tid();
    unsigned char* ws = P.ws;
    const u16* H = (const u16*)(ws + OFF_H);
    u16* G = (u16*)(ws + OFF_G);
    const float* sinks = P.in[5];
    const int lane = tid_ & 63, w = __builtin_amdgcn_readfirstlane(tid_ >> 6), c = lane & 15, g4 = lane >> 4;
    constexpr int LD = 2304;
    const int xcd_ = blockIdx.x & 7, slot_ = blockIdx.x >> 3, nslot_ = gridDim.x >> 3;
    for (int tile = slot_; tile < 512; tile += nslot_) {
        const int b = xcd_ >> 2, hq = xcd_ & 3;
        const int head = hq * 4 + w, kvh = head >> 3;
        const int t0 = tile * 16, sq = t0 + c;
        const size_t rowq = (size_t)b * 8192 + sq;
        float m = NEG_INF, l = 0.f;
        f32x4 o[4];
#pragma unroll
        for (int d = 0; d < 4; ++d) o[d] = f32x4{0.f, 0.f, 0.f, 0.f};
        const u16* Hq = H + rowq * LD + head * 64 + g4 * 8;
        const bf16x8 q0 = *(const bf16x8*)Hq, q1 = *(const bf16x8*)(Hq + 32);
        const char* Kb = (const char*)((const u16*)(ws + OFF_KI0) + ((size_t)(b * 2 + kvh) * 512) * 1024);
        const char* Vb = (const char*)((const u16*)(ws + OFF_VT0) + ((size_t)(b * 2 + kvh) * 512) * 1024);
        band_loop(tid_, m, l, o, q0, q1, Kb, Vb, 0, t0 - 144, 5, sq, t0, 15, 127);
        l = red16_sum(l);
        const float mu = (m == NEG_INF) ? 0.f : m;
        const float lf = l + __builtin_amdgcn_exp2f(sinks[head] * 1.4426950408889634f - mu);
        const float inv = 1.f / lf;
#pragma unroll
        for (int dt = 0; dt < 4; ++dt) {
            const int dh = dt * 16 + g4 * 4;
            const u32x2 z = *(const u32x2*)(H + rowq * LD + 1280 + head * 64 + dh);
            const float r0 = o[dt][0] * inv * siluf_(bflo(z[0])), r1 = o[dt][1] * inv * siluf_(bfhi(z[0]));
            const float r2 = o[dt][2] * inv * siluf_(bflo(z[1])), r3 = o[dt][3] * inv * siluf_(bfhi(z[1]));
            *(u32x2*)(G + kb_off((int)rowq, head * 64 + dh, 1024)) = u32x2{pack2(r0, r1), pack2(r2, r3)};
        }
    }
}

DEV void compress_phase(const Prm& P) {
    const int tid_ = opaque_tid();
    unsigned char* ws = P.ws;
    const u16* H = (const u16*)(ws + OFF_H);
    constexpr int LD = 3840;
    const float* bias = (const float*)(ws + OFF_BIAS);
    const int lane = tid_ & 63, w = __builtin_amdgcn_readfirstlane(tid_ >> 6), c = lane & 15, g4 = lane >> 4;
    for (int it = blockIdx.x; it < 128; it += gridDim.x) {
        const int unit = it * 4 + w;
        const int which = unit >> 8, b = (unit >> 7) & 1, kvh = (unit >> 5) & 3, ntile = unit & 31;
        const u16* Wt = (const u16*)(ws + (which ? OFF_WCV : OFF_WCK));
        const int colbase = (which ? 1280 : 1024) + kvh * 64;
        const int n = ntile * 16 + c;
        const u16* Wl = Wt + c * 32 + g4 * 8;
        f32x4 acc[4];
#pragma unroll
        for (int e = 0; e < 4; ++e) acc[e] = f32x4{0.f, 0.f, 0.f, 0.f};
#pragma unroll 4
        for (int kk = 0; kk < 64; ++kk) {
            const int j = kk >> 1, d0 = (kk & 1) * 32 + g4 * 8;
            int s = 16 * n + j; s = min(s, 8191);
            const bf16x8 xf = *(const bf16x8*)(H + ((size_t)b * 8192 + s) * LD + colbase + d0);
            bf16x8 wf[4];
#pragma unroll
            for (int e = 0; e < 4; ++e) wf[e] = *(const bf16x8*)(Wl + (size_t)(e * 64 + kk) * 512);
            if (which == 0) {
#pragma unroll
                for (int e = 0; e < 4; ++e) acc[e] = MFMA16(wf[e], xf, acc[e]);
            } else {
#pragma unroll
                for (int e = 0; e < 4; ++e) acc[e] = MFMA16(xf, wf[e], acc[e]);
            }
        }
        if (which == 0) {
            u16* kc = (u16*)(ws + OFF_KCMP) + ((size_t)(b * 4 + kvh) * 32 + ntile) * 1024 + c * 32;
#pragma unroll
            for (int e = 0; e < 4; ++e) {
                const int e0 = e * 16 + g4 * 4;
                const f32x4 bv = *(const f32x4*)(bias + e0);
                const f32x4 r = acc[e] + bv;
                *(u32x2*)(kc + (e0 >> 5) * 512 + (e0 & 31)) = u32x2{pack2(r[0], r[1]), pack2(r[2], r[3])};
            }
        } else {
            u16* vc = (u16*)(ws + OFF_VCMP) + (((size_t)(b * 4 + kvh) * 32 + ntile) * 64) * 16;
#pragma unroll
            for (int e = 0; e < 4; ++e) {
                const int ee = e * 16 + c;
                const float bv = bias[64 + ee];
                *(u32x2*)(vc + ee * 16 + g4 * 4) = u32x2{pack2(acc[e][0] + bv, acc[e][1] + bv), pack2(acc[e][2] + bv, acc[e][3] + bv)};
            }
        }
    }
}

DEV void attnC_phase(const Prm& P, unsigned char* smem) {
    const int tid_ = opaque_tid();
    unsigned char* ws = P.ws;
    const u16* H = (const u16*)(ws + OFF_H);
    u16* G = (u16*)(ws + OFF_G);
    constexpr int LD = 3840;
    float* imp = (float*)smem;
    float* scb = (float*)(smem + 32768);
    float* oslc = (float*)(smem + 34816);
    const int tid = tid_, lane = tid & 63, w = __builtin_amdgcn_readfirstlane(tid >> 6), c = lane & 15, g4 = lane >> 4;
    const int xcd_ = blockIdx.x & 7, slot_ = blockIdx.x >> 3, nslot_ = gridDim.x >> 3;
    for (int i = tid; i < 8192; i += 256) imp[i] = 0.f;
    __syncthreads();
    for (int tk_ = 0; tk_ * nslot_ < 512; ++tk_) {
        const int tile = tk_ * nslot_ + ((tk_ & 1) ? (nslot_ - 1 - slot_) : slot_);
        const int b = xcd_ >> 2, kvh = xcd_ & 3;
        const int t0 = tile * 16;
        const int head = kvh * 4 + w;
        const size_t rowq = (size_t)b * 8192 + t0 + c;
        const u16* Hq = H + rowq * LD + head * 64 + g4 * 8;
        const bf16x8 q0 = *(const bf16x8*)Hq, q1 = *(const bf16x8*)(Hq + 32);
        f32x4 oacc[4];
#pragma unroll
        for (int d = 0; d < 4; ++d) oacc[d] = f32x4{0.f, 0.f, 0.f, 0.f};
        const int nmax = (t0 + c - 31) >> 4;
        const int nmaxw = (t0 - 16) >> 4;
        const float g0 = sigmoidf_(bf2f(H[rowq * LD + 3584 + head]));
        const float g1 = sigmoidf_(bf2f(H[rowq * LD + 3584 + 16 + head]));
        const float g2 = sigmoidf_(bf2f(H[rowq * LD + 3584 + 32 + head]));
        if (nmaxw >= 0) {
            const int nsteps = (nmaxw >> 5) + 1;
            const char* Kb = (const char*)((const u16*)(ws + OFF_KCMP) + ((size_t)(b * 4 + kvh) * 32) * 1024);
            const char* Vb = (const char*)((const u16*)(ws + OFF_VCMP) + ((size_t)(b * 4 + kvh) * 32) * 1024);
            const unsigned kl = c * 64 + g4 * 16, vl = c * 32 + g4 * 8;
            float m = NEG_INF, l = 0.f;
#define CM_LOAD(R, S) do { const int na_ = (S) * 32; const unsigned ba_ = (unsigned)(na_ >> 4) * 2048u, bb_ = (unsigned)min((na_ >> 4) + 1, 31) * 2048u; \
        load_kv(R, Kb, ba_ + kl, bb_ + kl, Vb, ba_ + vl, bb_ + vl); } while (0)
#define CM_PASS1(R, S) do { const int na_ = (S) * 32; f32x4 sa, sb; qk_scores(R, q0, q1, sa, sb); float mx = NEG_INF; float x[8]; \
        _Pragma("unroll") for (int j = 0; j < 8; ++j) { const int n = na_ + (j >> 2) * 16 + g4 * 4 + (j & 3); \
            x[j] = (n <= nmax) ? ((j < 4) ? sa[j & 3] : sb[j & 3]) * 0.125f : NEG_INF; mx = fmaxf(mx, x[j]); } \
        const float mn = fmaxf(m, mx); const float mu = (mn == NEG_INF) ? 0.f : mn; float ps = 0.f; \
        _Pragma("unroll") for (int j = 0; j < 8; ++j) ps += __expf(x[j] - mu); \
        l = l * __expf(m - mu) + ps; m = mn; } while (0)
            RING4(nsteps, CM_LOAD, CM_PASS1);
            float mall = red16_max(m);
            mall = (mall == NEG_INF) ? 0.f : mall;
            l = l * __expf(m - mall);
            l = red16_sum(l);
            const float invl = (l > 0.f) ? 1.f / l : 0.f;
#define CM_PASS2(R, S) do { const int na_ = (S) * 32; f32x4 sa, sb; qk_scores(R, q0, q1, sa, sb); float p[8]; \
        _Pragma("unroll") for (int j = 0; j < 8; ++j) { const int n = na_ + (j >> 2) * 16 + g4 * 4 + (j & 3); \
            const float sv = ((j < 4) ? sa[j & 3] : sb[j & 3]) * 0.125f; \
            p[j] = (n <= nmax) ? __expf(sv - mall) * invl : 0.f; \
            if (n <= nmax) atomicAdd(&imp[n * 16 + c], p[j]); } \
        const bf16x8 pf = pack8(p); \
        oacc[0] = MFMA16(R.v0, pf, oacc[0]); oacc[1] = MFMA16(R.v1, pf, oacc[1]); \
        oacc[2] = MFMA16(R.v2, pf, oacc[2]); oacc[3] = MFMA16(R.v3, pf, oacc[3]); } while (0)
            RING4(nsteps, CM_LOAD, CM_PASS2);
#undef CM_LOAD
#undef CM_PASS1
#undef CM_PASS2
#pragma unroll
            for (int d = 0; d < 4; ++d) oacc[d] *= g0;
        }
        {
            float m = NEG_INF, l = 0.f;
            f32x4 o[4];
#pragma unroll
            for (int d = 0; d < 4; ++d) o[d] = f32x4{0.f, 0.f, 0.f, 0.f};
            const char* Kb = (const char*)((const u16*)(ws + OFF_KI1) + ((size_t)(b * 4 + kvh) * 512) * 1024);
            const char* Vb = (const char*)((const u16*)(ws + OFF_VT1) + ((size_t)(b * 4 + kvh) * 512) * 1024);
            band_loop(tid_, m, l, o, q0, q1, Kb, Vb, 0, t0 - 528, 17, t0 + c, t0, 15, 511);
            l = red16_sum(l);
            const float sc = g2 / l;
#pragma unroll
            for (int d = 0; d < 4; ++d) oacc[d] += o[d] * sc;
        }
        __syncthreads();
        unsigned long long* msk = (unsigned long long*)(smem + 51200) + w * 8;
#pragma unroll 1
        for (int i = 0; i < 4; ++i) {
            const int tok = 4 * w + i, tq = t0 + tok, cur = tq >> 6;
            float my0, my1;
            {
                const int j0 = lane, j1 = lane + 64;
                float a0 = 2.f * (imp[(4 * j0) * 16 + tok] + imp[(4 * j0 + 1) * 16 + tok] + imp[(4 * j0 + 2) * 16 + tok]) + imp[(4 * j0 + 3) * 16 + tok];
                if (j0 > 0) a0 += imp[(4 * j0 - 1) * 16 + tok];
                const float a1 = 2.f * (imp[(4 * j1) * 16 + tok] + imp[(4 * j1 + 1) * 16 + tok] + imp[(4 * j1 + 2) * 16 + tok]) + imp[(4 * j1 + 3) * 16 + tok]
                                 + imp[(4 * j1 - 1) * 16 + tok];
                const bool f0 = (j0 == 0) || (j0 == cur) || (j0 == cur - 1);
                const bool f1 = (j1 == cur) || (j1 == cur - 1);
                my0 = f0 ? 1e4f : ((j0 <= cur) ? a0 : -1.f);
                my1 = f1 ? 1e4f : ((j1 <= cur) ? a1 : -1.f);
            }
            const unsigned k0 = (lane <= cur) ? (__float_as_uint(my0) + 1u) : 0u;
            const unsigned k1 = (lane + 64 <= cur) ? (__float_as_uint(my1) + 1u) : 0u;
            unsigned T = 0u;
#pragma unroll
            for (int bit = 31; bit >= 0; --bit) {
                const unsigned tr = T | (1u << bit);
                const int cnt = __builtin_popcountll(__ballot(k0 >= tr)) + __builtin_popcountll(__ballot(k1 >= tr));
                if (cnt >= 16) T = tr;
            }
            const unsigned long long eq0 = __ballot(k0 == T), eq1 = __ballot(k1 == T);
            const int need = 16 - __builtin_popcountll(__ballot(k0 > T)) - __builtin_popcountll(__ballot(k1 > T));
            const unsigned long long lm = (1ull << lane) - 1ull;
            const bool s0 = (k0 > 0u) && (k0 > T || (k0 == T && __builtin_popcountll(eq0 & lm) < need));
            const bool s1 = (k1 > 0u) && (k1 > T || (k1 == T && __builtin_popcountll(eq0) + __builtin_popcountll(eq1 & lm) < need));
            const unsigned long long lo = __ballot(s0);
            const unsigned long long hi = __ballot(s1);
            if (lane == 0) { msk[i * 2] = lo; msk[i * 2 + 1] = hi; }
        }
#pragma unroll 4
        for (int i = 0; i < 32; ++i) { const int e = i * 64 + lane; imp[(e >> 2) * 16 + 4 * w + (e & 3)] = 0.f; }
        __builtin_amdgcn_fence(__ATOMIC_RELEASE, "wavefront"); __builtin_amdgcn_wave_barrier(); __builtin_amdgcn_fence(__ATOMIC_ACQUIRE, "wavefront");
        {
            const int tokL = 4 * w + (c >> 2), tq = t0 + tokL, hd = kvh * 4 + (c & 3);
            const size_t rq = (size_t)b * 8192 + tq;
            const u16* Hs = H + rq * LD + hd * 64 + g4 * 8;
            const bf16x8 s0 = *(const bf16x8*)Hs, s1 = *(const bf16x8*)(Hs + 32);
            const char* Kb = (const char*)((const u16*)(ws + OFF_KI0) + ((size_t)(b * 4 + kvh) * 512) * 1024);
            const char* Vb = (const char*)((const u16*)(ws + OFF_VT0) + ((size_t)(b * 4 + kvh) * 512) * 1024);
            const unsigned kl = c * 64 + g4 * 16, vl = c * 32 + g4 * 8;
            float m = NEG_INF, l = 0.f;
            f32x4 o[4];
#pragma unroll
            for (int d = 0; d < 4; ++d) o[d] = f32x4{0.f, 0.f, 0.f, 0.f};
            const int ti = c >> 2;
            const unsigned long long mylo = msk[ti * 2], myhi = msk[ti * 2 + 1];
            const unsigned long long ulo = msk[0] | msk[2] | msk[4] | msk[6];
            const unsigned long long uhi = msk[1] | msk[3] | msk[5] | msk[7];
            const unsigned long long alo = msk[0] & msk[2] & msk[4] & msk[6], ahi = msk[1] & msk[3] & msk[5] & msk[7];
            int* blist = (int*)(scb + w * 128);
            const int nlo = __builtin_popcountll(ulo), nblk = nlo + __builtin_popcountll(uhi);
            if ((ulo >> lane) & 1ull) blist[__builtin_popcountll(ulo & ((1ull << lane) - 1ull))] = lane;
            if ((uhi >> lane) & 1ull) blist[nlo + __builtin_popcountll(uhi & ((1ull << lane) - 1ull))] = 64 + lane;
            __builtin_amdgcn_fence(__ATOMIC_RELEASE, "wavefront");
            __builtin_amdgcn_wave_barrier();
            __builtin_amdgcn_fence(__ATOMIC_ACQUIRE, "wavefront");
            const int nst = 2 * nblk;
#define SL_LOAD(R, S) do { const int j_ = __builtin_amdgcn_readfirstlane(blist[(S) >> 1]); const int ua_ = j_ * 64 + ((S) & 1) * 32; \
        load_kv(R, Kb, (unsigned)(ua_ >> 4) * 2048u + kl, (unsigned)((ua_ >> 4) + 1) * 2048u + kl, \
                Vb, (unsigned)(ua_ >> 4) * 2048u + vl, (unsigned)((ua_ >> 4) + 1) * 2048u + vl); } while (0)
#define SL_COMP(R, S) do { const int j_ = __builtin_amdgcn_readfirstlane(blist[(S) >> 1]); const int ua_ = j_ * 64 + ((S) & 1) * 32; \
        const bool selj = (j_ < 64) ? ((mylo >> j_) & 1ull) : ((myhi >> (j_ - 64)) & 1ull); \
        const bool alls_ = (j_ < 64) ? ((alo >> j_) & 1ull) : ((ahi >> (j_ - 64)) & 1ull); \
        const bool fast_ = alls_ && (ua_ + 31 <= t0 + 4 * w); \
        flash_core(m, l, o, s0, s1, R, fast_, selj ? (tq - ua_ - g4 * 4) : -(1 << 30), 0x7fffffffu); } while (0)
            RING4(nst, SL_LOAD, SL_COMP);
#undef SL_LOAD
#undef SL_COMP
            l = red16_sum(l);
            const float inv = 1.f / l;
#pragma unroll
            for (int dt = 0; dt < 4; ++dt)
                *(f32x4*)(oslc + (tokL * 4 + (c & 3)) * 64 + dt * 16 + g4 * 4) = o[dt] * inv;
        }
        __syncthreads();
#pragma unroll
        for (int dt = 0; dt < 4; ++dt) {
            const int dh = dt * 16 + g4 * 4;
            const f32x4 os = *(const f32x4*)(oslc + (c * 4 + w) * 64 + dh);
            const f32x4 r = oacc[dt] + os * g1;
            const u32x2 z = *(const u32x2*)(H + rowq * LD + 2560 + head * 64 + dh);
            const float r0 = r[0] * siluf_(bflo(z[0])), r1 = r[1] * siluf_(bfhi(z[0]));
            const float r2 = r[2] * siluf_(bflo(z[1])), r3 = r[3] * siluf_(bfhi(z[1]));
            *(u32x2*)(G + kb_off((int)rowq, head * 64 + dh, 1024)) = u32x2{pack2(r0, r1), pack2(r2, r3)};
        }
    }
}

#ifndef PROBE_DUP
#define PROBE_DUP 0
#endif
#define REP(k) for (int rep_ = 0; rep_ < 1 + ((PROBE_DUP >> (k)) & 1); ++rep_)
constexpr int LDS_BYTES = 3 * GSTAGE + 64;
__global__ void __launch_bounds__(256, 2) mk_fwd(Prm P) {
    extern __shared__ __attribute__((aligned(16))) unsigned char smem[];
    unsigned* xb_words = (unsigned*)(smem + 3 * GSTAGE);
    if (threadIdx.x < 4) xb_words[threadIdx.x] = 0u;
    __syncthreads();
    XcdBarrier bar = xcd_barrier_post((unsigned*)(P.ws + OFF_BAR), (volatile LAS unsigned*)xb_words);
    unsigned char* ws = P.ws;

    phase0(P, smem);
    if (P.ws == nullptr) cg::this_grid().sync();
    xcd_barrier(bar);

#pragma unroll 1
    for (int layer = 0; layer < 4; ++layer) {
        const int kind = layer % 3, lj = layer / 3;
        const u16* Win; const u16* Wout; int N, nsub;
        if (kind == 0)      { Win = (const u16*)(ws + OFF_WA_IN + (size_t)lj * SZ_WA_IN); Wout = (const u16*)(ws + OFF_WA_OUT + (size_t)lj * SZ_SQ); N = 2560; nsub = 4; }
        else if (kind == 1) { Win = (const u16*)(ws + OFF_WB_IN); Wout = (const u16*)(ws + OFF_WB_OUT); N = 2304; nsub = 1; }
        else                { Win = (const u16*)(ws + OFF_WC_IN); Wout = (const u16*)(ws + OFF_WC_OUT); N = 3840; nsub = 1; }
#pragma unroll 1
        for (int sub = 0; sub < nsub; ++sub) {
            REP(0) gemm_in_phase(smem, P, kind, Win + (size_t)sub * 2560 * 1024, N);
            xcd_barrier(bar);
            if (kind == 0) REP(1) attnA_phase(P, sub);
            else if (kind == 1) REP(2) attnB_phase(P);
            else { REP(3) compress_phase(P); xcd_barrier(bar); REP(4) attnC_phase(P, smem); }
            xcd_barrier(bar);
        }
        gemm_out_phase(smem, P, Wout, layer == 0 ? P.in[0] : P.out);
        xcd_barrier(bar);
        ln_phase(P, layer);
        xcd_barrier(bar);
        gemm_gate_phase(smem, P, (const u16*)(ws + OFF_WG + (size_t)layer * SZ_SQ), (const u16*)(ws + OFF_WP + (size_t)layer * SZ_WP));
        if (layer < 3) xcd_barrier(bar);
    }
}

extern "C" void kernel_launch(void* const* d_in, const int* in_sizes, int n_in, void* d_out, int out_size, void* d_ws, size_t ws_size,
                              hipStream_t stream) {
    static int grid_blocks = 0;
    if (!grid_blocks) {
        int dev = 0, cus = 0, per_cu = 0;
        (void)hipGetDevice(&dev);
        (void)hipDeviceGetAttribute(&cus, hipDeviceAttributeMultiprocessorCount, dev);
        (void)hipFuncSetAttribute((const void*)mk_fwd, hipFuncAttributeMaxDynamicSharedMemorySize, LDS_BYTES);
        (void)hipOccupancyMaxActiveBlocksPerMultiprocessor(&per_cu, (const void*)mk_fwd, 256, LDS_BYTES);
        if (per_cu > 2) per_cu = 2;
        if (per_cu < 1) per_cu = 1;
        grid_blocks = cus * per_cu;
        if (ws_size < WS_END || n_in != 16) { fprintf(stderr, "kernel_launch: workspace too small (%zu < %zu) or n_in %d != 16\n", ws_size, (size_t)WS_END, n_in); grid_blocks = -1; }
    }
    if (grid_blocks < 0) return;
    (void)hipMemsetAsync((char*)d_ws + OFF_BAR, 0, 16384, stream);
    Prm p{};
    for (int i = 0; i < 16; ++i) p.in[i] = (const float*)d_in[i];
    p.out = (float*)d_out; p.ws = (unsigned char*)d_ws;
    void* args[] = {&p};
    hipError_t e = hipLaunchCooperativeKernel((const void*)mk_fwd, dim3(grid_blocks), dim3(256), args, LDS_BYTES, stream);
    if (e != hipSuccess) fprintf(stderr, "cooperative launch failed: %s (grid %d)\n", hipGetErrorString(e), grid_blocks);
}
```

```cpp
#include <hip/hip_runtime.h>
#include <hip/hip_cooperative_groups.h>
#include <cstdio>
#include <cstdint>
namespace cg = cooperative_groups;

typedef unsigned short u16;
using bf16x8 = __attribute__((ext_vector_type(8))) short;
using s16x4  = __attribute__((ext_vector_type(4))) short;
using f32x4  = __attribute__((ext_vector_type(4))) float;
using u32x4  = __attribute__((ext_vector_type(4))) unsigned;
using u32x2  = __attribute__((ext_vector_type(2))) unsigned;
#define DEV __device__ __forceinline__
using h16x8 = __attribute__((ext_vector_type(8))) _Float16;
#define MFMA16(a, b, c) __builtin_amdgcn_mfma_f32_16x16x32_f16(__builtin_bit_cast(h16x8, (a)), __builtin_bit_cast(h16x8, (b)), (c), 0, 0, 0)
#define LAS __attribute__((address_space(3)))

constexpr int T = 16384, S = 8192;
constexpr float LN_EPS = 1e-5f;
constexpr float DN_ALPHA = 1.6817928305074290f;
constexpr float NEG_INF = -__builtin_huge_valf();

constexpr size_t OFF_BAR   = 0;
constexpr size_t OFF_COS   = 16384;
constexpr size_t OFF_SIN   = OFF_COS + (size_t)8192 * 32 * 4;
constexpr size_t OFF_BIAS  = OFF_SIN + (size_t)8192 * 32 * 4;
constexpr size_t OFF_WA_IN = OFF_BIAS + 1024;
constexpr size_t SZ_WA_IN  = (size_t)10240 * 1024 * 2;
constexpr size_t SZ_SQ     = (size_t)1024 * 1024 * 2;
constexpr size_t OFF_WA_OUT = OFF_WA_IN + 2 * SZ_WA_IN;
constexpr size_t OFF_WB_IN  = OFF_WA_OUT + 2 * SZ_SQ;
constexpr size_t OFF_WB_OUT = OFF_WB_IN + (size_t)2304 * 1024 * 2;
constexpr size_t OFF_WC_IN  = OFF_WB_OUT + SZ_SQ;
constexpr size_t OFF_WC_OUT = OFF_WC_IN + (size_t)3840 * 1024 * 2;
constexpr size_t OFF_WG     = OFF_WC_OUT + SZ_SQ;
constexpr size_t OFF_WP     = OFF_WG + 4 * SZ_SQ;
constexpr size_t SZ_WP      = (size_t)1024 * 256 * 2;
constexpr size_t OFF_WCK    = OFF_WP + 4 * SZ_WP;
constexpr size_t OFF_WCV    = OFF_WCK + (size_t)64 * 2048 * 2;
constexpr size_t OFF_XB     = OFF_WCV + (size_t)64 * 2048 * 2;
constexpr size_t SZ_ACT     = (size_t)T * 1024 * 2;
constexpr size_t OFF_G      = OFF_XB + SZ_ACT;
constexpr size_t OFF_H      = OFF_G + SZ_ACT;
constexpr size_t SZ_HMAX    = (size_t)T * 3840 * 2;
constexpr size_t OFF_VT0    = OFF_H + SZ_HMAX;
constexpr size_t SZ_VT      = (size_t)2 * 4 * 8192 * 64 * 2;
constexpr size_t OFF_VT1    = OFF_VT0 + SZ_VT;
constexpr size_t OFF_VT2    = OFF_VT1 + SZ_VT;
constexpr size_t OFF_KCMP   = OFF_VT2 + SZ_VT;
constexpr size_t SZ_CMP     = (size_t)2 * 512 * 4 * 64 * 2;
constexpr size_t OFF_VCMP   = OFF_KCMP + SZ_CMP;
constexpr size_t OFF_KI0    = OFF_VCMP + SZ_CMP;
constexpr size_t OFF_KI1    = OFF_KI0 + SZ_VT;
constexpr size_t OFF_KI2    = OFF_KI1 + SZ_VT;
constexpr size_t WS_END     = OFF_KI2 + SZ_VT;
constexpr size_t OFF_XLB    = OFF_H;
constexpr size_t OFF_PB     = OFF_H + SZ_ACT;
constexpr size_t OFF_PP     = OFF_H + SZ_ACT + (size_t)16 * 1024 * 1024;

struct Prm { const float* in[16]; float* out; unsigned char* ws; };

__device__ __forceinline__ size_t kb_off(int row, int k, int K) { return ((size_t)(row >> 4) * (K >> 5) + (k >> 5)) * 512 + (row & 15) * 32 + (k & 31); }
DEV u16 f2bf(float f) { return __builtin_bit_cast(u16, (_Float16)f); }
DEV float bf2f(u16 h) { return (float)__builtin_bit_cast(_Float16, h); }
DEV unsigned pack2(float a, float b) { return (unsigned)f2bf(a) | ((unsigned)f2bf(b) << 16); }
DEV float bflo(unsigned u) { return bf2f((u16)(u & 0xffffu)); }
DEV float bfhi(unsigned u) { return bf2f((u16)(u >> 16)); }
DEV float sigmoidf_(float x) { return 1.f / (1.f + __expf(-x)); }
DEV float siluf_(float x) { return x / (1.f + __expf(-x)); }
DEV float red16_max(float v) { v = fmaxf(v, __shfl_xor(v, 16)); v = fmaxf(v, __shfl_xor(v, 32)); return v; }
DEV float red16_sum(float v) { v += __shfl_xor(v, 16); v += __shfl_xor(v, 32); return v; }
DEV float wave_sum(float v) { for (int o = 32; o > 0; o >>= 1) v += __shfl_xor(v, o); return v; }

DEV int opaque_tid() { int t = threadIdx.x; asm volatile("" : "+v"(t)); return t; }
#define XB_TMO      128
#define XB_XCNT(j)  (256  + 64 * (j))
#define XB_XSUB(j)  (1280 + 64 * (j))
#define XB_XGEN(j)  (2304 + 64 * (j))
#define XB_TOP      3328
#define XB_TOPGEN   3392
#define XCD_BAR_WORDS 3456
#define XB_SPIN_CAP (1u << 24)
DEV unsigned xb_ld(unsigned* p)              { return __hip_atomic_load(p, __ATOMIC_RELAXED, __HIP_MEMORY_SCOPE_AGENT); }
DEV unsigned xb_add(unsigned* p, unsigned v) { return __hip_atomic_fetch_add(p, v, __ATOMIC_RELAXED, __HIP_MEMORY_SCOPE_AGENT); }
DEV unsigned xb_xcc_id() { return (unsigned)__builtin_amdgcn_s_getreg((3 << 11) | 20) & 0xFu; }
#define XB_SPIN(cond, bar) do { unsigned _sp = 0; while (cond) { __builtin_amdgcn_s_sleep(1); \
    if ((++_sp & 255u) == 0u) { if (xb_ld(&(bar)[XB_TMO])) break; if (_sp > XB_SPIN_CAP) { atomicAdd(&(bar)[XB_TMO], 1u); break; } } } } while (0)
struct XcdBarrier { unsigned* bar; unsigned x; volatile LAS unsigned* st; };
DEV XcdBarrier xcd_barrier_post(unsigned* bar, volatile LAS unsigned* st) {
    XcdBarrier b; b.bar = bar; b.x = xb_xcc_id(); b.st = st;
    if (threadIdx.x == 0) (void)xb_add(&bar[XB_XCNT(b.x)], 1u);
    return b;
}
DEV void xcd_barrier_complete(unsigned* bar, unsigned x, unsigned& nloc, unsigned& nx) {
    const unsigned G = gridDim.x * gridDim.y * gridDim.z;
    unsigned sum, cnt, mine, sp = 0u;
    for (;;) {
        sum = 0u; cnt = 0u; mine = 0u;
#pragma unroll
        for (unsigned j = 0; j < 16; ++j) { const unsigned c = xb_ld(&bar[XB_XCNT(j)]); sum += c; cnt += (c > 0u) ? 1u : 0u; mine = (j == x) ? c : mine; }
        if (sum == G) break;
        __builtin_amdgcn_s_sleep(1);
        if ((++sp & 255u) == 0u) { if (xb_ld(&bar[XB_TMO])) break; if (sp > XB_SPIN_CAP) { atomicAdd(&bar[XB_TMO], 1u); break; } }
    }
    nloc = mine > 0u ? mine : 1u; nx = cnt > 0u ? cnt : 1u;
}
DEV void xcd_barrier(const XcdBarrier& b) {
    asm volatile("s_waitcnt vmcnt(0)" ::: "memory");
    __syncthreads();
    if (threadIdx.x == 0) {
        unsigned* bar = b.bar;
        __builtin_amdgcn_s_waitcnt(0);
        unsigned nloc = b.st[0], nx = b.st[1];
        if (nloc == 0u) { xcd_barrier_complete(bar, b.x, nloc, nx); b.st[0] = nloc; b.st[1] = nx; }
        const unsigned old = xb_add(&bar[XB_XSUB(b.x)], 1u);
        const unsigned gen = old / nloc;
        if (old + 1u == (gen + 1u) * nloc) {
            __builtin_amdgcn_fence(__ATOMIC_RELEASE, "agent");
            asm volatile("s_waitcnt vmcnt(0)" ::: "memory");
            const unsigned og = xb_add(&bar[XB_TOP], 1u);
            const unsigned tg = og / nx;
            if (og + 1u == (tg + 1u) * nx) xb_add(&bar[XB_TOPGEN], 1u);
            else XB_SPIN(xb_ld(&bar[XB_TOPGEN]) == tg, bar);
            __builtin_amdgcn_fence(__ATOMIC_ACQUIRE, "agent");
            xb_add(&bar[XB_XGEN(b.x)], 1u);
            asm volatile("s_waitcnt vmcnt(0)" ::: "memory");
        } else {
            XB_SPIN(xb_ld(&bar[XB_XGEN(b.x)]) == gen, bar);
            __builtin_amdgcn_fence(__ATOMIC_ACQUIRE, "agent");
            asm volatile("s_waitcnt vmcnt(0)" ::: "memory");
        }
    }
    __syncthreads();
}

DEV int colmap(int kind, int n) {
    if (kind == 0) return n;
    if (kind == 1) {
        const int c = n / 2560, nn = n - c * 2560;
        if (nn < 2304) { const int g = nn / 768, rem = nn - g * 768, part = rem >> 8, hh = (rem & 255) >> 6, d = rem & 63;
                         return g * 3072 + part * 1024 + (c * 4 + hh) * 64 + d; }
        const int z = nn - 2304; return 9216 + (c * 4 + (z >> 6)) * 64 + (z & 63);
    }
    if (n < 2560) return n;
    if (n < 3584) return n - 2560 + 2608;
    if (n < 3632) return n - 3584 + 2560;
    return -1;
}
DEV void tconv(const int tid_, float* lds, const float* __restrict__ src, int K, int Nsrc, u16* __restrict__ dst, int Ndst, int kind, int& acc_tiles) {
    const int G = gridDim.x, tid = tid_;
    const int ntn = Ndst >> 6, ntk = K >> 6, nt = ntn * ntk;
    int first = ((int)blockIdx.x - (acc_tiles % G) + G) % G;
    acc_tiles += nt;
    for (int t = first; t < nt; t += G) {
        const int tn = t / ntk, tk = t - tn * ntk;
        const int n0 = tn << 6, k0 = tk << 6;
        const int nl = tid & 63;
        const int c = colmap(kind, n0 + nl);
#pragma unroll
        for (int i = 0; i < 16; ++i) {
            const int kl = (tid >> 6) + 4 * i;
            const float v = (c >= 0) ? src[(size_t)(k0 + kl) * Nsrc + c] : 0.f;
            lds[kl * 65 + nl] = v;
        }
        __syncthreads();
        const int r = tid >> 2, kk = (tid & 3) << 4;
        unsigned o[8];
#pragma unroll
        for (int i = 0; i < 8; ++i) o[i] = pack2(lds[(kk + 2 * i) * 65 + r], lds[(kk + 2 * i + 1) * 65 + r]);
        u32x4* dp = (u32x4*)(dst + kb_off(n0 + r, k0 + kk, K));
        dp[0] = u32x4{o[0], o[1], o[2], o[3]};
        dp[1] = u32x4{o[4], o[5], o[6], o[7]};
        __syncthreads();
    }
}

DEV void phase0(const Prm& P, unsigned char* smem) {
    const int tid_ = opaque_tid();
    float* lds = (float*)smem;
    unsigned char* ws = P.ws;
    int acc = 0;
    tconv(tid_, lds, P.in[2], 1024, 10240, (u16*)(ws + OFF_WA_IN), 10240, 1, acc);
    tconv(tid_, lds, P.in[2] + (size_t)1024 * 10240, 1024, 10240, (u16*)(ws + OFF_WA_IN + SZ_WA_IN), 10240, 1, acc);
    tconv(tid_, lds, P.in[3], 1024, 1024, (u16*)(ws + OFF_WA_OUT), 1024, 0, acc);
    tconv(tid_, lds, P.in[3] + (size_t)1024 * 1024, 1024, 1024, (u16*)(ws + OFF_WA_OUT + SZ_SQ), 1024, 0, acc);
    tconv(tid_, lds, P.in[4], 1024, 2304, (u16*)(ws + OFF_WB_IN), 2304, 0, acc);
    tconv(tid_, lds, P.in[6], 1024, 1024, (u16*)(ws + OFF_WB_OUT), 1024, 0, acc);
    tconv(tid_, lds, P.in[7], 1024, 3632, (u16*)(ws + OFF_WC_IN), 3840, 2, acc);
    tconv(tid_, lds, P.in[11], 1024, 1024, (u16*)(ws + OFF_WC_OUT), 1024, 0, acc);
    for (int i = 0; i < 4; ++i) {
        tconv(tid_, lds, P.in[15] + (size_t)i * 1024 * 1024, 1024, 1024, (u16*)(ws + OFF_WG + i * SZ_SQ), 1024, 0, acc);
        tconv(tid_, lds, P.in[14] + (size_t)i * 256 * 1024, 256, 1024, (u16*)(ws + OFF_WP + i * SZ_WP), 1024, 0, acc);
    }
    tconv(tid_, lds, P.in[8], 2048, 64, (u16*)(ws + OFF_WCK), 64, 0, acc);
    tconv(tid_, lds, P.in[9], 2048, 64, (u16*)(ws + OFF_WCV), 64, 0, acc);

    const size_t gtid = (size_t)blockIdx.x * 256 + tid_, gsz = (size_t)gridDim.x * 256;
    {
        const float* x = P.in[0]; u16* xb = (u16*)(ws + OFF_XB);
        for (size_t i = gtid; i < (size_t)T * 1024 / 8; i += gsz) {
            const f32x4 a = *(const f32x4*)(x + i * 8), b = *(const f32x4*)(x + i * 8 + 4);
            *(u32x4*)(xb + kb_off((int)(i >> 7), (int)(i & 127) * 8, 1024)) = u32x4{pack2(a[0], a[1]), pack2(a[2], a[3]), pack2(b[0], b[1]), pack2(b[2], b[3])};
        }
    }
    {
        float* ct = (float*)(ws + OFF_COS); float* st = (float*)(ws + OFF_SIN);
        for (size_t i = gtid; i < (size_t)8192 * 32; i += gsz) {
            const int pos = (int)(i >> 5), k = (int)(i & 31);
            const float inv = (float)(1.0 / pow(10000.0, (double)(2 * k) / 64.0));
            const float ang = (float)pos * inv;
            ct[i] = (float)cos((double)ang); st[i] = (float)sin((double)ang);
        }
    }
    {
        const int lane = tid_ & 63;
        const int wid = blockIdx.x * 4 + __builtin_amdgcn_readfirstlane(tid_ >> 6);
        if (wid < 128) {
            const float* w = (wid < 64) ? P.in[8] : P.in[9];
            const int e = wid & 63;
            float s = 0.f;
            for (int jd = lane; jd < 2048; jd += 64) s += P.in[10][jd] * w[(size_t)jd * 64 + e];
            s = wave_sum(s);
            if (lane == 0) ((float*)(ws + OFF_BIAS))[wid] = s;
        }
    }
}

constexpr int GSTAGE = 24576;
DEV int gsw(int r) { return (0x78 >> (2 * ((r >> 2) & 3))) & 3; }
DEV void gemm_issue(unsigned char* stage, const u16* ag0, const u16* ag1, const u16* bg, int bstep, int kt, int w) {
    __builtin_amdgcn_global_load_lds((const unsigned*)(ag0 + kt * 512), (unsigned*)(stage + w * 1024), 16, 0, 0);
    __builtin_amdgcn_global_load_lds((const unsigned*)(ag1 + kt * 512), (unsigned*)(stage + w * 1024 + 4096), 16, 0, 0);
#pragma unroll
    for (int i = 0; i < 4; ++i)
        __builtin_amdgcn_global_load_lds((const unsigned*)(bg + (size_t)i * bstep + kt * 512), (unsigned*)(stage + 8192 + w * 1024 + i * 4096), 16, 0, 0);
}
template <bool NONSWAP>
DEV void gemm_mainloop(const int tid_, unsigned char* smem, const u16* __restrict__ A, int lda, const u16* __restrict__ Bt, int ldb, int K,
                       int m0, int n0, f32x4 (&acc)[32], bool aperm = false) {
    const int tid = tid_, lane = tid & 63, w = __builtin_amdgcn_readfirstlane(tid >> 6), wm = w >> 1, wn = w & 1;
    const int lrow = tid >> 2, lsw = ((tid & 3) ^ gsw(lrow)) * 8;
    const int arow0 = aperm ? ((lrow & 31) * 4 + (lrow >> 5)) : lrow;
    const int arow1 = aperm ? (arow0 + 2) : (lrow + 64);
    const u16* ag0 = A + kb_off(m0 + arow0, 0, lda) + lsw;
    const u16* ag1 = A + kb_off(m0 + arow1, 0, lda) + lsw;
    const u16* bg = Bt + kb_off(n0 + lrow, 0, ldb) + lsw;
    const int bstep = 4 * (ldb >> 5) * 512;
    const int fr = lane & 15, fq = lane >> 4;
    const int coff = (fq ^ gsw(fr)) << 4;
    const int a_base = (wm * 64 + fr) * 64 + coff, b_base = 8192 + (wn * 128 + fr) * 64 + coff;
    const int nk = K >> 5;
    asm volatile("s_waitcnt vmcnt(0)" ::: "memory");
    __builtin_amdgcn_s_barrier();
    gemm_issue(smem, ag0, ag1, bg, bstep, 0, w);
    gemm_issue(smem + GSTAGE, ag0, ag1, bg, bstep, 1, w);
    int sc = 0, si = 2;
    for (int kt = 0; kt < nk; ++kt) {
        if (kt + 1 < nk) asm volatile("s_waitcnt vmcnt(6)" ::: "memory"); else asm volatile("s_waitcnt vmcnt(0)" ::: "memory");
        __builtin_amdgcn_s_barrier();
        if (kt + 2 < nk) { gemm_issue(smem + si * GSTAGE, ag0, ag1, bg, bstep, kt + 2, w); si = (si == 2) ? 0 : si + 1; }
        const unsigned char* st = smem + sc * GSTAGE; sc = (sc == 2) ? 0 : sc + 1;
        bf16x8 a[4], b[4];
#pragma unroll
        for (int i = 0; i < 4; ++i) a[i] = *(const bf16x8*)(st + a_base + i * 1024);
#pragma unroll
        for (int hb = 0; hb < 2; ++hb) {
#pragma unroll
            for (int i = 0; i < 4; ++i) b[i] = *(const bf16x8*)(st + b_base + (hb * 4 + i) * 1024);
            if (NONSWAP) {
#pragma unroll
                for (int mt = 0; mt < 4; ++mt)
#pragma unroll
                    for (int nt = 0; nt < 4; ++nt) acc[mt * 8 + hb * 4 + nt] = MFMA16(a[mt], b[nt], acc[mt * 8 + hb * 4 + nt]);
            } else {
#pragma unroll
                for (int nt = 0; nt < 4; ++nt)
#pragma unroll
                    for (int mt = 0; mt < 4; ++mt) acc[(hb * 4 + nt) * 4 + mt] = MFMA16(b[nt], a[mt], acc[(hb * 4 + nt) * 4 + mt]);
            }
        }
    }
}

DEV int vblock() { const int G = gridDim.x, b = blockIdx.x; return ((G & 7) == 0) ? (b & 7) * (G >> 3) + (b >> 3) : b; }
DEV void tile_mn(int t, int nN, int& mi, int& ni) { const int per = 8 * nN; const int mg = t / per, r = t - mg * per; mi = mg * 8 + (r & 7); ni = r >> 3; }
#define ZERO_ACC(acc) _Pragma("unroll") for (int i_ = 0; i_ < 32; ++i_) acc[i_] = f32x4{0.f, 0.f, 0.f, 0.f}

DEV void classify(int kind, int cgi, int& mode, int& vsel, int& vth, int& dsh, int& nhv, int& ksel) {
    mode = 0; vsel = 0; vth = 0; dsh = 0; nhv = 4; ksel = -1;
    if (kind == 0) {
        if (cgi < 36) { const int g = cgi / 12, part = (cgi - g * 12) >> 2; vth = cgi & 3; if (part < 2) { mode = 1; if (part == 1) { ksel = g; dsh = 2 * g; } } else { mode = 2; vsel = g; dsh = 2 * g; } }
    } else if (kind == 1) {
        if (cgi < 16) mode = 1; else if (cgi < 18) { mode = 1; ksel = 0; vth = cgi - 16; nhv = 2; } else if (cgi < 20) { mode = 2; vsel = 0; vth = cgi - 18; nhv = 2; }
    } else {
        if (cgi < 20) mode = 1; else if (cgi < 24) mode = 0; else if (cgi < 28) { mode = 1; ksel = 0; vth = cgi - 24; } else if (cgi < 32) { mode = 2; vsel = 0; vth = cgi - 28; }
        else if (cgi < 36) { mode = 1; ksel = 1; vth = cgi - 32; } else if (cgi < 40) { mode = 2; vsel = 1; vth = cgi - 36; }
    }
}

DEV void gemm_in_phase(unsigned char* smem, const Prm& P, int kind, const u16* Wt, int N) {
    const int tid_ = opaque_tid();
    unsigned char* ws = P.ws;
    const u16* A = (const u16*)(ws + OFF_XB);
    u16* H = (u16*)(ws + OFF_H);
    const float* cosT = (const float*)(ws + OFF_COS); const float* sinT = (const float*)(ws + OFF_SIN);
    const int nN = N >> 8, ntiles = 128 * nN;
    const int lane = tid_ & 63, w = __builtin_amdgcn_readfirstlane(tid_ >> 6), wm = w >> 1, wn = w & 1, fr = lane & 15, fq = lane >> 4;
    const int G_ = gridDim.x, vb_ = vblock(), nfull_ = ntiles / G_, R_ = ntiles - nfull_ * G_;
    const int per_x = ((G_ & 7) == 0) ? (G_ >> 3) : G_, rx_ = ((G_ & 7) == 0 && (R_ & 7) == 0) ? (R_ >> 3) : 0;
    const int xs_ = vb_ / per_x, sl_ = vb_ - xs_ * per_x;
    const int tail_t = (rx_ > 0) ? ((sl_ < rx_) ? nfull_ * G_ + xs_ * rx_ + sl_ : -1) : ((vb_ < R_) ? nfull_ * G_ + vb_ : -1);
    for (int rnd_ = 0; rnd_ <= nfull_; ++rnd_) {
        const int t = (rnd_ < nfull_) ? (vb_ + rnd_ * G_) : tail_t;
        if (t < 0) break;
        int mi, ni; tile_mn(t, nN, mi, ni);
        const int m0 = mi << 7, n0 = ni << 8;
        const int ncol = n0 + wn * 128, cg0 = ncol >> 6;
        int mode, vsel, vth, dsh, nhv, ksel; classify(kind, cg0, mode, vsel, vth, dsh, nhv, ksel);
        const int mw = m0 + wm * 64;
        f32x4 acc[32]; ZERO_ACC(acc);
        if (mode == 2) {
            gemm_mainloop<true>(tid_, smem, A, 1024, Wt, 1024, 1024, m0, n0, acc, dsh == 2);
            __builtin_amdgcn_s_barrier();
            u16* vt = (u16*)(ws + (vsel == 0 ? OFF_VT0 : (vsel == 1 ? OFF_VT1 : OFF_VT2)));
            if (dsh == 0) {
#pragma unroll
                for (int mt = 0; mt < 4; ++mt) {
                    const int m = mw + mt * 16 + fq * 4;
                    const int b = m >> 13, p = m & 8191;
#pragma unroll
                    for (int grp = 0; grp < 2; ++grp) {
                        u16* dst = vt + ((((size_t)(b * nhv + vth + grp)) * 512 + (p >> 4)) * 64) * 16 + (p & 15);
#pragma unroll
                        for (int nt = 0; nt < 4; ++nt) { const f32x4 v = acc[mt * 8 + grp * 4 + nt]; *(u32x2*)(dst + (nt * 16 + fr) * 16) = u32x2{pack2(v[0], v[1]), pack2(v[2], v[3])}; }
                    }
                }
            } else if (dsh == 4) {
#pragma unroll
                for (int j = 0; j < 4; ++j) {
                    const int m = mw + fq * 4 + j;
                    const int b = m >> 13, s = m & 8191;
                    const int p = ((s & 15) << 9) + (s >> 4);
#pragma unroll
                    for (int grp = 0; grp < 2; ++grp) {
                        u16* dst = vt + ((((size_t)(b * nhv + vth + grp)) * 512 + (p >> 4)) * 64) * 16 + (p & 15);
#pragma unroll
                        for (int nt = 0; nt < 4; ++nt)
                            *(u32x2*)(dst + (nt * 16 + fr) * 16) = u32x2{pack2(acc[0 * 8 + grp * 4 + nt][j], acc[1 * 8 + grp * 4 + nt][j]), pack2(acc[2 * 8 + grp * 4 + nt][j], acc[3 * 8 + grp * 4 + nt][j])};
                    }
                }
            } else {
#pragma unroll
                for (int mt = 0; mt < 4; ++mt) {
                    const int r0 = wm * 64 + mt * 16 + fq * 4;
                    const int m = m0 + (r0 & 31) * 4 + (r0 >> 5);
                    const int b = m >> 13, s = m & 8191;
                    const int p = ((s & 3) << 11) + (s >> 2);
#pragma unroll
                    for (int grp = 0; grp < 2; ++grp) {
                        u16* dst = vt + ((((size_t)(b * nhv + vth + grp)) * 512 + (p >> 4)) * 64) * 16 + (p & 15);
#pragma unroll
                        for (int nt = 0; nt < 4; ++nt) { const f32x4 v = acc[mt * 8 + grp * 4 + nt]; *(u32x2*)(dst + (nt * 16 + fr) * 16) = u32x2{pack2(v[0], v[1]), pack2(v[2], v[3])}; }
                    }
                }
            }
        } else {
            gemm_mainloop<false>(tid_, smem, A, 1024, Wt, 1024, 1024, m0, n0, acc);
            __builtin_amdgcn_s_barrier();
            constexpr int EROW = 272;
            unsigned char* est = smem + w * (64 * EROW);
            int l4_ = lane; asm volatile("" : "+v"(l4_));
            const int fr = l4_ & 15, fq = l4_ >> 4;
#pragma unroll
            for (int mt = 0; mt < 4; ++mt) {
                const int s = (mw + mt * 16 + fr) & 8191;
                unsigned char* erow = est + (mt * 16 + fr) * EROW + fq * 8;
                if (mode == 1) {
#pragma unroll
                    for (int nt = 0; nt < 2; ++nt) {
                        const f32x4 c4 = *(const f32x4*)(cosT + s * 32 + nt * 16 + fq * 4);
                        const f32x4 s4 = *(const f32x4*)(sinT + s * 32 + nt * 16 + fq * 4);
#pragma unroll
                        for (int grp = 0; grp < 2; ++grp) {
                            const f32x4 x1 = acc[(grp * 4 + nt) * 4 + mt], x2 = acc[(grp * 4 + nt + 2) * 4 + mt];
                            const f32x4 o1 = x1 * c4 - x2 * s4, o2 = x2 * c4 + x1 * s4;
                            *(u32x2*)(erow + (grp * 64 + nt * 16) * 2) = u32x2{pack2(o1[0], o1[1]), pack2(o1[2], o1[3])};
                            *(u32x2*)(erow + (grp * 64 + (nt + 2) * 16) * 2) = u32x2{pack2(o2[0], o2[1]), pack2(o2[2], o2[3])};
                        }
                    }
                } else {
#pragma unroll
                    for (int nt = 0; nt < 8; ++nt) { const f32x4 v = acc[nt * 4 + mt]; *(u32x2*)(erow + nt * 32) = u32x2{pack2(v[0], v[1]), pack2(v[2], v[3])}; }
                }
            }
            __builtin_amdgcn_fence(__ATOMIC_RELEASE, "wavefront"); __builtin_amdgcn_wave_barrier(); __builtin_amdgcn_fence(__ATOMIC_ACQUIRE, "wavefront");
            {
                const int rr = l4_ >> 4, ch = l4_ & 15;
                if (ksel >= 0) {
                    u16* ki = (u16*)(ws + (ksel == 0 ? OFF_KI0 : (ksel == 1 ? OFF_KI1 : OFF_KI2)));
                    const int dmask = (1 << dsh) - 1, lsh = 13 - dsh, numask = (64 >> dsh) - 1;
                    const int kk = l4_ >> 2, c4 = l4_ & 3;
#pragma unroll 4
                    for (int i = 0; i < 16; ++i) {
                        const int rgp = i >> 2, hd = (i >> 1) & 1, half = i & 1;
                        const int tt = rgp * 16 + kk;
                        const int row = ((tt & numask) << dsh) + (tt >> (6 - dsh));
                        const int m = mw + row, b = m >> 13, s = m & 8191;
                        const int p = ((s & dmask) << lsh) + (s >> dsh);
                        const u32x4 v = *(const u32x4*)(est + row * EROW + (hd * 64 + half * 32 + c4 * 8) * 2);
                        *(u32x4*)(ki + ((((size_t)(b * nhv + vth + hd) * 512 + (p >> 4)) * 2 + half) * 16 + (p & 15)) * 32 + c4 * 8) = v;
                    }
                } else {
                u16* hbase = H + (size_t)mw * N + ncol + ch * 8;
#pragma unroll
                for (int i = 0; i < 16; ++i) {
                    const int row = i * 4 + rr;
                    const u32x4 v = *(const u32x4*)(est + row * EROW + ch * 16);
                    *(u32x4*)(hbase + (size_t)row * N) = v;
                }
                }
            }
        }
    }
}

DEV void gemm_out_phase(unsigned char* smem, const Prm& P, const u16* Wt, const float* xin) {
    const int tid_ = opaque_tid();
    const u16* A = (const u16*)(P.ws + OFF_G);
    const int lane = tid_ & 63, w = __builtin_amdgcn_readfirstlane(tid_ >> 6), wm = w >> 1, wn = w & 1, fr = lane & 15, fq = lane >> 4;
    for (int t = vblock(); t < 512; t += gridDim.x) {
        int mi, ni; tile_mn(t, 4, mi, ni);
        const int m0 = mi << 7, n0 = ni << 8;
        f32x4 acc[32]; ZERO_ACC(acc);
        gemm_mainloop<false>(tid_, smem, A, 1024, Wt, 1024, 1024, m0, n0, acc);
        {
            __builtin_amdgcn_s_barrier();
            constexpr int EROWF = 528;
            unsigned char* est = smem + w * (32 * EROWF);
            const size_t ub = (size_t)(m0 + wm * 64) * 1024 + n0 + wn * 128;
            const float* xw = xin + ub; float* ow = P.out + ub;
            int l2_ = lane; asm volatile("" : "+v"(l2_));
            const int fr2 = l2_ & 15, fq2 = l2_ >> 4, rr = l2_ >> 5, ch = l2_ & 31;
#pragma unroll
            for (int h = 0; h < 2; ++h) {
#pragma unroll
                for (int mh = 0; mh < 2; ++mh) {
                    unsigned char* erow = est + (mh * 16 + fr2) * EROWF + fq2 * 16;
#pragma unroll
                    for (int nt = 0; nt < 8; ++nt) *(f32x4*)(erow + nt * 64) = acc[nt * 4 + h * 2 + mh];
                }
                __builtin_amdgcn_fence(__ATOMIC_RELEASE, "wavefront"); __builtin_amdgcn_wave_barrier(); __builtin_amdgcn_fence(__ATOMIC_ACQUIRE, "wavefront");
#pragma unroll 4
                for (int i = 0; i < 16; ++i) {
                    const int row = i * 2 + rr;
                    const unsigned ix = (unsigned)((h * 32 + row) * 1024 + ch * 4);
                    const f32x4 v = *(const f32x4*)(est + row * EROWF + ch * 16);
                    const f32x4 xv = *(const f32x4*)(xw + ix);
                    *(f32x4*)(ow + ix) = xv * DN_ALPHA + v;
                }
                __builtin_amdgcn_fence(__ATOMIC_RELEASE, "wavefront"); __builtin_amdgcn_wave_barrier(); __builtin_amdgcn_fence(__ATOMIC_ACQUIRE, "wavefront");
            }
        }
    }
}

DEV void gemm_gate_phase(unsigned char* smem, const Prm& P, const u16* Wg, const u16* Wp) {
    const int tid_ = opaque_tid();
    const u16* A1 = (const u16*)(P.ws + OFF_XLB);
    const u16* A2 = (const u16*)(P.ws + OFF_PB);
    u16* xb = (u16*)(P.ws + OFF_XB);
    u16* ppb = (u16*)(P.ws + OFF_PP);
    const int lane = tid_ & 63, w = __builtin_amdgcn_readfirstlane(tid_ >> 6), wm = w >> 1, wn = w & 1, fr = lane & 15, fq = lane >> 4;
    for (int t = vblock(); t < 512; t += gridDim.x) {
        int mi, ni; tile_mn(t, 4, mi, ni);
        const int m0 = mi << 7, n0 = ni << 8;
        f32x4 acc[32]; ZERO_ACC(acc);
        gemm_mainloop<false>(tid_, smem, A2, 256, Wp, 256, 256, m0, n0, acc);
        const size_t ub = (size_t)(m0 + wm * 64) * 1024 + n0 + wn * 128;
        float* ow = P.out + ub; u16* pw = ppb + ub; u16* xw = xb + ub;
        {
            int l2_ = lane; asm volatile("" : "+v"(l2_));
            const unsigned lo = (unsigned)((l2_ & 15) * 1024 + (l2_ >> 4) * 4);
#pragma unroll
            for (int mt = 0; mt < 4; ++mt) {
#pragma unroll
                for (int nt = 0; nt < 8; ++nt) { const f32x4 v = acc[nt * 4 + mt]; *(u32x2*)(pw + (lo + mt * 16384 + nt * 16)) = u32x2{pack2(v[0], v[1]), pack2(v[2], v[3])}; }
                __builtin_amdgcn_sched_barrier(0);
            }
        }
        ZERO_ACC(acc);
        gemm_mainloop<false>(tid_, smem, A1, 1024, Wg, 1024, 1024, m0, n0, acc);
        int l3_ = lane; asm volatile("" : "+v"(l3_));
        const unsigned lo = (unsigned)((l3_ & 15) * 1024 + (l3_ >> 4) * 4);
#pragma unroll
        for (int mt = 0; mt < 4; ++mt) {
#pragma unroll
            for (int nt = 0; nt < 8; ++nt) {
                const unsigned ix = lo + mt * 16384 + nt * 16;
                const f32x4 xv = *(const f32x4*)(ow + ix);
                const u32x2 pq = *(const u32x2*)(pw + ix);
                const f32x4 ga = acc[nt * 4 + mt];
                f32x4 r;
                r[0] = xv[0] + sigmoidf_(ga[0]) * bflo(pq[0]); r[1] = xv[1] + sigmoidf_(ga[1]) * bfhi(pq[0]);
                r[2] = xv[2] + sigmoidf_(ga[2]) * bflo(pq[1]); r[3] = xv[3] + sigmoidf_(ga[3]) * bfhi(pq[1]);
                *(f32x4*)(ow + ix) = r;
                *(u32x2*)(xb + kb_off(m0 + wm * 64 + mt * 16 + (l3_ & 15), n0 + wn * 128 + nt * 16 + (l3_ >> 4) * 4, 1024)) = u32x2{pack2(r[0], r[1]), pack2(r[2], r[3])};
            }
            __builtin_amdgcn_sched_barrier(0);
        }
    }
}

DEV void ln_phase(const Prm& P, int layer) {
    const int tid_ = opaque_tid();
    const int lane = tid_ & 63, w = __builtin_amdgcn_readfirstlane(tid_ >> 6);
    const float* g = P.in[12] + layer * 1024; const float* bb = P.in[13] + layer * 1024;
    u16* xlb = (u16*)(P.ws + OFF_XLB);
    f32x4 gg[4], bv[4];
#pragma unroll
    for (int i = 0; i < 4; ++i) { gg[i] = *(const f32x4*)(g + i * 256 + lane * 4); bv[i] = *(const f32x4*)(bb + i * 256 + lane * 4); }
    for (int rb = blockIdx.x * 4 + w; rb < T / 4; rb += gridDim.x * 4) {
        float* xr = P.out + (size_t)rb * 4096;
        f32x4 v[4][4];
#pragma unroll
        for (int r = 0; r < 4; ++r)
#pragma unroll
            for (int i = 0; i < 4; ++i) v[r][i] = *(const f32x4*)(xr + r * 1024 + i * 256 + lane * 4);
#pragma unroll
        for (int r = 0; r < 4; ++r) {
            float s = 0.f;
#pragma unroll
            for (int i = 0; i < 4; ++i) s += v[r][i][0] + v[r][i][1] + v[r][i][2] + v[r][i][3];
            const float mean = wave_sum(s) * (1.f / 1024.f);
            float q = 0.f;
#pragma unroll
            for (int i = 0; i < 4; ++i)
#pragma unroll
                for (int j = 0; j < 4; ++j) { const float d = v[r][i][j] - mean; q += d * d; }
            const float rstd = rsqrtf(wave_sum(q) * (1.f / 1024.f) + LN_EPS);
            const int row = rb * 4 + r;
#pragma unroll
            for (int i = 0; i < 4; ++i) {
                f32x4 y;
#pragma unroll
                for (int j = 0; j < 4; ++j) y[j] = (v[r][i][j] - mean) * rstd * gg[i][j] + bv[i][j];
                *(f32x4*)(xr + r * 1024 + i * 256 + lane * 4) = y;
                *(u32x2*)(xlb + kb_off(row, i * 256 + lane * 4, 1024)) = u32x2{pack2(y[0], y[1]), pack2(y[2], y[3])};
            }
        }
    }
    const float* p = P.in[1] + (size_t)layer * T * 256; u16* pb = (u16*)(P.ws + OFF_PB);
    const size_t gtid = (size_t)blockIdx.x * 256 + tid_, gsz = (size_t)gridDim.x * 256;
    for (size_t i = gtid; i < (size_t)T * 256 / 8; i += gsz) {
        const f32x4 a = *(const f32x4*)(p + i * 8), b = *(const f32x4*)(p + i * 8 + 4);
        *(u32x4*)(pb + kb_off((int)(i >> 5), (int)(i & 31) * 8, 256)) = u32x4{pack2(a[0], a[1]), pack2(a[2], a[3]), pack2(b[0], b[1]), pack2(b[2], b[3])};
    }
}

struct KV { bf16x8 ka0, ka1, kb0, kb1; bf16x8 v0, v1, v2, v3; };
template <int KH = 1024>
DEV void load_kv(KV& t, const char* Kb, unsigned koa, unsigned kob, const char* Vb, unsigned voa, unsigned vob) {
    t.ka0 = *(const bf16x8*)(Kb + koa); t.ka1 = *(const bf16x8*)(Kb + koa + KH);
    t.kb0 = *(const bf16x8*)(Kb + kob); t.kb1 = *(const bf16x8*)(Kb + kob + KH);
    t.v0 = __builtin_shufflevector(*(const s16x4*)(Vb + voa), *(const s16x4*)(Vb + vob), 0, 1, 2, 3, 4, 5, 6, 7);
    t.v1 = __builtin_shufflevector(*(const s16x4*)(Vb + voa + 512), *(const s16x4*)(Vb + vob + 512), 0, 1, 2, 3, 4, 5, 6, 7);
    t.v2 = __builtin_shufflevector(*(const s16x4*)(Vb + voa + 1024), *(const s16x4*)(Vb + vob + 1024), 0, 1, 2, 3, 4, 5, 6, 7);
    t.v3 = __builtin_shufflevector(*(const s16x4*)(Vb + voa + 1536), *(const s16x4*)(Vb + vob + 1536), 0, 1, 2, 3, 4, 5, 6, 7);
}
DEV unsigned pkrtz(float a, float b) { return __builtin_bit_cast(unsigned, __builtin_amdgcn_cvt_pkrtz(a, b)); }
DEV bf16x8 pack8(const float (&p)[8]) {
    return __builtin_bit_cast(bf16x8, u32x4{pkrtz(p[0], p[1]), pkrtz(p[2], p[3]), pkrtz(p[4], p[5]), pkrtz(p[6], p[7])});
}
DEV void qk_scores(const KV& t, const bf16x8& q0, const bf16x8& q1, f32x4& sa, f32x4& sb) {
    sa = f32x4{0.f, 0.f, 0.f, 0.f}; sb = f32x4{0.f, 0.f, 0.f, 0.f};
    sa = MFMA16(t.ka0, q0, sa); sa = MFMA16(t.ka1, q1, sa);
    sb = MFMA16(t.kb0, q0, sb); sb = MFMA16(t.kb1, q1, sb);
}
constexpr float QK_C = 0.125f * 1.4426950408889634f;
DEV void flash_core(float& mref, float& l, f32x4 (&o)[4], const bf16x8& q0, const bf16x8& q1, const KV& t, bool fast, int d0, unsigned lim) {
    f32x4 sa, sb; qk_scores(t, q0, q1, sa, sb);
    float y[8];
    if (fast) {
#pragma unroll
        for (int j = 0; j < 4; ++j) { y[j] = sa[j] * QK_C; y[4 + j] = sb[j] * QK_C; }
    } else {
#pragma unroll
        for (int j = 0; j < 4; ++j) {
            y[j]     = ((unsigned)(d0 - j) <= lim)      ? sa[j] * QK_C : NEG_INF;
            y[4 + j] = ((unsigned)(d0 - 16 - j) <= lim) ? sb[j] * QK_C : NEG_INF;
        }
    }
    float mx = fmaxf(fmaxf(fmaxf(y[0], y[1]), fmaxf(y[2], y[3])), fmaxf(fmaxf(y[4], y[5]), fmaxf(y[6], y[7])));
    if (__ballot(mx > mref + 8.f) != 0ull) {
        mx = red16_max(mx);
        const float mn = fmaxf(mref, mx);
        const float alpha = (mn == NEG_INF) ? 1.f : __builtin_amdgcn_exp2f(mref - mn);
        l *= alpha;
#pragma unroll
        for (int d = 0; d < 4; ++d) o[d] *= alpha;
        mref = mn;
    }
    const float mu = (mref == NEG_INF) ? 0.f : mref;
    float p[8]; float ps = 0.f;
#pragma unroll
    for (int j = 0; j < 8; ++j) { p[j] = __builtin_amdgcn_exp2f(y[j] - mu); ps += p[j]; }
    l += ps;
    const bf16x8 pf = pack8(p);
    o[0] = MFMA16(t.v0, pf, o[0]); o[1] = MFMA16(t.v1, pf, o[1]); o[2] = MFMA16(t.v2, pf, o[2]); o[3] = MFMA16(t.v3, pf, o[3]);
}

#define RING4(NSTEPS, LOADSTEP, COMPUTE) do { \
    KV cur_; \
    for (int st_ = 0; st_ < (NSTEPS); ++st_) { LOADSTEP(cur_, st_); COMPUTE(cur_, st_); } \
    } while (0)

DEV void band_loop(const int tid_, float& m, float& l, f32x4 (&o)[4], const bf16x8& q0, const bf16x8& q1, const char* Kb,
                   const char* Vb, int vblk0, int ustart, int nsteps, int uq, int uq0, int qspan, int maxd) {
    const int c = tid_ & 15, g4 = (tid_ & 63) >> 4;
    const unsigned kl = c * 64 + g4 * 16, vl = c * 32 + g4 * 8;
    const unsigned lim = (unsigned)min(maxd, uq);
#define BL_LOAD(R, S) do { const int ua_ = ustart + (S) * 32, ub_ = ua_ + 16; \
        const unsigned ba_ = (unsigned)(vblk0 + (max(ua_, 0) >> 4)) * 2048u, bb_ = (unsigned)(vblk0 + (max(ub_, 0) >> 4)) * 2048u; \
        load_kv(R, Kb, ba_ + kl, bb_ + kl, Vb, ba_ + vl, bb_ + vl); } while (0)
#define BL_COMP(R, S) do { const int ua_ = ustart + (S) * 32; \
        const bool fast_ = (ua_ >= 0) && (ua_ + 31 <= uq0) && (uq0 + qspan - ua_ <= maxd); \
        flash_core(m, l, o, q0, q1, R, fast_, uq - ua_ - g4 * 4, lim); } while (0)
    RING4(nsteps, BL_LOAD, BL_COMP);
#undef BL_LOAD
#undef BL_COMP
}

DEV void attnA_phase(const Prm& P, int chunk) {
    const int tid_ = opaque_tid();
    unsigned char* ws = P.ws;
    const u16* H = (const u16*)(ws + OFF_H);
    u16* G = (u16*)(ws + OFF_G);
    const int lane = tid_ & 63, w = __builtin_amdgcn_readfirstlane(tid_ >> 6), c = lane & 15, g4 = lane >> 4;
    constexpr int LD = 2560;
    const int xcd_ = blockIdx.x & 7, slot_ = blockIdx.x >> 3, nslot_ = gridDim.x >> 3;
    for (int i_ = slot_; i_ < 128; i_ += nslot_) {
        const int rq = i_ & 3, tbi = i_ >> 2, hh = xcd_ & 3, b = xcd_ >> 2;
        const int r = w * 4 + rq, tb = tbi * 256;
        const int sq = tb + r + 16 * c;
        const size_t rowq = (size_t)b * 8192 + sq;
        float m = NEG_INF, l = 0.f;
        f32x4 o[4];
#pragma unroll
        for (int d = 0; d < 4; ++d) o[d] = f32x4{0.f, 0.f, 0.f, 0.f};
#pragma unroll 1
        for (int g = 0; g < 3; ++g) {
            const int dsh = 2 * g, dmask = (1 << dsh) - 1;
            const int rg = r & dmask;
            const int uq = sq >> dsh, uq0 = (tb + r) >> dsh;
            int ustart = (uq0 - 128) & ~15;
            const int ulast = (uq0 + (15 << (4 - dsh))) & ~15;
            int ntile = ((ulast - ustart) >> 4) + 1;
            if (ntile & 1) { ustart -= 16; ntile += 1; }
            const u16* Hq = H + rowq * LD + g * 768 + hh * 64 + g4 * 8;
            const bf16x8 q0 = *(const bf16x8*)Hq, q1 = *(const bf16x8*)(Hq + 32);
            const char* Kb = (const char*)((const u16*)(ws + (g == 0 ? OFF_KI0 : (g == 1 ? OFF_KI1 : OFF_KI2))) + ((size_t)(b * 4 + hh) * 512) * 1024);
            const char* Vb = (const char*)((const u16*)(ws + (g == 0 ? OFF_VT0 : (g == 1 ? OFF_VT1 : OFF_VT2))) + ((size_t)(b * 4 + hh) * 512) * 1024);
            const int vblk0 = rg * ((8192 >> dsh) >> 4);
            band_loop(tid_, m, l, o, q0, q1, Kb, Vb, vblk0, ustart, ntile >> 1, uq, uq0, 15 << (4 - dsh), 128);
        }
        l = red16_sum(l);
        const float inv = 1.f / l;
#pragma unroll
        for (int dt = 0; dt < 4; ++dt) {
            const int dh = dt * 16 + g4 * 4;
            const u32x2 z = *(const u32x2*)(H + rowq * LD + 2304 + hh * 64 + dh);
            const float r0 = o[dt][0] * inv * siluf_(bflo(z[0])), r1 = o[dt][1] * inv * siluf_(bfhi(z[0]));
            const float r2 = o[dt][2] * inv * siluf_(bflo(z[1])), r3 = o[dt][3] * inv * siluf_(bfhi(z[1]));
            *(u32x2*)(G + kb_off((int)rowq, (chunk * 4 + hh) * 64 + dh, 1024)) = u32x2{pack2(r0, r1), pack2(r2, r3)};
        }
    }
}

DEV void attnB_phase(const Prm& P) {
    const int tid_ = opaque_tid();
    unsigned char* ws = P.ws;
    const u16* H = (const u16*)(ws + OFF_H);
    u16* G = (u16*)(ws + OFF_G);
    const float* sinks = P.in[5];
    const int lane = tid_ & 63, w = __builtin_amdgcn_readfirstlane(tid_ >> 6), c = lane & 15, g4 = lane >> 4;
    constexpr int LD = 2304;
    const int xcd_ = blockIdx.x & 7, slot_ = blockIdx.x >> 3, nslot_ = gridDim.x >> 3;
    for (int tile = slot_; tile < 512; tile += nslot_) {
        const int b = xcd_ >> 2, hq = xcd_ & 3;
        const int head = hq * 4 + w, kvh = head >> 3;
        const int t0 = tile * 16, sq = t0 + c;
        const size_t rowq = (size_t)b * 8192 + sq;
        float m = NEG_INF, l = 0.f;
        f32x4 o[4];
#pragma unroll
        for (int d = 0; d < 4; ++d) o[d] = f32x4{0.f, 0.f, 0.f, 0.f};
        const u16* Hq = H + rowq * LD + head * 64 + g4 * 8;
        const bf16x8 q0 = *(const bf16x8*)Hq, q1 = *(const bf16x8*)(Hq + 32);
        const char* Kb = (const char*)((const u16*)(ws + OFF_KI0) + ((size_t)(b * 2 + kvh) * 512) * 1024);
        const char* Vb = (const char*)((const u16*)(ws + OFF_VT0) + ((size_t)(b * 2 + kvh) * 512) * 1024);
        band_loop(tid_, m, l, o, q0, q1, Kb, Vb, 0, t0 - 144, 5, sq, t0, 15, 127);
        l = red16_sum(l);
        const float mu = (m == NEG_INF) ? 0.f : m;
        const float lf = l + __builtin_amdgcn_exp2f(sinks[head] * 1.4426950408889634f - mu);
        const float inv = 1.f / lf;
#pragma unroll
        for (int dt = 0; dt < 4; ++dt) {
            const int dh = dt * 16 + g4 * 4;
            const u32x2 z = *(const u32x2*)(H + rowq * LD + 1280 + head * 64 + dh);
            const float r0 = o[dt][0] * inv * siluf_(bflo(z[0])), r1 = o[dt][1] * inv * siluf_(bfhi(z[0]));
            const float r2 = o[dt][2] * inv * siluf_(bflo(z[1])), r3 = o[dt][3] * inv * siluf_(bfhi(z[1]));
            *(u32x2*)(G + kb_off((int)rowq, head * 64 + dh, 1024)) = u32x2{pack2(r0, r1), pack2(r2, r3)};
        }
    }
}

DEV void compress_phase(const Prm& P) {
    const int tid_ = opaque_tid();
    unsigned char* ws = P.ws;
    const u16* H = (const u16*)(ws + OFF_H);
    constexpr int LD = 3840;
    const float* bias = (const float*)(ws + OFF_BIAS);
    const int lane = tid_ & 63, w = __builtin_amdgcn_readfirstlane(tid_ >> 6), c = lane & 15, g4 = lane >> 4;
    for (int it = blockIdx.x; it < 128; it += gridDim.x) {
        const int unit = it * 4 + w;
        const int which = unit >> 8, b = (unit >> 7) & 1, kvh = (unit >> 5) & 3, ntile = unit & 31;
        const u16* Wt = (const u16*)(ws + (which ? OFF_WCV : OFF_WCK));
        const int colbase = (which ? 1280 : 1024) + kvh * 64;
        const int n = ntile * 16 + c;
        const u16* Wl = Wt + c * 32 + g4 * 8;
        f32x4 acc[4];
#pragma unroll
        for (int e = 0; e < 4; ++e) acc[e] = f32x4{0.f, 0.f, 0.f, 0.f};
#pragma unroll 4
        for (int kk = 0; kk < 64; ++kk) {
            const int j = kk >> 1, d0 = (kk & 1) * 32 + g4 * 8;
            int s = 16 * n + j; s = min(s, 8191);
            const bf16x8 xf = *(const bf16x8*)(H + ((size_t)b * 8192 + s) * LD + colbase + d0);
            bf16x8 wf[4];
#pragma unroll
            for (int e = 0; e < 4; ++e) wf[e] = *(const bf16x8*)(Wl + (size_t)(e * 64 + kk) * 512);
            if (which == 0) {
#pragma unroll
                for (int e = 0; e < 4; ++e) acc[e] = MFMA16(wf[e], xf, acc[e]);
            } else {
#pragma unroll
                for (int e = 0; e < 4; ++e) acc[e] = MFMA16(xf, wf[e], acc[e]);
            }
        }
        if (which == 0) {
            u16* kc = (u16*)(ws + OFF_KCMP) + ((size_t)(b * 4 + kvh) * 32 + ntile) * 1024 + c * 32;
#pragma unroll
            for (int e = 0; e < 4; ++e) {
                const int e0 = e * 16 + g4 * 4;
                const f32x4 bv = *(const f32x4*)(bias + e0);
                const f32x4 r = acc[e] + bv;
                *(u32x2*)(kc + (e0 >> 5) * 512 + (e0 & 31)) = u32x2{pack2(r[0], r[1]), pack2(r[2], r[3])};
            }
        } else {
            u16* vc = (u16*)(ws + OFF_VCMP) + (((size_t)(b * 4 + kvh) * 32 + ntile) * 64) * 16;
#pragma unroll
            for (int e = 0; e < 4; ++e) {
                const int ee = e * 16 + c;
                const float bv = bias[64 + ee];
                *(u32x2*)(vc + ee * 16 + g4 * 4) = u32x2{pack2(acc[e][0] + bv, acc[e][1] + bv), pack2(acc[e][2] + bv, acc[e][3] + bv)};
            }
        }
    }
}

DEV void attnC_phase(const Prm& P, unsigned char* smem) {
    const int tid_ = opaque_tid();
    unsigned char* ws = P.ws;
    const u16* H = (const u16*)(ws + OFF_H);
    u16* G = (u16*)(ws + OFF_G);
    constexpr int LD = 3840;
    float* imp = (float*)smem;
    float* scb = (float*)(smem + 32768);
    float* oslc = (float*)(smem + 34816);
    const int tid = tid_, lane = tid & 63, w = __builtin_amdgcn_readfirstlane(tid >> 6), c = lane & 15, g4 = lane >> 4;
    const int xcd_ = blockIdx.x & 7, slot_ = blockIdx.x >> 3, nslot_ = gridDim.x >> 3;
    for (int i = tid; i < 8192; i += 256) imp[i] = 0.f;
    __syncthreads();
    for (int tk_ = 0; tk_ * nslot_ < 512; ++tk_) {
        const int tile = tk_ * nslot_ + ((tk_ & 1) ? (nslot_ - 1 - slot_) : slot_);
        const int b = xcd_ >> 2, kvh = xcd_ & 3;
        const int t0 = tile * 16;
        const int head = kvh * 4 + w;
        const size_t rowq = (size_t)b * 8192 + t0 + c;
        const u16* Hq = H + rowq * LD + head * 64 + g4 * 8;
        const bf16x8 q0 = *(const bf16x8*)Hq, q1 = *(const bf16x8*)(Hq + 32);
        f32x4 oacc[4];
#pragma unroll
        for (int d = 0; d < 4; ++d) oacc[d] = f32x4{0.f, 0.f, 0.f, 0.f};
        const int nmax = (t0 + c - 31) >> 4;
        const int nmaxw = (t0 - 16) >> 4;
        const float g0 = sigmoidf_(bf2f(H[rowq * LD + 3584 + head]));
        const float g1 = sigmoidf_(bf2f(H[rowq * LD + 3584 + 16 + head]));
        const float g2 = sigmoidf_(bf2f(H[rowq * LD + 3584 + 32 + head]));
        if (nmaxw >= 0) {
            const int nsteps = (nmaxw >> 5) + 1;
            const char* Kb = (const char*)((const u16*)(ws + OFF_KCMP) + ((size_t)(b * 4 + kvh) * 32) * 1024);
            const char* Vb = (const char*)((const u16*)(ws + OFF_VCMP) + ((size_t)(b * 4 + kvh) * 32) * 1024);
            const unsigned kl = c * 64 + g4 * 16, vl = c * 32 + g4 * 8;
            float m = NEG_INF, l = 0.f;
#define CM_LOAD(R, S) do { const int na_ = (S) * 32; const unsigned ba_ = (unsigned)(na_ >> 4) * 2048u, bb_ = (unsigned)min((na_ >> 4) + 1, 31) * 2048u; \
        load_kv(R, Kb, ba_ + kl, bb_ + kl, Vb, ba_ + vl, bb_ + vl); } while (0)
#define CM_PASS1(R, S) do { const int na_ = (S) * 32; f32x4 sa, sb; qk_scores(R, q0, q1, sa, sb); float mx = NEG_INF; float x[8]; \
        _Pragma("unroll") for (int j = 0; j < 8; ++j) { const int n = na_ + (j >> 2) * 16 + g4 * 4 + (j & 3); \
            x[j] = (n <= nmax) ? ((j < 4) ? sa[j & 3] : sb[j & 3]) * 0.125f : NEG_INF; mx = fmaxf(mx, x[j]); } \
        const float mn = fmaxf(m, mx); const float mu = (mn == NEG_INF) ? 0.f : mn; float ps = 0.f; \
        _Pragma("unroll") for (int j = 0; j < 8; ++j) ps += __expf(x[j] - mu); \
        l = l * __expf(m - mu) + ps; m = mn; } while (0)
            RING4(nsteps, CM_LOAD, CM_PASS1);
            float mall = red16_max(m);
            mall = (mall == NEG_INF) ? 0.f : mall;
            l = l * __expf(m - mall);
            l = red16_sum(l);
            const float invl = (l > 0.f) ? 1.f / l : 0.f;
#define CM_PASS2(R, S) do { const int na_ = (S) * 32; f32x4 sa, sb; qk_scores(R, q0, q1, sa, sb); float p[8]; \
        _Pragma("unroll") for (int j = 0; j < 8; ++j) { const int n = na_ + (j >> 2) * 16 + g4 * 4 + (j & 3); \
            const float sv = ((j < 4) ? sa[j & 3] : sb[j & 3]) * 0.125f; \
            p[j] = (n <= nmax) ? __expf(sv - mall) * invl : 0.f; \
            if (n <= nmax) atomicAdd(&imp[n * 16 + c], p[j]); } \
        const bf16x8 pf = pack8(p); \
        oacc[0] = MFMA16(R.v0, pf, oacc[0]); oacc[1] = MFMA16(R.v1, pf, oacc[1]); \
        oacc[2] = MFMA16(R.v2, pf, oacc[2]); oacc[3] = MFMA16(R.v3, pf, oacc[3]); } while (0)
            RING4(nsteps, CM_LOAD, CM_PASS2);
#undef CM_LOAD
#undef CM_PASS1
#undef CM_PASS2
#pragma unroll
            for (int d = 0; d < 4; ++d) oacc[d] *= g0;
        }
        {
            float m = NEG_INF, l = 0.f;
            f32x4 o[4];
#pragma unroll
            for (int d = 0; d < 4; ++d) o[d] = f32x4{0.f, 0.f, 0.f, 0.f};
            const char* Kb = (const char*)((const u16*)(ws + OFF_KI1) + ((size_t)(b * 4 + kvh) * 512) * 1024);
            const char* Vb = (const char*)((const u16*)(ws + OFF_VT1) + ((size_t)(b * 4 + kvh) * 512) * 1024);
            band_loop(tid_, m, l, o, q0, q1, Kb, Vb, 0, t0 - 528, 17, t0 + c, t0, 15, 511);
            l = red16_sum(l);
            const float sc = g2 / l;
#pragma unroll
            for (int d = 0; d < 4; ++d) oacc[d] += o[d] * sc;
        }
        __syncthreads();
        unsigned long long* msk = (unsigned long long*)(smem + 51200) + w * 8;
#pragma unroll 1
        for (int i = 0; i < 4; ++i) {
            const int tok = 4 * w + i, tq = t0 + tok, cur = tq >> 6;
            float my0, my1;
            {
                const int j0 = lane, j1 = lane + 64;
                float a0 = 2.f * (imp[(4 * j0) * 16 + tok] + imp[(4 * j0 + 1) * 16 + tok] + imp[(4 * j0 + 2) * 16 + tok]) + imp[(4 * j0 + 3) * 16 + tok];
                if (j0 > 0) a0 += imp[(4 * j0 - 1) * 16 + tok];
                const float a1 = 2.f * (imp[(4 * j1) * 16 + tok] + imp[(4 * j1 + 1) * 16 + tok] + imp[(4 * j1 + 2) * 16 + tok]) + imp[(4 * j1 + 3) * 16 + tok]
                                 + imp[(4 * j1 - 1) * 16 + tok];
                const bool f0 = (j0 == 0) || (j0 == cur) || (j0 == cur - 1);
                const bool f1 = (j1 == cur) || (j1 == cur - 1);
                my0 = f0 ? 1e4f : ((j0 <= cur) ? a0 : -1.f);
                my1 = f1 ? 1e4f : ((j1 <= cur) ? a1 : -1.f);
            }
            const unsigned k0 = (lane <= cur) ? (__float_as_uint(my0) + 1u) : 0u;
            const unsigned k1 = (lane + 64 <= cur) ? (__float_as_uint(my1) + 1u) : 0u;
            unsigned T = 0u;
#pragma unroll
            for (int bit = 31; bit >= 0; --bit) {
                const unsigned tr = T | (1u << bit);
                const int cnt = __builtin_popcountll(__ballot(k0 >= tr)) + __builtin_popcountll(__ballot(k1 >= tr));
                if (cnt >= 16) T = tr;
            }
            const unsigned long long eq0 = __ballot(k0 == T), eq1 = __ballot(k1 == T);
            const int need = 16 - __builtin_popcountll(__ballot(k0 > T)) - __builtin_popcountll(__ballot(k1 > T));
            const unsigned long long lm = (1ull << lane) - 1ull;
            const bool s0 = (k0 > 0u) && (k0 > T || (k0 == T && __builtin_popcountll(eq0 & lm) < need));
            const bool s1 = (k1 > 0u) && (k1 > T || (k1 == T && __builtin_popcountll(eq0) + __builtin_popcountll(eq1 & lm) < need));
            const unsigned long long lo = __ballot(s0);
            const unsigned long long hi = __ballot(s1);
            if (lane == 0) { msk[i * 2] = lo; msk[i * 2 + 1] = hi; }
        }
#pragma unroll 4
        for (int i = 0; i < 32; ++i) { const int e = i * 64 + lane; imp[(e >> 2) * 16 + 4 * w + (e & 3)] = 0.f; }
        __builtin_amdgcn_fence(__ATOMIC_RELEASE, "wavefront"); __builtin_amdgcn_wave_barrier(); __builtin_amdgcn_fence(__ATOMIC_ACQUIRE, "wavefront");
        {
            const int tokL = 4 * w + (c >> 2), tq = t0 + tokL, hd = kvh * 4 + (c & 3);
            const size_t rq = (size_t)b * 8192 + tq;
            const u16* Hs = H + rq * LD + hd * 64 + g4 * 8;
            const bf16x8 s0 = *(const bf16x8*)Hs, s1 = *(const bf16x8*)(Hs + 32);
            const char* Kb = (const char*)((const u16*)(ws + OFF_KI0) + ((size_t)(b * 4 + kvh) * 512) * 1024);
            const char* Vb = (const char*)((const u16*)(ws + OFF_VT0) + ((size_t)(b * 4 + kvh) * 512) * 1024);
            const unsigned kl = c * 64 + g4 * 16, vl = c * 32 + g4 * 8;
            float m = NEG_INF, l = 0.f;
            f32x4 o[4];
#pragma unroll
            for (int d = 0; d < 4; ++d) o[d] = f32x4{0.f, 0.f, 0.f, 0.f};
            const int ti = c >> 2;
            const unsigned long long mylo = msk[ti * 2], myhi = msk[ti * 2 + 1];
            const unsigned long long ulo = msk[0] | msk[2] | msk[4] | msk[6];
            const unsigned long long uhi = msk[1] | msk[3] | msk[5] | msk[7];
            const unsigned long long alo = msk[0] & msk[2] & msk[4] & msk[6], ahi = msk[1] & msk[3] & msk[5] & msk[7];
            int* blist = (int*)(scb + w * 128);
            const int nlo = __builtin_popcountll(ulo), nblk = nlo + __builtin_popcountll(uhi);
            if ((ulo >> lane) & 1ull) blist[__builtin_popcountll(ulo & ((1ull << lane) - 1ull))] = lane;
            if ((uhi >> lane) & 1ull) blist[nlo + __builtin_popcountll(uhi & ((1ull << lane) - 1ull))] = 64 + lane;
            __builtin_amdgcn_fence(__ATOMIC_RELEASE, "wavefront");
            __builtin_amdgcn_wave_barrier();
            __builtin_amdgcn_fence(__ATOMIC_ACQUIRE, "wavefront");
            const int nst = 2 * nblk;
#define SL_LOAD(R, S) do { const int j_ = __builtin_amdgcn_readfirstlane(blist[(S) >> 1]); const int ua_ = j_ * 64 + ((S) & 1) * 32; \
        load_kv(R, Kb, (unsigned)(ua_ >> 4) * 2048u + kl, (unsigned)((ua_ >> 4) + 1) * 2048u + kl, \
                Vb, (unsigned)(ua_ >> 4) * 2048u + vl, (unsigned)((ua_ >> 4) + 1) * 2048u + vl); } while (0)
#define SL_COMP(R, S) do { const int j_ = __builtin_amdgcn_readfirstlane(blist[(S) >> 1]); const int ua_ = j_ * 64 + ((S) & 1) * 32; \
        const bool selj = (j_ < 64) ? ((mylo >> j_) & 1ull) : ((myhi >> (j_ - 64)) & 1ull); \
        const bool alls_ = (j_ < 64) ? ((alo >> j_) & 1ull) : ((ahi >> (j_ - 64)) & 1ull); \
        const bool fast_ = alls_ && (ua_ + 31 <= t0 + 4 * w); \
        flash_core(m, l, o, s0, s1, R, fast_, selj ? (tq - ua_ - g4 * 4) : -(1 << 30), 0x7fffffffu); } while (0)
            RING4(nst, SL_LOAD, SL_COMP);
#undef SL_LOAD
#undef SL_COMP
            l = red16_sum(l);
            const float inv = 1.f / l;
#pragma unroll
            for (int dt = 0; dt < 4; ++dt)
                *(f32x4*)(oslc + (tokL * 4 + (c & 3)) * 64 + dt * 16 + g4 * 4) = o[dt] * inv;
        }
        __syncthreads();
#pragma unroll
        for (int dt = 0; dt < 4; ++dt) {
            const int dh = dt * 16 + g4 * 4;
            const f32x4 os = *(const f32x4*)(oslc + (c * 4 + w) * 64 + dh);
            const f32x4 r = oacc[dt] + os * g1;
            const u32x2 z = *(const u32x2*)(H + rowq * LD + 2560 + head * 64 + dh);
            const float r0 = r[0] * siluf_(bflo(z[0])), r1 = r[1] * siluf_(bfhi(z[0]));
            const float r2 = r[2] * siluf_(bflo(z[1])), r3 = r[3] * siluf_(bfhi(z[1]));
            *(u32x2*)(G + kb_off((int)rowq, head * 64 + dh, 1024)) = u32x2{pack2(r0, r1), pack2(r2, r3)};
        }
    }
}

#ifndef PROBE_DUP
#define PROBE_DUP 0
#endif
#define REP(k) for (int rep_ = 0; rep_ < 1 + ((PROBE_DUP >> (k)) & 1); ++rep_)
constexpr int LDS_BYTES = 3 * GSTAGE + 64;
__global__ void __launch_bounds__(256, 2) mk_fwd(Prm P) {
    extern __shared__ __attribute__((aligned(16))) unsigned char smem[];
    unsigned* xb_words = (unsigned*)(smem + 3 * GSTAGE);
    if (threadIdx.x < 4) xb_words[threadIdx.x] = 0u;
    __syncthreads();
    XcdBarrier bar = xcd_barrier_post((unsigned*)(P.ws + OFF_BAR), (volatile LAS unsigned*)xb_words);
    unsigned char* ws = P.ws;

    phase0(P, smem);
    if (P.ws == nullptr) cg::this_grid().sync();
    xcd_barrier(bar);

#pragma unroll 1
    for (int layer = 0; layer < 4; ++layer) {
        const int kind = layer % 3, lj = layer / 3;
        const u16* Win; const u16* Wout; int N, nsub;
        if (kind == 0)      { Win = (const u16*)(ws + OFF_WA_IN + (size_t)lj * SZ_WA_IN); Wout = (const u16*)(ws + OFF_WA_OUT + (size_t)lj * SZ_SQ); N = 2560; nsub = 4; }
        else if (kind == 1) { Win = (const u16*)(ws + OFF_WB_IN); Wout = (const u16*)(ws + OFF_WB_OUT); N = 2304; nsub = 1; }
        else                { Win = (const u16*)(ws + OFF_WC_IN); Wout = (const u16*)(ws + OFF_WC_OUT); N = 3840; nsub = 1; }
#pragma unroll 1
        for (int sub = 0; sub < nsub; ++sub) {
            REP(0) gemm_in_phase(smem, P, kind, Win + (size_t)sub * 2560 * 1024, N);
            xcd_barrier(bar);
            if (kind == 0) REP(1) attnA_phase(P, sub);
            else if (kind == 1) REP(2) attnB_phase(P);
            else { REP(3) compress_phase(P); xcd_barrier(bar); REP(4) attnC_phase(P, smem); }
            xcd_barrier(bar);
        }
        gemm_out_phase(smem, P, Wout, layer == 0 ? P.in[0] : P.out);
        xcd_barrier(bar);
        ln_phase(P, layer);
        xcd_barrier(bar);
        gemm_gate_phase(smem, P, (const u16*)(ws + OFF_WG + (size_t)layer * SZ_SQ), (const u16*)(ws + OFF_WP + (size_t)layer * SZ_WP));
        if (layer < 3) xcd_barrier(bar);
    }
}

extern "C" void kernel_launch(void* const* d_in, const int* in_sizes, int n_in, void* d_out, int out_size, void* d_ws, size_t ws_size,
                              hipStream_t stream) {
    static int grid_blocks = 0;
    if (!grid_blocks) {
        int dev = 0, cus = 0, per_cu = 0;
        (void)hipGetDevice(&dev);
        (void)hipDeviceGetAttribute(&cus, hipDeviceAttributeMultiprocessorCount, dev);
        (void)hipFuncSetAttribute((const void*)mk_fwd, hipFuncAttributeMaxDynamicSharedMemorySize, LDS_BYTES);
        (void)hipOccupancyMaxActiveBlocksPerMultiprocessor(&per_cu, (const void*)mk_fwd, 256, LDS_BYTES);
        if (per_cu > 2) per_cu = 2;
        if (per_cu < 1) per_cu = 1;
        grid_blocks = cus * per_cu;
        if (ws_size < WS_END || n_in != 16) { fprintf(stderr, "kernel_launch: workspace too small (%zu < %zu) or n_in %d != 16\n", ws_size, (size_t)WS_END, n_in); grid_blocks = -1; }
    }
    if (grid_blocks < 0) return;
    (void)hipMemsetAsync((char*)d_ws + OFF_BAR, 0, 16384, stream);
    Prm p{};
    for (int i = 0; i < 16; ++i) p.in[i] = (const float*)d_in[i];
    p.out = (float*)d_out; p.ws = (unsigned char*)d_ws;
    void* args[] = {&p};
    hipError_t e = hipLaunchCooperativeKernel((const void*)mk_fwd, dim3(grid_blocks), dim3(256), args, LDS_BYTES, stream);
    if (e != hipSuccess) fprintf(stderr, "cooperative launch failed: %s (grid %d)\n", hipGetErrorString(e), grid_blocks);
}
```

```cpp
#include <hip/hip_runtime.h>
#include <hip/hip_cooperative_groups.h>
#include <cstdio>
#include <cstdint>
namespace cg = cooperative_groups;

typedef unsigned short u16;
using bf16x8 = __attribute__((ext_vector_type(8))) short;
using s16x4  = __attribute__((ext_vector_type(4))) short;
using f32x4  = __attribute__((ext_vector_type(4))) float;
using u32x4  = __attribute__((ext_vector_type(4))) unsigned;
using u32x2  = __attribute__((ext_vector_type(2))) unsigned;
#define DEV __device__ __forceinline__
using h16x8 = __attribute__((ext_vector_type(8))) _Float16;
#define MFMA16(a, b, c) __builtin_amdgcn_mfma_f32_16x16x32_f16(__builtin_bit_cast(h16x8, (a)), __builtin_bit_cast(h16x8, (b)), (c), 0, 0, 0)
#define LAS __attribute__((address_space(3)))

constexpr int T = 16384, S = 8192;
constexpr float LN_EPS = 1e-5f;
constexpr float DN_ALPHA = 1.6817928305074290f;
constexpr float NEG_INF = -__builtin_huge_valf();

constexpr size_t OFF_BAR   = 0;
constexpr size_t OFF_COS   = 16384;
constexpr size_t OFF_SIN   = OFF_COS + (size_t)8192 * 32 * 4;
constexpr size_t OFF_BIAS  = OFF_SIN + (size_t)8192 * 32 * 4;
constexpr size_t OFF_WA_IN = OFF_BIAS + 1024;
constexpr size_t SZ_WA_IN  = (size_t)10240 * 1024 * 2;
constexpr size_t SZ_SQ     = (size_t)1024 * 1024 * 2;
constexpr size_t OFF_WA_OUT = OFF_WA_IN + 2 * SZ_WA_IN;
constexpr size_t OFF_WB_IN  = OFF_WA_OUT + 2 * SZ_SQ;
constexpr size_t OFF_WB_OUT = OFF_WB_IN + (size_t)2304 * 1024 * 2;
constexpr size_t OFF_WC_IN  = OFF_WB_OUT + SZ_SQ;
constexpr size_t OFF_WC_OUT = OFF_WC_IN + (size_t)3840 * 1024 * 2;
constexpr size_t OFF_WG     = OFF_WC_OUT + SZ_SQ;
constexpr size_t OFF_WP     = OFF_WG + 4 * SZ_SQ;
constexpr size_t SZ_WP      = (size_t)1024 * 256 * 2;
constexpr size_t OFF_WCK    = OFF_WP + 4 * SZ_WP;
constexpr size_t OFF_WCV    = OFF_WCK + (size_t)64 * 2048 * 2;
constexpr size_t OFF_XB     = OFF_WCV + (size_t)64 * 2048 * 2;
constexpr size_t SZ_ACT     = (size_t)T * 1024 * 2;
constexpr size_t OFF_G      = OFF_XB + SZ_ACT;
constexpr size_t OFF_H      = OFF_G + SZ_ACT;
constexpr size_t SZ_HMAX    = (size_t)T * 3840 * 2;
constexpr size_t OFF_VT0    = OFF_H + SZ_HMAX;
constexpr size_t SZ_VT      = (size_t)2 * 4 * 8192 * 64 * 2;
constexpr size_t OFF_VT1    = OFF_VT0 + SZ_VT;
constexpr size_t OFF_VT2    = OFF_VT1 + SZ_VT;
constexpr size_t OFF_KCMP   = OFF_VT2 + SZ_VT;
constexpr size_t SZ_CMP     = (size_t)2 * 512 * 4 * 64 * 2;
constexpr size_t OFF_VCMP   = OFF_KCMP + SZ_CMP;
constexpr size_t OFF_KI0    = OFF_VCMP + SZ_CMP;
constexpr size_t OFF_KI1    = OFF_KI0 + SZ_VT;
constexpr size_t OFF_KI2    = OFF_KI1 + SZ_VT;
constexpr size_t WS_END     = OFF_KI2 + SZ_VT;
constexpr size_t OFF_XLB    = OFF_H;
constexpr size_t OFF_PB     = OFF_H + SZ_ACT;
constexpr size_t OFF_PP     = OFF_H + SZ_ACT + (size_t)16 * 1024 * 1024;

struct Prm { const float* in[16]; float* out; unsigned char* ws; };

__device__ __forceinline__ size_t kb_off(int row, int k, int K) { return ((size_t)(row >> 4) * (K >> 5) + (k >> 5)) * 512 + (row & 15) * 32 + (k & 31); }
DEV u16 f2bf(float f) { return __builtin_bit_cast(u16, (_Float16)f); }
DEV float bf2f(u16 h) { return (float)__builtin_bit_cast(_Float16, h); }
DEV unsigned pack2(float a, float b) { return (unsigned)f2bf(a) | ((unsigned)f2bf(b) << 16); }
DEV float bflo(unsigned u) { return bf2f((u16)(u & 0xffffu)); }
DEV float bfhi(unsigned u) { return bf2f((u16)(u >> 16)); }
DEV float sigmoidf_(float x) { return 1.f / (1.f + __expf(-x)); }
DEV float siluf_(float x) { return x / (1.f + __expf(-x)); }
DEV float red16_max(float v) { v = fmaxf(v, __shfl_xor(v, 16)); v = fmaxf(v, __shfl_xor(v, 32)); return v; }
DEV float red16_sum(float v) { v += __shfl_xor(v, 16); v += __shfl_xor(v, 32); return v; }
DEV float wave_sum(float v) { for (int o = 32; o > 0; o >>= 1) v += __shfl_xor(v, o); return v; }

DEV int opaque_tid() { int t = threadIdx.x; asm volatile("" : "+v"(t)); return t; }
#define XB_TMO      128
#define XB_XCNT(j)  (256  + 64 * (j))
#define XB_XSUB(j)  (1280 + 64 * (j))
#define XB_XGEN(j)  (2304 + 64 * (j))
#define XB_TOP      3328
#define XB_TOPGEN   3392
#define XCD_BAR_WORDS 3456
#define XB_SPIN_CAP (1u << 24)
DEV unsigned xb_ld(unsigned* p)              { return __hip_atomic_load(p, __ATOMIC_RELAXED, __HIP_MEMORY_SCOPE_AGENT); }
DEV unsigned xb_add(unsigned* p, unsigned v) { return __hip_atomic_fetch_add(p, v, __ATOMIC_RELAXED, __HIP_MEMORY_SCOPE_AGENT); }
DEV unsigned xb_xcc_id() { return (unsigned)__builtin_amdgcn_s_getreg((3 << 11) | 20) & 0xFu; }
#define XB_SPIN(cond, bar) do { unsigned _sp = 0; while (cond) { __builtin_amdgcn_s_sleep(1); \
    if ((++_sp & 255u) == 0u) { if (xb_ld(&(bar)[XB_TMO])) break; if (_sp > XB_SPIN_CAP) { atomicAdd(&(bar)[XB_TMO], 1u); break; } } } } while (0)
struct XcdBarrier { unsigned* bar; unsigned x; volatile LAS unsigned* st; };
DEV XcdBarrier xcd_barrier_post(unsigned* bar, volatile LAS unsigned* st) {
    XcdBarrier b; b.bar = bar; b.x = xb_xcc_id(); b.st = st;
    if (threadIdx.x == 0) (void)xb_add(&bar[XB_XCNT(b.x)], 1u);
    return b;
}
DEV void xcd_barrier_complete(unsigned* bar, unsigned x, unsigned& nloc, unsigned& nx) {
    const unsigned G = gridDim.x * gridDim.y * gridDim.z;
    unsigned sum, cnt, mine, sp = 0u;
    for (;;) {
        sum = 0u; cnt = 0u; mine = 0u;
#pragma unroll
        for (unsigned j = 0; j < 16; ++j) { const unsigned c = xb_ld(&bar[XB_XCNT(j)]); sum += c; cnt += (c > 0u) ? 1u : 0u; mine = (j == x) ? c : mine; }
        if (sum == G) break;
        __builtin_amdgcn_s_sleep(1);
        if ((++sp & 255u) == 0u) { if (xb_ld(&bar[XB_TMO])) break; if (sp > XB_SPIN_CAP) { atomicAdd(&bar[XB_TMO], 1u); break; } }
    }
    nloc = mine > 0u ? mine : 1u; nx = cnt > 0u ? cnt : 1u;
}
DEV void xcd_barrier(const XcdBarrier& b) {
    asm volatile("s_waitcnt vmcnt(0)" ::: "memory");
    __syncthreads();
    if (threadIdx.x == 0) {
        unsigned* bar = b.bar;
        __builtin_amdgcn_s_waitcnt(0);
        unsigned nloc = b.st[0], nx = b.st[1];
        if (nloc == 0u) { xcd_barrier_complete(bar, b.x, nloc, nx); b.st[0] = nloc; b.st[1] = nx; }
        const unsigned old = xb_add(&bar[XB_XSUB(b.x)], 1u);
        const unsigned gen = old / nloc;
        if (old + 1u == (gen + 1u) * nloc) {
            __builtin_amdgcn_fence(__ATOMIC_RELEASE, "agent");
            asm volatile("s_waitcnt vmcnt(0)" ::: "memory");
            const unsigned og = xb_add(&bar[XB_TOP], 1u);
            const unsigned tg = og / nx;
            if (og + 1u == (tg + 1u) * nx) xb_add(&bar[XB_TOPGEN], 1u);
            else XB_SPIN(xb_ld(&bar[XB_TOPGEN]) == tg, bar);
            __builtin_amdgcn_fence(__ATOMIC_ACQUIRE, "agent");
            xb_add(&bar[XB_XGEN(b.x)], 1u);
            asm volatile("s_waitcnt vmcnt(0)" ::: "memory");
        } else {
            XB_SPIN(xb_ld(&bar[XB_XGEN(b.x)]) == gen, bar);
            __builtin_amdgcn_fence(__ATOMIC_ACQUIRE, "agent");
            asm volatile("s_waitcnt vmcnt(0)" ::: "memory");
        }
    }
    __syncthreads();
}

DEV int colmap(int kind, int n) {
    if (kind == 0) return n;
    if (kind == 1) {
        const int c = n / 2560, nn = n - c * 2560;
        if (nn < 2304) { const int g = nn / 768, rem = nn - g * 768, part = rem >> 8, hh = (rem & 255) >> 6, d = rem & 63;
                         return g * 3072 + part * 1024 + (c * 4 + hh) * 64 + d; }
        const int z = nn - 2304; return 9216 + (c * 4 + (z >> 6)) * 64 + (z & 63);
    }
    if (n < 2560) return n;
    if (n < 3584) return n - 2560 + 2608;
    if (n < 3632) return n - 3584 + 2560;
    return -1;
}
DEV void tconv(const int tid_, float* lds, const float* __restrict__ src, int K, int Nsrc, u16* __restrict__ dst, int Ndst, int kind, int& acc_tiles) {
    const int G = gridDim.x, tid = tid_;
    const int ntn = Ndst >> 6, ntk = K >> 6, nt = ntn * ntk;
    int first = ((int)blockIdx.x - (acc_tiles % G) + G) % G;
    acc_tiles += nt;
    for (int t = first; t < nt; t += G) {
        const int tn = t / ntk, tk = t - tn * ntk;
        const int n0 = tn << 6, k0 = tk << 6;
        const int nl = tid & 63;
        const int c = colmap(kind, n0 + nl);
#pragma unroll
        for (int i = 0; i < 16; ++i) {
            const int kl = (tid >> 6) + 4 * i;
            const float v = (c >= 0) ? src[(size_t)(k0 + kl) * Nsrc + c] : 0.f;
            lds[kl * 65 + nl] = v;
        }
        __syncthreads();
        const int r = tid >> 2, kk = (tid & 3) << 4;
        unsigned o[8];
#pragma unroll
        for (int i = 0; i < 8; ++i) o[i] = pack2(lds[(kk + 2 * i) * 65 + r], lds[(kk + 2 * i + 1) * 65 + r]);
        u32x4* dp = (u32x4*)(dst + kb_off(n0 + r, k0 + kk, K));
        dp[0] = u32x4{o[0], o[1], o[2], o[3]};
        dp[1] = u32x4{o[4], o[5], o[6], o[7]};
        __syncthreads();
    }
}

DEV void phase0(const Prm& P, unsigned char* smem) {
    const int tid_ = opaque_tid();
    float* lds = (float*)smem;
    unsigned char* ws = P.ws;
    int acc = 0;
    tconv(tid_, lds, P.in[2], 1024, 10240, (u16*)(ws + OFF_WA_IN), 10240, 1, acc);
    tconv(tid_, lds, P.in[2] + (size_t)1024 * 10240, 1024, 10240, (u16*)(ws + OFF_WA_IN + SZ_WA_IN), 10240, 1, acc);
    tconv(tid_, lds, P.in[3], 1024, 1024, (u16*)(ws + OFF_WA_OUT), 1024, 0, acc);
    tconv(tid_, lds, P.in[3] + (size_t)1024 * 1024, 1024, 1024, (u16*)(ws + OFF_WA_OUT + SZ_SQ), 1024, 0, acc);
    tconv(tid_, lds, P.in[4], 1024, 2304, (u16*)(ws + OFF_WB_IN), 2304, 0, acc);
    tconv(tid_, lds, P.in[6], 1024, 1024, (u16*)(ws + OFF_WB_OUT), 1024, 0, acc);
    tconv(tid_, lds, P.in[7], 1024, 3632, (u16*)(ws + OFF_WC_IN), 3840, 2, acc);
    tconv(tid_, lds, P.in[11], 1024, 1024, (u16*)(ws + OFF_WC_OUT), 1024, 0, acc);
    for (int i = 0; i < 4; ++i) {
        tconv(tid_, lds, P.in[15] + (size_t)i * 1024 * 1024, 1024, 1024, (u16*)(ws + OFF_WG + i * SZ_SQ), 1024, 0, acc);
        tconv(tid_, lds, P.in[14] + (size_t)i * 256 * 1024, 256, 1024, (u16*)(ws + OFF_WP + i * SZ_WP), 1024, 0, acc);
    }
    tconv(tid_, lds, P.in[8], 2048, 64, (u16*)(ws + OFF_WCK), 64, 0, acc);
    tconv(tid_, lds, P.in[9], 2048, 64, (u16*)(ws + OFF_WCV), 64, 0, acc);

    const size_t gtid = (size_t)blockIdx.x * 256 + tid_, gsz = (size_t)gridDim.x * 256;
    {
        const float* x = P.in[0]; u16* xb = (u16*)(ws + OFF_XB);
        for (size_t i = gtid; i < (size_t)T * 1024 / 8; i += gsz) {
            const f32x4 a = *(const f32x4*)(x + i * 8), b = *(const f32x4*)(x + i * 8 + 4);
            *(u32x4*)(xb + kb_off((int)(i >> 7), (int)(i & 127) * 8, 1024)) = u32x4{pack2(a[0], a[1]), pack2(a[2], a[3]), pack2(b[0], b[1]), pack2(b[2], b[3])};
        }
    }
    {
        float* ct = (float*)(ws + OFF_COS); float* st = (float*)(ws + OFF_SIN);
        for (size_t i = gtid; i < (size_t)8192 * 32; i += gsz) {
            const int pos = (int)(i >> 5), k = (int)(i & 31);
            const float inv = (float)(1.0 / pow(10000.0, (double)(2 * k) / 64.0));
            const float ang = (float)pos * inv;
            ct[i] = (float)cos((double)ang); st[i] = (float)sin((double)ang);
        }
    }
    {
        const int lane = tid_ & 63;
        const int wid = blockIdx.x * 4 + __builtin_amdgcn_readfirstlane(tid_ >> 6);
        if (wid < 128) {
            const float* w = (wid < 64) ? P.in[8] : P.in[9];
            const int e = wid & 63;
            float s = 0.f;
            for (int jd = lane; jd < 2048; jd += 64) s += P.in[10][jd] * w[(size_t)jd * 64 + e];
            s = wave_sum(s);
            if (lane == 0) ((float*)(ws + OFF_BIAS))[wid] = s;
        }
    }
}

constexpr int GSTAGE = 24576;
DEV int gsw(int r) { return (0x78 >> (2 * ((r >> 2) & 3))) & 3; }
DEV void gemm_issue(unsigned char* stage, const u16* ag0, const u16* ag1, const u16* bg, int bstep, int kt, int w) {
    __builtin_amdgcn_global_load_lds((const unsigned*)(ag0 + kt * 512), (unsigned*)(stage + w * 1024), 16, 0, 0);
    __builtin_amdgcn_global_load_lds((const unsigned*)(ag1 + kt * 512), (unsigned*)(stage + w * 1024 + 4096), 16, 0, 0);
#pragma unroll
    for (int i = 0; i < 4; ++i)
        __builtin_amdgcn_global_load_lds((const unsigned*)(bg + (size_t)i * bstep + kt * 512), (unsigned*)(stage + 8192 + w * 1024 + i * 4096), 16, 0, 0);
}
template <bool NONSWAP>
DEV void gemm_mainloop(const int tid_, unsigned char* smem, const u16* __restrict__ A, int lda, const u16* __restrict__ Bt, int ldb, int K,
                       int m0, int n0, f32x4 (&acc)[32], bool aperm = false) {
    const int tid = tid_, lane = tid & 63, w = __builtin_amdgcn_readfirstlane(tid >> 6), wm = w >> 1, wn = w & 1;
    const int lrow = tid >> 2, lsw = ((tid & 3) ^ gsw(lrow)) * 8;
    const int arow0 = aperm ? ((lrow & 31) * 4 + (lrow >> 5)) : lrow;
    const int arow1 = aperm ? (arow0 + 2) : (lrow + 64);
    const u16* ag0 = A + kb_off(m0 + arow0, 0, lda) + lsw;
    const u16* ag1 = A + kb_off(m0 + arow1, 0, lda) + lsw;
    const u16* bg = Bt + kb_off(n0 + lrow, 0, ldb) + lsw;
    const int bstep = 4 * (ldb >> 5) * 512;
    const int fr = lane & 15, fq = lane >> 4;
    const int coff = (fq ^ gsw(fr)) << 4;
    const int a_base = (wm * 64 + fr) * 64 + coff, b_base = 8192 + (wn * 128 + fr) * 64 + coff;
    const int nk = K >> 5;
    asm volatile("s_waitcnt vmcnt(0)" ::: "memory");
    __builtin_amdgcn_s_barrier();
    gemm_issue(smem, ag0, ag1, bg, bstep, 0, w);
    gemm_issue(smem + GSTAGE, ag0, ag1, bg, bstep, 1, w);
    int sc = 0, si = 2;
    for (int kt = 0; kt < nk; ++kt) {
        if (kt + 1 < nk) asm volatile("s_waitcnt vmcnt(6)" ::: "memory"); else asm volatile("s_waitcnt vmcnt(0)" ::: "memory");
        __builtin_amdgcn_s_barrier();
        if (kt + 2 < nk) { gemm_issue(smem + si * GSTAGE, ag0, ag1, bg, bstep, kt + 2, w); si = (si == 2) ? 0 : si + 1; }
        const unsigned char* st = smem + sc * GSTAGE; sc = (sc == 2) ? 0 : sc + 1;
        bf16x8 a[4], b[4];
#pragma unroll
        for (int i = 0; i < 4; ++i) a[i] = *(const bf16x8*)(st + a_base + i * 1024);
#pragma unroll
        for (int hb = 0; hb < 2; ++hb) {
#pragma unroll
            for (int i = 0; i < 4; ++i) b[i] = *(const bf16x8*)(st + b_base + (hb * 4 + i) * 1024);
            if (NONSWAP) {
#pragma unroll
                for (int mt = 0; mt < 4; ++mt)
#pragma unroll
                    for (int nt = 0; nt < 4; ++nt) acc[mt * 8 + hb * 4 + nt] = MFMA16(a[mt], b[nt], acc[mt * 8 + hb * 4 + nt]);
            } else {
#pragma unroll
                for (int nt = 0; nt < 4; ++nt)
#pragma unroll
                    for (int mt = 0; mt < 4; ++mt) acc[(hb * 4 + nt) * 4 + mt] = MFMA16(b[nt], a[mt], acc[(hb * 4 + nt) * 4 + mt]);
            }
        }
    }
}

DEV int vblock() { const int G = gridDim.x, b = blockIdx.x; return ((G & 7) == 0) ? (b & 7) * (G >> 3) + (b >> 3) : b; }
DEV void tile_mn(int t, int nN, int& mi, int& ni) { const int per = 8 * nN; const int mg = t / per, r = t - mg * per; mi = mg * 8 + (r & 7); ni = r >> 3; }
#define ZERO_ACC(acc) _Pragma("unroll") for (int i_ = 0; i_ < 32; ++i_) acc[i_] = f32x4{0.f, 0.f, 0.f, 0.f}

DEV void classify(int kind, int cgi, int& mode, int& vsel, int& vth, int& dsh, int& nhv, int& ksel) {
    mode = 0; vsel = 0; vth = 0; dsh = 0; nhv = 4; ksel = -1;
    if (kind == 0) {
        if (cgi < 36) { const int g = cgi / 12, part = (cgi - g * 12) >> 2; vth = cgi & 3; if (part < 2) { mode = 1; if (part == 1) { ksel = g; dsh = 2 * g; } } else { mode = 2; vsel = g; dsh = 2 * g; } }
    } else if (kind == 1) {
        if (cgi < 16) mode = 1; else if (cgi < 18) { mode = 1; ksel = 0; vth = cgi - 16; nhv = 2; } else if (cgi < 20) { mode = 2; vsel = 0; vth = cgi - 18; nhv = 2; }
    } else {
        if (cgi < 20) mode = 1; else if (cgi < 24) mode = 0; else if (cgi < 28) { mode = 1; ksel = 0; vth = cgi - 24; } else if (cgi < 32) { mode = 2; vsel = 0; vth = cgi - 28; }
        else if (cgi < 36) { mode = 1; ksel = 1; vth = cgi - 32; } else if (cgi < 40) { mode = 2; vsel = 1; vth = cgi - 36; }
    }
}

DEV void gemm_in_phase(unsigned char* smem, const Prm& P, int kind, const u16* Wt, int N) {
    const int tid_ = opaque_tid();
    unsigned char* ws = P.ws;
    const u16* A = (const u16*)(ws + OFF_XB);
    u16* H = (u16*)(ws + OFF_H);
    const float* cosT = (const float*)(ws + OFF_COS); const float* sinT = (const float*)(ws + OFF_SIN);
    const int nN = N >> 8, ntiles = 128 * nN;
    const int lane = tid_ & 63, w = __builtin_amdgcn_readfirstlane(tid_ >> 6), wm = w >> 1, wn = w & 1, fr = lane & 15, fq = lane >> 4;
    const int G_ = gridDim.x, vb_ = vblock(), nfull_ = ntiles / G_, R_ = ntiles - nfull_ * G_;
    const int per_x = ((G_ & 7) == 0) ? (G_ >> 3) : G_, rx_ = ((G_ & 7) == 0 && (R_ & 7) == 0) ? (R_ >> 3) : 0;
    const int xs_ = vb_ / per_x, sl_ = vb_ - xs_ * per_x;
    const int tail_t = (rx_ > 0) ? ((sl_ < rx_) ? nfull_ * G_ + xs_ * rx_ + sl_ : -1) : ((vb_ < R_) ? nfull_ * G_ + vb_ : -1);
    for (int rnd_ = 0; rnd_ <= nfull_; ++rnd_) {
        const int t = (rnd_ < nfull_) ? (vb_ + rnd_ * G_) : tail_t;
        if (t < 0) break;
        int mi, ni; tile_mn(t, nN, mi, ni);
        const int m0 = mi << 7, n0 = ni << 8;
        const int ncol = n0 + wn * 128, cg0 = ncol >> 6;
        int mode, vsel, vth, dsh, nhv, ksel; classify(kind, cg0, mode, vsel, vth, dsh, nhv, ksel);
        const int mw = m0 + wm * 64;
        f32x4 acc[32]; ZERO_ACC(acc);
        if (mode == 2) {
            gemm_mainloop<true>(tid_, smem, A, 1024, Wt, 1024, 1024, m0, n0, acc, dsh == 2);
            __builtin_amdgcn_s_barrier();
            u16* vt = (u16*)(ws + (vsel == 0 ? OFF_VT0 : (vsel == 1 ? OFF_VT1 : OFF_VT2)));
            if (dsh == 0) {
#pragma unroll
                for (int mt = 0; mt < 4; ++mt) {
                    const int m = mw + mt * 16 + fq * 4;
                    const int b = m >> 13, p = m & 8191;
#pragma unroll
                    for (int grp = 0; grp < 2; ++grp) {
                        u16* dst = vt + ((((size_t)(b * nhv + vth + grp)) * 512 + (p >> 4)) * 64) * 16 + (p & 15);
#pragma unroll
                        for (int nt = 0; nt < 4; ++nt) { const f32x4 v = acc[mt * 8 + grp * 4 + nt]; *(u32x2*)(dst + (nt * 16 + fr) * 16) = u32x2{pack2(v[0], v[1]), pack2(v[2], v[3])}; }
                    }
                }
            } else if (dsh == 4) {
#pragma unroll
                for (int j = 0; j < 4; ++j) {
                    const int m = mw + fq * 4 + j;
                    const int b = m >> 13, s = m & 8191;
                    const int p = ((s & 15) << 9) + (s >> 4);
#pragma unroll
                    for (int grp = 0; grp < 2; ++grp) {
                        u16* dst = vt + ((((size_t)(b * nhv + vth + grp)) * 512 + (p >> 4)) * 64) * 16 + (p & 15);
#pragma unroll
                        for (int nt = 0; nt < 4; ++nt)
                            *(u32x2*)(dst + (nt * 16 + fr) * 16) = u32x2{pack2(acc[0 * 8 + grp * 4 + nt][j], acc[1 * 8 + grp * 4 + nt][j]), pack2(acc[2 * 8 + grp * 4 + nt][j], acc[3 * 8 + grp * 4 + nt][j])};
                    }
                }
            } else {
#pragma unroll
                for (int mt = 0; mt < 4; ++mt) {
                    const int r0 = wm * 64 + mt * 16 + fq * 4;
                    const int m = m0 + (r0 & 31) * 4 + (r0 >> 5);
                    const int b = m >> 13, s = m & 8191;
                    const int p = ((s & 3) << 11) + (s >> 2);
#pragma unroll
                    for (int grp = 0; grp < 2; ++grp) {
                        u16* dst = vt + ((((size_t)(b * nhv + vth + grp)) * 512 + (p >> 4)) * 64) * 16 + (p & 15);
#pragma unroll
                        for (int nt = 0; nt < 4; ++nt) { const f32x4 v = acc[mt * 8 + grp * 4 + nt]; *(u32x2*)(dst + (nt * 16 + fr) * 16) = u32x2{pack2(v[0], v[1]), pack2(v[2], v[3])}; }
                    }
                }
            }
        } else {
            gemm_mainloop<false>(tid_, smem, A, 1024, Wt, 1024, 1024, m0, n0, acc);
            __builtin_amdgcn_s_barrier();
            constexpr int EROW = 272;
            unsigned char* est = smem + w * (64 * EROW);
            int l4_ = lane; asm volatile("" : "+v"(l4_));
            const int fr = l4_ & 15, fq = l4_ >> 4;
#pragma unroll
            for (int mt = 0; mt < 4; ++mt) {
                const int s = (mw + mt * 16 + fr) & 8191;
                unsigned char* erow = est + (mt * 16 + fr) * EROW + fq * 8;
                if (mode == 1) {
#pragma unroll
                    for (int nt = 0; nt < 2; ++nt) {
                        const f32x4 c4 = *(const f32x4*)(cosT + s * 32 + nt * 16 + fq * 4);
                        const f32x4 s4 = *(const f32x4*)(sinT + s * 32 + nt * 16 + fq * 4);
#pragma unroll
                        for (int grp = 0; grp < 2; ++grp) {
                            const f32x4 x1 = acc[(grp * 4 + nt) * 4 + mt], x2 = acc[(grp * 4 + nt + 2) * 4 + mt];
                            const f32x4 o1 = x1 * c4 - x2 * s4, o2 = x2 * c4 + x1 * s4;
                            *(u32x2*)(erow + (grp * 64 + nt * 16) * 2) = u32x2{pack2(o1[0], o1[1]), pack2(o1[2], o1[3])};
                            *(u32x2*)(erow + (grp * 64 + (nt + 2) * 16) * 2) = u32x2{pack2(o2[0], o2[1]), pack2(o2[2], o2[3])};
                        }
                    }
                } else {
#pragma unroll
                    for (int nt = 0; nt < 8; ++nt) { const f32x4 v = acc[nt * 4 + mt]; *(u32x2*)(erow + nt * 32) = u32x2{pack2(v[0], v[1]), pack2(v[2], v[3])}; }
                }
            }
            __builtin_amdgcn_fence(__ATOMIC_RELEASE, "wavefront"); __builtin_amdgcn_wave_barrier(); __builtin_amdgcn_fence(__ATOMIC_ACQUIRE, "wavefront");
            {
                const int rr = l4_ >> 4, ch = l4_ & 15;
                if (ksel >= 0) {
                    u16* ki = (u16*)(ws + (ksel == 0 ? OFF_KI0 : (ksel == 1 ? OFF_KI1 : OFF_KI2)));
                    const int dmask = (1 << dsh) - 1, lsh = 13 - dsh, numask = (64 >> dsh) - 1;
                    const int kk = l4_ >> 2, c4 = l4_ & 3;
#pragma unroll 4
                    for (int i = 0; i < 16; ++i) {
                        const int rgp = i >> 2, hd = (i >> 1) & 1, half = i & 1;
                        const int tt = rgp * 16 + kk;
                        const int row = ((tt & numask) << dsh) + (tt >> (6 - dsh));
                        const int m = mw + row, b = m >> 13, s = m & 8191;
                        const int p = ((s & dmask) << lsh) + (s >> dsh);
                        const u32x4 v = *(const u32x4*)(est + row * EROW + (hd * 64 + half * 32 + c4 * 8) * 2);
                        *(u32x4*)(ki + ((((size_t)(b * nhv + vth + hd) * 512 + (p >> 4)) * 2 + half) * 16 + (p & 15)) * 32 + c4 * 8) = v;
                    }
                } else {
                u16* hbase = H + (size_t)mw * N + ncol + ch * 8;
#pragma unroll
                for (int i = 0; i < 16; ++i) {
                    const int row = i * 4 + rr;
                    const u32x4 v = *(const u32x4*)(est + row * EROW + ch * 16);
                    *(u32x4*)(hbase + (size_t)row * N) = v;
                }
                }
            }
        }
    }
}

DEV void gemm_out_phase(unsigned char* smem, const Prm& P, const u16* Wt, const float* xin) {
    const int tid_ = opaque_tid();
    const u16* A = (const u16*)(P.ws + OFF_G);
    const int lane = tid_ & 63, w = __builtin_amdgcn_readfirstlane(tid_ >> 6), wm = w >> 1, wn = w & 1, fr = lane & 15, fq = lane >> 4;
    for (int t = vblock(); t < 512; t += gridDim.x) {
        int mi, ni; tile_mn(t, 4, mi, ni);
        const int m0 = mi << 7, n0 = ni << 8;
        f32x4 acc[32]; ZERO_ACC(acc);
        gemm_mainloop<false>(tid_, smem, A, 1024, Wt, 1024, 1024, m0, n0, acc);
        {
            __builtin_amdgcn_s_barrier();
            constexpr int EROWF = 528;
            unsigned char* est = smem + w * (32 * EROWF);
            const size_t ub = (size_t)(m0 + wm * 64) * 1024 + n0 + wn * 128;
            const float* xw = xin + ub; float* ow = P.out + ub;
            int l2_ = lane; asm volatile("" : "+v"(l2_));
            const int fr2 = l2_ & 15, fq2 = l2_ >> 4, rr = l2_ >> 5, ch = l2_ & 31;
#pragma unroll
            for (int h = 0; h < 2; ++h) {
#pragma unroll
                for (int mh = 0; mh < 2; ++mh) {
                    unsigned char* erow = est + (mh * 16 + fr2) * EROWF + fq2 * 16;
#pragma unroll
                    for (int nt = 0; nt < 8; ++nt) *(f32x4*)(erow + nt * 64) = acc[nt * 4 + h * 2 + mh];
                }
                __builtin_amdgcn_fence(__ATOMIC_RELEASE, "wavefront"); __builtin_amdgcn_wave_barrier(); __builtin_amdgcn_fence(__ATOMIC_ACQUIRE, "wavefront");
#pragma unroll 4
                for (int i = 0; i < 16; ++i) {
                    const int row = i * 2 + rr;
                    const unsigned ix = (unsigned)((h * 32 + row) * 1024 + ch * 4);
                    const f32x4 v = *(const f32x4*)(est + row * EROWF + ch * 16);
                    const f32x4 xv = *(const f32x4*)(xw + ix);
                    *(f32x4*)(ow + ix) = xv * DN_ALPHA + v;
                }
                __builtin_amdgcn_fence(__ATOMIC_RELEASE, "wavefront"); __builtin_amdgcn_wave_barrier(); __builtin_amdgcn_fence(__ATOMIC_ACQUIRE, "wavefront");
            }
        }
    }
}

DEV void gemm_gate_phase(unsigned char* smem, const Prm& P, const u16* Wg, const u16* Wp) {
    const int tid_ = opaque_tid();
    const u16* A1 = (const u16*)(P.ws + OFF_XLB);
    const u16* A2 = (const u16*)(P.ws + OFF_PB);
    u16* xb = (u16*)(P.ws + OFF_XB);
    u16* ppb = (u16*)(P.ws + OFF_PP);
    const int lane = tid_ & 63, w = __builtin_amdgcn_readfirstlane(tid_ >> 6), wm = w >> 1, wn = w & 1, fr = lane & 15, fq = lane >> 4;
    for (int t = vblock(); t < 512; t += gridDim.x) {
        int mi, ni; tile_mn(t, 4, mi, ni);
        const int m0 = mi << 7, n0 = ni << 8;
        f32x4 acc[32]; ZERO_ACC(acc);
        gemm_mainloop<false>(tid_, smem, A2, 256, Wp, 256, 256, m0, n0, acc);
        const size_t ub = (size_t)(m0 + wm * 64) * 1024 + n0 + wn * 128;
        float* ow = P.out + ub; u16* pw = ppb + ub; u16* xw = xb + ub;
        {
            int l2_ = lane; asm volatile("" : "+v"(l2_));
            const unsigned lo = (unsigned)((l2_ & 15) * 1024 + (l2_ >> 4) * 4);
#pragma unroll
            for (int mt = 0; mt < 4; ++mt) {
#pragma unroll
                for (int nt = 0; nt < 8; ++nt) { const f32x4 v = acc[nt * 4 + mt]; *(u32x2*)(pw + (lo + mt * 16384 + nt * 16)) = u32x2{pack2(v[0], v[1]), pack2(v[2], v[3])}; }
                __builtin_amdgcn_sched_barrier(0);
            }
        }
        ZERO_ACC(acc);
        gemm_mainloop<false>(tid_, smem, A1, 1024, Wg, 1024, 1024, m0, n0, acc);
        int l3_ = lane; asm volatile("" : "+v"(l3_));
        const unsigned lo = (unsigned)((l3_ & 15) * 1024 + (l3_ >> 4) * 4);
#pragma unroll
        for (int mt = 0; mt < 4; ++mt) {
#pragma unroll
            for (int nt = 0; nt < 8; ++nt) {
                const unsigned ix = lo + mt * 16384 + nt * 16;
                const f32x4 xv = *(const f32x4*)(ow + ix);
                const u32x2 pq = *(const u32x2*)(pw + ix);
                const f32x4 ga = acc[nt * 4 + mt];
                f32x4 r;
                r[0] = xv[0] + sigmoidf_(ga[0]) * bflo(pq[0]); r[1] = xv[1] + sigmoidf_(ga[1]) * bfhi(pq[0]);
                r[2] = xv[2] + sigmoidf_(ga[2]) * bflo(pq[1]); r[3] = xv[3] + sigmoidf_(ga[3]) * bfhi(pq[1]);
                *(f32x4*)(ow + ix) = r;
                *(u32x2*)(xb + kb_off(m0 + wm * 64 + mt * 16 + (l3_ & 15), n0 + wn * 128 + nt * 16 + (l3_ >> 4) * 4, 1024)) = u32x2{pack2(r[0], r[1]), pack2(r[2], r[3])};
            }
            __builtin_amdgcn_sched_barrier(0);
        }
    }
}

DEV void ln_phase(const Prm& P, int layer) {
    const int tid_ = opaque_tid();
    const int lane = tid_ & 63, w = __builtin_amdgcn_readfirstlane(tid_ >> 6);
    const float* g = P.in[12] + layer * 1024; const float* bb = P.in[13] + layer * 1024;
    u16* xlb = (u16*)(P.ws + OFF_XLB);
    f32x4 gg[4], bv[4];
#pragma unroll
    for (int i = 0; i < 4; ++i) { gg[i] = *(const f32x4*)(g + i * 256 + lane * 4); bv[i] = *(const f32x4*)(bb + i * 256 + lane * 4); }
    for (int rb = blockIdx.x * 4 + w; rb < T / 4; rb += gridDim.x * 4) {
        float* xr = P.out + (size_t)rb * 4096;
        f32x4 v[4][4];
#pragma unroll
        for (int r = 0; r < 4; ++r)
#pragma unroll
            for (int i = 0; i < 4; ++i) v[r][i] = *(const f32x4*)(xr + r * 1024 + i * 256 + lane * 4);
#pragma unroll
        for (int r = 0; r < 4; ++r) {
            float s = 0.f;
#pragma unroll
            for (int i = 0; i < 4; ++i) s += v[r][i][0] + v[r][i][1] + v[r][i][2] + v[r][i][3];
            const float mean = wave_sum(s) * (1.f / 1024.f);
            float q = 0.f;
#pragma unroll
            for (int i = 0; i < 4; ++i)
#pragma unroll
                for (int j = 0; j < 4; ++j) { const float d = v[r][i][j] - mean; q += d * d; }
            const float rstd = rsqrtf(wave_sum(q) * (1.f / 1024.f) + LN_EPS);
            const int row = rb * 4 + r;
#pragma unroll
            for (int i = 0; i < 4; ++i) {
                f32x4 y;
#pragma unroll
                for (int j = 0; j < 4; ++j) y[j] = (v[r][i][j] - mean) * rstd * gg[i][j] + bv[i][j];
                *(f32x4*)(xr + r * 1024 + i * 256 + lane * 4) = y;
                *(u32x2*)(xlb + kb_off(row, i * 256 + lane * 4, 1024)) = u32x2{pack2(y[0], y[1]), pack2(y[2], y[3])};
            }
        }
    }
    const float* p = P.in[1] + (size_t)layer * T * 256; u16* pb = (u16*)(P.ws + OFF_PB);
    const size_t gtid = (size_t)blockIdx.x * 256 + tid_, gsz = (size_t)gridDim.x * 256;
    for (size_t i = gtid; i < (size_t)T * 256 / 8; i += gsz) {
        const f32x4 a = *(const f32x4*)(p + i * 8), b = *(const f32x4*)(p + i * 8 + 4);
        *(u32x4*)(pb + kb_off((int)(i >> 5), (int)(i & 31) * 8, 256)) = u32x4{pack2(a[0], a[1]), pack2(a[2], a[3]), pack2(b[0], b[1]), pack2(b[2], b[3])};
    }
}

struct KV { bf16x8 ka0, ka1, kb0, kb1; bf16x8 v0, v1, v2, v3; };
template <int KH = 1024>
DEV void load_kv(KV& t, const char* Kb, unsigned koa, unsigned kob, const char* Vb, unsigned voa, unsigned vob) {
    t.ka0 = *(const bf16x8*)(Kb + koa); t.ka1 = *(const bf16x8*)(Kb + koa + KH);
    t.kb0 = *(const bf16x8*)(Kb + kob); t.kb1 = *(const bf16x8*)(Kb + kob + KH);
    t.v0 = __builtin_shufflevector(*(const s16x4*)(Vb + voa), *(const s16x4*)(Vb + vob), 0, 1, 2, 3, 4, 5, 6, 7);
    t.v1 = __builtin_shufflevector(*(const s16x4*)(Vb + voa + 512), *(const s16x4*)(Vb + vob + 512), 0, 1, 2, 3, 4, 5, 6, 7);
    t.v2 = __builtin_shufflevector(*(const s16x4*)(Vb + voa + 1024), *(const s16x4*)(Vb + vob + 1024), 0, 1, 2, 3, 4, 5, 6, 7);
    t.v3 = __builtin_shufflevector(*(const s16x4*)(Vb + voa + 1536), *(const s16x4*)(Vb + vob + 1536), 0, 1, 2, 3, 4, 5, 6, 7);
}
DEV unsigned pkrtz(float a, float b) { return __builtin_bit_cast(unsigned, __builtin_amdgcn_cvt_pkrtz(a, b)); }
DEV bf16x8 pack8(const float (&p)[8]) {
    return __builtin_bit_cast(bf16x8, u32x4{pkrtz(p[0], p[1]), pkrtz(p[2], p[3]), pkrtz(p[4], p[5]), pkrtz(p[6], p[7])});
}
DEV void qk_scores(const KV& t, const bf16x8& q0, const bf16x8& q1, f32x4& sa, f32x4& sb) {
    sa = f32x4{0.f, 0.f, 0.f, 0.f}; sb = f32x4{0.f, 0.f, 0.f, 0.f};
    sa = MFMA16(t.ka0, q0, sa); sa = MFMA16(t.ka1, q1, sa);
    sb = MFMA16(t.kb0, q0, sb); sb = MFMA16(t.kb1, q1, sb);
}
constexpr float QK_C = 0.125f * 1.4426950408889634f;
using f32x2 = __attribute__((ext_vector_type(2))) float;
DEV void mask8(f32x4& sa, f32x4& sb, int d0, unsigned lim) {
#pragma unroll
    for (int j = 0; j < 4; ++j) {
        sa[j] = ((unsigned)(d0 - j) <= lim)      ? sa[j] : NEG_INF;
        sb[j] = ((unsigned)(d0 - 16 - j) <= lim) ? sb[j] : NEG_INF;
    }
}
DEV float max8(const f32x4& sa, const f32x4& sb) {
    return fmaxf(fmaxf(fmaxf(sa[0], sa[1]), fmaxf(sa[2], sa[3])), fmaxf(fmaxf(sb[0], sb[1]), fmaxf(sb[2], sb[3])));
}
DEV void lazy_rescale(float& mref, float& l, f32x4 (&o)[4], float mxr) {
    const float mxs = mxr * QK_C;
    if (__ballot(mxs > mref + 8.f) != 0ull) {
        const float mx = red16_max(mxs);
        const float mn = fmaxf(mref, mx);
        const float alpha = (mn == NEG_INF) ? 1.f : __builtin_amdgcn_exp2f(mref - mn);
        l *= alpha;
#pragma unroll
        for (int d = 0; d < 4; ++d) o[d] *= alpha;
        mref = mn;
    }
}
DEV bf16x8 exp8(const f32x4& sa, const f32x4& sb, float mu, float& l) {
    float p[8]; const float nm = -mu;
#pragma unroll
    for (int j = 0; j < 4; ++j) { p[j] = __builtin_amdgcn_exp2f(__builtin_fmaf(sa[j], QK_C, nm)); p[4 + j] = __builtin_amdgcn_exp2f(__builtin_fmaf(sb[j], QK_C, nm)); }
    l += ((p[0] + p[1]) + (p[2] + p[3])) + ((p[4] + p[5]) + (p[6] + p[7]));
    return pack8(p);
}
DEV void flash_core(float& mref, float& l, f32x4 (&o)[4], const bf16x8& q0, const bf16x8& q1, const KV& t, bool fast, int d0, unsigned lim) {
    f32x4 sa, sb; qk_scores(t, q0, q1, sa, sb);
    if (!fast) mask8(sa, sb, d0, lim);
    lazy_rescale(mref, l, o, max8(sa, sb));
    const float mu = (mref == NEG_INF) ? 0.f : mref;
    const bf16x8 pf = exp8(sa, sb, mu, l);
    o[0] = MFMA16(t.v0, pf, o[0]); o[1] = MFMA16(t.v1, pf, o[1]); o[2] = MFMA16(t.v2, pf, o[2]); o[3] = MFMA16(t.v3, pf, o[3]);
}

DEV void flash_core2(float& mref, float& l, f32x4 (&o)[4], const bf16x8& q0, const bf16x8& q1, const KV& ta, const KV& tb,
                     bool fasta, bool fastb, int d0a, int d0b, unsigned lim) {
    f32x4 sa, sb, sc, sd; qk_scores(ta, q0, q1, sa, sb); qk_scores(tb, q0, q1, sc, sd);
    if (!fasta) mask8(sa, sb, d0a, lim);
    if (!fastb) mask8(sc, sd, d0b, lim);
    lazy_rescale(mref, l, o, fmaxf(max8(sa, sb), max8(sc, sd)));
    const float mu = (mref == NEG_INF) ? 0.f : mref;
    const bf16x8 pfa = exp8(sa, sb, mu, l), pfb = exp8(sc, sd, mu, l);
    o[0] = MFMA16(ta.v0, pfa, o[0]); o[1] = MFMA16(ta.v1, pfa, o[1]); o[2] = MFMA16(ta.v2, pfa, o[2]); o[3] = MFMA16(ta.v3, pfa, o[3]);
    o[0] = MFMA16(tb.v0, pfb, o[0]); o[1] = MFMA16(tb.v1, pfb, o[1]); o[2] = MFMA16(tb.v2, pfb, o[2]); o[3] = MFMA16(tb.v3, pfb, o[3]);
}

#define RING4(NSTEPS, LOADSTEP, COMPUTE) do { \
    KV cur_; \
    for (int st_ = 0; st_ < (NSTEPS); ++st_) { LOADSTEP(cur_, st_); COMPUTE(cur_, st_); } \
    } while (0)

DEV void band_loop(const int tid_, float& m, float& l, f32x4 (&o)[4], const bf16x8& q0, const bf16x8& q1, const char* Kb,
                   const char* Vb, int vblk0, int ustart, int nsteps, int uq, int uq0, int qspan, int maxd) {
    const int c = tid_ & 15, g4 = (tid_ & 63) >> 4;
    const unsigned kl = c * 64 + g4 * 16, vl = c * 32 + g4 * 8;
    const unsigned lim = (unsigned)min(maxd, uq);
#define BL_LOAD(R, S) do { const int ua_ = ustart + (S) * 32, ub_ = ua_ + 16; \
        const unsigned ba_ = (unsigned)(vblk0 + (max(ua_, 0) >> 4)) * 2048u, bb_ = (unsigned)(vblk0 + (max(ub_, 0) >> 4)) * 2048u; \
        load_kv(R, Kb, ba_ + kl, bb_ + kl, Vb, ba_ + vl, bb_ + vl); } while (0)
#define BL_COMP(R, S) do { const int ua_ = ustart + (S) * 32; \
        const bool fast_ = (ua_ >= 0) && (ua_ + 31 <= uq0) && (uq0 + qspan - ua_ <= maxd); \
        flash_core(m, l, o, q0, q1, R, fast_, uq - ua_ - g4 * 4, lim); } while (0)
    RING4(nsteps, BL_LOAD, BL_COMP);
#undef BL_LOAD
#undef BL_COMP
}

DEV void attnA_phase(const Prm& P, int chunk) {
    const int tid_ = opaque_tid();
    unsigned char* ws = P.ws;
    const u16* H = (const u16*)(ws + OFF_H);
    u16* G = (u16*)(ws + OFF_G);
    const int lane = tid_ & 63, w = __builtin_amdgcn_readfirstlane(tid_ >> 6), c = lane & 15, g4 = lane >> 4;
    constexpr int LD = 2560;
    const int xcd_ = blockIdx.x & 7, slot_ = blockIdx.x >> 3, nslot_ = gridDim.x >> 3;
    for (int i_ = slot_; i_ < 128; i_ += nslot_) {
        const int rq = i_ & 3, tbi = i_ >> 2, hh = xcd_ & 3, b = xcd_ >> 2;
        const int r = w * 4 + rq, tb = tbi * 256;
        const int sq = tb + r + 16 * c;
        const size_t rowq = (size_t)b * 8192 + sq;
        float m = NEG_INF, l = 0.f;
        f32x4 o[4];
#pragma unroll
        for (int d = 0; d < 4; ++d) o[d] = f32x4{0.f, 0.f, 0.f, 0.f};
#pragma unroll 1
        for (int g = 0; g < 3; ++g) {
            const int dsh = 2 * g, dmask = (1 << dsh) - 1;
            const int rg = r & dmask;
            const int uq = sq >> dsh, uq0 = (tb + r) >> dsh;
            int ustart = (uq0 - 128) & ~15;
            const int ulast = (uq0 + (15 << (4 - dsh))) & ~15;
            int ntile = ((ulast - ustart) >> 4) + 1;
            if (ntile & 1) { ustart -= 16; ntile += 1; }
            const u16* Hq = H + rowq * LD + g * 768 + hh * 64 + g4 * 8;
            const bf16x8 q0 = *(const bf16x8*)Hq, q1 = *(const bf16x8*)(Hq + 32);
            const char* Kb = (const char*)((const u16*)(ws + (g == 0 ? OFF_KI0 : (g == 1 ? OFF_KI1 : OFF_KI2))) + ((size_t)(b * 4 + hh) * 512) * 1024);
            const char* Vb = (const char*)((const u16*)(ws + (g == 0 ? OFF_VT0 : (g == 1 ? OFF_VT1 : OFF_VT2))) + ((size_t)(b * 4 + hh) * 512) * 1024);
            const int vblk0 = rg * ((8192 >> dsh) >> 4);
            band_loop(tid_, m, l, o, q0, q1, Kb, Vb, vblk0, ustart, ntile >> 1, uq, uq0, 15 << (4 - dsh), 128);
        }
        l = red16_sum(l);
        const float inv = 1.f / l;
#pragma unroll
        for (int dt = 0; dt < 4; ++dt) {
            const int dh = dt * 16 + g4 * 4;
            const u32x2 z = *(const u32x2*)(H + rowq * LD + 2304 + hh * 64 + dh);
            const float r0 = o[dt][0] * inv * siluf_(bflo(z[0])), r1 = o[dt][1] * inv * siluf_(bfhi(z[0]));
            const float r2 = o[dt][2] * inv * siluf_(bflo(z[1])), r3 = o[dt][3] * inv * siluf_(bfhi(z[1]));
            *(u32x2*)(G + kb_off((int)rowq, (chunk * 4 + hh) * 64 + dh, 1024)) = u32x2{pack2(r0, r1), pack2(r2, r3)};
        }
    }
}

DEV void attnB_phase(const Prm& P) {
    const int tid_ = opaque_tid();
    unsigned char* ws = P.ws;
    const u16* H = (const u16*)(ws + OFF_H);
    u16* G = (u16*)(ws + OFF_G);
    const float* sinks = P.in[5];
    const int lane = tid_ & 63, w = __builtin_amdgcn_readfirstlane(tid_ >> 6), c = lane & 15, g4 = lane >> 4;
    constexpr int LD = 2304;
    const int xcd_ = blockIdx.x & 7, slot_ = blockIdx.x >> 3, nslot_ = gridDim.x >> 3;
    for (int tile = slot_; tile < 512; tile += nslot_) {
        const int b = xcd_ >> 2, hq = xcd_ & 3;
        const int head = hq * 4 + w, kvh = head >> 3;
        const int t0 = tile * 16, sq = t0 + c;
        const size_t rowq = (size_t)b * 8192 + sq;
        float m = NEG_INF, l = 0.f;
        f32x4 o[4];
#pragma unroll
        for (int d = 0; d < 4; ++d) o[d] = f32x4{0.f, 0.f, 0.f, 0.f};
        const u16* Hq = H + rowq * LD + head * 64 + g4 * 8;
        const bf16x8 q0 = *(const bf16x8*)Hq, q1 = *(const bf16x8*)(Hq + 32);
        const char* Kb = (const char*)((const u16*)(ws + OFF_KI0) + ((size_t)(b * 2 + kvh) * 512) * 1024);
        const char* Vb = (const char*)((const u16*)(ws + OFF_VT0) + ((size_t)(b * 2 + kvh) * 512) * 1024);
        band_loop(tid_, m, l, o, q0, q1, Kb, Vb, 0, t0 - 144, 5, sq, t0, 15, 127);
        l = red16_sum(l);
        const float mu = (m == NEG_INF) ? 0.f : m;
        const float lf = l + __builtin_amdgcn_exp2f(sinks[head] * 1.4426950408889634f - mu);
        const float inv = 1.f / lf;
#pragma unroll
        for (int dt = 0; dt < 4; ++dt) {
            const int dh = dt * 16 + g4 * 4;
            const u32x2 z = *(const u32x2*)(H + rowq * LD + 1280 + head * 64 + dh);
            const float r0 = o[dt][0] * inv * siluf_(bflo(z[0])), r1 = o[dt][1] * inv * siluf_(bfhi(z[0]));
            const float r2 = o[dt][2] * inv * siluf_(bflo(z[1])), r3 = o[dt][3] * inv * siluf_(bfhi(z[1]));
            *(u32x2*)(G + kb_off((int)rowq, head * 64 + dh, 1024)) = u32x2{pack2(r0, r1), pack2(r2, r3)};
        }
    }
}

DEV void compress_phase(const Prm& P) {
    const int tid_ = opaque_tid();
    unsigned char* ws = P.ws;
    const u16* H = (const u16*)(ws + OFF_H);
    constexpr int LD = 3840;
    const float* bias = (const float*)(ws + OFF_BIAS);
    const int lane = tid_ & 63, w = __builtin_amdgcn_readfirstlane(tid_ >> 6), c = lane & 15, g4 = lane >> 4;
    for (int it = blockIdx.x; it < 128; it += gridDim.x) {
        const int unit = it * 4 + w;
        const int which = unit >> 8, b = (unit >> 7) & 1, kvh = (unit >> 5) & 3, ntile = unit & 31;
        const u16* Wt = (const u16*)(ws + (which ? OFF_WCV : OFF_WCK));
        const int colbase = (which ? 1280 : 1024) + kvh * 64;
        const int n = ntile * 16 + c;
        const u16* Wl = Wt + c * 32 + g4 * 8;
        f32x4 acc[4];
#pragma unroll
        for (int e = 0; e < 4; ++e) acc[e] = f32x4{0.f, 0.f, 0.f, 0.f};
#pragma unroll 4
        for (int kk = 0; kk < 64; ++kk) {
            const int j = kk >> 1, d0 = (kk & 1) * 32 + g4 * 8;
            int s = 16 * n + j; s = min(s, 8191);
            const bf16x8 xf = *(const bf16x8*)(H + ((size_t)b * 8192 + s) * LD + colbase + d0);
            bf16x8 wf[4];
#pragma unroll
            for (int e = 0; e < 4; ++e) wf[e] = *(const bf16x8*)(Wl + (size_t)(e * 64 + kk) * 512);
            if (which == 0) {
#pragma unroll
                for (int e = 0; e < 4; ++e) acc[e] = MFMA16(wf[e], xf, acc[e]);
            } else {
#pragma unroll
                for (int e = 0; e < 4; ++e) acc[e] = MFMA16(xf, wf[e], acc[e]);
            }
        }
        if (which == 0) {
            u16* kc = (u16*)(ws + OFF_KCMP) + ((size_t)(b * 4 + kvh) * 32 + ntile) * 1024 + c * 32;
#pragma unroll
            for (int e = 0; e < 4; ++e) {
                const int e0 = e * 16 + g4 * 4;
                const f32x4 bv = *(const f32x4*)(bias + e0);
                const f32x4 r = acc[e] + bv;
                *(u32x2*)(kc + (e0 >> 5) * 512 + (e0 & 31)) = u32x2{pack2(r[0], r[1]), pack2(r[2], r[3])};
            }
        } else {
            u16* vc = (u16*)(ws + OFF_VCMP) + (((size_t)(b * 4 + kvh) * 32 + ntile) * 64) * 16;
#pragma unroll
            for (int e = 0; e < 4; ++e) {
                const int ee = e * 16 + c;
                const float bv = bias[64 + ee];
                *(u32x2*)(vc + ee * 16 + g4 * 4) = u32x2{pack2(acc[e][0] + bv, acc[e][1] + bv), pack2(acc[e][2] + bv, acc[e][3] + bv)};
            }
        }
    }
}

DEV void attnC_phase(const Prm& P, unsigned char* smem) {
    const int tid_ = opaque_tid();
    unsigned char* ws = P.ws;
    const u16* H = (const u16*)(ws + OFF_H);
    u16* G = (u16*)(ws + OFF_G);
    constexpr int LD = 3840;
    float* imp = (float*)smem;
    float* scb = (float*)(smem + 32768);
    float* oslc = (float*)(smem + 34816);
    const int tid = tid_, lane = tid & 63, w = __builtin_amdgcn_readfirstlane(tid >> 6), c = lane & 15, g4 = lane >> 4;
    const int xcd_ = blockIdx.x & 7, slot_ = blockIdx.x >> 3, nslot_ = gridDim.x >> 3;
    for (int i = tid; i < 8192; i += 256) imp[i] = 0.f;
    __syncthreads();
    for (int tk_ = 0; tk_ * nslot_ < 512; ++tk_) {
        const int tile = tk_ * nslot_ + ((tk_ & 1) ? (nslot_ - 1 - slot_) : slot_);
        const int b = xcd_ >> 2, kvh = xcd_ & 3;
        const int t0 = tile * 16;
        const int head = kvh * 4 + w;
        const size_t rowq = (size_t)b * 8192 + t0 + c;
        const u16* Hq = H + rowq * LD + head * 64 + g4 * 8;
        const bf16x8 q0 = *(const bf16x8*)Hq, q1 = *(const bf16x8*)(Hq + 32);
        f32x4 oacc[4];
#pragma unroll
        for (int d = 0; d < 4; ++d) oacc[d] = f32x4{0.f, 0.f, 0.f, 0.f};
        const int nmax = (t0 + c - 31) >> 4;
        const int nmaxw = (t0 - 16) >> 4;
        const float g0 = sigmoidf_(bf2f(H[rowq * LD + 3584 + head]));
        const float g1 = sigmoidf_(bf2f(H[rowq * LD + 3584 + 16 + head]));
        const float g2 = sigmoidf_(bf2f(H[rowq * LD + 3584 + 32 + head]));
        if (nmaxw >= 0) {
            const int nsteps = (nmaxw >> 5) + 1;
            const char* Kb = (const char*)((const u16*)(ws + OFF_KCMP) + ((size_t)(b * 4 + kvh) * 32) * 1024);
            const char* Vb = (const char*)((const u16*)(ws + OFF_VCMP) + ((size_t)(b * 4 + kvh) * 32) * 1024);
            const unsigned kl = c * 64 + g4 * 16, vl = c * 32 + g4 * 8;
            float m = NEG_INF, l = 0.f;
#define CM_LOAD(R, S) do { const int na_ = (S) * 32; const unsigned ba_ = (unsigned)(na_ >> 4) * 2048u, bb_ = (unsigned)min((na_ >> 4) + 1, 31) * 2048u; \
        load_kv(R, Kb, ba_ + kl, bb_ + kl, Vb, ba_ + vl, bb_ + vl); } while (0)
#define CM_PASS1(R, S) do { const int na_ = (S) * 32; f32x4 sa, sb; qk_scores(R, q0, q1, sa, sb); float mx = NEG_INF; float x[8]; \
        _Pragma("unroll") for (int j = 0; j < 8; ++j) { const int n = na_ + (j >> 2) * 16 + g4 * 4 + (j & 3); \
            x[j] = (n <= nmax) ? ((j < 4) ? sa[j & 3] : sb[j & 3]) * 0.125f : NEG_INF; mx = fmaxf(mx, x[j]); } \
        const float mn = fmaxf(m, mx); const float mu = (mn == NEG_INF) ? 0.f : mn; float ps = 0.f; \
        _Pragma("unroll") for (int j = 0; j < 8; ++j) ps += __expf(x[j] - mu); \
        l = l * __expf(m - mu) + ps; m = mn; } while (0)
            RING4(nsteps, CM_LOAD, CM_PASS1);
            float mall = red16_max(m);
            mall = (mall == NEG_INF) ? 0.f : mall;
            l = l * __expf(m - mall);
            l = red16_sum(l);
            const float invl = (l > 0.f) ? 1.f / l : 0.f;
#define CM_PASS2(R, S) do { const int na_ = (S) * 32; f32x4 sa, sb; qk_scores(R, q0, q1, sa, sb); float p[8]; \
        _Pragma("unroll") for (int j = 0; j < 8; ++j) { const int n = na_ + (j >> 2) * 16 + g4 * 4 + (j & 3); \
            const float sv = ((j < 4) ? sa[j & 3] : sb[j & 3]) * 0.125f; \
            p[j] = (n <= nmax) ? __expf(sv - mall) * invl : 0.f; \
            if (n <= nmax) atomicAdd(&imp[n * 16 + c], p[j]); } \
        const bf16x8 pf = pack8(p); \
        oacc[0] = MFMA16(R.v0, pf, oacc[0]); oacc[1] = MFMA16(R.v1, pf, oacc[1]); \
        oacc[2] = MFMA16(R.v2, pf, oacc[2]); oacc[3] = MFMA16(R.v3, pf, oacc[3]); } while (0)
            RING4(nsteps, CM_LOAD, CM_PASS2);
#undef CM_LOAD
#undef CM_PASS1
#undef CM_PASS2
#pragma unroll
            for (int d = 0; d < 4; ++d) oacc[d] *= g0;
        }
        {
            float m = NEG_INF, l = 0.f;
            f32x4 o[4];
#pragma unroll
            for (int d = 0; d < 4; ++d) o[d] = f32x4{0.f, 0.f, 0.f, 0.f};
            const char* Kb = (const char*)((const u16*)(ws + OFF_KI1) + ((size_t)(b * 4 + kvh) * 512) * 1024);
            const char* Vb = (const char*)((const u16*)(ws + OFF_VT1) + ((size_t)(b * 4 + kvh) * 512) * 1024);
            band_loop(tid_, m, l, o, q0, q1, Kb, Vb, 0, t0 - 528, 17, t0 + c, t0, 15, 511);
            l = red16_sum(l);
            const float sc = g2 / l;
#pragma unroll
            for (int d = 0; d < 4; ++d) oacc[d] += o[d] * sc;
        }
        __syncthreads();
        unsigned long long* msk = (unsigned long long*)(smem + 51200) + w * 8;
#pragma unroll 1
        for (int i = 0; i < 4; ++i) {
            const int tok = 4 * w + i, tq = t0 + tok, cur = tq >> 6;
            float my0, my1;
            {
                const int j0 = lane, j1 = lane + 64;
                float a0 = 2.f * (imp[(4 * j0) * 16 + tok] + imp[(4 * j0 + 1) * 16 + tok] + imp[(4 * j0 + 2) * 16 + tok]) + imp[(4 * j0 + 3) * 16 + tok];
                if (j0 > 0) a0 += imp[(4 * j0 - 1) * 16 + tok];
                const float a1 = 2.f * (imp[(4 * j1) * 16 + tok] + imp[(4 * j1 + 1) * 16 + tok] + imp[(4 * j1 + 2) * 16 + tok]) + imp[(4 * j1 + 3) * 16 + tok]
                                 + imp[(4 * j1 - 1) * 16 + tok];
                const bool f0 = (j0 == 0) || (j0 == cur) || (j0 == cur - 1);
                const bool f1 = (j1 == cur) || (j1 == cur - 1);
                my0 = f0 ? 1e4f : ((j0 <= cur) ? a0 : -1.f);
                my1 = f1 ? 1e4f : ((j1 <= cur) ? a1 : -1.f);
            }
            const unsigned k0 = (lane <= cur) ? (__float_as_uint(my0) + 1u) : 0u;
            const unsigned k1 = (lane + 64 <= cur) ? (__float_as_uint(my1) + 1u) : 0u;
            unsigned T = 0u;
#pragma unroll
            for (int bit = 31; bit >= 0; --bit) {
                const unsigned tr = T | (1u << bit);
                const int cnt = __builtin_popcountll(__ballot(k0 >= tr)) + __builtin_popcountll(__ballot(k1 >= tr));
                if (cnt >= 16) T = tr;
            }
            const unsigned long long eq0 = __ballot(k0 == T), eq1 = __ballot(k1 == T);
            const int need = 16 - __builtin_popcountll(__ballot(k0 > T)) - __builtin_popcountll(__ballot(k1 > T));
            const unsigned long long lm = (1ull << lane) - 1ull;
            const bool s0 = (k0 > 0u) && (k0 > T || (k0 == T && __builtin_popcountll(eq0 & lm) < need));
            const bool s1 = (k1 > 0u) && (k1 > T || (k1 == T && __builtin_popcountll(eq0) + __builtin_popcountll(eq1 & lm) < need));
            const unsigned long long lo = __ballot(s0);
            const unsigned long long hi = __ballot(s1);
            if (lane == 0) { msk[i * 2] = lo; msk[i * 2 + 1] = hi; }
        }
#pragma unroll 4
        for (int i = 0; i < 32; ++i) { const int e = i * 64 + lane; imp[(e >> 2) * 16 + 4 * w + (e & 3)] = 0.f; }
        __builtin_amdgcn_fence(__ATOMIC_RELEASE, "wavefront"); __builtin_amdgcn_wave_barrier(); __builtin_amdgcn_fence(__ATOMIC_ACQUIRE, "wavefront");
        {
            const int tokL = 4 * w + (c >> 2), tq = t0 + tokL, hd = kvh * 4 + (c & 3);
            const size_t rq = (size_t)b * 8192 + tq;
            const u16* Hs = H + rq * LD + hd * 64 + g4 * 8;
            const bf16x8 s0 = *(const bf16x8*)Hs, s1 = *(const bf16x8*)(Hs + 32);
            const char* Kb = (const char*)((const u16*)(ws + OFF_KI0) + ((size_t)(b * 4 + kvh) * 512) * 1024);
            const char* Vb = (const char*)((const u16*)(ws + OFF_VT0) + ((size_t)(b * 4 + kvh) * 512) * 1024);
            const unsigned kl = c * 64 + g4 * 16, vl = c * 32 + g4 * 8;
            float m = NEG_INF, l = 0.f;
            f32x4 o[4];
#pragma unroll
            for (int d = 0; d < 4; ++d) o[d] = f32x4{0.f, 0.f, 0.f, 0.f};
            const int ti = c >> 2;
            const unsigned long long mylo = msk[ti * 2], myhi = msk[ti * 2 + 1];
            const unsigned long long ulo = msk[0] | msk[2] | msk[4] | msk[6];
            const unsigned long long uhi = msk[1] | msk[3] | msk[5] | msk[7];
            const unsigned long long alo = msk[0] & msk[2] & msk[4] & msk[6], ahi = msk[1] & msk[3] & msk[5] & msk[7];
            int* blist = (int*)(scb + w * 128);
            const int nlo = __builtin_popcountll(ulo), nblk = nlo + __builtin_popcountll(uhi);
            if ((ulo >> lane) & 1ull) blist[__builtin_popcountll(ulo & ((1ull << lane) - 1ull))] = lane;
            if ((uhi >> lane) & 1ull) blist[nlo + __builtin_popcountll(uhi & ((1ull << lane) - 1ull))] = 64 + lane;
            __builtin_amdgcn_fence(__ATOMIC_RELEASE, "wavefront");
            __builtin_amdgcn_wave_barrier();
            __builtin_amdgcn_fence(__ATOMIC_ACQUIRE, "wavefront");
#pragma unroll 1
            for (int e_ = 0; e_ < nblk; ++e_) {
                const int j_ = __builtin_amdgcn_readfirstlane(blist[e_]);
                const unsigned kb_ = (unsigned)(j_ * 4) * 2048u;
                KV ta, tb;
                load_kv(ta, Kb, kb_ + kl, kb_ + 2048u + kl, Vb, kb_ + vl, kb_ + 2048u + vl);
                load_kv(tb, Kb, kb_ + 4096u + kl, kb_ + 6144u + kl, Vb, kb_ + 4096u + vl, kb_ + 6144u + vl);
                const bool selj = (j_ < 64) ? ((mylo >> j_) & 1ull) : ((myhi >> (j_ - 64)) & 1ull);
                const bool alls_ = (j_ < 64) ? ((alo >> j_) & 1ull) : ((ahi >> (j_ - 64)) & 1ull);
                const int ua_ = j_ * 64;
                const bool fa_ = alls_ && (ua_ + 31 <= t0 + 4 * w), fb_ = alls_ && (ua_ + 63 <= t0 + 4 * w);
                const int d0_ = selj ? (tq - ua_ - g4 * 4) : -(1 << 30);
                flash_core2(m, l, o, s0, s1, ta, tb, fa_, fb_, d0_, selj ? (d0_ - 32) : -(1 << 30), 0x7fffffffu);
            }
            l = red16_sum(l);
            const float inv = 1.f / l;
#pragma unroll
            for (int dt = 0; dt < 4; ++dt)
                *(f32x4*)(oslc + (tokL * 4 + (c & 3)) * 64 + dt * 16 + g4 * 4) = o[dt] * inv;
        }
        __syncthreads();
#pragma unroll
        for (int dt = 0; dt < 4; ++dt) {
            const int dh = dt * 16 + g4 * 4;
            const f32x4 os = *(const f32x4*)(oslc + (c * 4 + w) * 64 + dh);
            const f32x4 r = oacc[dt] + os * g1;
            const u32x2 z = *(const u32x2*)(H + rowq * LD + 2560 + head * 64 + dh);
            const float r0 = r[0] * siluf_(bflo(z[0])), r1 = r[1] * siluf_(bfhi(z[0]));
            const float r2 = r[2] * siluf_(bflo(z[1])), r3 = r[3] * siluf_(bfhi(z[1]));
            *(u32x2*)(G + kb_off((int)rowq, head * 64 + dh, 1024)) = u32x2{pack2(r0, r1), pack2(r2, r3)};
        }
    }
}

#ifndef PROBE_DUP
#define PROBE_DUP 0
#endif
#define REP(k) for (int rep_ = 0; rep_ < 1 + ((PROBE_DUP >> (k)) & 1); ++rep_)
constexpr int LDS_BYTES = 3 * GSTAGE + 64;
__global__ void __launch_bounds__(256, 2) mk_fwd(Prm P) {
    extern __shared__ __attribute__((aligned(16))) unsigned char smem[];
    unsigned* xb_words = (unsigned*)(smem + 3 * GSTAGE);
    if (threadIdx.x < 4) xb_words[threadIdx.x] = 0u;
    __syncthreads();
    XcdBarrier bar = xcd_barrier_post((unsigned*)(P.ws + OFF_BAR), (volatile LAS unsigned*)xb_words);
    unsigned char* ws = P.ws;

    phase0(P, smem);
    if (P.ws == nullptr) cg::this_grid().sync();
    xcd_barrier(bar);

#pragma unroll 1
    for (int layer = 0; layer < 4; ++layer) {
        const int kind = layer % 3, lj = layer / 3;
        const u16* Win; const u16* Wout; int N, nsub;
        if (kind == 0)      { Win = (const u16*)(ws + OFF_WA_IN + (size_t)lj * SZ_WA_IN); Wout = (const u16*)(ws + OFF_WA_OUT + (size_t)lj * SZ_SQ); N = 2560; nsub = 4; }
        else if (kind == 1) { Win = (const u16*)(ws + OFF_WB_IN); Wout = (const u16*)(ws + OFF_WB_OUT); N = 2304; nsub = 1; }
        else                { Win = (const u16*)(ws + OFF_WC_IN); Wout = (const u16*)(ws + OFF_WC_OUT); N = 3840; nsub = 1; }
#pragma unroll 1
        for (int sub = 0; sub < nsub; ++sub) {
            REP(0) gemm_in_phase(smem, P, kind, Win + (size_t)sub * 2560 * 1024, N);
            xcd_barrier(bar);
            if (kind == 0) REP(1) attnA_phase(P, sub);
            else if (kind == 1) REP(2) attnB_phase(P);
            else { REP(3) compress_phase(P); xcd_barrier(bar); REP(4) attnC_phase(P, smem); }
            xcd_barrier(bar);
        }
        gemm_out_phase(smem, P, Wout, layer == 0 ? P.in[0] : P.out);
        xcd_barrier(bar);
        ln_phase(P, layer);
        xcd_barrier(bar);
        gemm_gate_phase(smem, P, (const u16*)(ws + OFF_WG + (size_t)layer * SZ_SQ), (const u16*)(ws + OFF_WP + (size_t)layer * SZ_WP));
        if (layer < 3) xcd_barrier(bar);
    }
}

extern "C" void kernel_launch(void* const* d_in, const int* in_sizes, int n_in, void* d_out, int out_size, void* d_ws, size_t ws_size,
                              hipStream_t stream) {
    static int grid_blocks = 0;
    if (!grid_blocks) {
        int dev = 0, cus = 0, per_cu = 0;
        (void)hipGetDevice(&dev);
        (void)hipDeviceGetAttribute(&cus, hipDeviceAttributeMultiprocessorCount, dev);
        (void)hipFuncSetAttribute((const void*)mk_fwd, hipFuncAttributeMaxDynamicSharedMemorySize, LDS_BYTES);
        (void)hipOccupancyMaxActiveBlocksPerMultiprocessor(&per_cu, (const void*)mk_fwd, 256, LDS_BYTES);
        if (per_cu > 2) per_cu = 2;
        if (per_cu < 1) per_cu = 1;
        grid_blocks = cus * per_cu;
        if (ws_size < WS_END || n_in != 16) { fprintf(stderr, "kernel_launch: workspace too small (%zu < %zu) or n_in %d != 16\n", ws_size, (size_t)WS_END, n_in); grid_blocks = -1; }
    }
    if (grid_blocks < 0) return;
    (void)hipMemsetAsync((char*)d_ws + OFF_BAR, 0, 16384, stream);
    Prm p{};
    for (int i = 0; i < 16; ++i) p.in[i] = (const float*)d_in[i];
    p.out = (float*)d_out; p.ws = (unsigned char*)d_ws;
    void* args[] = {&p};
    hipError_t e = hipLaunchCooperativeKernel((const void*)mk_fwd, dim3(grid_blocks), dim3(256), args, LDS_BYTES, stream);
    if (e != hipSuccess) fprintf(stderr, "cooperative launch failed: %s (grid %d)\n", hipGetErrorString(e), grid_blocks);
}
```

```cpp
#include <hip/hip_runtime.h>
#include <hip/hip_cooperative_groups.h>
#include <cstdio>
#include <cstdint>
namespace cg = cooperative_groups;

typedef unsigned short u16;
using bf16x8 = __attribute__((ext_vector_type(8))) short;
using s16x4  = __attribute__((ext_vector_type(4))) short;
using f32x4  = __attribute__((ext_vector_type(4))) float;
using u32x4  = __attribute__((ext_vector_type(4))) unsigned;
using u32x2  = __attribute__((ext_vector_type(2))) unsigned;
#define DEV __device__ __forceinline__
using h16x8 = __attribute__((ext_vector_type(8))) _Float16;
#define MFMA16(a, b, c) __builtin_amdgcn_mfma_f32_16x16x32_f16(__builtin_bit_cast(h16x8, (a)), __builtin_bit_cast(h16x8, (b)), (c), 0, 0, 0)
#define LAS __attribute__((address_space(3)))

constexpr int T = 16384, S = 8192;
constexpr float LN_EPS = 1e-5f;
constexpr float DN_ALPHA = 1.6817928305074290f;
constexpr float NEG_INF = -__builtin_huge_valf();

constexpr size_t OFF_BAR   = 0;
constexpr size_t OFF_COS   = 16384;
constexpr size_t OFF_SIN   = OFF_COS + (size_t)8192 * 32 * 4;
constexpr size_t OFF_BIAS  = OFF_SIN + (size_t)8192 * 32 * 4;
constexpr size_t OFF_WA_IN = OFF_BIAS + 1024;
constexpr size_t SZ_WA_IN  = (size_t)10240 * 1024 * 2;
constexpr size_t SZ_SQ     = (size_t)1024 * 1024 * 2;
constexpr size_t OFF_WA_OUT = OFF_WA_IN + 2 * SZ_WA_IN;
constexpr size_t OFF_WB_IN  = OFF_WA_OUT + 2 * SZ_SQ;
constexpr size_t OFF_WB_OUT = OFF_WB_IN + (size_t)2304 * 1024 * 2;
constexpr size_t OFF_WC_IN  = OFF_WB_OUT + SZ_SQ;
constexpr size_t OFF_WC_OUT = OFF_WC_IN + (size_t)3840 * 1024 * 2;
constexpr size_t OFF_WG     = OFF_WC_OUT + SZ_SQ;
constexpr size_t OFF_WP     = OFF_WG + 4 * SZ_SQ;
constexpr size_t SZ_WP      = (size_t)1024 * 256 * 2;
constexpr size_t OFF_WCK    = OFF_WP + 4 * SZ_WP;
constexpr size_t OFF_WCV    = OFF_WCK + (size_t)64 * 2048 * 2;
constexpr size_t OFF_XB     = OFF_WCV + (size_t)64 * 2048 * 2;
constexpr size_t SZ_ACT     = (size_t)T * 1024 * 2;
constexpr size_t OFF_G      = OFF_XB + SZ_ACT;
constexpr size_t OFF_H      = OFF_G + SZ_ACT;
constexpr size_t SZ_HMAX    = (size_t)T * 3840 * 2;
constexpr size_t OFF_VT0    = OFF_H + SZ_HMAX;
constexpr size_t SZ_VT      = (size_t)2 * 4 * 8192 * 64 * 2;
constexpr size_t OFF_VT1    = OFF_VT0 + SZ_VT;
constexpr size_t OFF_VT2    = OFF_VT1 + SZ_VT;
constexpr size_t OFF_KCMP   = OFF_VT2 + SZ_VT;
constexpr size_t SZ_CMP     = (size_t)2 * 512 * 4 * 64 * 2;
constexpr size_t OFF_VCMP   = OFF_KCMP + SZ_CMP;
constexpr size_t OFF_KI0    = OFF_VCMP + SZ_CMP;
constexpr size_t OFF_KI1    = OFF_KI0 + SZ_VT;
constexpr size_t OFF_KI2    = OFF_KI1 + SZ_VT;
constexpr size_t WS_END     = OFF_KI2 + SZ_VT;
constexpr size_t OFF_XLB    = OFF_H;
constexpr size_t OFF_PB     = OFF_H + SZ_ACT;
constexpr size_t OFF_PP     = OFF_H + SZ_ACT + (size_t)16 * 1024 * 1024;

struct Prm { const float* in[16]; float* out; unsigned char* ws; };

__device__ __forceinline__ size_t kb_off(int row, int k, int K) { return ((size_t)(row >> 4) * (K >> 5) + (k >> 5)) * 512 + (row & 15) * 32 + (k & 31); }
DEV u16 f2bf(float f) { return __builtin_bit_cast(u16, (_Float16)f); }
DEV float bf2f(u16 h) { return (float)__builtin_bit_cast(_Float16, h); }
DEV unsigned pack2(float a, float b) { return (unsigned)f2bf(a) | ((unsigned)f2bf(b) << 16); }
DEV float bflo(unsigned u) { return bf2f((u16)(u & 0xffffu)); }
DEV float bfhi(unsigned u) { return bf2f((u16)(u >> 16)); }
DEV float sigmoidf_(float x) { return 1.f / (1.f + __expf(-x)); }
DEV float siluf_(float x) { return x / (1.f + __expf(-x)); }
DEV float red16_max(float v) { v = fmaxf(v, __shfl_xor(v, 16)); v = fmaxf(v, __shfl_xor(v, 32)); return v; }
DEV float red16_sum(float v) { v += __shfl_xor(v, 16); v += __shfl_xor(v, 32); return v; }
DEV float wave_sum(float v) { for (int o = 32; o > 0; o >>= 1) v += __shfl_xor(v, o); return v; }

DEV int opaque_tid() { int t = threadIdx.x; asm volatile("" : "+v"(t)); return t; }
#define XB_TMO      128
#define XB_XCNT(j)  (256  + 64 * (j))
#define XB_XSUB(j)  (1280 + 64 * (j))
#define XB_XGEN(j)  (2304 + 64 * (j))
#define XB_TOP      3328
#define XB_TOPGEN   3392
#define XCD_BAR_WORDS 3456
#define XB_SPIN_CAP (1u << 24)
DEV unsigned xb_ld(unsigned* p)              { return __hip_atomic_load(p, __ATOMIC_RELAXED, __HIP_MEMORY_SCOPE_AGENT); }
DEV unsigned xb_add(unsigned* p, unsigned v) { return __hip_atomic_fetch_add(p, v, __ATOMIC_RELAXED, __HIP_MEMORY_SCOPE_AGENT); }
DEV unsigned xb_xcc_id() { return (unsigned)__builtin_amdgcn_s_getreg((3 << 11) | 20) & 0xFu; }
#define XB_SPIN(cond, bar) do { unsigned _sp = 0; while (cond) { __builtin_amdgcn_s_sleep(1); \
    if ((++_sp & 255u) == 0u) { if (xb_ld(&(bar)[XB_TMO])) break; if (_sp > XB_SPIN_CAP) { atomicAdd(&(bar)[XB_TMO], 1u); break; } } } } while (0)
struct XcdBarrier { unsigned* bar; unsigned x; volatile LAS unsigned* st; };
DEV XcdBarrier xcd_barrier_post(unsigned* bar, volatile LAS unsigned* st) {
    XcdBarrier b; b.bar = bar; b.x = xb_xcc_id(); b.st = st;
    if (threadIdx.x == 0) (void)xb_add(&bar[XB_XCNT(b.x)], 1u);
    return b;
}
DEV void xcd_barrier_complete(unsigned* bar, unsigned x, unsigned& nloc, unsigned& nx) {
    const unsigned G = gridDim.x * gridDim.y * gridDim.z;
    unsigned sum, cnt, mine, sp = 0u;
    for (;;) {
        sum = 0u; cnt = 0u; mine = 0u;
#pragma unroll
        for (unsigned j = 0; j < 16; ++j) { const unsigned c = xb_ld(&bar[XB_XCNT(j)]); sum += c; cnt += (c > 0u) ? 1u : 0u; mine = (j == x) ? c : mine; }
        if (sum == G) break;
        __builtin_amdgcn_s_sleep(1);
        if ((++sp & 255u) == 0u) { if (xb_ld(&bar[XB_TMO])) break; if (sp > XB_SPIN_CAP) { atomicAdd(&bar[XB_TMO], 1u); break; } }
    }
    nloc = mine > 0u ? mine : 1u; nx = cnt > 0u ? cnt : 1u;
}
DEV void xcd_barrier(const XcdBarrier& b) {
    asm volatile("s_waitcnt vmcnt(0)" ::: "memory");
    __syncthreads();
    if (threadIdx.x == 0) {
        unsigned* bar = b.bar;
        __builtin_amdgcn_s_waitcnt(0);
        unsigned nloc = b.st[0], nx = b.st[1];
        if (nloc == 0u) { xcd_barrier_complete(bar, b.x, nloc, nx); b.st[0] = nloc; b.st[1] = nx; }
        const unsigned old = xb_add(&bar[XB_XSUB(b.x)], 1u);
        const unsigned gen = old / nloc;
        if (old + 1u == (gen + 1u) * nloc) {
            __builtin_amdgcn_fence(__ATOMIC_RELEASE, "agent");
            asm volatile("s_waitcnt vmcnt(0)" ::: "memory");
            const unsigned og = xb_add(&bar[XB_TOP], 1u);
            const unsigned tg = og / nx;
            if (og + 1u == (tg + 1u) * nx) xb_add(&bar[XB_TOPGEN], 1u);
            else XB_SPIN(xb_ld(&bar[XB_TOPGEN]) == tg, bar);
            __builtin_amdgcn_fence(__ATOMIC_ACQUIRE, "agent");
            xb_add(&bar[XB_XGEN(b.x)], 1u);
            asm volatile("s_waitcnt vmcnt(0)" ::: "memory");
        } else {
            XB_SPIN(xb_ld(&bar[XB_XGEN(b.x)]) == gen, bar);
            __builtin_amdgcn_fence(__ATOMIC_ACQUIRE, "agent");
            asm volatile("s_waitcnt vmcnt(0)" ::: "memory");
        }
    }
    __syncthreads();
}

DEV int colmap(int kind, int n) {
    if (kind == 0) return n;
    if (kind == 1) {
        const int c = n / 2560, nn = n - c * 2560;
        if (nn < 2304) { const int g = nn / 768, rem = nn - g * 768, part = rem >> 8, hh = (rem & 255) >> 6, d = rem & 63;
                         return g * 3072 + part * 1024 + (c * 4 + hh) * 64 + d; }
        const int z = nn - 2304; return 9216 + (c * 4 + (z >> 6)) * 64 + (z & 63);
    }
    if (n < 2560) return n;
    if (n < 3584) return n - 2560 + 2608;
    if (n < 3632) return n - 3584 + 2560;
    return -1;
}
DEV void tconv(const int tid_, float* lds, const float* __restrict__ src, int K, int Nsrc, u16* __restrict__ dst, int Ndst, int kind, int& acc_tiles) {
    const int G = gridDim.x, tid = tid_;
    const int ntn = Ndst >> 6, ntk = K >> 6, nt = ntn * ntk;
    int first = ((int)blockIdx.x - (acc_tiles % G) + G) % G;
    acc_tiles += nt;
    for (int t = first; t < nt; t += G) {
        const int tn = t / ntk, tk = t - tn * ntk;
        const int n0 = tn << 6, k0 = tk << 6;
        const int nl = tid & 63;
        const int c = colmap(kind, n0 + nl);
#pragma unroll
        for (int i = 0; i < 16; ++i) {
            const int kl = (tid >> 6) + 4 * i;
            const float v = (c >= 0) ? src[(size_t)(k0 + kl) * Nsrc + c] : 0.f;
            lds[kl * 65 + nl] = v;
        }
        __syncthreads();
        const int r = tid >> 2, kk = (tid & 3) << 4;
        unsigned o[8];
#pragma unroll
        for (int i = 0; i < 8; ++i) o[i] = pack2(lds[(kk + 2 * i) * 65 + r], lds[(kk + 2 * i + 1) * 65 + r]);
        u32x4* dp = (u32x4*)(dst + kb_off(n0 + r, k0 + kk, K));
        dp[0] = u32x4{o[0], o[1], o[2], o[3]};
        dp[1] = u32x4{o[4], o[5], o[6], o[7]};
        __syncthreads();
    }
}

DEV void phase0(const Prm& P, unsigned char* smem) {
    const int tid_ = opaque_tid();
    float* lds = (float*)smem;
    unsigned char* ws = P.ws;
    int acc = 0;
    tconv(tid_, lds, P.in[2], 1024, 10240, (u16*)(ws + OFF_WA_IN), 10240, 1, acc);
    tconv(tid_, lds, P.in[2] + (size_t)1024 * 10240, 1024, 10240, (u16*)(ws + OFF_WA_IN + SZ_WA_IN), 10240, 1, acc);
    tconv(tid_, lds, P.in[3], 1024, 1024, (u16*)(ws + OFF_WA_OUT), 1024, 0, acc);
    tconv(tid_, lds, P.in[3] + (size_t)1024 * 1024, 1024, 1024, (u16*)(ws + OFF_WA_OUT + SZ_SQ), 1024, 0, acc);
    tconv(tid_, lds, P.in[4], 1024, 2304, (u16*)(ws + OFF_WB_IN), 2304, 0, acc);
    tconv(tid_, lds, P.in[6], 1024, 1024, (u16*)(ws + OFF_WB_OUT), 1024, 0, acc);
    tconv(tid_, lds, P.in[7], 1024, 3632, (u16*)(ws + OFF_WC_IN), 3840, 2, acc);
    tconv(tid_, lds, P.in[11], 1024, 1024, (u16*)(ws + OFF_WC_OUT), 1024, 0, acc);
    for (int i = 0; i < 4; ++i) {
        tconv(tid_, lds, P.in[15] + (size_t)i * 1024 * 1024, 1024, 1024, (u16*)(ws + OFF_WG + i * SZ_SQ), 1024, 0, acc);
        tconv(tid_, lds, P.in[14] + (size_t)i * 256 * 1024, 256, 1024, (u16*)(ws + OFF_WP + i * SZ_WP), 1024, 0, acc);
    }
    tconv(tid_, lds, P.in[8], 2048, 64, (u16*)(ws + OFF_WCK), 64, 0, acc);
    tconv(tid_, lds, P.in[9], 2048, 64, (u16*)(ws + OFF_WCV), 64, 0, acc);

    const size_t gtid = (size_t)blockIdx.x * 256 + tid_, gsz = (size_t)gridDim.x * 256;
    {
        const float* x = P.in[0]; u16* xb = (u16*)(ws + OFF_XB);
        for (size_t i = gtid; i < (size_t)T * 1024 / 8; i += gsz) {
            const f32x4 a = *(const f32x4*)(x + i * 8), b = *(const f32x4*)(x + i * 8 + 4);
            *(u32x4*)(xb + kb_off((int)(i >> 7), (int)(i & 127) * 8, 1024)) = u32x4{pack2(a[0], a[1]), pack2(a[2], a[3]), pack2(b[0], b[1]), pack2(b[2], b[3])};
        }
    }
    {
        float* ct = (float*)(ws + OFF_COS); float* st = (float*)(ws + OFF_SIN);
        for (size_t i = gtid; i < (size_t)8192 * 32; i += gsz) {
            const int pos = (int)(i >> 5), k = (int)(i & 31);
            const float inv = (float)(1.0 / pow(10000.0, (double)(2 * k) / 64.0));
            const float ang = (float)pos * inv;
            ct[i] = (float)cos((double)ang); st[i] = (float)sin((double)ang);
        }
    }
    {
        const int lane = tid_ & 63;
        const int wid = blockIdx.x * 4 + __builtin_amdgcn_readfirstlane(tid_ >> 6);
        if (wid < 128) {
            const float* w = (wid < 64) ? P.in[8] : P.in[9];
            const int e = wid & 63;
            float s = 0.f;
            for (int jd = lane; jd < 2048; jd += 64) s += P.in[10][jd] * w[(size_t)jd * 64 + e];
            s = wave_sum(s);
            if (lane == 0) ((float*)(ws + OFF_BIAS))[wid] = s;
        }
    }
}

constexpr int GSTAGE = 24576;
DEV int gsw(int r) { return (0x78 >> (2 * ((r >> 2) & 3))) & 3; }
DEV void gemm_issue(unsigned char* stage, const u16* ag0, const u16* ag1, const u16* bg, int bstep, int kt, int w) {
    __builtin_amdgcn_global_load_lds((const unsigned*)(ag0 + kt * 512), (unsigned*)(stage + w * 1024), 16, 0, 0);
    __builtin_amdgcn_global_load_lds((const unsigned*)(ag1 + kt * 512), (unsigned*)(stage + w * 1024 + 4096), 16, 0, 0);
#pragma unroll
    for (int i = 0; i < 4; ++i)
        __builtin_amdgcn_global_load_lds((const unsigned*)(bg + (size_t)i * bstep + kt * 512), (unsigned*)(stage + 8192 + w * 1024 + i * 4096), 16, 0, 0);
}
template <bool NONSWAP>
DEV void gemm_mainloop(const int tid_, unsigned char* smem, const u16* __restrict__ A, int lda, const u16* __restrict__ Bt, int ldb, int K,
                       int m0, int n0, f32x4 (&acc)[32], bool aperm = false) {
    const int tid = tid_, lane = tid & 63, w = __builtin_amdgcn_readfirstlane(tid >> 6), wm = w >> 1, wn = w & 1;
    const int lrow = tid >> 2, lsw = ((tid & 3) ^ gsw(lrow)) * 8;
    const int arow0 = aperm ? ((lrow & 31) * 4 + (lrow >> 5)) : lrow;
    const int arow1 = aperm ? (arow0 + 2) : (lrow + 64);
    const u16* ag0 = A + kb_off(m0 + arow0, 0, lda) + lsw;
    const u16* ag1 = A + kb_off(m0 + arow1, 0, lda) + lsw;
    const u16* bg = Bt + kb_off(n0 + lrow, 0, ldb) + lsw;
    const int bstep = 4 * (ldb >> 5) * 512;
    const int fr = lane & 15, fq = lane >> 4;
    const int coff = (fq ^ gsw(fr)) << 4;
    const int a_base = (wm * 64 + fr) * 64 + coff, b_base = 8192 + (wn * 128 + fr) * 64 + coff;
    const int nk = K >> 5;
    asm volatile("s_waitcnt vmcnt(0)" ::: "memory");
    __builtin_amdgcn_s_barrier();
    gemm_issue(smem, ag0, ag1, bg, bstep, 0, w);
    gemm_issue(smem + GSTAGE, ag0, ag1, bg, bstep, 1, w);
    int sc = 0, si = 2;
    for (int kt = 0; kt < nk; ++kt) {
        if (kt + 1 < nk) asm volatile("s_waitcnt vmcnt(6)" ::: "memory"); else asm volatile("s_waitcnt vmcnt(0)" ::: "memory");
        __builtin_amdgcn_s_barrier();
        if (kt + 2 < nk) { gemm_issue(smem + si * GSTAGE, ag0, ag1, bg, bstep, kt + 2, w); si = (si == 2) ? 0 : si + 1; }
        const unsigned char* st = smem + sc * GSTAGE; sc = (sc == 2) ? 0 : sc + 1;
        bf16x8 a[4], b[4];
#pragma unroll
        for (int i = 0; i < 4; ++i) a[i] = *(const bf16x8*)(st + a_base + i * 1024);
#pragma unroll
        for (int hb = 0; hb < 2; ++hb) {
#pragma unroll
            for (int i = 0; i < 4; ++i) b[i] = *(const bf16x8*)(st + b_base + (hb * 4 + i) * 1024);
            if (NONSWAP) {
#pragma unroll
                for (int mt = 0; mt < 4; ++mt)
#pragma unroll
                    for (int nt = 0; nt < 4; ++nt) acc[mt * 8 + hb * 4 + nt] = MFMA16(a[mt], b[nt], acc[mt * 8 + hb * 4 + nt]);
            } else {
#pragma unroll
                for (int nt = 0; nt < 4; ++nt)
#pragma unroll
                    for (int mt = 0; mt < 4; ++mt) acc[(hb * 4 + nt) * 4 + mt] = MFMA16(b[nt], a[mt], acc[(hb * 4 + nt) * 4 + mt]);
            }
        }
    }
}

DEV int vblock() { const int G = gridDim.x, b = blockIdx.x; return ((G & 7) == 0) ? (b & 7) * (G >> 3) + (b >> 3) : b; }
DEV void tile_mn(int t, int nN, int& mi, int& ni) { const int per = 8 * nN; const int mg = t / per, r = t - mg * per; mi = mg * 8 + (r & 7); ni = r >> 3; }
#define ZERO_ACC(acc) _Pragma("unroll") for (int i_ = 0; i_ < 32; ++i_) acc[i_] = f32x4{0.f, 0.f, 0.f, 0.f}

DEV void classify(int kind, int cgi, int& mode, int& vsel, int& vth, int& dsh, int& nhv, int& ksel) {
    mode = 0; vsel = 0; vth = 0; dsh = 0; nhv = 4; ksel = -1;
    if (kind == 0) {
        if (cgi < 36) { const int g = cgi / 12, part = (cgi - g * 12) >> 2; vth = cgi & 3; if (part < 2) { mode = 1; if (part == 1) { ksel = g; dsh = 2 * g; } } else { mode = 2; vsel = g; dsh = 2 * g; } }
    } else if (kind == 1) {
        if (cgi < 16) mode = 1; else if (cgi < 18) { mode = 1; ksel = 0; vth = cgi - 16; nhv = 2; } else if (cgi < 20) { mode = 2; vsel = 0; vth = cgi - 18; nhv = 2; }
    } else {
        if (cgi < 20) mode = 1; else if (cgi < 24) mode = 0; else if (cgi < 28) { mode = 1; ksel = 0; vth = cgi - 24; } else if (cgi < 32) { mode = 2; vsel = 0; vth = cgi - 28; }
        else if (cgi < 36) { mode = 1; ksel = 1; vth = cgi - 32; } else if (cgi < 40) { mode = 2; vsel = 1; vth = cgi - 36; }
    }
}

DEV void gemm_in_phase(unsigned char* smem, const Prm& P, int kind, const u16* Wt, int N) {
    const int tid_ = opaque_tid();
    unsigned char* ws = P.ws;
    const u16* A = (const u16*)(ws + OFF_XB);
    u16* H = (u16*)(ws + OFF_H);
    const float* cosT = (const float*)(ws + OFF_COS); const float* sinT = (const float*)(ws + OFF_SIN);
    const int nN = N >> 8, ntiles = 128 * nN;
    const int lane = tid_ & 63, w = __builtin_amdgcn_readfirstlane(tid_ >> 6), wm = w >> 1, wn = w & 1, fr = lane & 15, fq = lane >> 4;
    const int G_ = gridDim.x, vb_ = vblock(), nfull_ = ntiles / G_, R_ = ntiles - nfull_ * G_;
    const int per_x = ((G_ & 7) == 0) ? (G_ >> 3) : G_, rx_ = ((G_ & 7) == 0 && (R_ & 7) == 0) ? (R_ >> 3) : 0;
    const int xs_ = vb_ / per_x, sl_ = vb_ - xs_ * per_x;
    const int tail_t = (rx_ > 0) ? ((sl_ < rx_) ? nfull_ * G_ + xs_ * rx_ + sl_ : -1) : ((vb_ < R_) ? nfull_ * G_ + vb_ : -1);
    for (int rnd_ = 0; rnd_ <= nfull_; ++rnd_) {
        const int t = (rnd_ < nfull_) ? (vb_ + rnd_ * G_) : tail_t;
        if (t < 0) break;
        int mi, ni; tile_mn(t, nN, mi, ni);
        const int m0 = mi << 7, n0 = ni << 8;
        const int ncol = n0 + wn * 128, cg0 = ncol >> 6;
        int mode, vsel, vth, dsh, nhv, ksel; classify(kind, cg0, mode, vsel, vth, dsh, nhv, ksel);
        const int mw = m0 + wm * 64;
        f32x4 acc[32]; ZERO_ACC(acc);
        if (mode == 2) {
            gemm_mainloop<true>(tid_, smem, A, 1024, Wt, 1024, 1024, m0, n0, acc, dsh == 2);
            __builtin_amdgcn_s_barrier();
            u16* vt = (u16*)(ws + (vsel == 0 ? OFF_VT0 : (vsel == 1 ? OFF_VT1 : OFF_VT2)));
            if (dsh == 0) {
#pragma unroll
                for (int mt = 0; mt < 4; ++mt) {
                    const int m = mw + mt * 16 + fq * 4;
                    const int b = m >> 13, p = m & 8191;
#pragma unroll
                    for (int grp = 0; grp < 2; ++grp) {
                        u16* dst = vt + ((((size_t)(b * nhv + vth + grp)) * 512 + (p >> 4)) * 64) * 16 + (p & 15);
#pragma unroll
                        for (int nt = 0; nt < 4; ++nt) { const f32x4 v = acc[mt * 8 + grp * 4 + nt]; *(u32x2*)(dst + (nt * 16 + fr) * 16) = u32x2{pack2(v[0], v[1]), pack2(v[2], v[3])}; }
                    }
                }
            } else if (dsh == 4) {
#pragma unroll
                for (int j = 0; j < 4; ++j) {
                    const int m = mw + fq * 4 + j;
                    const int b = m >> 13, s = m & 8191;
                    const int p = ((s & 15) << 9) + (s >> 4);
#pragma unroll
                    for (int grp = 0; grp < 2; ++grp) {
                        u16* dst = vt + ((((size_t)(b * nhv + vth + grp)) * 512 + (p >> 4)) * 64) * 16 + (p & 15);
#pragma unroll
                        for (int nt = 0; nt < 4; ++nt)
                            *(u32x2*)(dst + (nt * 16 + fr) * 16) = u32x2{pack2(acc[0 * 8 + grp * 4 + nt][j], acc[1 * 8 + grp * 4 + nt][j]), pack2(acc[2 * 8 + grp * 4 + nt][j], acc[3 * 8 + grp * 4 + nt][j])};
                    }
                }
            } else {
#pragma unroll
                for (int mt = 0; mt < 4; ++mt) {
                    const int r0 = wm * 64 + mt * 16 + fq * 4;
                    const int m = m0 + (r0 & 31) * 4 + (r0 >> 5);
                    const int b = m >> 13, s = m & 8191;
                    const int p = ((s & 3) << 11) + (s >> 2);
#pragma unroll
                    for (int grp = 0; grp < 2; ++grp) {
                        u16* dst = vt + ((((size_t)(b * nhv + vth + grp)) * 512 + (p >> 4)) * 64) * 16 + (p & 15);
#pragma unroll
                        for (int nt = 0; nt < 4; ++nt) { const f32x4 v = acc[mt * 8 + grp * 4 + nt]; *(u32x2*)(dst + (nt * 16 + fr) * 16) = u32x2{pack2(v[0], v[1]), pack2(v[2], v[3])}; }
                    }
                }
            }
        } else {
            gemm_mainloop<false>(tid_, smem, A, 1024, Wt, 1024, 1024, m0, n0, acc);
            __builtin_amdgcn_s_barrier();
            constexpr int EROW = 272;
            unsigned char* est = smem + w * (64 * EROW);
            int l4_ = lane; asm volatile("" : "+v"(l4_));
            const int fr = l4_ & 15, fq = l4_ >> 4;
#pragma unroll
            for (int mt = 0; mt < 4; ++mt) {
                const int s = (mw + mt * 16 + fr) & 8191;
                unsigned char* erow = est + (mt * 16 + fr) * EROW + fq * 8;
                if (mode == 1) {
#pragma unroll
                    for (int nt = 0; nt < 2; ++nt) {
                        const f32x4 c4 = *(const f32x4*)(cosT + s * 32 + nt * 16 + fq * 4);
                        const f32x4 s4 = *(const f32x4*)(sinT + s * 32 + nt * 16 + fq * 4);
#pragma unroll
                        for (int grp = 0; grp < 2; ++grp) {
                            const f32x4 x1 = acc[(grp * 4 + nt) * 4 + mt], x2 = acc[(grp * 4 + nt + 2) * 4 + mt];
                            const f32x4 o1 = x1 * c4 - x2 * s4, o2 = x2 * c4 + x1 * s4;
                            *(u32x2*)(erow + (grp * 64 + nt * 16) * 2) = u32x2{pack2(o1[0], o1[1]), pack2(o1[2], o1[3])};
                            *(u32x2*)(erow + (grp * 64 + (nt + 2) * 16) * 2) = u32x2{pack2(o2[0], o2[1]), pack2(o2[2], o2[3])};
                        }
                    }
                } else {
#pragma unroll
                    for (int nt = 0; nt < 8; ++nt) { const f32x4 v = acc[nt * 4 + mt]; *(u32x2*)(erow + nt * 32) = u32x2{pack2(v[0], v[1]), pack2(v[2], v[3])}; }
                }
            }
            __builtin_amdgcn_fence(__ATOMIC_RELEASE, "wavefront"); __builtin_amdgcn_wave_barrier(); __builtin_amdgcn_fence(__ATOMIC_ACQUIRE, "wavefront");
            {
                const int rr = l4_ >> 4, ch = l4_ & 15;
                if (ksel >= 0) {
                    u16* ki = (u16*)(ws + (ksel == 0 ? OFF_KI0 : (ksel == 1 ? OFF_KI1 : OFF_KI2)));
                    const int dmask = (1 << dsh) - 1, lsh = 13 - dsh, numask = (64 >> dsh) - 1;
                    const int kk = l4_ >> 2, c4 = l4_ & 3;
#pragma unroll 4
                    for (int i = 0; i < 16; ++i) {
                        const int rgp = i >> 2, hd = (i >> 1) & 1, half = i & 1;
                        const int tt = rgp * 16 + kk;
                        const int row = ((tt & numask) << dsh) + (tt >> (6 - dsh));
                        const int m = mw + row, b = m >> 13, s = m & 8191;
                        const int p = ((s & dmask) << lsh) + (s >> dsh);
                        const u32x4 v = *(const u32x4*)(est + row * EROW + (hd * 64 + half * 32 + c4 * 8) * 2);
                        *(u32x4*)(ki + ((((size_t)(b * nhv + vth + hd) * 512 + (p >> 4)) * 2 + half) * 16 + (p & 15)) * 32 + c4 * 8) = v;
                    }
                } else {
                u16* hbase = H + (size_t)mw * N + ncol + ch * 8;
#pragma unroll
                for (int i = 0; i < 16; ++i) {
                    const int row = i * 4 + rr;
                    const u32x4 v = *(const u32x4*)(est + row * EROW + ch * 16);
                    *(u32x4*)(hbase + (size_t)row * N) = v;
                }
                }
            }
        }
    }
}

DEV void gemm_out_phase(unsigned char* smem, const Prm& P, const u16* Wt, const float* xin) {
    const int tid_ = opaque_tid();
    const u16* A = (const u16*)(P.ws + OFF_G);
    const int lane = tid_ & 63, w = __builtin_amdgcn_readfirstlane(tid_ >> 6), wm = w >> 1, wn = w & 1, fr = lane & 15, fq = lane >> 4;
    for (int t = vblock(); t < 512; t += gridDim.x) {
        int mi, ni; tile_mn(t, 4, mi, ni);
        const int m0 = mi << 7, n0 = ni << 8;
        f32x4 acc[32]; ZERO_ACC(acc);
        gemm_mainloop<false>(tid_, smem, A, 1024, Wt, 1024, 1024, m0, n0, acc);
        {
            __builtin_amdgcn_s_barrier();
            constexpr int EROWF = 528;
            unsigned char* est = smem + w * (32 * EROWF);
            const size_t ub = (size_t)(m0 + wm * 64) * 1024 + n0 + wn * 128;
            const float* xw = xin + ub; float* ow = P.out + ub;
            int l2_ = lane; asm volatile("" : "+v"(l2_));
            const int fr2 = l2_ & 15, fq2 = l2_ >> 4, rr = l2_ >> 5, ch = l2_ & 31;
#pragma unroll
            for (int h = 0; h < 2; ++h) {
#pragma unroll
                for (int mh = 0; mh < 2; ++mh) {
                    unsigned char* erow = est + (mh * 16 + fr2) * EROWF + fq2 * 16;
#pragma unroll
                    for (int nt = 0; nt < 8; ++nt) *(f32x4*)(erow + nt * 64) = acc[nt * 4 + h * 2 + mh];
                }
                __builtin_amdgcn_fence(__ATOMIC_RELEASE, "wavefront"); __builtin_amdgcn_wave_barrier(); __builtin_amdgcn_fence(__ATOMIC_ACQUIRE, "wavefront");
#pragma unroll 4
                for (int i = 0; i < 16; ++i) {
                    const int row = i * 2 + rr;
                    const unsigned ix = (unsigned)((h * 32 + row) * 1024 + ch * 4);
                    const f32x4 v = *(const f32x4*)(est + row * EROWF + ch * 16);
                    const f32x4 xv = *(const f32x4*)(xw + ix);
                    *(f32x4*)(ow + ix) = xv * DN_ALPHA + v;
                }
                __builtin_amdgcn_fence(__ATOMIC_RELEASE, "wavefront"); __builtin_amdgcn_wave_barrier(); __builtin_amdgcn_fence(__ATOMIC_ACQUIRE, "wavefront");
            }
        }
    }
}

DEV void gemm_gate_phase(unsigned char* smem, const Prm& P, const u16* Wg, const u16* Wp) {
    const int tid_ = opaque_tid();
    const u16* A1 = (const u16*)(P.ws + OFF_XLB);
    const u16* A2 = (const u16*)(P.ws + OFF_PB);
    u16* xb = (u16*)(P.ws + OFF_XB);
    u16* ppb = (u16*)(P.ws + OFF_PP);
    const int lane = tid_ & 63, w = __builtin_amdgcn_readfirstlane(tid_ >> 6), wm = w >> 1, wn = w & 1, fr = lane & 15, fq = lane >> 4;
    for (int t = vblock(); t < 512; t += gridDim.x) {
        int mi, ni; tile_mn(t, 4, mi, ni);
        const int m0 = mi << 7, n0 = ni << 8;
        f32x4 acc[32]; ZERO_ACC(acc);
        gemm_mainloop<false>(tid_, smem, A2, 256, Wp, 256, 256, m0, n0, acc);
        const size_t ub = (size_t)(m0 + wm * 64) * 1024 + n0 + wn * 128;
        float* ow = P.out + ub; u16* pw = ppb + ub; u16* xw = xb + ub;
        {
            int l2_ = lane; asm volatile("" : "+v"(l2_));
            const unsigned lo = (unsigned)((l2_ & 15) * 1024 + (l2_ >> 4) * 4);
#pragma unroll
            for (int mt = 0; mt < 4; ++mt) {
#pragma unroll
                for (int nt = 0; nt < 8; ++nt) { const f32x4 v = acc[nt * 4 + mt]; *(u32x2*)(pw + (lo + mt * 16384 + nt * 16)) = u32x2{pack2(v[0], v[1]), pack2(v[2], v[3])}; }
                __builtin_amdgcn_sched_barrier(0);
            }
        }
        ZERO_ACC(acc);
        gemm_mainloop<false>(tid_, smem, A1, 1024, Wg, 1024, 1024, m0, n0, acc);
        int l3_ = lane; asm volatile("" : "+v"(l3_));
        const unsigned lo = (unsigned)((l3_ & 15) * 1024 + (l3_ >> 4) * 4);
#pragma unroll
        for (int mt = 0; mt < 4; ++mt) {
#pragma unroll
            for (int nt = 0; nt < 8; ++nt) {
                const unsigned ix = lo + mt * 16384 + nt * 16;
                const f32x4 xv = *(const f32x4*)(ow + ix);
                const u32x2 pq = *(const u32x2*)(pw + ix);
                const f32x4 ga = acc[nt * 4 + mt];
                f32x4 r;
                r[0] = xv[0] + sigmoidf_(ga[0]) * bflo(pq[0]); r[1] = xv[1] + sigmoidf_(ga[1]) * bfhi(pq[0]);
                r[2] = xv[2] + sigmoidf_(ga[2]) * bflo(pq[1]); r[3] = xv[3] + sigmoidf_(ga[3]) * bfhi(pq[1]);
                *(f32x4*)(ow + ix) = r;
                *(u32x2*)(xb + kb_off(m0 + wm * 64 + mt * 16 + (l3_ & 15), n0 + wn * 128 + nt * 16 + (l3_ >> 4) * 4, 1024)) = u32x2{pack2(r[0], r[1]), pack2(r[2], r[3])};
            }
            __builtin_amdgcn_sched_barrier(0);
        }
    }
}

DEV void ln_phase(const Prm& P, int layer) {
    const int tid_ = opaque_tid();
    const int lane = tid_ & 63, w = __builtin_amdgcn_readfirstlane(tid_ >> 6);
    const float* g = P.in[12] + layer * 1024; const float* bb = P.in[13] + layer * 1024;
    u16* xlb = (u16*)(P.ws + OFF_XLB);
    f32x4 gg[4], bv[4];
#pragma unroll
    for (int i = 0; i < 4; ++i) { gg[i] = *(const f32x4*)(g + i * 256 + lane * 4); bv[i] = *(const f32x4*)(bb + i * 256 + lane * 4); }
    for (int rb = blockIdx.x * 4 + w; rb < T / 4; rb += gridDim.x * 4) {
        float* xr = P.out + (size_t)rb * 4096;
        f32x4 v[4][4];
#pragma unroll
        for (int r = 0; r < 4; ++r)
#pragma unroll
            for (int i = 0; i < 4; ++i) v[r][i] = *(const f32x4*)(xr + r * 1024 + i * 256 + lane * 4);
#pragma unroll
        for (int r = 0; r < 4; ++r) {
            float s = 0.f;
#pragma unroll
            for (int i = 0; i < 4; ++i) s += v[r][i][0] + v[r][i][1] + v[r][i][2] + v[r][i][3];
            const float mean = wave_sum(s) * (1.f / 1024.f);
            float q = 0.f;
#pragma unroll
            for (int i = 0; i < 4; ++i)
#pragma unroll
                for (int j = 0; j < 4; ++j) { const float d = v[r][i][j] - mean; q += d * d; }
            const float rstd = rsqrtf(wave_sum(q) * (1.f / 1024.f) + LN_EPS);
            const int row = rb * 4 + r;
#pragma unroll
            for (int i = 0; i < 4; ++i) {
                f32x4 y;
#pragma unroll
                for (int j = 0; j < 4; ++j) y[j] = (v[r][i][j] - mean) * rstd * gg[i][j] + bv[i][j];
                *(f32x4*)(xr + r * 1024 + i * 256 + lane * 4) = y;
                *(u32x2*)(xlb + kb_off(row, i * 256 + lane * 4, 1024)) = u32x2{pack2(y[0], y[1]), pack2(y[2], y[3])};
            }
        }
    }
    const float* p = P.in[1] + (size_t)layer * T * 256; u16* pb = (u16*)(P.ws + OFF_PB);
    const size_t gtid = (size_t)blockIdx.x * 256 + tid_, gsz = (size_t)gridDim.x * 256;
    for (size_t i = gtid; i < (size_t)T * 256 / 8; i += gsz) {
        const f32x4 a = *(const f32x4*)(p + i * 8), b = *(const f32x4*)(p + i * 8 + 4);
        *(u32x4*)(pb + kb_off((int)(i >> 5), (int)(i & 31) * 8, 256)) = u32x4{pack2(a[0], a[1]), pack2(a[2], a[3]), pack2(b[0], b[1]), pack2(b[2], b[3])};
    }
}

struct KV { bf16x8 ka0, ka1, kb0, kb1; bf16x8 v0, v1, v2, v3; };
template <int KH = 1024>
DEV void load_kv(KV& t, const char* Kb, unsigned koa, unsigned kob, const char* Vb, unsigned voa, unsigned vob) {
    t.ka0 = *(const bf16x8*)(Kb + koa); t.ka1 = *(const bf16x8*)(Kb + koa + KH);
    t.kb0 = *(const bf16x8*)(Kb + kob); t.kb1 = *(const bf16x8*)(Kb + kob + KH);
    t.v0 = __builtin_shufflevector(*(const s16x4*)(Vb + voa), *(const s16x4*)(Vb + vob), 0, 1, 2, 3, 4, 5, 6, 7);
    t.v1 = __builtin_shufflevector(*(const s16x4*)(Vb + voa + 512), *(const s16x4*)(Vb + vob + 512), 0, 1, 2, 3, 4, 5, 6, 7);
    t.v2 = __builtin_shufflevector(*(const s16x4*)(Vb + voa + 1024), *(const s16x4*)(Vb + vob + 1024), 0, 1, 2, 3, 4, 5, 6, 7);
    t.v3 = __builtin_shufflevector(*(const s16x4*)(Vb + voa + 1536), *(const s16x4*)(Vb + vob + 1536), 0, 1, 2, 3, 4, 5, 6, 7);
}
DEV unsigned pkrtz(float a, float b) { return __builtin_bit_cast(unsigned, __builtin_amdgcn_cvt_pkrtz(a, b)); }
DEV bf16x8 pack8(const float (&p)[8]) {
    return __builtin_bit_cast(bf16x8, u32x4{pkrtz(p[0], p[1]), pkrtz(p[2], p[3]), pkrtz(p[4], p[5]), pkrtz(p[6], p[7])});
}
DEV void qk_scores(const KV& t, const bf16x8& q0, const bf16x8& q1, f32x4& sa, f32x4& sb) {
    sa = f32x4{0.f, 0.f, 0.f, 0.f}; sb = f32x4{0.f, 0.f, 0.f, 0.f};
    sa = MFMA16(t.ka0, q0, sa); sa = MFMA16(t.ka1, q1, sa);
    sb = MFMA16(t.kb0, q0, sb); sb = MFMA16(t.kb1, q1, sb);
}
constexpr float QK_C = 0.125f * 1.4426950408889634f;
using f32x2 = __attribute__((ext_vector_type(2))) float;
DEV void mask8(f32x4& sa, f32x4& sb, int d0, unsigned lim) {
#pragma unroll
    for (int j = 0; j < 4; ++j) {
        sa[j] = ((unsigned)(d0 - j) <= lim)      ? sa[j] : NEG_INF;
        sb[j] = ((unsigned)(d0 - 16 - j) <= lim) ? sb[j] : NEG_INF;
    }
}
DEV float max8(const f32x4& sa, const f32x4& sb) {
    return fmaxf(fmaxf(fmaxf(sa[0], sa[1]), fmaxf(sa[2], sa[3])), fmaxf(fmaxf(sb[0], sb[1]), fmaxf(sb[2], sb[3])));
}
DEV void lazy_rescale(float& mref, float& l, f32x4 (&o)[4], float mxr) {
    const float mxs = mxr * QK_C;
    if (__ballot(mxs > mref + 8.f) != 0ull) {
        const float mx = red16_max(mxs);
        const float mn = fmaxf(mref, mx);
        const float alpha = (mn == NEG_INF) ? 1.f : __builtin_amdgcn_exp2f(mref - mn);
        l *= alpha;
#pragma unroll
        for (int d = 0; d < 4; ++d) o[d] *= alpha;
        mref = mn;
    }
}
DEV bf16x8 exp8(const f32x4& sa, const f32x4& sb, float mu, float& l) {
    float p[8]; const float nm = -mu;
#pragma unroll
    for (int j = 0; j < 4; ++j) { p[j] = __builtin_amdgcn_exp2f(__builtin_fmaf(sa[j], QK_C, nm)); p[4 + j] = __builtin_amdgcn_exp2f(__builtin_fmaf(sb[j], QK_C, nm)); }
    l += ((p[0] + p[1]) + (p[2] + p[3])) + ((p[4] + p[5]) + (p[6] + p[7]));
    return pack8(p);
}
DEV void flash_core(float& mref, float& l, f32x4 (&o)[4], const bf16x8& q0, const bf16x8& q1, const KV& t, bool fast, int d0, unsigned lim) {
    f32x4 sa, sb; qk_scores(t, q0, q1, sa, sb);
    if (!fast) mask8(sa, sb, d0, lim);
    lazy_rescale(mref, l, o, max8(sa, sb));
    const float mu = (mref == NEG_INF) ? 0.f : mref;
    const bf16x8 pf = exp8(sa, sb, mu, l);
    o[0] = MFMA16(t.v0, pf, o[0]); o[1] = MFMA16(t.v1, pf, o[1]); o[2] = MFMA16(t.v2, pf, o[2]); o[3] = MFMA16(t.v3, pf, o[3]);
}

DEV void flash_core2(float& mref, float& l, f32x4 (&o)[4], const bf16x8& q0, const bf16x8& q1, const KV& ta, const KV& tb,
                     bool fasta, bool fastb, int d0a, int d0b, unsigned lim) {
    f32x4 sa, sb, sc, sd; qk_scores(ta, q0, q1, sa, sb); qk_scores(tb, q0, q1, sc, sd);
    if (!fasta) mask8(sa, sb, d0a, lim);
    if (!fastb) mask8(sc, sd, d0b, lim);
    lazy_rescale(mref, l, o, fmaxf(max8(sa, sb), max8(sc, sd)));
    const float mu = (mref == NEG_INF) ? 0.f : mref;
    const bf16x8 pfa = exp8(sa, sb, mu, l), pfb = exp8(sc, sd, mu, l);
    o[0] = MFMA16(ta.v0, pfa, o[0]); o[1] = MFMA16(ta.v1, pfa, o[1]); o[2] = MFMA16(ta.v2, pfa, o[2]); o[3] = MFMA16(ta.v3, pfa, o[3]);
    o[0] = MFMA16(tb.v0, pfb, o[0]); o[1] = MFMA16(tb.v1, pfb, o[1]); o[2] = MFMA16(tb.v2, pfb, o[2]); o[3] = MFMA16(tb.v3, pfb, o[3]);
}

#define RING4(NSTEPS, LOADSTEP, COMPUTE) do { \
    KV cur_; \
    for (int st_ = 0; st_ < (NSTEPS); ++st_) { LOADSTEP(cur_, st_); COMPUTE(cur_, st_); } \
    } while (0)

DEV void band_loop(const int tid_, float& m, float& l, f32x4 (&o)[4], const bf16x8& q0, const bf16x8& q1, const char* Kb,
                   const char* Vb, int vblk0, int ustart, int nsteps, int uq, int uq0, int qspan, int maxd) {
    const int c = tid_ & 15, g4 = (tid_ & 63) >> 4;
    const unsigned kl = c * 64 + g4 * 16, vl = c * 32 + g4 * 8;
    const unsigned lim = (unsigned)min(maxd, uq);
#define BL_LOAD(R, S) do { const int ua_ = ustart + (S) * 32, ub_ = ua_ + 16; \
        const unsigned ba_ = (unsigned)(vblk0 + (max(ua_, 0) >> 4)) * 2048u, bb_ = (unsigned)(vblk0 + (max(ub_, 0) >> 4)) * 2048u; \
        load_kv(R, Kb, ba_ + kl, bb_ + kl, Vb, ba_ + vl, bb_ + vl); } while (0)
#define BL_COMP(R, S) do { const int ua_ = ustart + (S) * 32; \
        const bool fast_ = (ua_ >= 0) && (ua_ + 31 <= uq0) && (uq0 + qspan - ua_ <= maxd); \
        flash_core(m, l, o, q0, q1, R, fast_, uq - ua_ - g4 * 4, lim); } while (0)
    RING4(nsteps, BL_LOAD, BL_COMP);
#undef BL_LOAD
#undef BL_COMP
}

DEV void attnA_phase(const Prm& P, int chunk) {
    const int tid_ = opaque_tid();
    unsigned char* ws = P.ws;
    const u16* H = (const u16*)(ws + OFF_H);
    u16* G = (u16*)(ws + OFF_G);
    const int lane = tid_ & 63, w = __builtin_amdgcn_readfirstlane(tid_ >> 6), c = lane & 15, g4 = lane >> 4;
    constexpr int LD = 2560;
    const int xcd_ = blockIdx.x & 7, slot_ = blockIdx.x >> 3, nslot_ = gridDim.x >> 3;
    for (int i_ = slot_; i_ < 128; i_ += nslot_) {
        const int rq = i_ & 3, tbi = i_ >> 2, hh = xcd_ & 3, b = xcd_ >> 2;
        const int r = w * 4 + rq, tb = tbi * 256;
        const int sq = tb + r + 16 * c;
        const size_t rowq = (size_t)b * 8192 + sq;
        float m = NEG_INF, l = 0.f;
        f32x4 o[4];
#pragma unroll
        for (int d = 0; d < 4; ++d) o[d] = f32x4{0.f, 0.f, 0.f, 0.f};
#pragma unroll 1
        for (int g = 0; g < 3; ++g) {
            const int dsh = 2 * g, dmask = (1 << dsh) - 1;
            const int rg = r & dmask;
            const int uq = sq >> dsh, uq0 = (tb + r) >> dsh;
            int ustart = (uq0 - 128) & ~15;
            const int ulast = (uq0 + (15 << (4 - dsh))) & ~15;
            int ntile = ((ulast - ustart) >> 4) + 1;
            if (ntile & 1) { ustart -= 16; ntile += 1; }
            const u16* Hq = H + rowq * LD + g * 768 + hh * 64 + g4 * 8;
            const bf16x8 q0 = *(const bf16x8*)Hq, q1 = *(const bf16x8*)(Hq + 32);
            const char* Kb = (const char*)((const u16*)(ws + (g == 0 ? OFF_KI0 : (g == 1 ? OFF_KI1 : OFF_KI2))) + ((size_t)(b * 4 + hh) * 512) * 1024);
            const char* Vb = (const char*)((const u16*)(ws + (g == 0 ? OFF_VT0 : (g == 1 ? OFF_VT1 : OFF_VT2))) + ((size_t)(b * 4 + hh) * 512) * 1024);
            const int vblk0 = rg * ((8192 >> dsh) >> 4);
            band_loop(tid_, m, l, o, q0, q1, Kb, Vb, vblk0, ustart, ntile >> 1, uq, uq0, 15 << (4 - dsh), 128);
        }
        l = red16_sum(l);
        const float inv = 1.f / l;
#pragma unroll
        for (int dt = 0; dt < 4; ++dt) {
            const int dh = dt * 16 + g4 * 4;
            const u32x2 z = *(const u32x2*)(H + rowq * LD + 2304 + hh * 64 + dh);
            const float r0 = o[dt][0] * inv * siluf_(bflo(z[0])), r1 = o[dt][1] * inv * siluf_(bfhi(z[0]));
            const float r2 = o[dt][2] * inv * siluf_(bflo(z[1])), r3 = o[dt][3] * inv * siluf_(bfhi(z[1]));
            *(u32x2*)(G + kb_off((int)rowq, (chunk * 4 + hh) * 64 + dh, 1024)) = u32x2{pack2(r0, r1), pack2(r2, r3)};
        }
    }
}

DEV void attnB_phase(const Prm& P) {
    const int tid_ = opaque_tid();
    unsigned char* ws = P.ws;
    const u16* H = (const u16*)(ws + OFF_H);
    u16* G = (u16*)(ws + OFF_G);
    const float* sinks = P.in[5];
    const int lane = tid_ & 63, w = __builtin_amdgcn_readfirstlane(tid_ >> 6), c = lane & 15, g4 = lane >> 4;
    constexpr int LD = 2304;
    const int xcd_ = blockIdx.x & 7, slot_ = blockIdx.x >> 3, nslot_ = gridDim.x >> 3;
    for (int tile = slot_; tile < 512; tile += nslot_) {
        const int b = xcd_ >> 2, hq = xcd_ & 3;
        const int head = hq * 4 + w, kvh = head >> 3;
        const int t0 = tile * 16, sq = t0 + c;
        const size_t rowq = (size_t)b * 8192 + sq;
        float m = NEG_INF, l = 0.f;
        f32x4 o[4];
#pragma unroll
        for (int d = 0; d < 4; ++d) o[d] = f32x4{0.f, 0.f, 0.f, 0.f};
        const u16* Hq = H + rowq * LD + head * 64 + g4 * 8;
        const bf16x8 q0 = *(const bf16x8*)Hq, q1 = *(const bf16x8*)(Hq + 32);
        const char* Kb = (const char*)((const u16*)(ws + OFF_KI0) + ((size_t)(b * 2 + kvh) * 512) * 1024);
        const char* Vb = (const char*)((const u16*)(ws + OFF_VT0) + ((size_t)(b * 2 + kvh) * 512) * 1024);
        band_loop(tid_, m, l, o, q0, q1, Kb, Vb, 0, t0 - 144, 5, sq, t0, 15, 127);
        l = red16_sum(l);
        const float mu = (m == NEG_INF) ? 0.f : m;
        const float lf = l + __builtin_amdgcn_exp2f(sinks[head] * 1.4426950408889634f - mu);
        const float inv = 1.f / lf;
#pragma unroll
        for (int dt = 0; dt < 4; ++dt) {
            const int dh = dt * 16 + g4 * 4;
            const u32x2 z = *(const u32x2*)(H + rowq * LD + 1280 + head * 64 + dh);
            const float r0 = o[dt][0] * inv * siluf_(bflo(z[0])), r1 = o[dt][1] * inv * siluf_(bfhi(z[0]));
            const float r2 = o[dt][2] * inv * siluf_(bflo(z[1])), r3 = o[dt][3] * inv * siluf_(bfhi(z[1]));
            *(u32x2*)(G + kb_off((int)rowq, head * 64 + dh, 1024)) = u32x2{pack2(r0, r1), pack2(r2, r3)};
        }
    }
}

DEV void compress_phase(const Prm& P) {
    const int tid_ = opaque_tid();
    unsigned char* ws = P.ws;
    const u16* H = (const u16*)(ws + OFF_H);
    constexpr int LD = 3840;
    const float* bias = (const float*)(ws + OFF_BIAS);
    const int lane = tid_ & 63, w = __builtin_amdgcn_readfirstlane(tid_ >> 6), c = lane & 15, g4 = lane >> 4;
    for (int it = blockIdx.x; it < 128; it += gridDim.x) {
        const int unit = it * 4 + w;
        const int which = unit >> 8, b = (unit >> 7) & 1, kvh = (unit >> 5) & 3, ntile = unit & 31;
        const u16* Wt = (const u16*)(ws + (which ? OFF_WCV : OFF_WCK));
        const int colbase = (which ? 1280 : 1024) + kvh * 64;
        const int n = ntile * 16 + c;
        const u16* Wl = Wt + c * 32 + g4 * 8;
        f32x4 acc[4];
#pragma unroll
        for (int e = 0; e < 4; ++e) acc[e] = f32x4{0.f, 0.f, 0.f, 0.f};
#pragma unroll 4
        for (int kk = 0; kk < 64; ++kk) {
            const int j = kk >> 1, d0 = (kk & 1) * 32 + g4 * 8;
            int s = 16 * n + j; s = min(s, 8191);
            const bf16x8 xf = *(const bf16x8*)(H + ((size_t)b * 8192 + s) * LD + colbase + d0);
            bf16x8 wf[4];
#pragma unroll
            for (int e = 0; e < 4; ++e) wf[e] = *(const bf16x8*)(Wl + (size_t)(e * 64 + kk) * 512);
            if (which == 0) {
#pragma unroll
                for (int e = 0; e < 4; ++e) acc[e] = MFMA16(wf[e], xf, acc[e]);
            } else {
#pragma unroll
                for (int e = 0; e < 4; ++e) acc[e] = MFMA16(xf, wf[e], acc[e]);
            }
        }
        if (which == 0) {
            u16* kc = (u16*)(ws + OFF_KCMP) + ((size_t)(b * 4 + kvh) * 32 + ntile) * 1024 + c * 32;
#pragma unroll
            for (int e = 0; e < 4; ++e) {
                const int e0 = e * 16 + g4 * 4;
                const f32x4 bv = *(const f32x4*)(bias + e0);
                const f32x4 r = acc[e] + bv;
                *(u32x2*)(kc + (e0 >> 5) * 512 + (e0 & 31)) = u32x2{pack2(r[0], r[1]), pack2(r[2], r[3])};
            }
        } else {
            u16* vc = (u16*)(ws + OFF_VCMP) + (((size_t)(b * 4 + kvh) * 32 + ntile) * 64) * 16;
#pragma unroll
            for (int e = 0; e < 4; ++e) {
                const int ee = e * 16 + c;
                const float bv = bias[64 + ee];
                *(u32x2*)(vc + ee * 16 + g4 * 4) = u32x2{pack2(acc[e][0] + bv, acc[e][1] + bv), pack2(acc[e][2] + bv, acc[e][3] + bv)};
            }
        }
    }
}

DEV void attnC_phase(const Prm& P, unsigned char* smem) {
    const int tid_ = opaque_tid();
    unsigned char* ws = P.ws;
    const u16* H = (const u16*)(ws + OFF_H);
    u16* G = (u16*)(ws + OFF_G);
    constexpr int LD = 3840;
    float* imp = (float*)smem;
    float* scb = (float*)(smem + 32768);
    float* oslc = (float*)(smem + 34816);
    const int tid = tid_, lane = tid & 63, w = __builtin_amdgcn_readfirstlane(tid >> 6), c = lane & 15, g4 = lane >> 4;
    const int xcd_ = blockIdx.x & 7, slot_ = blockIdx.x >> 3, nslot_ = gridDim.x >> 3;
    unsigned* qcnt = (unsigned*)(P.ws + OFF_BAR) + 3584 + xcd_ * 16;
    volatile int* tkt = (volatile int*)(smem + 51456);
    if (tid == 0) tkt[0] = (int)xb_add(qcnt, 1u);
    for (int i = tid; i < 8192; i += 256) imp[i] = 0.f;
    __syncthreads();
    (void)slot_; (void)nslot_;
    for (int par_ = 0;; par_ ^= 1) {
        const int ticket = __builtin_amdgcn_readfirstlane(tkt[par_]);
        if (ticket >= 512) break;
        if (tid == 0) tkt[par_ ^ 1] = (int)xb_add(qcnt, 1u);
        const int tile = 511 - ticket;
        const int b = xcd_ >> 2, kvh = xcd_ & 3;
        const int t0 = tile * 16;
        const int head = kvh * 4 + w;
        const size_t rowq = (size_t)b * 8192 + t0 + c;
        const u16* Hq = H + rowq * LD + head * 64 + g4 * 8;
        const bf16x8 q0 = *(const bf16x8*)Hq, q1 = *(const bf16x8*)(Hq + 32);
        f32x4 oacc[4];
#pragma unroll
        for (int d = 0; d < 4; ++d) oacc[d] = f32x4{0.f, 0.f, 0.f, 0.f};
        const int nmax = (t0 + c - 31) >> 4;
        const int nmaxw = (t0 - 16) >> 4;
        const float g0 = sigmoidf_(bf2f(H[rowq * LD + 3584 + head]));
        const float g1 = sigmoidf_(bf2f(H[rowq * LD + 3584 + 16 + head]));
        const float g2 = sigmoidf_(bf2f(H[rowq * LD + 3584 + 32 + head]));
        if (nmaxw >= 0) {
            const int nsteps = (nmaxw >> 5) + 1;
            const char* Kb = (const char*)((const u16*)(ws + OFF_KCMP) + ((size_t)(b * 4 + kvh) * 32) * 1024);
            const char* Vb = (const char*)((const u16*)(ws + OFF_VCMP) + ((size_t)(b * 4 + kvh) * 32) * 1024);
            const unsigned kl = c * 64 + g4 * 16, vl = c * 32 + g4 * 8;
            float m = NEG_INF, l = 0.f;
#define CM_LOAD(R, S) do { const int na_ = (S) * 32; const unsigned ba_ = (unsigned)(na_ >> 4) * 2048u, bb_ = (unsigned)min((na_ >> 4) + 1, 31) * 2048u; \
        load_kv(R, Kb, ba_ + kl, bb_ + kl, Vb, ba_ + vl, bb_ + vl); } while (0)
#define CM_PASS1(R, S) do { const int na_ = (S) * 32; f32x4 sa, sb; qk_scores(R, q0, q1, sa, sb); float mx = NEG_INF; float x[8]; \
        _Pragma("unroll") for (int j = 0; j < 8; ++j) { const int n = na_ + (j >> 2) * 16 + g4 * 4 + (j & 3); \
            x[j] = (n <= nmax) ? ((j < 4) ? sa[j & 3] : sb[j & 3]) * 0.125f : NEG_INF; mx = fmaxf(mx, x[j]); } \
        const float mn = fmaxf(m, mx); const float mu = (mn == NEG_INF) ? 0.f : mn; float ps = 0.f; \
        _Pragma("unroll") for (int j = 0; j < 8; ++j) ps += __expf(x[j] - mu); \
        l = l * __expf(m - mu) + ps; m = mn; } while (0)
            RING4(nsteps, CM_LOAD, CM_PASS1);
            float mall = red16_max(m);
            mall = (mall == NEG_INF) ? 0.f : mall;
            l = l * __expf(m - mall);
            l = red16_sum(l);
            const float invl = (l > 0.f) ? 1.f / l : 0.f;
#define CM_PASS2(R, S) do { const int na_ = (S) * 32; f32x4 sa, sb; qk_scores(R, q0, q1, sa, sb); float p[8]; \
        _Pragma("unroll") for (int j = 0; j < 8; ++j) { const int n = na_ + (j >> 2) * 16 + g4 * 4 + (j & 3); \
            const float sv = ((j < 4) ? sa[j & 3] : sb[j & 3]) * 0.125f; \
            p[j] = (n <= nmax) ? __expf(sv - mall) * invl : 0.f; \
            if (n <= nmax) atomicAdd(&imp[n * 16 + c], p[j]); } \
        const bf16x8 pf = pack8(p); \
        oacc[0] = MFMA16(R.v0, pf, oacc[0]); oacc[1] = MFMA16(R.v1, pf, oacc[1]); \
        oacc[2] = MFMA16(R.v2, pf, oacc[2]); oacc[3] = MFMA16(R.v3, pf, oacc[3]); } while (0)
            RING4(nsteps, CM_LOAD, CM_PASS2);
#undef CM_LOAD
#undef CM_PASS1
#undef CM_PASS2
#pragma unroll
            for (int d = 0; d < 4; ++d) oacc[d] *= g0;
        }
        {
            float m = NEG_INF, l = 0.f;
            f32x4 o[4];
#pragma unroll
            for (int d = 0; d < 4; ++d) o[d] = f32x4{0.f, 0.f, 0.f, 0.f};
            const char* Kb = (const char*)((const u16*)(ws + OFF_KI1) + ((size_t)(b * 4 + kvh) * 512) * 1024);
            const char* Vb = (const char*)((const u16*)(ws + OFF_VT1) + ((size_t)(b * 4 + kvh) * 512) * 1024);
            band_loop(tid_, m, l, o, q0, q1, Kb, Vb, 0, t0 - 528, 17, t0 + c, t0, 15, 511);
            l = red16_sum(l);
            const float sc = g2 / l;
#pragma unroll
            for (int d = 0; d < 4; ++d) oacc[d] += o[d] * sc;
        }
        __syncthreads();
        unsigned long long* msk = (unsigned long long*)(smem + 51200) + w * 8;
#pragma unroll 1
        for (int i = 0; i < 4; ++i) {
            const int tok = 4 * w + i, tq = t0 + tok, cur = tq >> 6;
            float my0, my1;
            {
                const int j0 = lane, j1 = lane + 64;
                float a0 = 2.f * (imp[(4 * j0) * 16 + tok] + imp[(4 * j0 + 1) * 16 + tok] + imp[(4 * j0 + 2) * 16 + tok]) + imp[(4 * j0 + 3) * 16 + tok];
                if (j0 > 0) a0 += imp[(4 * j0 - 1) * 16 + tok];
                const float a1 = 2.f * (imp[(4 * j1) * 16 + tok] + imp[(4 * j1 + 1) * 16 + tok] + imp[(4 * j1 + 2) * 16 + tok]) + imp[(4 * j1 + 3) * 16 + tok]
                                 + imp[(4 * j1 - 1) * 16 + tok];
                const bool f0 = (j0 == 0) || (j0 == cur) || (j0 == cur - 1);
                const bool f1 = (j1 == cur) || (j1 == cur - 1);
                my0 = f0 ? 1e4f : ((j0 <= cur) ? a0 : -1.f);
                my1 = f1 ? 1e4f : ((j1 <= cur) ? a1 : -1.f);
            }
            const unsigned k0 = (lane <= cur) ? (__float_as_uint(my0) + 1u) : 0u;
            const unsigned k1 = (lane + 64 <= cur) ? (__float_as_uint(my1) + 1u) : 0u;
            unsigned T = 0u;
#pragma unroll
            for (int bit = 31; bit >= 0; --bit) {
                const unsigned tr = T | (1u << bit);
                const int cnt = __builtin_popcountll(__ballot(k0 >= tr)) + __builtin_popcountll(__ballot(k1 >= tr));
                if (cnt >= 16) T = tr;
            }
            const unsigned long long eq0 = __ballot(k0 == T), eq1 = __ballot(k1 == T);
            const int need = 16 - __builtin_popcountll(__ballot(k0 > T)) - __builtin_popcountll(__ballot(k1 > T));
            const unsigned long long lm = (1ull << lane) - 1ull;
            const bool s0 = (k0 > 0u) && (k0 > T || (k0 == T && __builtin_popcountll(eq0 & lm) < need));
            const bool s1 = (k1 > 0u) && (k1 > T || (k1 == T && __builtin_popcountll(eq0) + __builtin_popcountll(eq1 & lm) < need));
            const unsigned long long lo = __ballot(s0);
            const unsigned long long hi = __ballot(s1);
            if (lane == 0) { msk[i * 2] = lo; msk[i * 2 + 1] = hi; }
        }
#pragma unroll 4
        for (int i = 0; i < 32; ++i) { const int e = i * 64 + lane; imp[(e >> 2) * 16 + 4 * w + (e & 3)] = 0.f; }
        __builtin_amdgcn_fence(__ATOMIC_RELEASE, "wavefront"); __builtin_amdgcn_wave_barrier(); __builtin_amdgcn_fence(__ATOMIC_ACQUIRE, "wavefront");
        {
            const int tokL = 4 * w + (c >> 2), tq = t0 + tokL, hd = kvh * 4 + (c & 3);
            const size_t rq = (size_t)b * 8192 + tq;
            const u16* Hs = H + rq * LD + hd * 64 + g4 * 8;
            const bf16x8 s0 = *(const bf16x8*)Hs, s1 = *(const bf16x8*)(Hs + 32);
            const char* Kb = (const char*)((const u16*)(ws + OFF_KI0) + ((size_t)(b * 4 + kvh) * 512) * 1024);
            const char* Vb = (const char*)((const u16*)(ws + OFF_VT0) + ((size_t)(b * 4 + kvh) * 512) * 1024);
            const unsigned kl = c * 64 + g4 * 16, vl = c * 32 + g4 * 8;
            float m = NEG_INF, l = 0.f;
            f32x4 o[4];
#pragma unroll
            for (int d = 0; d < 4; ++d) o[d] = f32x4{0.f, 0.f, 0.f, 0.f};
            const int ti = c >> 2;
            const unsigned long long mylo = msk[ti * 2], myhi = msk[ti * 2 + 1];
            const unsigned long long ulo = msk[0] | msk[2] | msk[4] | msk[6];
            const unsigned long long uhi = msk[1] | msk[3] | msk[5] | msk[7];
            const unsigned long long alo = msk[0] & msk[2] & msk[4] & msk[6], ahi = msk[1] & msk[3] & msk[5] & msk[7];
            int* blist = (int*)(scb + w * 128);
            const int nlo = __builtin_popcountll(ulo), nblk = nlo + __builtin_popcountll(uhi);
            if ((ulo >> lane) & 1ull) blist[__builtin_popcountll(ulo & ((1ull << lane) - 1ull))] = lane;
            if ((uhi >> lane) & 1ull) blist[nlo + __builtin_popcountll(uhi & ((1ull << lane) - 1ull))] = 64 + lane;
            __builtin_amdgcn_fence(__ATOMIC_RELEASE, "wavefront");
            __builtin_amdgcn_wave_barrier();
            __builtin_amdgcn_fence(__ATOMIC_ACQUIRE, "wavefront");
#pragma unroll 1
            for (int e_ = 0; e_ < nblk; ++e_) {
                const int j_ = __builtin_amdgcn_readfirstlane(blist[e_]);
                const unsigned kb_ = (unsigned)(j_ * 4) * 2048u;
                KV ta, tb;
                load_kv(ta, Kb, kb_ + kl, kb_ + 2048u + kl, Vb, kb_ + vl, kb_ + 2048u + vl);
                load_kv(tb, Kb, kb_ + 4096u + kl, kb_ + 6144u + kl, Vb, kb_ + 4096u + vl, kb_ + 6144u + vl);
                const bool selj = (j_ < 64) ? ((mylo >> j_) & 1ull) : ((myhi >> (j_ - 64)) & 1ull);
                const bool alls_ = (j_ < 64) ? ((alo >> j_) & 1ull) : ((ahi >> (j_ - 64)) & 1ull);
                const int ua_ = j_ * 64;
                const bool fa_ = alls_ && (ua_ + 31 <= t0 + 4 * w), fb_ = alls_ && (ua_ + 63 <= t0 + 4 * w);
                const int d0_ = selj ? (tq - ua_ - g4 * 4) : -(1 << 30);
                flash_core2(m, l, o, s0, s1, ta, tb, fa_, fb_, d0_, selj ? (d0_ - 32) : -(1 << 30), 0x7fffffffu);
            }
            l = red16_sum(l);
            const float inv = 1.f / l;
#pragma unroll
            for (int dt = 0; dt < 4; ++dt)
                *(f32x4*)(oslc + (tokL * 4 + (c & 3)) * 64 + dt * 16 + g4 * 4) = o[dt] * inv;
        }
        __syncthreads();
#pragma unroll
        for (int dt = 0; dt < 4; ++dt) {
            const int dh = dt * 16 + g4 * 4;
            const f32x4 os = *(const f32x4*)(oslc + (c * 4 + w) * 64 + dh);
            const f32x4 r = oacc[dt] + os * g1;
            const u32x2 z = *(const u32x2*)(H + rowq * LD + 2560 + head * 64 + dh);
            const float r0 = r[0] * siluf_(bflo(z[0])), r1 = r[1] * siluf_(bfhi(z[0]));
            const float r2 = r[2] * siluf_(bflo(z[1])), r3 = r[3] * siluf_(bfhi(z[1]));
            *(u32x2*)(G + kb_off((int)rowq, head * 64 + dh, 1024)) = u32x2{pack2(r0, r1), pack2(r2, r3)};
        }
    }
}

#ifndef PROBE_DUP
#define PROBE_DUP 0
#endif
#define REP(k) for (int rep_ = 0; rep_ < 1 + ((PROBE_DUP >> (k)) & 1); ++rep_)
constexpr int LDS_BYTES = 3 * GSTAGE + 64;
__global__ void __launch_bounds__(256, 2) mk_fwd(Prm P) {
    extern __shared__ __attribute__((aligned(16))) unsigned char smem[];
    unsigned* xb_words = (unsigned*)(smem + 3 * GSTAGE);
    if (threadIdx.x < 4) xb_words[threadIdx.x] = 0u;
    __syncthreads();
    XcdBarrier bar = xcd_barrier_post((unsigned*)(P.ws + OFF_BAR), (volatile LAS unsigned*)xb_words);
    unsigned char* ws = P.ws;

    phase0(P, smem);
    if (P.ws == nullptr) cg::this_grid().sync();
    xcd_barrier(bar);

#pragma unroll 1
    for (int layer = 0; layer < 4; ++layer) {
        const int kind = layer % 3, lj = layer / 3;
        const u16* Win; const u16* Wout; int N, nsub;
        if (kind == 0)      { Win = (const u16*)(ws + OFF_WA_IN + (size_t)lj * SZ_WA_IN); Wout = (const u16*)(ws + OFF_WA_OUT + (size_t)lj * SZ_SQ); N = 2560; nsub = 4; }
        else if (kind == 1) { Win = (const u16*)(ws + OFF_WB_IN); Wout = (const u16*)(ws + OFF_WB_OUT); N = 2304; nsub = 1; }
        else                { Win = (const u16*)(ws + OFF_WC_IN); Wout = (const u16*)(ws + OFF_WC_OUT); N = 3840; nsub = 1; }
#pragma unroll 1
        for (int sub = 0; sub < nsub; ++sub) {
            REP(0) gemm_in_phase(smem, P, kind, Win + (size_t)sub * 2560 * 1024, N);
            xcd_barrier(bar);
            if (kind == 0) REP(1) attnA_phase(P, sub);
            else if (kind == 1) REP(2) attnB_phase(P);
            else { REP(3) compress_phase(P); xcd_barrier(bar); REP(4) attnC_phase(P, smem); }
            xcd_barrier(bar);
        }
        gemm_out_phase(smem, P, Wout, layer == 0 ? P.in[0] : P.out);
        xcd_barrier(bar);
        ln_phase(P, layer);
        xcd_barrier(bar);
        gemm_gate_phase(smem, P, (const u16*)(ws + OFF_WG + (size_t)layer * SZ_SQ), (const u16*)(ws + OFF_WP + (size_t)layer * SZ_WP));
        if (layer < 3) xcd_barrier(bar);
    }
}

extern "C" void kernel_launch(void* const* d_in, const int* in_sizes, int n_in, void* d_out, int out_size, void* d_ws, size_t ws_size,
                              hipStream_t stream) {
    static int grid_blocks = 0;
    if (!grid_blocks) {
        int dev = 0, cus = 0, per_cu = 0;
        (void)hipGetDevice(&dev);
        (void)hipDeviceGetAttribute(&cus, hipDeviceAttributeMultiprocessorCount, dev);
        (void)hipFuncSetAttribute((const void*)mk_fwd, hipFuncAttributeMaxDynamicSharedMemorySize, LDS_BYTES);
        (void)hipOccupancyMaxActiveBlocksPerMultiprocessor(&per_cu, (const void*)mk_fwd, 256, LDS_BYTES);
        if (per_cu > 2) per_cu = 2;
        if (per_cu < 1) per_cu = 1;
        grid_blocks = cus * per_cu;
        if (ws_size < WS_END || n_in != 16) { fprintf(stderr, "kernel_launch: workspace too small (%zu < %zu) or n_in %d != 16\n", ws_size, (size_t)WS_END, n_in); grid_blocks = -1; }
    }
    if (grid_blocks < 0) return;
    (void)hipMemsetAsync((char*)d_ws + OFF_BAR, 0, 16384, stream);
    Prm p{};
    for (int i = 0; i < 16; ++i) p.in[i] = (const float*)d_in[i];
    p.out = (float*)d_out; p.ws = (unsigned char*)d_ws;
    void* args[] = {&p};
    hipError_t e = hipLaunchCooperativeKernel((const void*)mk_fwd, dim3(grid_blocks), dim3(256), args, LDS_BYTES, stream);
    if (e != hipSuccess) fprintf(stderr, "cooperative launch failed: %s (grid %d)\n", hipGetErrorString(e), grid_blocks);
}
```

```cpp
#include <hip/hip_runtime.h>
#include <hip/hip_cooperative_groups.h>
#include <cstdio>
#include <cstdint>
namespace cg = cooperative_groups;

typedef unsigned short u16;
using bf16x8 = __attribute__((ext_vector_type(8))) short;
using s16x4  = __attribute__((ext_vector_type(4))) short;
using f32x4  = __attribute__((ext_vector_type(4))) float;
using u32x4  = __attribute__((ext_vector_type(4))) unsigned;
using u32x2  = __attribute__((ext_vector_type(2))) unsigned;
#define DEV __device__ __forceinline__
using h16x8 = __attribute__((ext_vector_type(8))) _Float16;
#define MFMA16(a, b, c) __builtin_amdgcn_mfma_f32_16x16x32_f16(__builtin_bit_cast(h16x8, (a)), __builtin_bit_cast(h16x8, (b)), (c), 0, 0, 0)
#define LAS __attribute__((address_space(3)))

constexpr int T = 16384, S = 8192;
constexpr float LN_EPS = 1e-5f;
constexpr float DN_ALPHA = 1.6817928305074290f;
constexpr float NEG_INF = -__builtin_huge_valf();

constexpr size_t OFF_BAR   = 0;
constexpr size_t OFF_COS   = 16384;
constexpr size_t OFF_SIN   = OFF_COS + (size_t)8192 * 32 * 4;
constexpr size_t OFF_BIAS  = OFF_SIN + (size_t)8192 * 32 * 4;
constexpr size_t OFF_WA_IN = OFF_BIAS + 1024;
constexpr size_t SZ_WA_IN  = (size_t)10240 * 1024 * 2;
constexpr size_t SZ_SQ     = (size_t)1024 * 1024 * 2;
constexpr size_t OFF_WA_OUT = OFF_WA_IN + 2 * SZ_WA_IN;
constexpr size_t OFF_WB_IN  = OFF_WA_OUT + 2 * SZ_SQ;
constexpr size_t OFF_WB_OUT = OFF_WB_IN + (size_t)2304 * 1024 * 2;
constexpr size_t OFF_WC_IN  = OFF_WB_OUT + SZ_SQ;
constexpr size_t OFF_WC_OUT = OFF_WC_IN + (size_t)3840 * 1024 * 2;
constexpr size_t OFF_WG     = OFF_WC_OUT + SZ_SQ;
constexpr size_t OFF_WP     = OFF_WG + 4 * SZ_SQ;
constexpr size_t SZ_WP      = (size_t)1024 * 256 * 2;
constexpr size_t OFF_WCK    = OFF_WP + 4 * SZ_WP;
constexpr size_t OFF_WCV    = OFF_WCK + (size_t)64 * 2048 * 2;
constexpr size_t OFF_XB     = OFF_WCV + (size_t)64 * 2048 * 2;
constexpr size_t SZ_ACT     = (size_t)T * 1024 * 2;
constexpr size_t OFF_G      = OFF_XB + SZ_ACT;
constexpr size_t OFF_H      = OFF_G + SZ_ACT;
constexpr size_t SZ_HMAX    = (size_t)T * 3840 * 2;
constexpr size_t OFF_VT0    = OFF_H + SZ_HMAX;
constexpr size_t SZ_VT      = (size_t)2 * 4 * 8192 * 64 * 2;
constexpr size_t OFF_VT1    = OFF_VT0 + SZ_VT;
constexpr size_t OFF_VT2    = OFF_VT1 + SZ_VT;
constexpr size_t OFF_KCMP   = OFF_VT2 + SZ_VT;
constexpr size_t SZ_CMP     = (size_t)2 * 512 * 4 * 64 * 2;
constexpr size_t OFF_VCMP   = OFF_KCMP + SZ_CMP;
constexpr size_t OFF_KI0    = OFF_VCMP + SZ_CMP;
constexpr size_t OFF_KI1    = OFF_KI0 + SZ_VT;
constexpr size_t OFF_KI2    = OFF_KI1 + SZ_VT;
constexpr size_t WS_END     = OFF_KI2 + SZ_VT;
constexpr size_t OFF_XLB    = OFF_H;
constexpr size_t OFF_PB     = OFF_H + SZ_ACT;
constexpr size_t OFF_PP     = OFF_H + SZ_ACT + (size_t)16 * 1024 * 1024;

struct Prm { const float* in[16]; float* out; unsigned char* ws; };

__device__ __forceinline__ size_t kb_off(int row, int k, int K) { return ((size_t)(row >> 4) * (K >> 5) + (k >> 5)) * 512 + (row & 15) * 32 + (k & 31); }
DEV u16 f2bf(float f) { return __builtin_bit_cast(u16, (_Float16)f); }
DEV float bf2f(u16 h) { return (float)__builtin_bit_cast(_Float16, h); }
DEV unsigned pack2(float a, float b) { return (unsigned)f2bf(a) | ((unsigned)f2bf(b) << 16); }
DEV float bflo(unsigned u) { return bf2f((u16)(u & 0xffffu)); }
DEV float bfhi(unsigned u) { return bf2f((u16)(u >> 16)); }
DEV float sigmoidf_(float x) { return 1.f / (1.f + __expf(-x)); }
DEV float siluf_(float x) { return x / (1.f + __expf(-x)); }
DEV float red16_max(float v) { v = fmaxf(v, __shfl_xor(v, 16)); v = fmaxf(v, __shfl_xor(v, 32)); return v; }
DEV float red16_sum(float v) { v += __shfl_xor(v, 16); v += __shfl_xor(v, 32); return v; }
DEV float wave_sum(float v) { for (int o = 32; o > 0; o >>= 1) v += __shfl_xor(v, o); return v; }

DEV int opaque_tid() { int t = threadIdx.x; asm volatile("" : "+v"(t)); return t; }
#define XB_TMO      128
#define XB_XCNT(j)  (256  + 64 * (j))
#define XB_XSUB(j)  (1280 + 64 * (j))
#define XB_XGEN(j)  (2304 + 64 * (j))
#define XB_TOP      3328
#define XB_TOPGEN   3392
#define XCD_BAR_WORDS 3456
#define XB_SPIN_CAP (1u << 24)
DEV unsigned xb_ld(unsigned* p)              { return __hip_atomic_load(p, __ATOMIC_RELAXED, __HIP_MEMORY_SCOPE_AGENT); }
DEV unsigned xb_add(unsigned* p, unsigned v) { return __hip_atomic_fetch_add(p, v, __ATOMIC_RELAXED, __HIP_MEMORY_SCOPE_AGENT); }
DEV unsigned xb_xcc_id() { return (unsigned)__builtin_amdgcn_s_getreg((3 << 11) | 20) & 0xFu; }
#define XB_SPIN(cond, bar) do { unsigned _sp = 0; while (cond) { __builtin_amdgcn_s_sleep(1); \
    if ((++_sp & 255u) == 0u) { if (xb_ld(&(bar)[XB_TMO])) break; if (_sp > XB_SPIN_CAP) { atomicAdd(&(bar)[XB_TMO], 1u); break; } } } } while (0)
struct XcdBarrier { unsigned* bar; unsigned x; volatile LAS unsigned* st; };
DEV XcdBarrier xcd_barrier_post(unsigned* bar, volatile LAS unsigned* st) {
    XcdBarrier b; b.bar = bar; b.x = xb_xcc_id(); b.st = st;
    if (threadIdx.x == 0) (void)xb_add(&bar[XB_XCNT(b.x)], 1u);
    return b;
}
DEV void xcd_barrier_complete(unsigned* bar, unsigned x, unsigned& nloc, unsigned& nx) {
    const unsigned G = gridDim.x * gridDim.y * gridDim.z;
    unsigned sum, cnt, mine, sp = 0u;
    for (;;) {
        sum = 0u; cnt = 0u; mine = 0u;
#pragma unroll
        for (unsigned j = 0; j < 16; ++j) { const unsigned c = xb_ld(&bar[XB_XCNT(j)]); sum += c; cnt += (c > 0u) ? 1u : 0u; mine = (j == x) ? c : mine; }
        if (sum == G) break;
        __builtin_amdgcn_s_sleep(1);
        if ((++sp & 255u) == 0u) { if (xb_ld(&bar[XB_TMO])) break; if (sp > XB_SPIN_CAP) { atomicAdd(&bar[XB_TMO], 1u); break; } }
    }
    nloc = mine > 0u ? mine : 1u; nx = cnt > 0u ? cnt : 1u;
}
DEV void xcd_barrier(const XcdBarrier& b) {
    asm volatile("s_waitcnt vmcnt(0)" ::: "memory");
    __syncthreads();
    if (threadIdx.x == 0) {
        unsigned* bar = b.bar;
        __builtin_amdgcn_s_waitcnt(0);
        unsigned nloc = b.st[0], nx = b.st[1];
        if (nloc == 0u) { xcd_barrier_complete(bar, b.x, nloc, nx); b.st[0] = nloc; b.st[1] = nx; }
        const unsigned old = xb_add(&bar[XB_XSUB(b.x)], 1u);
        const unsigned gen = old / nloc;
        if (old + 1u == (gen + 1u) * nloc) {
            __builtin_amdgcn_fence(__ATOMIC_RELEASE, "agent");
            asm volatile("s_waitcnt vmcnt(0)" ::: "memory");
            const unsigned og = xb_add(&bar[XB_TOP], 1u);
            const unsigned tg = og / nx;
            if (og + 1u == (tg + 1u) * nx) xb_add(&bar[XB_TOPGEN], 1u);
            else XB_SPIN(xb_ld(&bar[XB_TOPGEN]) == tg, bar);
            __builtin_amdgcn_fence(__ATOMIC_ACQUIRE, "agent");
            xb_add(&bar[XB_XGEN(b.x)], 1u);
            asm volatile("s_waitcnt vmcnt(0)" ::: "memory");
        } else {
            XB_SPIN(xb_ld(&bar[XB_XGEN(b.x)]) == gen, bar);
            __builtin_amdgcn_fence(__ATOMIC_ACQUIRE, "agent");
            asm volatile("s_waitcnt vmcnt(0)" ::: "memory");
        }
    }
    __syncthreads();
}

DEV int colmap(int kind, int n) {
    if (kind == 0) return n;
    if (kind == 1) {
        const int c = n / 2560, nn = n - c * 2560;
        if (nn < 2304) { const int g = nn / 768, rem = nn - g * 768, part = rem >> 8, hh = (rem & 255) >> 6, d = rem & 63;
                         return g * 3072 + part * 1024 + (c * 4 + hh) * 64 + d; }
        const int z = nn - 2304; return 9216 + (c * 4 + (z >> 6)) * 64 + (z & 63);
    }
    if (n < 2560) return n;
    if (n < 3584) return n - 2560 + 2608;
    if (n < 3632) return n - 3584 + 2560;
    return -1;
}
DEV void tconv(const int tid_, float* lds, const float* __restrict__ src, int K, int Nsrc, u16* __restrict__ dst, int Ndst, int kind, int& acc_tiles) {
    const int G = gridDim.x, tid = tid_;
    const int ntn = Ndst >> 6, ntk = K >> 6, nt = ntn * ntk;
    int first = ((int)blockIdx.x - (acc_tiles % G) + G) % G;
    acc_tiles += nt;
    for (int t = first; t < nt; t += G) {
        const int tn = t / ntk, tk = t - tn * ntk;
        const int n0 = tn << 6, k0 = tk << 6;
        const int nl = tid & 63;
        const int c = colmap(kind, n0 + nl);
#pragma unroll
        for (int i = 0; i < 16; ++i) {
            const int kl = (tid >> 6) + 4 * i;
            const float v = (c >= 0) ? src[(size_t)(k0 + kl) * Nsrc + c] : 0.f;
            lds[kl * 65 + nl] = v;
        }
        __syncthreads();
        const int r = tid >> 2, kk = (tid & 3) << 4;
        unsigned o[8];
#pragma unroll
        for (int i = 0; i < 8; ++i) o[i] = pack2(lds[(kk + 2 * i) * 65 + r], lds[(kk + 2 * i + 1) * 65 + r]);
        u32x4* dp = (u32x4*)(dst + kb_off(n0 + r, k0 + kk, K));
        dp[0] = u32x4{o[0], o[1], o[2], o[3]};
        dp[1] = u32x4{o[4], o[5], o[6], o[7]};
        __syncthreads();
    }
}

DEV void phase0(const Prm& P, unsigned char* smem) {
    const int tid_ = opaque_tid();
    float* lds = (float*)smem;
    unsigned char* ws = P.ws;
    int acc = 0;
    tconv(tid_, lds, P.in[2], 1024, 10240, (u16*)(ws + OFF_WA_IN), 10240, 1, acc);
    tconv(tid_, lds, P.in[2] + (size_t)1024 * 10240, 1024, 10240, (u16*)(ws + OFF_WA_IN + SZ_WA_IN), 10240, 1, acc);
    tconv(tid_, lds, P.in[3], 1024, 1024, (u16*)(ws + OFF_WA_OUT), 1024, 0, acc);
    tconv(tid_, lds, P.in[3] + (size_t)1024 * 1024, 1024, 1024, (u16*)(ws + OFF_WA_OUT + SZ_SQ), 1024, 0, acc);
    tconv(tid_, lds, P.in[4], 1024, 2304, (u16*)(ws + OFF_WB_IN), 2304, 0, acc);
    tconv(tid_, lds, P.in[6], 1024, 1024, (u16*)(ws + OFF_WB_OUT), 1024, 0, acc);
    tconv(tid_, lds, P.in[7], 1024, 3632, (u16*)(ws + OFF_WC_IN), 3840, 2, acc);
    tconv(tid_, lds, P.in[11], 1024, 1024, (u16*)(ws + OFF_WC_OUT), 1024, 0, acc);
    for (int i = 0; i < 4; ++i) {
        tconv(tid_, lds, P.in[15] + (size_t)i * 1024 * 1024, 1024, 1024, (u16*)(ws + OFF_WG + i * SZ_SQ), 1024, 0, acc);
        tconv(tid_, lds, P.in[14] + (size_t)i * 256 * 1024, 256, 1024, (u16*)(ws + OFF_WP + i * SZ_WP), 1024, 0, acc);
    }
    tconv(tid_, lds, P.in[8], 2048, 64, (u16*)(ws + OFF_WCK), 64, 0, acc);
    tconv(tid_, lds, P.in[9], 2048, 64, (u16*)(ws + OFF_WCV), 64, 0, acc);

    const size_t gtid = (size_t)blockIdx.x * 256 + tid_, gsz = (size_t)gridDim.x * 256;
    {
        const float* x = P.in[0]; u16* xb = (u16*)(ws + OFF_XB);
        for (size_t i = gtid; i < (size_t)T * 1024 / 8; i += gsz) {
            const f32x4 a = *(const f32x4*)(x + i * 8), b = *(const f32x4*)(x + i * 8 + 4);
            *(u32x4*)(xb + kb_off((int)(i >> 7), (int)(i & 127) * 8, 1024)) = u32x4{pack2(a[0], a[1]), pack2(a[2], a[3]), pack2(b[0], b[1]), pack2(b[2], b[3])};
        }
    }
    {
        float* ct = (float*)(ws + OFF_COS); float* st = (float*)(ws + OFF_SIN);
        for (size_t i = gtid; i < (size_t)8192 * 32; i += gsz) {
            const int pos = (int)(i >> 5), k = (int)(i & 31);
            const float inv = (float)(1.0 / pow(10000.0, (double)(2 * k) / 64.0));
            const float ang = (float)pos * inv;
            ct[i] = (float)cos((double)ang); st[i] = (float)sin((double)ang);
        }
    }
    {
        const int lane = tid_ & 63;
        const int wid = blockIdx.x * 4 + __builtin_amdgcn_readfirstlane(tid_ >> 6);
        if (wid < 128) {
            const float* w = (wid < 64) ? P.in[8] : P.in[9];
            const int e = wid & 63;
            float s = 0.f;
            for (int jd = lane; jd < 2048; jd += 64) s += P.in[10][jd] * w[(size_t)jd * 64 + e];
            s = wave_sum(s);
            if (lane == 0) ((float*)(ws + OFF_BIAS))[wid] = s;
        }
    }
}

constexpr int GSTAGE = 24576;
DEV int gsw(int r) { return (0x78 >> (2 * ((r >> 2) & 3))) & 3; }
DEV void gemm_issue(unsigned char* stage, const u16* ag0, const u16* ag1, const u16* bg, int bstep, int kt, int w) {
    __builtin_amdgcn_global_load_lds((const unsigned*)(ag0 + kt * 512), (unsigned*)(stage + w * 1024), 16, 0, 0);
    __builtin_amdgcn_global_load_lds((const unsigned*)(ag1 + kt * 512), (unsigned*)(stage + w * 1024 + 4096), 16, 0, 0);
#pragma unroll
    for (int i = 0; i < 4; ++i)
        __builtin_amdgcn_global_load_lds((const unsigned*)(bg + (size_t)i * bstep + kt * 512), (unsigned*)(stage + 8192 + w * 1024 + i * 4096), 16, 0, 0);
}
template <bool NONSWAP>
DEV void gemm_mainloop(const int tid_, unsigned char* smem, const u16* __restrict__ A, int lda, const u16* __restrict__ Bt, int ldb, int K,
                       int m0, int n0, f32x4 (&acc)[32], bool aperm = false) {
    const int tid = tid_, lane = tid & 63, w = __builtin_amdgcn_readfirstlane(tid >> 6), wm = w >> 1, wn = w & 1;
    const int lrow = tid >> 2, lsw = ((tid & 3) ^ gsw(lrow)) * 8;
    const int arow0 = aperm ? ((lrow & 31) * 4 + (lrow >> 5)) : lrow;
    const int arow1 = aperm ? (arow0 + 2) : (lrow + 64);
    const u16* ag0 = A + kb_off(m0 + arow0, 0, lda) + lsw;
    const u16* ag1 = A + kb_off(m0 + arow1, 0, lda) + lsw;
    const u16* bg = Bt + kb_off(n0 + lrow, 0, ldb) + lsw;
    const int bstep = 4 * (ldb >> 5) * 512;
    const int fr = lane & 15, fq = lane >> 4;
    const int coff = (fq ^ gsw(fr)) << 4;
    const int a_base = (wm * 64 + fr) * 64 + coff, b_base = 8192 + (wn * 128 + fr) * 64 + coff;
    const int nk = K >> 5;
    asm volatile("s_waitcnt vmcnt(0)" ::: "memory");
    __builtin_amdgcn_s_barrier();
    gemm_issue(smem, ag0, ag1, bg, bstep, 0, w);
    gemm_issue(smem + GSTAGE, ag0, ag1, bg, bstep, 1, w);
    int sc = 0, si = 2;
    for (int kt = 0; kt < nk; ++kt) {
        if (kt + 1 < nk) asm volatile("s_waitcnt vmcnt(6)" ::: "memory"); else asm volatile("s_waitcnt vmcnt(0)" ::: "memory");
        __builtin_amdgcn_s_barrier();
        if (kt + 2 < nk) { gemm_issue(smem + si * GSTAGE, ag0, ag1, bg, bstep, kt + 2, w); si = (si == 2) ? 0 : si + 1; }
        const unsigned char* st = smem + sc * GSTAGE; sc = (sc == 2) ? 0 : sc + 1;
        bf16x8 a[4], b[4];
#pragma unroll
        for (int i = 0; i < 4; ++i) a[i] = *(const bf16x8*)(st + a_base + i * 1024);
#pragma unroll
        for (int hb = 0; hb < 2; ++hb) {
#pragma unroll
            for (int i = 0; i < 4; ++i) b[i] = *(const bf16x8*)(st + b_base + (hb * 4 + i) * 1024);
            if (NONSWAP) {
#pragma unroll
                for (int mt = 0; mt < 4; ++mt)
#pragma unroll
                    for (int nt = 0; nt < 4; ++nt) acc[mt * 8 + hb * 4 + nt] = MFMA16(a[mt], b[nt], acc[mt * 8 + hb * 4 + nt]);
            } else {
#pragma unroll
                for (int nt = 0; nt < 4; ++nt)
#pragma unroll
                    for (int mt = 0; mt < 4; ++mt) acc[(hb * 4 + nt) * 4 + mt] = MFMA16(b[nt], a[mt], acc[(hb * 4 + nt) * 4 + mt]);
            }
        }
    }
}

DEV int vblock() { const int G = gridDim.x, b = blockIdx.x; return ((G & 7) == 0) ? (b & 7) * (G >> 3) + (b >> 3) : b; }
DEV void tile_mn(int t, int nN, int& mi, int& ni) { const int per = 8 * nN; const int mg = t / per, r = t - mg * per; mi = mg * 8 + (r & 7); ni = r >> 3; }
#define ZERO_ACC(acc) _Pragma("unroll") for (int i_ = 0; i_ < 32; ++i_) acc[i_] = f32x4{0.f, 0.f, 0.f, 0.f}

DEV void classify(int kind, int cgi, int& mode, int& vsel, int& vth, int& dsh, int& nhv, int& ksel) {
    mode = 0; vsel = 0; vth = 0; dsh = 0; nhv = 4; ksel = -1;
    if (kind == 0) {
        if (cgi < 36) { const int g = cgi / 12, part = (cgi - g * 12) >> 2; vth = cgi & 3; if (part < 2) { mode = 1; if (part == 1) { ksel = g; dsh = 2 * g; } } else { mode = 2; vsel = g; dsh = 2 * g; } }
    } else if (kind == 1) {
        if (cgi < 16) mode = 1; else if (cgi < 18) { mode = 1; ksel = 0; vth = cgi - 16; nhv = 2; } else if (cgi < 20) { mode = 2; vsel = 0; vth = cgi - 18; nhv = 2; }
    } else {
        if (cgi < 20) mode = 1; else if (cgi < 24) mode = 0; else if (cgi < 28) { mode = 1; ksel = 0; vth = cgi - 24; } else if (cgi < 32) { mode = 2; vsel = 0; vth = cgi - 28; }
        else if (cgi < 36) { mode = 1; ksel = 1; vth = cgi - 32; } else if (cgi < 40) { mode = 2; vsel = 1; vth = cgi - 36; }
    }
}

DEV void gemm_in_phase(unsigned char* smem, const Prm& P, int kind, const u16* Wt, int N) {
    const int tid_ = opaque_tid();
    unsigned char* ws = P.ws;
    const u16* A = (const u16*)(ws + OFF_XB);
    u16* H = (u16*)(ws + OFF_H);
    const float* cosT = (const float*)(ws + OFF_COS); const float* sinT = (const float*)(ws + OFF_SIN);
    const int nN = N >> 8, ntiles = 128 * nN;
    const int lane = tid_ & 63, w = __builtin_amdgcn_readfirstlane(tid_ >> 6), wm = w >> 1, wn = w & 1, fr = lane & 15, fq = lane >> 4;
    const int G_ = gridDim.x, vb_ = vblock(), nfull_ = ntiles / G_, R_ = ntiles - nfull_ * G_;
    const int per_x = ((G_ & 7) == 0) ? (G_ >> 3) : G_, rx_ = ((G_ & 7) == 0 && (R_ & 7) == 0) ? (R_ >> 3) : 0;
    const int xs_ = vb_ / per_x, sl_ = vb_ - xs_ * per_x;
    const int tail_t = (rx_ > 0) ? ((sl_ < rx_) ? nfull_ * G_ + xs_ * rx_ + sl_ : -1) : ((vb_ < R_) ? nfull_ * G_ + vb_ : -1);
    for (int rnd_ = 0; rnd_ <= nfull_; ++rnd_) {
        const int t = (rnd_ < nfull_) ? (vb_ + rnd_ * G_) : tail_t;
        if (t < 0) break;
        int mi, ni; tile_mn(t, nN, mi, ni);
        const int m0 = mi << 7, n0 = ni << 8;
        const int ncol = n0 + wn * 128, cg0 = ncol >> 6;
        int mode, vsel, vth, dsh, nhv, ksel; classify(kind, cg0, mode, vsel, vth, dsh, nhv, ksel);
        const int mw = m0 + wm * 64;
        f32x4 acc[32]; ZERO_ACC(acc);
        if (mode == 2) {
            gemm_mainloop<true>(tid_, smem, A, 1024, Wt, 1024, 1024, m0, n0, acc, dsh == 2);
            __builtin_amdgcn_s_barrier();
            u16* vt = (u16*)(ws + (vsel == 0 ? OFF_VT0 : (vsel == 1 ? OFF_VT1 : OFF_VT2)));
            if (dsh == 0) {
#pragma unroll
                for (int mt = 0; mt < 4; ++mt) {
                    const int m = mw + mt * 16 + fq * 4;
                    const int b = m >> 13, p = m & 8191;
#pragma unroll
                    for (int grp = 0; grp < 2; ++grp) {
                        u16* dst = vt + ((((size_t)(b * nhv + vth + grp)) * 512 + (p >> 4)) * 64) * 16 + (p & 15);
#pragma unroll
                        for (int nt = 0; nt < 4; ++nt) { const f32x4 v = acc[mt * 8 + grp * 4 + nt]; *(u32x2*)(dst + (nt * 16 + fr) * 16) = u32x2{pack2(v[0], v[1]), pack2(v[2], v[3])}; }
                    }
                }
            } else if (dsh == 4) {
#pragma unroll
                for (int j = 0; j < 4; ++j) {
                    const int m = mw + fq * 4 + j;
                    const int b = m >> 13, s = m & 8191;
                    const int p = ((s & 15) << 9) + (s >> 4);
#pragma unroll
                    for (int grp = 0; grp < 2; ++grp) {
                        u16* dst = vt + ((((size_t)(b * nhv + vth + grp)) * 512 + (p >> 4)) * 64) * 16 + (p & 15);
#pragma unroll
                        for (int nt = 0; nt < 4; ++nt)
                            *(u32x2*)(dst + (nt * 16 + fr) * 16) = u32x2{pack2(acc[0 * 8 + grp * 4 + nt][j], acc[1 * 8 + grp * 4 + nt][j]), pack2(acc[2 * 8 + grp * 4 + nt][j], acc[3 * 8 + grp * 4 + nt][j])};
                    }
                }
            } else {
#pragma unroll
                for (int mt = 0; mt < 4; ++mt) {
                    const int r0 = wm * 64 + mt * 16 + fq * 4;
                    const int m = m0 + (r0 & 31) * 4 + (r0 >> 5);
                    const int b = m >> 13, s = m & 8191;
                    const int p = ((s & 3) << 11) + (s >> 2);
#pragma unroll
                    for (int grp = 0; grp < 2; ++grp) {
                        u16* dst = vt + ((((size_t)(b * nhv + vth + grp)) * 512 + (p >> 4)) * 64) * 16 + (p & 15);
#pragma unroll
                        for (int nt = 0; nt < 4; ++nt) { const f32x4 v = acc[mt * 8 + grp * 4 + nt]; *(u32x2*)(dst + (nt * 16 + fr) * 16) = u32x2{pack2(v[0], v[1]), pack2(v[2], v[3])}; }
                    }
                }
            }
        } else {
            gemm_mainloop<false>(tid_, smem, A, 1024, Wt, 1024, 1024, m0, n0, acc);
            __builtin_amdgcn_s_barrier();
            constexpr int EROW = 272;
            unsigned char* est = smem + w * (64 * EROW);
            int l4_ = lane; asm volatile("" : "+v"(l4_));
            const int fr = l4_ & 15, fq = l4_ >> 4;
#pragma unroll
            for (int mt = 0; mt < 4; ++mt) {
                const int s = (mw + mt * 16 + fr) & 8191;
                unsigned char* erow = est + (mt * 16 + fr) * EROW + fq * 8;
                if (mode == 1) {
#pragma unroll
                    for (int nt = 0; nt < 2; ++nt) {
                        const f32x4 c4 = *(const f32x4*)(cosT + s * 32 + nt * 16 + fq * 4);
                        const f32x4 s4 = *(const f32x4*)(sinT + s * 32 + nt * 16 + fq * 4);
#pragma unroll
                        for (int grp = 0; grp < 2; ++grp) {
                            const f32x4 x1 = acc[(grp * 4 + nt) * 4 + mt], x2 = acc[(grp * 4 + nt + 2) * 4 + mt];
                            const f32x4 o1 = x1 * c4 - x2 * s4, o2 = x2 * c4 + x1 * s4;
                            *(u32x2*)(erow + (grp * 64 + nt * 16) * 2) = u32x2{pack2(o1[0], o1[1]), pack2(o1[2], o1[3])};
                            *(u32x2*)(erow + (grp * 64 + (nt + 2) * 16) * 2) = u32x2{pack2(o2[0], o2[1]), pack2(o2[2], o2[3])};
                        }
                    }
                } else {
#pragma unroll
                    for (int nt = 0; nt < 8; ++nt) { const f32x4 v = acc[nt * 4 + mt]; *(u32x2*)(erow + nt * 32) = u32x2{pack2(v[0], v[1]), pack2(v[2], v[3])}; }
                }
            }
            __builtin_amdgcn_fence(__ATOMIC_RELEASE, "wavefront"); __builtin_amdgcn_wave_barrier(); __builtin_amdgcn_fence(__ATOMIC_ACQUIRE, "wavefront");
            {
                const int rr = l4_ >> 4, ch = l4_ & 15;
                if (ksel >= 0) {
                    u16* ki = (u16*)(ws + (ksel == 0 ? OFF_KI0 : (ksel == 1 ? OFF_KI1 : OFF_KI2)));
                    const int dmask = (1 << dsh) - 1, lsh = 13 - dsh, numask = (64 >> dsh) - 1;
                    const int kk = l4_ >> 2, c4 = l4_ & 3;
#pragma unroll 4
                    for (int i = 0; i < 16; ++i) {
                        const int rgp = i >> 2, hd = (i >> 1) & 1, half = i & 1;
                        const int tt = rgp * 16 + kk;
                        const int row = ((tt & numask) << dsh) + (tt >> (6 - dsh));
                        const int m = mw + row, b = m >> 13, s = m & 8191;
                        const int p = ((s & dmask) << lsh) + (s >> dsh);
                        const u32x4 v = *(const u32x4*)(est + row * EROW + (hd * 64 + half * 32 + c4 * 8) * 2);
                        *(u32x4*)(ki + ((((size_t)(b * nhv + vth + hd) * 512 + (p >> 4)) * 2 + half) * 16 + (p & 15)) * 32 + c4 * 8) = v;
                    }
                } else {
                u16* hbase = H + (size_t)mw * N + ncol + ch * 8;
#pragma unroll
                for (int i = 0; i < 16; ++i) {
                    const int row = i * 4 + rr;
                    const u32x4 v = *(const u32x4*)(est + row * EROW + ch * 16);
                    *(u32x4*)(hbase + (size_t)row * N) = v;
                }
                }
            }
        }
    }
}

DEV void gemm_out_phase(unsigned char* smem, const Prm& P, const u16* Wt, const float* xin) {
    const int tid_ = opaque_tid();
    const u16* A = (const u16*)(P.ws + OFF_G);
    const int lane = tid_ & 63, w = __builtin_amdgcn_readfirstlane(tid_ >> 6), wm = w >> 1, wn = w & 1, fr = lane & 15, fq = lane >> 4;
    for (int t = vblock(); t < 512; t += gridDim.x) {
        int mi, ni; tile_mn(t, 4, mi, ni);
        const int m0 = mi << 7, n0 = ni << 8;
        f32x4 acc[32]; ZERO_ACC(acc);
        gemm_mainloop<false>(tid_, smem, A, 1024, Wt, 1024, 1024, m0, n0, acc);
        {
            __builtin_amdgcn_s_barrier();
            constexpr int EROWF = 528;
            unsigned char* est = smem + w * (32 * EROWF);
            const size_t ub = (size_t)(m0 + wm * 64) * 1024 + n0 + wn * 128;
            const float* xw = xin + ub; float* ow = P.out + ub;
            int l2_ = lane; asm volatile("" : "+v"(l2_));
            const int fr2 = l2_ & 15, fq2 = l2_ >> 4, rr = l2_ >> 5, ch = l2_ & 31;
#pragma unroll
            for (int h = 0; h < 2; ++h) {
#pragma unroll
                for (int mh = 0; mh < 2; ++mh) {
                    unsigned char* erow = est + (mh * 16 + fr2) * EROWF + fq2 * 16;
#pragma unroll
                    for (int nt = 0; nt < 8; ++nt) *(f32x4*)(erow + nt * 64) = acc[nt * 4 + h * 2 + mh];
                }
                __builtin_amdgcn_fence(__ATOMIC_RELEASE, "wavefront"); __builtin_amdgcn_wave_barrier(); __builtin_amdgcn_fence(__ATOMIC_ACQUIRE, "wavefront");
#pragma unroll 4
                for (int i = 0; i < 16; ++i) {
                    const int row = i * 2 + rr;
                    const unsigned ix = (unsigned)((h * 32 + row) * 1024 + ch * 4);
                    const f32x4 v = *(const f32x4*)(est + row * EROWF + ch * 16);
                    const f32x4 xv = *(const f32x4*)(xw + ix);
                    *(f32x4*)(ow + ix) = xv * DN_ALPHA + v;
                }
                __builtin_amdgcn_fence(__ATOMIC_RELEASE, "wavefront"); __builtin_amdgcn_wave_barrier(); __builtin_amdgcn_fence(__ATOMIC_ACQUIRE, "wavefront");
            }
        }
    }
}

DEV void gemm_gate_phase(unsigned char* smem, const Prm& P, const u16* Wg, const u16* Wp) {
    const int tid_ = opaque_tid();
    const u16* A1 = (const u16*)(P.ws + OFF_XLB);
    const u16* A2 = (const u16*)(P.ws + OFF_PB);
    u16* xb = (u16*)(P.ws + OFF_XB);
    u16* ppb = (u16*)(P.ws + OFF_PP);
    const int lane = tid_ & 63, w = __builtin_amdgcn_readfirstlane(tid_ >> 6), wm = w >> 1, wn = w & 1, fr = lane & 15, fq = lane >> 4;
    for (int t = vblock(); t < 512; t += gridDim.x) {
        int mi, ni; tile_mn(t, 4, mi, ni);
        const int m0 = mi << 7, n0 = ni << 8;
        f32x4 acc[32]; ZERO_ACC(acc);
        gemm_mainloop<false>(tid_, smem, A2, 256, Wp, 256, 256, m0, n0, acc);
        const size_t ub = (size_t)(m0 + wm * 64) * 1024 + n0 + wn * 128;
        float* ow = P.out + ub; u16* pw = ppb + ub; u16* xw = xb + ub;
        {
            int l2_ = lane; asm volatile("" : "+v"(l2_));
            const unsigned lo = (unsigned)((l2_ & 15) * 1024 + (l2_ >> 4) * 4);
#pragma unroll
            for (int mt = 0; mt < 4; ++mt) {
#pragma unroll
                for (int nt = 0; nt < 8; ++nt) { const f32x4 v = acc[nt * 4 + mt]; *(u32x2*)(pw + (lo + mt * 16384 + nt * 16)) = u32x2{pack2(v[0], v[1]), pack2(v[2], v[3])}; }
                __builtin_amdgcn_sched_barrier(0);
            }
        }
        ZERO_ACC(acc);
        gemm_mainloop<false>(tid_, smem, A1, 1024, Wg, 1024, 1024, m0, n0, acc);
        int l3_ = lane; asm volatile("" : "+v"(l3_));
        const unsigned lo = (unsigned)((l3_ & 15) * 1024 + (l3_ >> 4) * 4);
#pragma unroll
        for (int mt = 0; mt < 4; ++mt) {
#pragma unroll
            for (int nt = 0; nt < 8; ++nt) {
                const unsigned ix = lo + mt * 16384 + nt * 16;
                const f32x4 xv = *(const f32x4*)(ow + ix);
                const u32x2 pq = *(const u32x2*)(pw + ix);
                const f32x4 ga = acc[nt * 4 + mt];
                f32x4 r;
                r[0] = xv[0] + sigmoidf_(ga[0]) * bflo(pq[0]); r[1] = xv[1] + sigmoidf_(ga[1]) * bfhi(pq[0]);
                r[2] = xv[2] + sigmoidf_(ga[2]) * bflo(pq[1]); r[3] = xv[3] + sigmoidf_(ga[3]) * bfhi(pq[1]);
                *(f32x4*)(ow + ix) = r;
                *(u32x2*)(xb + kb_off(m0 + wm * 64 + mt * 16 + (l3_ & 15), n0 + wn * 128 + nt * 16 + (l3_ >> 4) * 4, 1024)) = u32x2{pack2(r[0], r[1]), pack2(r[2], r[3])};
            }
            __builtin_amdgcn_sched_barrier(0);
        }
    }
}

DEV void ln_phase(const Prm& P, int layer) {
    const int tid_ = opaque_tid();
    const int lane = tid_ & 63, w = __builtin_amdgcn_readfirstlane(tid_ >> 6);
    const float* g = P.in[12] + layer * 1024; const float* bb = P.in[13] + layer * 1024;
    u16* xlb = (u16*)(P.ws + OFF_XLB);
    f32x4 gg[4], bv[4];
#pragma unroll
    for (int i = 0; i < 4; ++i) { gg[i] = *(const f32x4*)(g + i * 256 + lane * 4); bv[i] = *(const f32x4*)(bb + i * 256 + lane * 4); }
    for (int rb = blockIdx.x * 4 + w; rb < T / 4; rb += gridDim.x * 4) {
        float* xr = P.out + (size_t)rb * 4096;
        f32x4 v[4][4];
#pragma unroll
        for (int r = 0; r < 4; ++r)
#pragma unroll
            for (int i = 0; i < 4; ++i) v[r][i] = *(const f32x4*)(xr + r * 1024 + i * 256 + lane * 4);
#pragma unroll
        for (int r = 0; r < 4; ++r) {
            float s = 0.f;
#pragma unroll
            for (int i = 0; i < 4; ++i) s += v[r][i][0] + v[r][i][1] + v[r][i][2] + v[r][i][3];
            const float mean = wave_sum(s) * (1.f / 1024.f);
            float q = 0.f;
#pragma unroll
            for (int i = 0; i < 4; ++i)
#pragma unroll
                for (int j = 0; j < 4; ++j) { const float d = v[r][i][j] - mean; q += d * d; }
            const float rstd = rsqrtf(wave_sum(q) * (1.f / 1024.f) + LN_EPS);
            const int row = rb * 4 + r;
#pragma unroll
            for (int i = 0; i < 4; ++i) {
                f32x4 y;
#pragma unroll
                for (int j = 0; j < 4; ++j) y[j] = (v[r][i][j] - mean) * rstd * gg[i][j] + bv[i][j];
                *(f32x4*)(xr + r * 1024 + i * 256 + lane * 4) = y;
                *(u32x2*)(xlb + kb_off(row, i * 256 + lane * 4, 1024)) = u32x2{pack2(y[0], y[1]), pack2(y[2], y[3])};
            }
        }
    }
    const float* p = P.in[1] + (size_t)layer * T * 256; u16* pb = (u16*)(P.ws + OFF_PB);
    const size_t gtid = (size_t)blockIdx.x * 256 + tid_, gsz = (size_t)gridDim.x * 256;
    for (size_t i = gtid; i < (size_t)T * 256 / 8; i += gsz) {
        const f32x4 a = *(const f32x4*)(p + i * 8), b = *(const f32x4*)(p + i * 8 + 4);
        *(u32x4*)(pb + kb_off((int)(i >> 5), (int)(i & 31) * 8, 256)) = u32x4{pack2(a[0], a[1]), pack2(a[2], a[3]), pack2(b[0], b[1]), pack2(b[2], b[3])};
    }
}

struct KV { bf16x8 ka0, ka1, kb0, kb1; bf16x8 v0, v1, v2, v3; };
template <int KH = 1024>
DEV void load_kv(KV& t, const char* Kb, unsigned koa, unsigned kob, const char* Vb, unsigned voa, unsigned vob) {
    t.ka0 = *(const bf16x8*)(Kb + koa); t.ka1 = *(const bf16x8*)(Kb + koa + KH);
    t.kb0 = *(const bf16x8*)(Kb + kob); t.kb1 = *(const bf16x8*)(Kb + kob + KH);
    t.v0 = __builtin_shufflevector(*(const s16x4*)(Vb + voa), *(const s16x4*)(Vb + vob), 0, 1, 2, 3, 4, 5, 6, 7);
    t.v1 = __builtin_shufflevector(*(const s16x4*)(Vb + voa + 512), *(const s16x4*)(Vb + vob + 512), 0, 1, 2, 3, 4, 5, 6, 7);
    t.v2 = __builtin_shufflevector(*(const s16x4*)(Vb + voa + 1024), *(const s16x4*)(Vb + vob + 1024), 0, 1, 2, 3, 4, 5, 6, 7);
    t.v3 = __builtin_shufflevector(*(const s16x4*)(Vb + voa + 1536), *(const s16x4*)(Vb + vob + 1536), 0, 1, 2, 3, 4, 5, 6, 7);
}
DEV unsigned pkrtz(float a, float b) { return __builtin_bit_cast(unsigned, __builtin_amdgcn_cvt_pkrtz(a, b)); }
DEV bf16x8 pack8(const float (&p)[8]) {
    return __builtin_bit_cast(bf16x8, u32x4{pkrtz(p[0], p[1]), pkrtz(p[2], p[3]), pkrtz(p[4], p[5]), pkrtz(p[6], p[7])});
}
DEV void qk_scores(const KV& t, const bf16x8& q0, const bf16x8& q1, f32x4& sa, f32x4& sb) {
    sa = f32x4{0.f, 0.f, 0.f, 0.f}; sb = f32x4{0.f, 0.f, 0.f, 0.f};
    sa = MFMA16(t.ka0, q0, sa); sa = MFMA16(t.ka1, q1, sa);
    sb = MFMA16(t.kb0, q0, sb); sb = MFMA16(t.kb1, q1, sb);
}
constexpr float QK_C = 0.125f * 1.4426950408889634f;
using f32x2 = __attribute__((ext_vector_type(2))) float;
DEV void mask8(f32x4& sa, f32x4& sb, int d0, unsigned lim) {
#pragma unroll
    for (int j = 0; j < 4; ++j) {
        sa[j] = ((unsigned)(d0 - j) <= lim)      ? sa[j] : NEG_INF;
        sb[j] = ((unsigned)(d0 - 16 - j) <= lim) ? sb[j] : NEG_INF;
    }
}
DEV float max8(const f32x4& sa, const f32x4& sb) {
    return fmaxf(fmaxf(fmaxf(sa[0], sa[1]), fmaxf(sa[2], sa[3])), fmaxf(fmaxf(sb[0], sb[1]), fmaxf(sb[2], sb[3])));
}
DEV void lazy_rescale(float& mref, float& l, f32x4 (&o)[4], float mxr) {
    const float mxs = mxr * QK_C;
    if (__ballot(mxs > mref + 8.f) != 0ull) {
        const float mx = red16_max(mxs);
        const float mn = fmaxf(mref, mx);
        const float alpha = (mn == NEG_INF) ? 1.f : __builtin_amdgcn_exp2f(mref - mn);
        l *= alpha;
#pragma unroll
        for (int d = 0; d < 4; ++d) o[d] *= alpha;
        mref = mn;
    }
}
DEV bf16x8 exp8(const f32x4& sa, const f32x4& sb, float mu, float& l) {
    float p[8]; const float nm = -mu;
#pragma unroll
    for (int j = 0; j < 4; ++j) { p[j] = __builtin_amdgcn_exp2f(__builtin_fmaf(sa[j], QK_C, nm)); p[4 + j] = __builtin_amdgcn_exp2f(__builtin_fmaf(sb[j], QK_C, nm)); }
    l += ((p[0] + p[1]) + (p[2] + p[3])) + ((p[4] + p[5]) + (p[6] + p[7]));
    return pack8(p);
}
DEV void flash_core(float& mref, float& l, f32x4 (&o)[4], const bf16x8& q0, const bf16x8& q1, const KV& t, bool fast, int d0, unsigned lim) {
    f32x4 sa, sb; qk_scores(t, q0, q1, sa, sb);
    if (!fast) mask8(sa, sb, d0, lim);
    lazy_rescale(mref, l, o, max8(sa, sb));
    const float mu = (mref == NEG_INF) ? 0.f : mref;
    const bf16x8 pf = exp8(sa, sb, mu, l);
    o[0] = MFMA16(t.v0, pf, o[0]); o[1] = MFMA16(t.v1, pf, o[1]); o[2] = MFMA16(t.v2, pf, o[2]); o[3] = MFMA16(t.v3, pf, o[3]);
}

DEV void flash_core2(float& mref, float& l, f32x4 (&o)[4], const bf16x8& q0, const bf16x8& q1, const KV& ta, const KV& tb,
                     bool fasta, bool fastb, int d0a, int d0b, unsigned lim) {
    f32x4 sa, sb, sc, sd; qk_scores(ta, q0, q1, sa, sb); qk_scores(tb, q0, q1, sc, sd);
    if (!fasta) mask8(sa, sb, d0a, lim);
    if (!fastb) mask8(sc, sd, d0b, lim);
    lazy_rescale(mref, l, o, fmaxf(max8(sa, sb), max8(sc, sd)));
    const float mu = (mref == NEG_INF) ? 0.f : mref;
    const bf16x8 pfa = exp8(sa, sb, mu, l), pfb = exp8(sc, sd, mu, l);
    o[0] = MFMA16(ta.v0, pfa, o[0]); o[1] = MFMA16(ta.v1, pfa, o[1]); o[2] = MFMA16(ta.v2, pfa, o[2]); o[3] = MFMA16(ta.v3, pfa, o[3]);
    o[0] = MFMA16(tb.v0, pfb, o[0]); o[1] = MFMA16(tb.v1, pfb, o[1]); o[2] = MFMA16(tb.v2, pfb, o[2]); o[3] = MFMA16(tb.v3, pfb, o[3]);
}

#define RING4(NSTEPS, LOADSTEP, COMPUTE) do { \
    KV cur_; \
    for (int st_ = 0; st_ < (NSTEPS); ++st_) { LOADSTEP(cur_, st_); COMPUTE(cur_, st_); } \
    } while (0)

DEV void band_loop(const int tid_, float& m, float& l, f32x4 (&o)[4], const bf16x8& q0, const bf16x8& q1, const char* Kb,
                   const char* Vb, int vblk0, int ustart, int nsteps, int uq, int uq0, int qspan, int maxd) {
    const int c = tid_ & 15, g4 = (tid_ & 63) >> 4;
    const unsigned kl = c * 64 + g4 * 16, vl = c * 32 + g4 * 8;
    const unsigned lim = (unsigned)min(maxd, uq);
#define BL_LOAD(R, S) do { const int ua_ = ustart + (S) * 32, ub_ = ua_ + 16; \
        const unsigned ba_ = (unsigned)(vblk0 + (max(ua_, 0) >> 4)) * 2048u, bb_ = (unsigned)(vblk0 + (max(ub_, 0) >> 4)) * 2048u; \
        load_kv(R, Kb, ba_ + kl, bb_ + kl, Vb, ba_ + vl, bb_ + vl); } while (0)
#define BL_COMP(R, S) do { const int ua_ = ustart + (S) * 32; \
        const bool fast_ = (ua_ >= 0) && (ua_ + 31 <= uq0) && (uq0 + qspan - ua_ <= maxd); \
        flash_core(m, l, o, q0, q1, R, fast_, uq - ua_ - g4 * 4, lim); } while (0)
    RING4(nsteps, BL_LOAD, BL_COMP);
#undef BL_LOAD
#undef BL_COMP
}

DEV void attnA_phase(const Prm& P, int chunk) {
    const int tid_ = opaque_tid();
    unsigned char* ws = P.ws;
    const u16* H = (const u16*)(ws + OFF_H);
    u16* G = (u16*)(ws + OFF_G);
    const int lane = tid_ & 63, w = __builtin_amdgcn_readfirstlane(tid_ >> 6), c = lane & 15, g4 = lane >> 4;
    constexpr int LD = 2560;
    const int xcd_ = blockIdx.x & 7, slot_ = blockIdx.x >> 3, nslot_ = gridDim.x >> 3;
    for (int i_ = slot_; i_ < 128; i_ += nslot_) {
        const int rq = i_ & 3, tbi = i_ >> 2, hh = xcd_ & 3, b = xcd_ >> 2;
        const int r = w * 4 + rq, tb = tbi * 256;
        const int sq = tb + r + 16 * c;
        const size_t rowq = (size_t)b * 8192 + sq;
        float m = NEG_INF, l = 0.f;
        f32x4 o[4];
#pragma unroll
        for (int d = 0; d < 4; ++d) o[d] = f32x4{0.f, 0.f, 0.f, 0.f};
#pragma unroll 1
        for (int g = 0; g < 3; ++g) {
            const int dsh = 2 * g, dmask = (1 << dsh) - 1;
            const int rg = r & dmask;
            const int uq = sq >> dsh, uq0 = (tb + r) >> dsh;
            int ustart = (uq0 - 128) & ~15;
            const int ulast = (uq0 + (15 << (4 - dsh))) & ~15;
            int ntile = ((ulast - ustart) >> 4) + 1;
            if (ntile & 1) { ustart -= 16; ntile += 1; }
            const u16* Hq = H + rowq * LD + g * 768 + hh * 64 + g4 * 8;
            const bf16x8 q0 = *(const bf16x8*)Hq, q1 = *(const bf16x8*)(Hq + 32);
            const char* Kb = (const char*)((const u16*)(ws + (g == 0 ? OFF_KI0 : (g == 1 ? OFF_KI1 : OFF_KI2))) + ((size_t)(b * 4 + hh) * 512) * 1024);
            const char* Vb = (const char*)((const u16*)(ws + (g == 0 ? OFF_VT0 : (g == 1 ? OFF_VT1 : OFF_VT2))) + ((size_t)(b * 4 + hh) * 512) * 1024);
            const int vblk0 = rg * ((8192 >> dsh) >> 4);
            band_loop(tid_, m, l, o, q0, q1, Kb, Vb, vblk0, ustart, ntile >> 1, uq, uq0, 15 << (4 - dsh), 128);
        }
        l = red16_sum(l);
        const float inv = 1.f / l;
#pragma unroll
        for (int dt = 0; dt < 4; ++dt) {
            const int dh = dt * 16 + g4 * 4;
            const u32x2 z = *(const u32x2*)(H + rowq * LD + 2304 + hh * 64 + dh);
            const float r0 = o[dt][0] * inv * siluf_(bflo(z[0])), r1 = o[dt][1] * inv * siluf_(bfhi(z[0]));
            const float r2 = o[dt][2] * inv * siluf_(bflo(z[1])), r3 = o[dt][3] * inv * siluf_(bfhi(z[1]));
            *(u32x2*)(G + kb_off((int)rowq, (chunk * 4 + hh) * 64 + dh, 1024)) = u32x2{pack2(r0, r1), pack2(r2, r3)};
        }
    }
}

DEV void attnB_phase(const Prm& P) {
    const int tid_ = opaque_tid();
    unsigned char* ws = P.ws;
    const u16* H = (const u16*)(ws + OFF_H);
    u16* G = (u16*)(ws + OFF_G);
    const float* sinks = P.in[5];
    const int lane = tid_ & 63, w = __builtin_amdgcn_readfirstlane(tid_ >> 6), c = lane & 15, g4 = lane >> 4;
    constexpr int LD = 2304;
    const int xcd_ = blockIdx.x & 7, slot_ = blockIdx.x >> 3, nslot_ = gridDim.x >> 3;
    for (int tile = slot_; tile < 512; tile += nslot_) {
        const int b = xcd_ >> 2, hq = xcd_ & 3;
        const int head = hq * 4 + w, kvh = head >> 3;
        const int t0 = tile * 16, sq = t0 + c;
        const size_t rowq = (size_t)b * 8192 + sq;
        float m = NEG_INF, l = 0.f;
        f32x4 o[4];
#pragma unroll
        for (int d = 0; d < 4; ++d) o[d] = f32x4{0.f, 0.f, 0.f, 0.f};
        const u16* Hq = H + rowq * LD + head * 64 + g4 * 8;
        const bf16x8 q0 = *(const bf16x8*)Hq, q1 = *(const bf16x8*)(Hq + 32);
        const char* Kb = (const char*)((const u16*)(ws + OFF_KI0) + ((size_t)(b * 2 + kvh) * 512) * 1024);
        const char* Vb = (const char*)((const u16*)(ws + OFF_VT0) + ((size_t)(b * 2 + kvh) * 512) * 1024);
        band_loop(tid_, m, l, o, q0, q1, Kb, Vb, 0, t0 - 144, 5, sq, t0, 15, 127);
        l = red16_sum(l);
        const float mu = (m == NEG_INF) ? 0.f : m;
        const float lf = l + __builtin_amdgcn_exp2f(sinks[head] * 1.4426950408889634f - mu);
        const float inv = 1.f / lf;
#pragma unroll
        for (int dt = 0; dt < 4; ++dt) {
            const int dh = dt * 16 + g4 * 4;
            const u32x2 z = *(const u32x2*)(H + rowq * LD + 1280 + head * 64 + dh);
            const float r0 = o[dt][0] * inv * siluf_(bflo(z[0])), r1 = o[dt][1] * inv * siluf_(bfhi(z[0]));
            const float r2 = o[dt][2] * inv * siluf_(bflo(z[1])), r3 = o[dt][3] * inv * siluf_(bfhi(z[1]));
            *(u32x2*)(G + kb_off((int)rowq, head * 64 + dh, 1024)) = u32x2{pack2(r0, r1), pack2(r2, r3)};
        }
    }
}

DEV void compress_phase(const Prm& P, unsigned char* smem) {
    const int tid_ = opaque_tid();
    unsigned char* ws = P.ws;
    const u16* H = (const u16*)(ws + OFF_H);
    constexpr int LD = 3840;
    const float* bias = (const float*)(ws + OFF_BIAS);
    const int lane = tid_ & 63, w = __builtin_amdgcn_readfirstlane(tid_ >> 6), c = lane & 15, g4 = lane >> 4;
    f32x4* red = (f32x4*)smem;
    for (int unit = blockIdx.x; unit < 512; unit += gridDim.x) {
        const int which = unit >> 8, b = (unit >> 7) & 1, kvh = (unit >> 5) & 3, ntile = unit & 31;
        const u16* Wt = (const u16*)(ws + (which ? OFF_WCV : OFF_WCK));
        const int colbase = (which ? 1280 : 1024) + kvh * 64;
        const int n = ntile * 16 + c;
        const u16* Wl = Wt + c * 32 + g4 * 8;
        f32x4 acc[4];
#pragma unroll
        for (int e = 0; e < 4; ++e) acc[e] = f32x4{0.f, 0.f, 0.f, 0.f};
#pragma unroll 4
        for (int k4 = 0; k4 < 16; ++k4) {
            const int kk = w * 16 + k4;
            const int j = kk >> 1, d0 = (kk & 1) * 32 + g4 * 8;
            int s = 16 * n + j; s = min(s, 8191);
            const bf16x8 xf = *(const bf16x8*)(H + ((size_t)b * 8192 + s) * LD + colbase + d0);
            bf16x8 wf[4];
#pragma unroll
            for (int e = 0; e < 4; ++e) wf[e] = *(const bf16x8*)(Wl + (size_t)(e * 64 + kk) * 512);
            if (which == 0) {
#pragma unroll
                for (int e = 0; e < 4; ++e) acc[e] = MFMA16(wf[e], xf, acc[e]);
            } else {
#pragma unroll
                for (int e = 0; e < 4; ++e) acc[e] = MFMA16(xf, wf[e], acc[e]);
            }
        }
        __syncthreads();
#pragma unroll
        for (int e = 0; e < 4; ++e) red[(w * 4 + e) * 64 + lane] = acc[e];
        __syncthreads();
        const int e = w;
        const f32x4 r4 = (red[(0 * 4 + e) * 64 + lane] + red[(1 * 4 + e) * 64 + lane]) + (red[(2 * 4 + e) * 64 + lane] + red[(3 * 4 + e) * 64 + lane]);
        if (which == 0) {
            u16* kc = (u16*)(ws + OFF_KCMP) + ((size_t)(b * 4 + kvh) * 32 + ntile) * 1024 + c * 32;
            const int e0 = e * 16 + g4 * 4;
            const f32x4 bv = *(const f32x4*)(bias + e0);
            const f32x4 r = r4 + bv;
            *(u32x2*)(kc + (e0 >> 5) * 512 + (e0 & 31)) = u32x2{pack2(r[0], r[1]), pack2(r[2], r[3])};
        } else {
            u16* vc = (u16*)(ws + OFF_VCMP) + (((size_t)(b * 4 + kvh) * 32 + ntile) * 64) * 16;
            const int ee = e * 16 + c;
            const float bv = bias[64 + ee];
            *(u32x2*)(vc + ee * 16 + g4 * 4) = u32x2{pack2(r4[0] + bv, r4[1] + bv), pack2(r4[2] + bv, r4[3] + bv)};
        }
    }
}

DEV void attnC_phase(const Prm& P, unsigned char* smem) {
    const int tid_ = opaque_tid();
    unsigned char* ws = P.ws;
    const u16* H = (const u16*)(ws + OFF_H);
    u16* G = (u16*)(ws + OFF_G);
    constexpr int LD = 3840;
    float* imp = (float*)smem;
    float* scb = (float*)(smem + 32768);
    float* oslc = (float*)(smem + 34816);
    const int tid = tid_, lane = tid & 63, w = __builtin_amdgcn_readfirstlane(tid >> 6), c = lane & 15, g4 = lane >> 4;
    const int xcd_ = blockIdx.x & 7, slot_ = blockIdx.x >> 3, nslot_ = gridDim.x >> 3;
    unsigned* qcnt = (unsigned*)(P.ws + OFF_BAR) + 3584 + xcd_ * 16;
    volatile int* tkt = (volatile int*)(smem + 51456);
    if (tid == 0) tkt[0] = (int)xb_add(qcnt, 1u);
    for (int i = tid; i < 8192; i += 256) imp[i] = 0.f;
    __syncthreads();
    (void)slot_; (void)nslot_;
    for (int par_ = 0;; par_ ^= 1) {
        const int ticket = __builtin_amdgcn_readfirstlane(tkt[par_]);
        if (ticket >= 512) break;
        if (tid == 0) tkt[par_ ^ 1] = (int)xb_add(qcnt, 1u);
        const int tile = 511 - ticket;
        const int b = xcd_ >> 2, kvh = xcd_ & 3;
        const int t0 = tile * 16;
        const int head = kvh * 4 + w;
        const size_t rowq = (size_t)b * 8192 + t0 + c;
        const u16* Hq = H + rowq * LD + head * 64 + g4 * 8;
        const bf16x8 q0 = *(const bf16x8*)Hq, q1 = *(const bf16x8*)(Hq + 32);
        f32x4 oacc[4];
#pragma unroll
        for (int d = 0; d < 4; ++d) oacc[d] = f32x4{0.f, 0.f, 0.f, 0.f};
        const int nmax = (t0 + c - 31) >> 4;
        const int nmaxw = (t0 - 16) >> 4;
        const float g0 = sigmoidf_(bf2f(H[rowq * LD + 3584 + head]));
        const float g1 = sigmoidf_(bf2f(H[rowq * LD + 3584 + 16 + head]));
        const float g2 = sigmoidf_(bf2f(H[rowq * LD + 3584 + 32 + head]));
        if (nmaxw >= 0) {
            const int nsteps = (nmaxw >> 5) + 1;
            const char* Kb = (const char*)((const u16*)(ws + OFF_KCMP) + ((size_t)(b * 4 + kvh) * 32) * 1024);
            const char* Vb = (const char*)((const u16*)(ws + OFF_VCMP) + ((size_t)(b * 4 + kvh) * 32) * 1024);
            const unsigned kl = c * 64 + g4 * 16, vl = c * 32 + g4 * 8;
            float m = NEG_INF, l = 0.f;
#define CM_LOAD(R, S) do { const int na_ = (S) * 32; const unsigned ba_ = (unsigned)(na_ >> 4) * 2048u, bb_ = (unsigned)min((na_ >> 4) + 1, 31) * 2048u; \
        load_kv(R, Kb, ba_ + kl, bb_ + kl, Vb, ba_ + vl, bb_ + vl); } while (0)
#define CM_PASS1(R, S) do { const int na_ = (S) * 32; f32x4 sa, sb; qk_scores(R, q0, q1, sa, sb); float mx = NEG_INF; float x[8]; \
        _Pragma("unroll") for (int j = 0; j < 8; ++j) { const int n = na_ + (j >> 2) * 16 + g4 * 4 + (j & 3); \
            x[j] = (n <= nmax) ? ((j < 4) ? sa[j & 3] : sb[j & 3]) * 0.125f : NEG_INF; mx = fmaxf(mx, x[j]); } \
        const float mn = fmaxf(m, mx); const float mu = (mn == NEG_INF) ? 0.f : mn; float ps = 0.f; \
        _Pragma("unroll") for (int j = 0; j < 8; ++j) ps += __expf(x[j] - mu); \
        l = l * __expf(m - mu) + ps; m = mn; } while (0)
            RING4(nsteps, CM_LOAD, CM_PASS1);
            float mall = red16_max(m);
            mall = (mall == NEG_INF) ? 0.f : mall;
            l = l * __expf(m - mall);
            l = red16_sum(l);
            const float invl = (l > 0.f) ? 1.f / l : 0.f;
#define CM_PASS2(R, S) do { const int na_ = (S) * 32; f32x4 sa, sb; qk_scores(R, q0, q1, sa, sb); float p[8]; \
        _Pragma("unroll") for (int j = 0; j < 8; ++j) { const int n = na_ + (j >> 2) * 16 + g4 * 4 + (j & 3); \
            const float sv = ((j < 4) ? sa[j & 3] : sb[j & 3]) * 0.125f; \
            p[j] = (n <= nmax) ? __expf(sv - mall) * invl : 0.f; \
            if (n <= nmax) atomicAdd(&imp[n * 16 + c], p[j]); } \
        const bf16x8 pf = pack8(p); \
        oacc[0] = MFMA16(R.v0, pf, oacc[0]); oacc[1] = MFMA16(R.v1, pf, oacc[1]); \
        oacc[2] = MFMA16(R.v2, pf, oacc[2]); oacc[3] = MFMA16(R.v3, pf, oacc[3]); } while (0)
            RING4(nsteps, CM_LOAD, CM_PASS2);
#undef CM_LOAD
#undef CM_PASS1
#undef CM_PASS2
#pragma unroll
            for (int d = 0; d < 4; ++d) oacc[d] *= g0;
        }
        {
            float m = NEG_INF, l = 0.f;
            f32x4 o[4];
#pragma unroll
            for (int d = 0; d < 4; ++d) o[d] = f32x4{0.f, 0.f, 0.f, 0.f};
            const char* Kb = (const char*)((const u16*)(ws + OFF_KI1) + ((size_t)(b * 4 + kvh) * 512) * 1024);
            const char* Vb = (const char*)((const u16*)(ws + OFF_VT1) + ((size_t)(b * 4 + kvh) * 512) * 1024);
            band_loop(tid_, m, l, o, q0, q1, Kb, Vb, 0, t0 - 528, 17, t0 + c, t0, 15, 511);
            l = red16_sum(l);
            const float sc = g2 / l;
#pragma unroll
            for (int d = 0; d < 4; ++d) oacc[d] += o[d] * sc;
        }
        __syncthreads();
        unsigned long long* msk = (unsigned long long*)(smem + 51200) + w * 8;
#pragma unroll 1
        for (int i = 0; i < 4; ++i) {
            const int tok = 4 * w + i, tq = t0 + tok, cur = tq >> 6;
            float my0, my1;
            {
                const int j0 = lane, j1 = lane + 64;
                float a0 = 2.f * (imp[(4 * j0) * 16 + tok] + imp[(4 * j0 + 1) * 16 + tok] + imp[(4 * j0 + 2) * 16 + tok]) + imp[(4 * j0 + 3) * 16 + tok];
                if (j0 > 0) a0 += imp[(4 * j0 - 1) * 16 + tok];
                const float a1 = 2.f * (imp[(4 * j1) * 16 + tok] + imp[(4 * j1 + 1) * 16 + tok] + imp[(4 * j1 + 2) * 16 + tok]) + imp[(4 * j1 + 3) * 16 + tok]
                                 + imp[(4 * j1 - 1) * 16 + tok];
                const bool f0 = (j0 == 0) || (j0 == cur) || (j0 == cur - 1);
                const bool f1 = (j1 == cur) || (j1 == cur - 1);
                my0 = f0 ? 1e4f : ((j0 <= cur) ? a0 : -1.f);
                my1 = f1 ? 1e4f : ((j1 <= cur) ? a1 : -1.f);
            }
            const unsigned k0 = (lane <= cur) ? (__float_as_uint(my0) + 1u) : 0u;
            const unsigned k1 = (lane + 64 <= cur) ? (__float_as_uint(my1) + 1u) : 0u;
            unsigned T = 0u;
#pragma unroll
            for (int bit = 31; bit >= 0; --bit) {
                const unsigned tr = T | (1u << bit);
                const int cnt = __builtin_popcountll(__ballot(k0 >= tr)) + __builtin_popcountll(__ballot(k1 >= tr));
                if (cnt >= 16) T = tr;
            }
            const unsigned long long eq0 = __ballot(k0 == T), eq1 = __ballot(k1 == T);
            const int need = 16 - __builtin_popcountll(__ballot(k0 > T)) - __builtin_popcountll(__ballot(k1 > T));
            const unsigned long long lm = (1ull << lane) - 1ull;
            const bool s0 = (k0 > 0u) && (k0 > T || (k0 == T && __builtin_popcountll(eq0 & lm) < need));
            const bool s1 = (k1 > 0u) && (k1 > T || (k1 == T && __builtin_popcountll(eq0) + __builtin_popcountll(eq1 & lm) < need));
            const unsigned long long lo = __ballot(s0);
            const unsigned long long hi = __ballot(s1);
            if (lane == 0) { msk[i * 2] = lo; msk[i * 2 + 1] = hi; }
        }
#pragma unroll 4
        for (int i = 0; i < 32; ++i) { const int e = i * 64 + lane; imp[(e >> 2) * 16 + 4 * w + (e & 3)] = 0.f; }
        __builtin_amdgcn_fence(__ATOMIC_RELEASE, "wavefront"); __builtin_amdgcn_wave_barrier(); __builtin_amdgcn_fence(__ATOMIC_ACQUIRE, "wavefront");
        {
            const int tokL = 4 * w + (c >> 2), tq = t0 + tokL, hd = kvh * 4 + (c & 3);
            const size_t rq = (size_t)b * 8192 + tq;
            const u16* Hs = H + rq * LD + hd * 64 + g4 * 8;
            const bf16x8 s0 = *(const bf16x8*)Hs, s1 = *(const bf16x8*)(Hs + 32);
            const char* Kb = (const char*)((const u16*)(ws + OFF_KI0) + ((size_t)(b * 4 + kvh) * 512) * 1024);
            const char* Vb = (const char*)((const u16*)(ws + OFF_VT0) + ((size_t)(b * 4 + kvh) * 512) * 1024);
            const unsigned kl = c * 64 + g4 * 16, vl = c * 32 + g4 * 8;
            float m = NEG_INF, l = 0.f;
            f32x4 o[4];
#pragma unroll
            for (int d = 0; d < 4; ++d) o[d] = f32x4{0.f, 0.f, 0.f, 0.f};
            const int ti = c >> 2;
            const unsigned long long mylo = msk[ti * 2], myhi = msk[ti * 2 + 1];
            const unsigned long long ulo = msk[0] | msk[2] | msk[4] | msk[6];
            const unsigned long long uhi = msk[1] | msk[3] | msk[5] | msk[7];
            const unsigned long long alo = msk[0] & msk[2] & msk[4] & msk[6], ahi = msk[1] & msk[3] & msk[5] & msk[7];
            int* blist = (int*)(scb + w * 128);
            const int nlo = __builtin_popcountll(ulo), nblk = nlo + __builtin_popcountll(uhi);
            if ((ulo >> lane) & 1ull) blist[__builtin_popcountll(ulo & ((1ull << lane) - 1ull))] = lane;
            if ((uhi >> lane) & 1ull) blist[nlo + __builtin_popcountll(uhi & ((1ull << lane) - 1ull))] = 64 + lane;
            __builtin_amdgcn_fence(__ATOMIC_RELEASE, "wavefront");
            __builtin_amdgcn_wave_barrier();
            __builtin_amdgcn_fence(__ATOMIC_ACQUIRE, "wavefront");
#pragma unroll 1
            for (int e_ = 0; e_ < nblk; ++e_) {
                const int j_ = __builtin_amdgcn_readfirstlane(blist[e_]);
                const unsigned kb_ = (unsigned)(j_ * 4) * 2048u;
                KV ta, tb;
                load_kv(ta, Kb, kb_ + kl, kb_ + 2048u + kl, Vb, kb_ + vl, kb_ + 2048u + vl);
                load_kv(tb, Kb, kb_ + 4096u + kl, kb_ + 6144u + kl, Vb, kb_ + 4096u + vl, kb_ + 6144u + vl);
                const bool selj = (j_ < 64) ? ((mylo >> j_) & 1ull) : ((myhi >> (j_ - 64)) & 1ull);
                const bool alls_ = (j_ < 64) ? ((alo >> j_) & 1ull) : ((ahi >> (j_ - 64)) & 1ull);
                const int ua_ = j_ * 64;
                const bool fa_ = alls_ && (ua_ + 31 <= t0 + 4 * w), fb_ = alls_ && (ua_ + 63 <= t0 + 4 * w);
                const int d0_ = selj ? (tq - ua_ - g4 * 4) : -(1 << 30);
                flash_core2(m, l, o, s0, s1, ta, tb, fa_, fb_, d0_, selj ? (d0_ - 32) : -(1 << 30), 0x7fffffffu);
            }
            l = red16_sum(l);
            const float inv = 1.f / l;
#pragma unroll
            for (int dt = 0; dt < 4; ++dt)
                *(f32x4*)(oslc + (tokL * 4 + (c & 3)) * 64 + dt * 16 + g4 * 4) = o[dt] * inv;
        }
        __syncthreads();
#pragma unroll
        for (int dt = 0; dt < 4; ++dt) {
            const int dh = dt * 16 + g4 * 4;
            const f32x4 os = *(const f32x4*)(oslc + (c * 4 + w) * 64 + dh);
            const f32x4 r = oacc[dt] + os * g1;
            const u32x2 z = *(const u32x2*)(H + rowq * LD + 2560 + head * 64 + dh);
            const float r0 = r[0] * siluf_(bflo(z[0])), r1 = r[1] * siluf_(bfhi(z[0]));
            const float r2 = r[2] * siluf_(bflo(z[1])), r3 = r[3] * siluf_(bfhi(z[1]));
            *(u32x2*)(G + kb_off((int)rowq, head * 64 + dh, 1024)) = u32x2{pack2(r0, r1), pack2(r2, r3)};
        }
    }
}

#ifndef PROBE_DUP
#define PROBE_DUP 0
#endif
#define REP(k) for (int rep_ = 0; rep_ < 1 + ((PROBE_DUP >> (k)) & 1); ++rep_)
constexpr int LDS_BYTES = 3 * GSTAGE + 64;
__global__ void __launch_bounds__(256, 2) mk_fwd(Prm P) {
    extern __shared__ __attribute__((aligned(16))) unsigned char smem[];
    unsigned* xb_words = (unsigned*)(smem + 3 * GSTAGE);
    if (threadIdx.x < 4) xb_words[threadIdx.x] = 0u;
    __syncthreads();
    XcdBarrier bar = xcd_barrier_post((unsigned*)(P.ws + OFF_BAR), (volatile LAS unsigned*)xb_words);
    unsigned char* ws = P.ws;

    phase0(P, smem);
    if (P.ws == nullptr) cg::this_grid().sync();
    xcd_barrier(bar);

#pragma unroll 1
    for (int layer = 0; layer < 4; ++layer) {
        const int kind = layer % 3, lj = layer / 3;
        const u16* Win; const u16* Wout; int N, nsub;
        if (kind == 0)      { Win = (const u16*)(ws + OFF_WA_IN + (size_t)lj * SZ_WA_IN); Wout = (const u16*)(ws + OFF_WA_OUT + (size_t)lj * SZ_SQ); N = 2560; nsub = 4; }
        else if (kind == 1) { Win = (const u16*)(ws + OFF_WB_IN); Wout = (const u16*)(ws + OFF_WB_OUT); N = 2304; nsub = 1; }
        else                { Win = (const u16*)(ws + OFF_WC_IN); Wout = (const u16*)(ws + OFF_WC_OUT); N = 3840; nsub = 1; }
#pragma unroll 1
        for (int sub = 0; sub < nsub; ++sub) {
            REP(0) gemm_in_phase(smem, P, kind, Win + (size_t)sub * 2560 * 1024, N);
            xcd_barrier(bar);
            if (kind == 0) REP(1) attnA_phase(P, sub);
            else if (kind == 1) REP(2) attnB_phase(P);
            else { REP(3) compress_phase(P, smem); xcd_barrier(bar); REP(4) attnC_phase(P, smem); }
            xcd_barrier(bar);
        }
        gemm_out_phase(smem, P, Wout, layer == 0 ? P.in[0] : P.out);
        xcd_barrier(bar);
        ln_phase(P, layer);
        xcd_barrier(bar);
        gemm_gate_phase(smem, P, (const u16*)(ws + OFF_WG + (size_t)layer * SZ_SQ), (const u16*)(ws + OFF_WP + (size_t)layer * SZ_WP));
        if (layer < 3) xcd_barrier(bar);
    }
}

extern "C" void kernel_launch(void* const* d_in, const int* in_sizes, int n_in, void* d_out, int out_size, void* d_ws, size_t ws_size,
                              hipStream_t stream) {
    static int grid_blocks = 0;
    if (!grid_blocks) {
        int dev = 0, cus = 0, per_cu = 0;
        (void)hipGetDevice(&dev);
        (void)hipDeviceGetAttribute(&cus, hipDeviceAttributeMultiprocessorCount, dev);
        (void)hipFuncSetAttribute((const void*)mk_fwd, hipFuncAttributeMaxDynamicSharedMemorySize, LDS_BYTES);
        (void)hipOccupancyMaxActiveBlocksPerMultiprocessor(&per_cu, (const void*)mk_fwd, 256, LDS_BYTES);
        if (per_cu > 2) per_cu = 2;
        if (per_cu < 1) per_cu = 1;
        grid_blocks = cus * per_cu;
        if (ws_size < WS_END || n_in != 16) { fprintf(stderr, "kernel_launch: workspace too small (%zu < %zu) or n_in %d != 16\n", ws_size, (size_t)WS_END, n_in); grid_blocks = -1; }
    }
    if (grid_blocks < 0) return;
    (void)hipMemsetAsync((char*)d_ws + OFF_BAR, 0, 16384, stream);
    Prm p{};
    for (int i = 0; i < 16; ++i) p.in[i] = (const float*)d_in[i];
    p.out = (float*)d_out; p.ws = (unsigned char*)d_ws;
    void* args[] = {&p};
    hipError_t e = hipLaunchCooperativeKernel((const void*)mk_fwd, dim3(grid_blocks), dim3(256), args, LDS_BYTES, stream);
    if (e != hipSuccess) fprintf(stderr, "cooperative launch failed: %s (grid %d)\n", hipGetErrorString(e), grid_blocks);
}
```

```cpp
#include <hip/hip_runtime.h>
#include <hip/hip_cooperative_groups.h>
#include <cstdio>
#include <cstdint>
namespace cg = cooperative_groups;

typedef unsigned short u16;
using bf16x8 = __attribute__((ext_vector_type(8))) short;
using s16x4  = __attribute__((ext_vector_type(4))) short;
using f32x4  = __attribute__((ext_vector_type(4))) float;
using u32x4  = __attribute__((ext_vector_type(4))) unsigned;
using u32x2  = __attribute__((ext_vector_type(2))) unsigned;
#define DEV __device__ __forceinline__
using h16x8 = __attribute__((ext_vector_type(8))) _Float16;
#define MFMA16(a, b, c) __builtin_amdgcn_mfma_f32_16x16x32_f16(__builtin_bit_cast(h16x8, (a)), __builtin_bit_cast(h16x8, (b)), (c), 0, 0, 0)
#define LAS __attribute__((address_space(3)))

constexpr int T = 16384, S = 8192;
constexpr float LN_EPS = 1e-5f;
constexpr float DN_ALPHA = 1.6817928305074290f;
constexpr float NEG_INF = -__builtin_huge_valf();

constexpr size_t OFF_BAR   = 0;
constexpr size_t OFF_COS   = 16384;
constexpr size_t OFF_SIN   = OFF_COS + (size_t)8192 * 32 * 4;
constexpr size_t OFF_BIAS  = OFF_SIN + (size_t)8192 * 32 * 4;
constexpr size_t OFF_WA_IN = OFF_BIAS + 1024;
constexpr size_t SZ_WA_IN  = (size_t)10240 * 1024 * 2;
constexpr size_t SZ_SQ     = (size_t)1024 * 1024 * 2;
constexpr size_t OFF_WA_OUT = OFF_WA_IN + 2 * SZ_WA_IN;
constexpr size_t OFF_WB_IN  = OFF_WA_OUT + 2 * SZ_SQ;
constexpr size_t OFF_WB_OUT = OFF_WB_IN + (size_t)2304 * 1024 * 2;
constexpr size_t OFF_WC_IN  = OFF_WB_OUT + SZ_SQ;
constexpr size_t OFF_WC_OUT = OFF_WC_IN + (size_t)3840 * 1024 * 2;
constexpr size_t OFF_WG     = OFF_WC_OUT + SZ_SQ;
constexpr size_t OFF_WP     = OFF_WG + 4 * SZ_SQ;
constexpr size_t SZ_WP      = (size_t)1024 * 256 * 2;
constexpr size_t OFF_WCK    = OFF_WP + 4 * SZ_WP;
constexpr size_t OFF_WCV    = OFF_WCK + (size_t)64 * 2048 * 2;
constexpr size_t OFF_XB     = OFF_WCV + (size_t)64 * 2048 * 2;
constexpr size_t SZ_ACT     = (size_t)T * 1024 * 2;
constexpr size_t OFF_G      = OFF_XB + SZ_ACT;
constexpr size_t OFF_H      = OFF_G + SZ_ACT;
constexpr size_t SZ_HMAX    = (size_t)T * 3840 * 2;
constexpr size_t OFF_VT0    = OFF_H + SZ_HMAX;
constexpr size_t SZ_VT      = (size_t)2 * 4 * 8192 * 64 * 2;
constexpr size_t OFF_VT1    = OFF_VT0 + SZ_VT;
constexpr size_t OFF_VT2    = OFF_VT1 + SZ_VT;
constexpr size_t OFF_KCMP   = OFF_VT2 + SZ_VT;
constexpr size_t SZ_CMP     = (size_t)2 * 512 * 4 * 64 * 2;
constexpr size_t OFF_VCMP   = OFF_KCMP + SZ_CMP;
constexpr size_t OFF_KI0    = OFF_VCMP + SZ_CMP;
constexpr size_t OFF_KI1    = OFF_KI0 + SZ_VT;
constexpr size_t OFF_KI2    = OFF_KI1 + SZ_VT;
constexpr size_t WS_END     = OFF_KI2 + SZ_VT;
constexpr size_t OFF_XLB    = OFF_H;
constexpr size_t OFF_PB     = OFF_H + SZ_ACT;
constexpr size_t OFF_PP     = OFF_H + SZ_ACT + (size_t)16 * 1024 * 1024;

struct Prm { const float* in[16]; float* out; unsigned char* ws; };

__device__ __forceinline__ size_t kb_off(int row, int k, int K) { return ((size_t)(row >> 4) * (K >> 5) + (k >> 5)) * 512 + (row & 15) * 32 + (k & 31); }
DEV u16 f2bf(float f) { return __builtin_bit_cast(u16, (_Float16)f); }
DEV float bf2f(u16 h) { return (float)__builtin_bit_cast(_Float16, h); }
DEV unsigned pack2(float a, float b) { return (unsigned)f2bf(a) | ((unsigned)f2bf(b) << 16); }
DEV float bflo(unsigned u) { return bf2f((u16)(u & 0xffffu)); }
DEV float bfhi(unsigned u) { return bf2f((u16)(u >> 16)); }
DEV float sigmoidf_(float x) { return 1.f / (1.f + __expf(-x)); }
DEV float siluf_(float x) { return x / (1.f + __expf(-x)); }
DEV float red16_max(float v) { v = fmaxf(v, __shfl_xor(v, 16)); v = fmaxf(v, __shfl_xor(v, 32)); return v; }
DEV float red16_sum(float v) { v += __shfl_xor(v, 16); v += __shfl_xor(v, 32); return v; }
DEV float wave_sum(float v) { for (int o = 32; o > 0; o >>= 1) v += __shfl_xor(v, o); return v; }

DEV int opaque_tid() { int t = threadIdx.x; asm volatile("" : "+v"(t)); return t; }
#define XB_TMO      128
#define XB_XCNT(j)  (256  + 64 * (j))
#define XB_XSUB(j)  (1280 + 64 * (j))
#define XB_XGEN(j)  (2304 + 64 * (j))
#define XB_TOP      3328
#define XB_TOPGEN   3392
#define XCD_BAR_WORDS 3456
#define XB_SPIN_CAP (1u << 24)
DEV unsigned xb_ld(unsigned* p)              { return __hip_atomic_load(p, __ATOMIC_RELAXED, __HIP_MEMORY_SCOPE_AGENT); }
DEV unsigned xb_add(unsigned* p, unsigned v) { return __hip_atomic_fetch_add(p, v, __ATOMIC_RELAXED, __HIP_MEMORY_SCOPE_AGENT); }
DEV unsigned xb_xcc_id() { return (unsigned)__builtin_amdgcn_s_getreg((3 << 11) | 20) & 0xFu; }
#define XB_SPIN(cond, bar) do { unsigned _sp = 0; while (cond) { __builtin_amdgcn_s_sleep(1); \
    if ((++_sp & 255u) == 0u) { if (xb_ld(&(bar)[XB_TMO])) break; if (_sp > XB_SPIN_CAP) { atomicAdd(&(bar)[XB_TMO], 1u); break; } } } } while (0)
struct XcdBarrier { unsigned* bar; unsigned x; volatile LAS unsigned* st; };
DEV XcdBarrier xcd_barrier_post(unsigned* bar, volatile LAS unsigned* st) {
    XcdBarrier b; b.bar = bar; b.x = xb_xcc_id(); b.st = st;
    if (threadIdx.x == 0) (void)xb_add(&bar[XB_XCNT(b.x)], 1u);
    return b;
}
DEV void xcd_barrier_complete(unsigned* bar, unsigned x, unsigned& nloc, unsigned& nx) {
    const unsigned G = gridDim.x * gridDim.y * gridDim.z;
    unsigned sum, cnt, mine, sp = 0u;
    for (;;) {
        sum = 0u; cnt = 0u; mine = 0u;
#pragma unroll
        for (unsigned j = 0; j < 16; ++j) { const unsigned c = xb_ld(&bar[XB_XCNT(j)]); sum += c; cnt += (c > 0u) ? 1u : 0u; mine = (j == x) ? c : mine; }
        if (sum == G) break;
        __builtin_amdgcn_s_sleep(1);
        if ((++sp & 255u) == 0u) { if (xb_ld(&bar[XB_TMO])) break; if (sp > XB_SPIN_CAP) { atomicAdd(&bar[XB_TMO], 1u); break; } }
    }
    nloc = mine > 0u ? mine : 1u; nx = cnt > 0u ? cnt : 1u;
}
DEV void xcd_barrier(const XcdBarrier& b) {
    asm volatile("s_waitcnt vmcnt(0)" ::: "memory");
    __syncthreads();
    if (threadIdx.x == 0) {
        unsigned* bar = b.bar;
        __builtin_amdgcn_s_waitcnt(0);
        unsigned nloc = b.st[0], nx = b.st[1];
        if (nloc == 0u) { xcd_barrier_complete(bar, b.x, nloc, nx); b.st[0] = nloc; b.st[1] = nx; }
        const unsigned old = xb_add(&bar[XB_XSUB(b.x)], 1u);
        const unsigned gen = old / nloc;
        if (old + 1u == (gen + 1u) * nloc) {
            __builtin_amdgcn_fence(__ATOMIC_RELEASE, "agent");
            asm volatile("s_waitcnt vmcnt(0)" ::: "memory");
            const unsigned og = xb_add(&bar[XB_TOP], 1u);
            const unsigned tg = og / nx;
            if (og + 1u == (tg + 1u) * nx) xb_add(&bar[XB_TOPGEN], 1u);
            else XB_SPIN(xb_ld(&bar[XB_TOPGEN]) == tg, bar);
            __builtin_amdgcn_fence(__ATOMIC_ACQUIRE, "agent");
            xb_add(&bar[XB_XGEN(b.x)], 1u);
            asm volatile("s_waitcnt vmcnt(0)" ::: "memory");
        } else {
            XB_SPIN(xb_ld(&bar[XB_XGEN(b.x)]) == gen, bar);
            __builtin_amdgcn_fence(__ATOMIC_ACQUIRE, "agent");
            asm volatile("s_waitcnt vmcnt(0)" ::: "memory");
        }
    }
    __syncthreads();
}

DEV int colmap(int kind, int n) {
    if (kind == 0) return n;
    if (kind == 1) {
        const int c = n / 2560, nn = n - c * 2560;
        if (nn < 2304) { const int g = nn / 768, rem = nn - g * 768, part = rem >> 8, hh = (rem & 255) >> 6, d = rem & 63;
                         return g * 3072 + part * 1024 + (c * 4 + hh) * 64 + d; }
        const int z = nn - 2304; return 9216 + (c * 4 + (z >> 6)) * 64 + (z & 63);
    }
    if (n < 2560) return n;
    if (n < 3584) return n - 2560 + 2608;
    if (n < 3632) return n - 3584 + 2560;
    return -1;
}
DEV void tconv(const int tid_, float* lds, const float* __restrict__ src, int K, int Nsrc, u16* __restrict__ dst, int Ndst, int kind, int& acc_tiles) {
    const int G = gridDim.x, tid = tid_;
    const int ntn = Ndst >> 6, ntk = K >> 6, nt = ntn * ntk;
    int first = ((int)blockIdx.x - (acc_tiles % G) + G) % G;
    acc_tiles += nt;
    if (first >= nt) return;
    const int nl = tid & 63, kq = tid >> 6;
    float v[16];
    {
        const int tn = first / ntk, tk = first - tn * ntk;
        const int c = colmap(kind, (tn << 6) + nl);
#pragma unroll
        for (int i = 0; i < 16; ++i) v[i] = (c >= 0) ? src[(size_t)((tk << 6) + kq + 4 * i) * Nsrc + c] : 0.f;
    }
    for (int t = first; t < nt; t += G) {
        const int tn = t / ntk, tk = t - tn * ntk;
        const int n0 = tn << 6, k0 = tk << 6;
        const int t2 = (t + G < nt) ? t + G : t;
        const int tn2 = t2 / ntk, tk2 = t2 - tn2 * ntk;
        const int c2 = colmap(kind, (tn2 << 6) + nl);
        float vn[16];
#pragma unroll
        for (int i = 0; i < 16; ++i) vn[i] = (c2 >= 0) ? src[(size_t)((tk2 << 6) + kq + 4 * i) * Nsrc + c2] : 0.f;
#pragma unroll
        for (int i = 0; i < 16; ++i) lds[(kq + 4 * i) * 65 + nl] = v[i];
        __syncthreads();
        const int r = tid >> 2, kk = (tid & 3) << 4;
        unsigned o[8];
#pragma unroll
        for (int i = 0; i < 8; ++i) o[i] = pack2(lds[(kk + 2 * i) * 65 + r], lds[(kk + 2 * i + 1) * 65 + r]);
        u32x4* dp = (u32x4*)(dst + kb_off(n0 + r, k0 + kk, K));
        dp[0] = u32x4{o[0], o[1], o[2], o[3]};
        dp[1] = u32x4{o[4], o[5], o[6], o[7]};
        __syncthreads();
#pragma unroll
        for (int i = 0; i < 16; ++i) v[i] = vn[i];
    }
}

DEV void phase0(const Prm& P, unsigned char* smem) {
    const int tid_ = opaque_tid();
    float* lds = (float*)smem;
    unsigned char* ws = P.ws;
    int acc = 0;
    tconv(tid_, lds, P.in[2], 1024, 10240, (u16*)(ws + OFF_WA_IN), 10240, 1, acc);
    tconv(tid_, lds, P.in[2] + (size_t)1024 * 10240, 1024, 10240, (u16*)(ws + OFF_WA_IN + SZ_WA_IN), 10240, 1, acc);
    tconv(tid_, lds, P.in[3], 1024, 1024, (u16*)(ws + OFF_WA_OUT), 1024, 0, acc);
    tconv(tid_, lds, P.in[3] + (size_t)1024 * 1024, 1024, 1024, (u16*)(ws + OFF_WA_OUT + SZ_SQ), 1024, 0, acc);
    tconv(tid_, lds, P.in[4], 1024, 2304, (u16*)(ws + OFF_WB_IN), 2304, 0, acc);
    tconv(tid_, lds, P.in[6], 1024, 1024, (u16*)(ws + OFF_WB_OUT), 1024, 0, acc);
    tconv(tid_, lds, P.in[7], 1024, 3632, (u16*)(ws + OFF_WC_IN), 3840, 2, acc);
    tconv(tid_, lds, P.in[11], 1024, 1024, (u16*)(ws + OFF_WC_OUT), 1024, 0, acc);
    for (int i = 0; i < 4; ++i) {
        tconv(tid_, lds, P.in[15] + (size_t)i * 1024 * 1024, 1024, 1024, (u16*)(ws + OFF_WG + i * SZ_SQ), 1024, 0, acc);
        tconv(tid_, lds, P.in[14] + (size_t)i * 256 * 1024, 256, 1024, (u16*)(ws + OFF_WP + i * SZ_WP), 1024, 0, acc);
    }
    tconv(tid_, lds, P.in[8], 2048, 64, (u16*)(ws + OFF_WCK), 64, 0, acc);
    tconv(tid_, lds, P.in[9], 2048, 64, (u16*)(ws + OFF_WCV), 64, 0, acc);

    const size_t gtid = (size_t)blockIdx.x * 256 + tid_, gsz = (size_t)gridDim.x * 256;
    {
        const float* x = P.in[0]; u16* xb = (u16*)(ws + OFF_XB);
        for (size_t i = gtid; i < (size_t)T * 1024 / 8; i += gsz) {
            const f32x4 a = *(const f32x4*)(x + i * 8), b = *(const f32x4*)(x + i * 8 + 4);
            *(u32x4*)(xb + kb_off((int)(i >> 7), (int)(i & 127) * 8, 1024)) = u32x4{pack2(a[0], a[1]), pack2(a[2], a[3]), pack2(b[0], b[1]), pack2(b[2], b[3])};
        }
    }
    {
        float* ct = (float*)(ws + OFF_COS); float* st = (float*)(ws + OFF_SIN);
        for (size_t i = gtid; i < (size_t)8192 * 32; i += gsz) {
            const int pos = (int)(i >> 5), k = (int)(i & 31);
            const float inv = (float)(1.0 / pow(10000.0, (double)(2 * k) / 64.0));
            const float ang = (float)pos * inv;
            ct[i] = (float)cos((double)ang); st[i] = (float)sin((double)ang);
        }
    }
    {
        const int lane = tid_ & 63;
        const int wid = blockIdx.x * 4 + __builtin_amdgcn_readfirstlane(tid_ >> 6);
        if (wid < 128) {
            const float* w = (wid < 64) ? P.in[8] : P.in[9];
            const int e = wid & 63;
            float s = 0.f;
            for (int jd = lane; jd < 2048; jd += 64) s += P.in[10][jd] * w[(size_t)jd * 64 + e];
            s = wave_sum(s);
            if (lane == 0) ((float*)(ws + OFF_BIAS))[wid] = s;
        }
    }
}

constexpr int GSTAGE = 24576;
DEV int gsw(int r) { return (0x78 >> (2 * ((r >> 2) & 3))) & 3; }
DEV void gemm_issue(unsigned char* stage, const u16* ag0, const u16* ag1, const u16* bg, int bstep, int kt, int w) {
    __builtin_amdgcn_global_load_lds((const unsigned*)(ag0 + kt * 512), (unsigned*)(stage + w * 1024), 16, 0, 0);
    __builtin_amdgcn_global_load_lds((const unsigned*)(ag1 + kt * 512), (unsigned*)(stage + w * 1024 + 4096), 16, 0, 0);
#pragma unroll
    for (int i = 0; i < 4; ++i)
        __builtin_amdgcn_global_load_lds((const unsigned*)(bg + (size_t)i * bstep + kt * 512), (unsigned*)(stage + 8192 + w * 1024 + i * 4096), 16, 0, 0);
}
template <bool NONSWAP>
DEV void gemm_mainloop(const int tid_, unsigned char* smem, const u16* __restrict__ A, int lda, const u16* __restrict__ Bt, int ldb, int K,
                       int m0, int n0, f32x4 (&acc)[32], bool aperm = false) {
    const int tid = tid_, lane = tid & 63, w = __builtin_amdgcn_readfirstlane(tid >> 6), wm = w >> 1, wn = w & 1;
    const int lrow = tid >> 2, lsw = ((tid & 3) ^ gsw(lrow)) * 8;
    const int arow0 = aperm ? ((lrow & 31) * 4 + (lrow >> 5)) : lrow;
    const int arow1 = aperm ? (arow0 + 2) : (lrow + 64);
    const u16* ag0 = A + kb_off(m0 + arow0, 0, lda) + lsw;
    const u16* ag1 = A + kb_off(m0 + arow1, 0, lda) + lsw;
    const u16* bg = Bt + kb_off(n0 + lrow, 0, ldb) + lsw;
    const int bstep = 4 * (ldb >> 5) * 512;
    const int fr = lane & 15, fq = lane >> 4;
    const int coff = (fq ^ gsw(fr)) << 4;
    const int a_base = (wm * 64 + fr) * 64 + coff, b_base = 8192 + (wn * 128 + fr) * 64 + coff;
    const int nk = K >> 5;
    asm volatile("s_waitcnt vmcnt(0)" ::: "memory");
    __builtin_amdgcn_s_barrier();
    gemm_issue(smem, ag0, ag1, bg, bstep, 0, w);
    gemm_issue(smem + GSTAGE, ag0, ag1, bg, bstep, 1, w);
    int sc = 0, si = 2;
    for (int kt = 0; kt < nk; ++kt) {
        if (kt + 1 < nk) asm volatile("s_waitcnt vmcnt(6)" ::: "memory"); else asm volatile("s_waitcnt vmcnt(0)" ::: "memory");
        __builtin_amdgcn_s_barrier();
        if (kt + 2 < nk) { gemm_issue(smem + si * GSTAGE, ag0, ag1, bg, bstep, kt + 2, w); si = (si == 2) ? 0 : si + 1; }
        const unsigned char* st = smem + sc * GSTAGE; sc = (sc == 2) ? 0 : sc + 1;
        bf16x8 a[4], b[4];
#pragma unroll
        for (int i = 0; i < 4; ++i) a[i] = *(const bf16x8*)(st + a_base + i * 1024);
#pragma unroll
        for (int hb = 0; hb < 2; ++hb) {
#pragma unroll
            for (int i = 0; i < 4; ++i) b[i] = *(const bf16x8*)(st + b_base + (hb * 4 + i) * 1024);
            if (NONSWAP) {
#pragma unroll
                for (int mt = 0; mt < 4; ++mt)
#pragma unroll
                    for (int nt = 0; nt < 4; ++nt) acc[mt * 8 + hb * 4 + nt] = MFMA16(a[mt], b[nt], acc[mt * 8 + hb * 4 + nt]);
            } else {
#pragma unroll
                for (int nt = 0; nt < 4; ++nt)
#pragma unroll
                    for (int mt = 0; mt < 4; ++mt) acc[(hb * 4 + nt) * 4 + mt] = MFMA16(b[nt], a[mt], acc[(hb * 4 + nt) * 4 + mt]);
            }
        }
    }
}

DEV int vblock() { const int G = gridDim.x, b = blockIdx.x; return ((G & 7) == 0) ? (b & 7) * (G >> 3) + (b >> 3) : b; }
DEV void tile_mn(int t, int nN, int& mi, int& ni) { const int per = 8 * nN; const int mg = t / per, r = t - mg * per; mi = mg * 8 + (r & 7); ni = r >> 3; }
#define ZERO_ACC(acc) _Pragma("unroll") for (int i_ = 0; i_ < 32; ++i_) acc[i_] = f32x4{0.f, 0.f, 0.f, 0.f}

DEV void classify(int kind, int cgi, int& mode, int& vsel, int& vth, int& dsh, int& nhv, int& ksel) {
    mode = 0; vsel = 0; vth = 0; dsh = 0; nhv = 4; ksel = -1;
    if (kind == 0) {
        if (cgi < 36) { const int g = cgi / 12, part = (cgi - g * 12) >> 2; vth = cgi & 3; if (part < 2) { mode = 1; if (part == 1) { ksel = g; dsh = 2 * g; } } else { mode = 2; vsel = g; dsh = 2 * g; } }
    } else if (kind == 1) {
        if (cgi < 16) mode = 1; else if (cgi < 18) { mode = 1; ksel = 0; vth = cgi - 16; nhv = 2; } else if (cgi < 20) { mode = 2; vsel = 0; vth = cgi - 18; nhv = 2; }
    } else {
        if (cgi < 20) mode = 1; else if (cgi < 24) mode = 0; else if (cgi < 28) { mode = 1; ksel = 0; vth = cgi - 24; } else if (cgi < 32) { mode = 2; vsel = 0; vth = cgi - 28; }
        else if (cgi < 36) { mode = 1; ksel = 1; vth = cgi - 32; } else if (cgi < 40) { mode = 2; vsel = 1; vth = cgi - 36; }
    }
}

DEV void gemm_in_phase(unsigned char* smem, const Prm& P, int kind, const u16* Wt, int N) {
    const int tid_ = opaque_tid();
    unsigned char* ws = P.ws;
    const u16* A = (const u16*)(ws + OFF_XB);
    u16* H = (u16*)(ws + OFF_H);
    const float* cosT = (const float*)(ws + OFF_COS); const float* sinT = (const float*)(ws + OFF_SIN);
    const int nN = N >> 8, ntiles = 128 * nN;
    const int lane = tid_ & 63, w = __builtin_amdgcn_readfirstlane(tid_ >> 6), wm = w >> 1, wn = w & 1, fr = lane & 15, fq = lane >> 4;
    const int G_ = gridDim.x, vb_ = vblock(), nfull_ = ntiles / G_, R_ = ntiles - nfull_ * G_;
    const int per_x = ((G_ & 7) == 0) ? (G_ >> 3) : G_, rx_ = ((G_ & 7) == 0 && (R_ & 7) == 0) ? (R_ >> 3) : 0;
    const int xs_ = vb_ / per_x, sl_ = vb_ - xs_ * per_x;
    const int tail_t = (rx_ > 0) ? ((sl_ < rx_) ? nfull_ * G_ + xs_ * rx_ + sl_ : -1) : ((vb_ < R_) ? nfull_ * G_ + vb_ : -1);
    for (int rnd_ = 0; rnd_ <= nfull_; ++rnd_) {
        const int t = (rnd_ < nfull_) ? (vb_ + rnd_ * G_) : tail_t;
        if (t < 0) break;
        int mi, ni; tile_mn(t, nN, mi, ni);
        const int m0 = mi << 7, n0 = ni << 8;
        const int ncol = n0 + wn * 128, cg0 = ncol >> 6;
        int mode, vsel, vth, dsh, nhv, ksel; classify(kind, cg0, mode, vsel, vth, dsh, nhv, ksel);
        const int mw = m0 + wm * 64;
        f32x4 acc[32]; ZERO_ACC(acc);
        if (mode == 2) {
            gemm_mainloop<true>(tid_, smem, A, 1024, Wt, 1024, 1024, m0, n0, acc, dsh == 2);
            __builtin_amdgcn_s_barrier();
            u16* vt = (u16*)(ws + (vsel == 0 ? OFF_VT0 : (vsel == 1 ? OFF_VT1 : OFF_VT2)));
            if (dsh == 0) {
#pragma unroll
                for (int mt = 0; mt < 4; ++mt) {
                    const int m = mw + mt * 16 + fq * 4;
                    const int b = m >> 13, p = m & 8191;
#pragma unroll
                    for (int grp = 0; grp < 2; ++grp) {
                        u16* dst = vt + ((((size_t)(b * nhv + vth + grp)) * 512 + (p >> 4)) * 64) * 16 + (p & 15);
#pragma unroll
                        for (int nt = 0; nt < 4; ++nt) { const f32x4 v = acc[mt * 8 + grp * 4 + nt]; *(u32x2*)(dst + (nt * 16 + fr) * 16) = u32x2{pack2(v[0], v[1]), pack2(v[2], v[3])}; }
                    }
                }
            } else if (dsh == 4) {
#pragma unroll
                for (int j = 0; j < 4; ++j) {
                    const int m = mw + fq * 4 + j;
                    const int b = m >> 13, s = m & 8191;
                    const int p = ((s & 15) << 9) + (s >> 4);
#pragma unroll
                    for (int grp = 0; grp < 2; ++grp) {
                        u16* dst = vt + ((((size_t)(b * nhv + vth + grp)) * 512 + (p >> 4)) * 64) * 16 + (p & 15);
#pragma unroll
                        for (int nt = 0; nt < 4; ++nt)
                            *(u32x2*)(dst + (nt * 16 + fr) * 16) = u32x2{pack2(acc[0 * 8 + grp * 4 + nt][j], acc[1 * 8 + grp * 4 + nt][j]), pack2(acc[2 * 8 + grp * 4 + nt][j], acc[3 * 8 + grp * 4 + nt][j])};
                    }
                }
            } else {
#pragma unroll
                for (int mt = 0; mt < 4; ++mt) {
                    const int r0 = wm * 64 + mt * 16 + fq * 4;
                    const int m = m0 + (r0 & 31) * 4 + (r0 >> 5);
                    const int b = m >> 13, s = m & 8191;
                    const int p = ((s & 3) << 11) + (s >> 2);
#pragma unroll
                    for (int grp = 0; grp < 2; ++grp) {
                        u16* dst = vt + ((((size_t)(b * nhv + vth + grp)) * 512 + (p >> 4)) * 64) * 16 + (p & 15);
#pragma unroll
                        for (int nt = 0; nt < 4; ++nt) { const f32x4 v = acc[mt * 8 + grp * 4 + nt]; *(u32x2*)(dst + (nt * 16 + fr) * 16) = u32x2{pack2(v[0], v[1]), pack2(v[2], v[3])}; }
                    }
                }
            }
        } else {
            gemm_mainloop<false>(tid_, smem, A, 1024, Wt, 1024, 1024, m0, n0, acc);
            __builtin_amdgcn_s_barrier();
            constexpr int EROW = 272;
            unsigned char* est = smem + w * (64 * EROW);
            int l4_ = lane; asm volatile("" : "+v"(l4_));
            const int fr = l4_ & 15, fq = l4_ >> 4;
#pragma unroll
            for (int mt = 0; mt < 4; ++mt) {
                const int s = (mw + mt * 16 + fr) & 8191;
                unsigned char* erow = est + (mt * 16 + fr) * EROW + fq * 8;
                if (mode == 1) {
#pragma unroll
                    for (int nt = 0; nt < 2; ++nt) {
                        const f32x4 c4 = *(const f32x4*)(cosT + s * 32 + nt * 16 + fq * 4);
                        const f32x4 s4 = *(const f32x4*)(sinT + s * 32 + nt * 16 + fq * 4);
#pragma unroll
                        for (int grp = 0; grp < 2; ++grp) {
                            const f32x4 x1 = acc[(grp * 4 + nt) * 4 + mt], x2 = acc[(grp * 4 + nt + 2) * 4 + mt];
                            const f32x4 o1 = x1 * c4 - x2 * s4, o2 = x2 * c4 + x1 * s4;
                            *(u32x2*)(erow + (grp * 64 + nt * 16) * 2) = u32x2{pack2(o1[0], o1[1]), pack2(o1[2], o1[3])};
                            *(u32x2*)(erow + (grp * 64 + (nt + 2) * 16) * 2) = u32x2{pack2(o2[0], o2[1]), pack2(o2[2], o2[3])};
                        }
                    }
                } else {
#pragma unroll
                    for (int nt = 0; nt < 8; ++nt) { const f32x4 v = acc[nt * 4 + mt]; *(u32x2*)(erow + nt * 32) = u32x2{pack2(v[0], v[1]), pack2(v[2], v[3])}; }
                }
            }
            __builtin_amdgcn_fence(__ATOMIC_RELEASE, "wavefront"); __builtin_amdgcn_wave_barrier(); __builtin_amdgcn_fence(__ATOMIC_ACQUIRE, "wavefront");
            {
                const int rr = l4_ >> 4, ch = l4_ & 15;
                if (ksel >= 0) {
                    u16* ki = (u16*)(ws + (ksel == 0 ? OFF_KI0 : (ksel == 1 ? OFF_KI1 : OFF_KI2)));
                    const int dmask = (1 << dsh) - 1, lsh = 13 - dsh, numask = (64 >> dsh) - 1;
                    const int kk = l4_ >> 2, c4 = l4_ & 3;
#pragma unroll 4
                    for (int i = 0; i < 16; ++i) {
                        const int rgp = i >> 2, hd = (i >> 1) & 1, half = i & 1;
                        const int tt = rgp * 16 + kk;
                        const int row = ((tt & numask) << dsh) + (tt >> (6 - dsh));
                        const int m = mw + row, b = m >> 13, s = m & 8191;
                        const int p = ((s & dmask) << lsh) + (s >> dsh);
                        const u32x4 v = *(const u32x4*)(est + row * EROW + (hd * 64 + half * 32 + c4 * 8) * 2);
                        *(u32x4*)(ki + ((((size_t)(b * nhv + vth + hd) * 512 + (p >> 4)) * 2 + half) * 16 + (p & 15)) * 32 + c4 * 8) = v;
                    }
                } else {
                u16* hbase = H + (size_t)mw * N + ncol + ch * 8;
#pragma unroll
                for (int i = 0; i < 16; ++i) {
                    const int row = i * 4 + rr;
                    const u32x4 v = *(const u32x4*)(est + row * EROW + ch * 16);
                    *(u32x4*)(hbase + (size_t)row * N) = v;
                }
                }
            }
        }
    }
}

DEV void gemm_out_phase(unsigned char* smem, const Prm& P, const u16* Wt, const float* xin) {
    const int tid_ = opaque_tid();
    const u16* A = (const u16*)(P.ws + OFF_G);
    const int lane = tid_ & 63, w = __builtin_amdgcn_readfirstlane(tid_ >> 6), wm = w >> 1, wn = w & 1, fr = lane & 15, fq = lane >> 4;
    for (int t = vblock(); t < 512; t += gridDim.x) {
        int mi, ni; tile_mn(t, 4, mi, ni);
        const int m0 = mi << 7, n0 = ni << 8;
        f32x4 acc[32]; ZERO_ACC(acc);
        gemm_mainloop<false>(tid_, smem, A, 1024, Wt, 1024, 1024, m0, n0, acc);
        {
            __builtin_amdgcn_s_barrier();
            constexpr int EROWF = 528;
            unsigned char* est = smem + w * (32 * EROWF);
            const size_t ub = (size_t)(m0 + wm * 64) * 1024 + n0 + wn * 128;
            const float* xw = xin + ub; float* ow = P.out + ub;
            int l2_ = lane; asm volatile("" : "+v"(l2_));
            const int fr2 = l2_ & 15, fq2 = l2_ >> 4, rr = l2_ >> 5, ch = l2_ & 31;
#pragma unroll
            for (int h = 0; h < 2; ++h) {
#pragma unroll
                for (int mh = 0; mh < 2; ++mh) {
                    unsigned char* erow = est + (mh * 16 + fr2) * EROWF + fq2 * 16;
#pragma unroll
                    for (int nt = 0; nt < 8; ++nt) *(f32x4*)(erow + nt * 64) = acc[nt * 4 + h * 2 + mh];
                }
                __builtin_amdgcn_fence(__ATOMIC_RELEASE, "wavefront"); __builtin_amdgcn_wave_barrier(); __builtin_amdgcn_fence(__ATOMIC_ACQUIRE, "wavefront");
#pragma unroll 4
                for (int i = 0; i < 16; ++i) {
                    const int row = i * 2 + rr;
                    const unsigned ix = (unsigned)((h * 32 + row) * 1024 + ch * 4);
                    const f32x4 v = *(const f32x4*)(est + row * EROWF + ch * 16);
                    const f32x4 xv = *(const f32x4*)(xw + ix);
                    *(f32x4*)(ow + ix) = xv * DN_ALPHA + v;
                }
                __builtin_amdgcn_fence(__ATOMIC_RELEASE, "wavefront"); __builtin_amdgcn_wave_barrier(); __builtin_amdgcn_fence(__ATOMIC_ACQUIRE, "wavefront");
            }
        }
    }
}

DEV void gemm_gate_phase(unsigned char* smem, const Prm& P, const u16* Wg, const u16* Wp) {
    const int tid_ = opaque_tid();
    const u16* A1 = (const u16*)(P.ws + OFF_XLB);
    const u16* A2 = (const u16*)(P.ws + OFF_PB);
    u16* xb = (u16*)(P.ws + OFF_XB);
    u16* ppb = (u16*)(P.ws + OFF_PP);
    const int lane = tid_ & 63, w = __builtin_amdgcn_readfirstlane(tid_ >> 6), wm = w >> 1, wn = w & 1, fr = lane & 15, fq = lane >> 4;
    for (int t = vblock(); t < 512; t += gridDim.x) {
        int mi, ni; tile_mn(t, 4, mi, ni);
        const int m0 = mi << 7, n0 = ni << 8;
        f32x4 acc[32]; ZERO_ACC(acc);
        gemm_mainloop<false>(tid_, smem, A2, 256, Wp, 256, 256, m0, n0, acc);
        const size_t ub = (size_t)(m0 + wm * 64) * 1024 + n0 + wn * 128;
        float* ow = P.out + ub; u16* pw = ppb + ub; u16* xw = xb + ub;
        {
            int l2_ = lane; asm volatile("" : "+v"(l2_));
            const unsigned lo = (unsigned)((l2_ & 15) * 1024 + (l2_ >> 4) * 4);
#pragma unroll
            for (int mt = 0; mt < 4; ++mt) {
#pragma unroll
                for (int nt = 0; nt < 8; ++nt) { const f32x4 v = acc[nt * 4 + mt]; *(u32x2*)(pw + (lo + mt * 16384 + nt * 16)) = u32x2{pack2(v[0], v[1]), pack2(v[2], v[3])}; }
                __builtin_amdgcn_sched_barrier(0);
            }
        }
        ZERO_ACC(acc);
        gemm_mainloop<false>(tid_, smem, A1, 1024, Wg, 1024, 1024, m0, n0, acc);
        int l3_ = lane; asm volatile("" : "+v"(l3_));
        const unsigned lo = (unsigned)((l3_ & 15) * 1024 + (l3_ >> 4) * 4);
#pragma unroll
        for (int mt = 0; mt < 4; ++mt) {
#pragma unroll
            for (int nt = 0; nt < 8; ++nt) {
                const unsigned ix = lo + mt * 16384 + nt * 16;
                const f32x4 xv = *(const f32x4*)(ow + ix);
                const u32x2 pq = *(const u32x2*)(pw + ix);
                const f32x4 ga = acc[nt * 4 + mt];
                f32x4 r;
                r[0] = xv[0] + sigmoidf_(ga[0]) * bflo(pq[0]); r[1] = xv[1] + sigmoidf_(ga[1]) * bfhi(pq[0]);
                r[2] = xv[2] + sigmoidf_(ga[2]) * bflo(pq[1]); r[3] = xv[3] + sigmoidf_(ga[3]) * bfhi(pq[1]);
                *(f32x4*)(ow + ix) = r;
                *(u32x2*)(xb + kb_off(m0 + wm * 64 + mt * 16 + (l3_ & 15), n0 + wn * 128 + nt * 16 + (l3_ >> 4) * 4, 1024)) = u32x2{pack2(r[0], r[1]), pack2(r[2], r[3])};
            }
            __builtin_amdgcn_sched_barrier(0);
        }
    }
}

DEV void ln_phase(const Prm& P, int layer) {
    const int tid_ = opaque_tid();
    const int lane = tid_ & 63, w = __builtin_amdgcn_readfirstlane(tid_ >> 6);
    const float* g = P.in[12] + layer * 1024; const float* bb = P.in[13] + layer * 1024;
    u16* xlb = (u16*)(P.ws + OFF_XLB);
    f32x4 gg[4], bv[4];
#pragma unroll
    for (int i = 0; i < 4; ++i) { gg[i] = *(const f32x4*)(g + i * 256 + lane * 4); bv[i] = *(const f32x4*)(bb + i * 256 + lane * 4); }
    for (int rb = blockIdx.x * 4 + w; rb < T / 4; rb += gridDim.x * 4) {
        float* xr = P.out + (size_t)rb * 4096;
        f32x4 v[4][4];
#pragma unroll
        for (int r = 0; r < 4; ++r)
#pragma unroll
            for (int i = 0; i < 4; ++i) v[r][i] = *(const f32x4*)(xr + r * 1024 + i * 256 + lane * 4);
#pragma unroll
        for (int r = 0; r < 4; ++r) {
            float s = 0.f;
#pragma unroll
            for (int i = 0; i < 4; ++i) s += v[r][i][0] + v[r][i][1] + v[r][i][2] + v[r][i][3];
            const float mean = wave_sum(s) * (1.f / 1024.f);
            float q = 0.f;
#pragma unroll
            for (int i = 0; i < 4; ++i)
#pragma unroll
                for (int j = 0; j < 4; ++j) { const float d = v[r][i][j] - mean; q += d * d; }
            const float rstd = rsqrtf(wave_sum(q) * (1.f / 1024.f) + LN_EPS);
            const int row = rb * 4 + r;
#pragma unroll
            for (int i = 0; i < 4; ++i) {
                f32x4 y;
#pragma unroll
                for (int j = 0; j < 4; ++j) y[j] = (v[r][i][j] - mean) * rstd * gg[i][j] + bv[i][j];
                *(f32x4*)(xr + r * 1024 + i * 256 + lane * 4) = y;
                *(u32x2*)(xlb + kb_off(row, i * 256 + lane * 4, 1024)) = u32x2{pack2(y[0], y[1]), pack2(y[2], y[3])};
            }
        }
    }
    const float* p = P.in[1] + (size_t)layer * T * 256; u16* pb = (u16*)(P.ws + OFF_PB);
    const size_t gtid = (size_t)blockIdx.x * 256 + tid_, gsz = (size_t)gridDim.x * 256;
    for (size_t i = gtid; i < (size_t)T * 256 / 8; i += gsz) {
        const f32x4 a = *(const f32x4*)(p + i * 8), b = *(const f32x4*)(p + i * 8 + 4);
        *(u32x4*)(pb + kb_off((int)(i >> 5), (int)(i & 31) * 8, 256)) = u32x4{pack2(a[0], a[1]), pack2(a[2], a[3]), pack2(b[0], b[1]), pack2(b[2], b[3])};
    }
}

struct KV { bf16x8 ka0, ka1, kb0, kb1; bf16x8 v0, v1, v2, v3; };
template <int KH = 1024>
DEV void load_kv(KV& t, const char* Kb, unsigned koa, unsigned kob, const char* Vb, unsigned voa, unsigned vob) {
    t.ka0 = *(const bf16x8*)(Kb + koa); t.ka1 = *(const bf16x8*)(Kb + koa + KH);
    t.kb0 = *(const bf16x8*)(Kb + kob); t.kb1 = *(const bf16x8*)(Kb + kob + KH);
    t.v0 = __builtin_shufflevector(*(const s16x4*)(Vb + voa), *(const s16x4*)(Vb + vob), 0, 1, 2, 3, 4, 5, 6, 7);
    t.v1 = __builtin_shufflevector(*(const s16x4*)(Vb + voa + 512), *(const s16x4*)(Vb + vob + 512), 0, 1, 2, 3, 4, 5, 6, 7);
    t.v2 = __builtin_shufflevector(*(const s16x4*)(Vb + voa + 1024), *(const s16x4*)(Vb + vob + 1024), 0, 1, 2, 3, 4, 5, 6, 7);
    t.v3 = __builtin_shufflevector(*(const s16x4*)(Vb + voa + 1536), *(const s16x4*)(Vb + vob + 1536), 0, 1, 2, 3, 4, 5, 6, 7);
}
DEV unsigned pkrtz(float a, float b) { return __builtin_bit_cast(unsigned, __builtin_amdgcn_cvt_pkrtz(a, b)); }
DEV bf16x8 pack8(const float (&p)[8]) {
    return __builtin_bit_cast(bf16x8, u32x4{pkrtz(p[0], p[1]), pkrtz(p[2], p[3]), pkrtz(p[4], p[5]), pkrtz(p[6], p[7])});
}
DEV void qk_scores(const KV& t, const bf16x8& q0, const bf16x8& q1, f32x4& sa, f32x4& sb) {
    sa = f32x4{0.f, 0.f, 0.f, 0.f}; sb = f32x4{0.f, 0.f, 0.f, 0.f};
    sa = MFMA16(t.ka0, q0, sa); sa = MFMA16(t.ka1, q1, sa);
    sb = MFMA16(t.kb0, q0, sb); sb = MFMA16(t.kb1, q1, sb);
}
constexpr float QK_C = 0.125f * 1.4426950408889634f;
using f32x2 = __attribute__((ext_vector_type(2))) float;
DEV void mask8(f32x4& sa, f32x4& sb, int d0, unsigned lim) {
#pragma unroll
    for (int j = 0; j < 4; ++j) {
        sa[j] = ((unsigned)(d0 - j) <= lim)      ? sa[j] : NEG_INF;
        sb[j] = ((unsigned)(d0 - 16 - j) <= lim) ? sb[j] : NEG_INF;
    }
}
DEV float max8(const f32x4& sa, const f32x4& sb) {
    return fmaxf(fmaxf(fmaxf(sa[0], sa[1]), fmaxf(sa[2], sa[3])), fmaxf(fmaxf(sb[0], sb[1]), fmaxf(sb[2], sb[3])));
}
DEV void lazy_rescale(float& mref, float& l, f32x4 (&o)[4], float mxr) {
    const float mxs = mxr * QK_C;
    if (__ballot(mxs > mref + 8.f) != 0ull) {
        const float mx = red16_max(mxs);
        const float mn = fmaxf(mref, mx);
        const float alpha = (mn == NEG_INF) ? 1.f : __builtin_amdgcn_exp2f(mref - mn);
        l *= alpha;
#pragma unroll
        for (int d = 0; d < 4; ++d) o[d] *= alpha;
        mref = mn;
    }
}
DEV bf16x8 exp8(const f32x4& sa, const f32x4& sb, float mu, float& l) {
    float p[8]; const float nm = -mu;
#pragma unroll
    for (int j = 0; j < 4; ++j) { p[j] = __builtin_amdgcn_exp2f(__builtin_fmaf(sa[j], QK_C, nm)); p[4 + j] = __builtin_amdgcn_exp2f(__builtin_fmaf(sb[j], QK_C, nm)); }
    l += ((p[0] + p[1]) + (p[2] + p[3])) + ((p[4] + p[5]) + (p[6] + p[7]));
    return pack8(p);
}
DEV void flash_core(float& mref, float& l, f32x4 (&o)[4], const bf16x8& q0, const bf16x8& q1, const KV& t, bool fast, int d0, unsigned lim) {
    f32x4 sa, sb; qk_scores(t, q0, q1, sa, sb);
    if (!fast) mask8(sa, sb, d0, lim);
    lazy_rescale(mref, l, o, max8(sa, sb));
    const float mu = (mref == NEG_INF) ? 0.f : mref;
    const bf16x8 pf = exp8(sa, sb, mu, l);
    o[0] = MFMA16(t.v0, pf, o[0]); o[1] = MFMA16(t.v1, pf, o[1]); o[2] = MFMA16(t.v2, pf, o[2]); o[3] = MFMA16(t.v3, pf, o[3]);
}

DEV void flash_core2(float& mref, float& l, f32x4 (&o)[4], const bf16x8& q0, const bf16x8& q1, const KV& ta, const KV& tb,
                     bool fasta, bool fastb, int d0a, int d0b, unsigned lim) {
    f32x4 sa, sb, sc, sd; qk_scores(ta, q0, q1, sa, sb); qk_scores(tb, q0, q1, sc, sd);
    if (!fasta) mask8(sa, sb, d0a, lim);
    if (!fastb) mask8(sc, sd, d0b, lim);
    lazy_rescale(mref, l, o, fmaxf(max8(sa, sb), max8(sc, sd)));
    const float mu = (mref == NEG_INF) ? 0.f : mref;
    const bf16x8 pfa = exp8(sa, sb, mu, l), pfb = exp8(sc, sd, mu, l);
    o[0] = MFMA16(ta.v0, pfa, o[0]); o[1] = MFMA16(ta.v1, pfa, o[1]); o[2] = MFMA16(ta.v2, pfa, o[2]); o[3] = MFMA16(ta.v3, pfa, o[3]);
    o[0] = MFMA16(tb.v0, pfb, o[0]); o[1] = MFMA16(tb.v1, pfb, o[1]); o[2] = MFMA16(tb.v2, pfb, o[2]); o[3] = MFMA16(tb.v3, pfb, o[3]);
}

#define RING4(NSTEPS, LOADSTEP, COMPUTE) do { \
    KV cur_; \
    for (int st_ = 0; st_ < (NSTEPS); ++st_) { LOADSTEP(cur_, st_); COMPUTE(cur_, st_); } \
    } while (0)

DEV void band_loop(const int tid_, float& m, float& l, f32x4 (&o)[4], const bf16x8& q0, const bf16x8& q1, const char* Kb,
                   const char* Vb, int vblk0, int ustart, int nsteps, int uq, int uq0, int qspan, int maxd) {
    const int c = tid_ & 15, g4 = (tid_ & 63) >> 4;
    const unsigned kl = c * 64 + g4 * 16, vl = c * 32 + g4 * 8;
    const unsigned lim = (unsigned)min(maxd, uq);
#define BL_LOAD(R, S) do { const int ua_ = ustart + (S) * 32, ub_ = ua_ + 16; \
        const unsigned ba_ = (unsigned)(vblk0 + (max(ua_, 0) >> 4)) * 2048u, bb_ = (unsigned)(vblk0 + (max(ub_, 0) >> 4)) * 2048u; \
        load_kv(R, Kb, ba_ + kl, bb_ + kl, Vb, ba_ + vl, bb_ + vl); } while (0)
#define BL_COMP(R, S) do { const int ua_ = ustart + (S) * 32; \
        const bool fast_ = (ua_ >= 0) && (ua_ + 31 <= uq0) && (uq0 + qspan - ua_ <= maxd); \
        flash_core(m, l, o, q0, q1, R, fast_, uq - ua_ - g4 * 4, lim); } while (0)
    RING4(nsteps, BL_LOAD, BL_COMP);
#undef BL_LOAD
#undef BL_COMP
}

DEV void attnA_phase(const Prm& P, int chunk) {
    const int tid_ = opaque_tid();
    unsigned char* ws = P.ws;
    const u16* H = (const u16*)(ws + OFF_H);
    u16* G = (u16*)(ws + OFF_G);
    const int lane = tid_ & 63, w = __builtin_amdgcn_readfirstlane(tid_ >> 6), c = lane & 15, g4 = lane >> 4;
    constexpr int LD = 2560;
    const int xcd_ = blockIdx.x & 7, slot_ = blockIdx.x >> 3, nslot_ = gridDim.x >> 3;
    for (int i_ = slot_; i_ < 128; i_ += nslot_) {
        const int rq = i_ & 3, tbi = i_ >> 2, hh = xcd_ & 3, b = xcd_ >> 2;
        const int r = w * 4 + rq, tb = tbi * 256;
        const int sq = tb + r + 16 * c;
        const size_t rowq = (size_t)b * 8192 + sq;
        float m = NEG_INF, l = 0.f;
        f32x4 o[4];
#pragma unroll
        for (int d = 0; d < 4; ++d) o[d] = f32x4{0.f, 0.f, 0.f, 0.f};
#pragma unroll 1
        for (int g = 0; g < 3; ++g) {
            const int dsh = 2 * g, dmask = (1 << dsh) - 1;
            const int rg = r & dmask;
            const int uq = sq >> dsh, uq0 = (tb + r) >> dsh;
            int ustart = (uq0 - 128) & ~15;
            const int ulast = (uq0 + (15 << (4 - dsh))) & ~15;
            int ntile = ((ulast - ustart) >> 4) + 1;
            if (ntile & 1) { ustart -= 16; ntile += 1; }
            const u16* Hq = H + rowq * LD + g * 768 + hh * 64 + g4 * 8;
            const bf16x8 q0 = *(const bf16x8*)Hq, q1 = *(const bf16x8*)(Hq + 32);
            const char* Kb = (const char*)((const u16*)(ws + (g == 0 ? OFF_KI0 : (g == 1 ? OFF_KI1 : OFF_KI2))) + ((size_t)(b * 4 + hh) * 512) * 1024);
            const char* Vb = (const char*)((const u16*)(ws + (g == 0 ? OFF_VT0 : (g == 1 ? OFF_VT1 : OFF_VT2))) + ((size_t)(b * 4 + hh) * 512) * 1024);
            const int vblk0 = rg * ((8192 >> dsh) >> 4);
            band_loop(tid_, m, l, o, q0, q1, Kb, Vb, vblk0, ustart, ntile >> 1, uq, uq0, 15 << (4 - dsh), 128);
        }
        l = red16_sum(l);
        const float inv = 1.f / l;
#pragma unroll
        for (int dt = 0; dt < 4; ++dt) {
            const int dh = dt * 16 + g4 * 4;
            const u32x2 z = *(const u32x2*)(H + rowq * LD + 2304 + hh * 64 + dh);
            const float r0 = o[dt][0] * inv * siluf_(bflo(z[0])), r1 = o[dt][1] * inv * siluf_(bfhi(z[0]));
            const float r2 = o[dt][2] * inv * siluf_(bflo(z[1])), r3 = o[dt][3] * inv * siluf_(bfhi(z[1]));
            *(u32x2*)(G + kb_off((int)rowq, (chunk * 4 + hh) * 64 + dh, 1024)) = u32x2{pack2(r0, r1), pack2(r2, r3)};
        }
    }
}

DEV void attnB_phase(const Prm& P) {
    const int tid_ = opaque_tid();
    unsigned char* ws = P.ws;
    const u16* H = (const u16*)(ws + OFF_H);
    u16* G = (u16*)(ws + OFF_G);
    const float* sinks = P.in[5];
    const int lane = tid_ & 63, w = __builtin_amdgcn_readfirstlane(tid_ >> 6), c = lane & 15, g4 = lane >> 4;
    constexpr int LD = 2304;
    const int xcd_ = blockIdx.x & 7, slot_ = blockIdx.x >> 3, nslot_ = gridDim.x >> 3;
    for (int tile = slot_; tile < 512; tile += nslot_) {
        const int b = xcd_ >> 2, hq = xcd_ & 3;
        const int head = hq * 4 + w, kvh = head >> 3;
        const int t0 = tile * 16, sq = t0 + c;
        const size_t rowq = (size_t)b * 8192 + sq;
        float m = NEG_INF, l = 0.f;
        f32x4 o[4];
#pragma unroll
        for (int d = 0; d < 4; ++d) o[d] = f32x4{0.f, 0.f, 0.f, 0.f};
        const u16* Hq = H + rowq * LD + head * 64 + g4 * 8;
        const bf16x8 q0 = *(const bf16x8*)Hq, q1 = *(const bf16x8*)(Hq + 32);
        const char* Kb = (const char*)((const u16*)(ws + OFF_KI0) + ((size_t)(b * 2 + kvh) * 512) * 1024);
        const char* Vb = (const char*)((const u16*)(ws + OFF_VT0) + ((size_t)(b * 2 + kvh) * 512) * 1024);
        band_loop(tid_, m, l, o, q0, q1, Kb, Vb, 0, t0 - 144, 5, sq, t0, 15, 127);
        l = red16_sum(l);
        const float mu = (m == NEG_INF) ? 0.f : m;
        const float lf = l + __builtin_amdgcn_exp2f(sinks[head] * 1.4426950408889634f - mu);
        const float inv = 1.f / lf;
#pragma unroll
        for (int dt = 0; dt < 4; ++dt) {
            const int dh = dt * 16 + g4 * 4;
            const u32x2 z = *(const u32x2*)(H + rowq * LD + 1280 + head * 64 + dh);
            const float r0 = o[dt][0] * inv * siluf_(bflo(z[0])), r1 = o[dt][1] * inv * siluf_(bfhi(z[0]));
            const float r2 = o[dt][2] * inv * siluf_(bflo(z[1])), r3 = o[dt][3] * inv * siluf_(bfhi(z[1]));
            *(u32x2*)(G + kb_off((int)rowq, head * 64 + dh, 1024)) = u32x2{pack2(r0, r1), pack2(r2, r3)};
        }
    }
}

DEV void compress_phase(const Prm& P, unsigned char* smem) {
    const int tid_ = opaque_tid();
    unsigned char* ws = P.ws;
    const u16* H = (const u16*)(ws + OFF_H);
    constexpr int LD = 3840;
    const float* bias = (const float*)(ws + OFF_BIAS);
    const int lane = tid_ & 63, w = __builtin_amdgcn_readfirstlane(tid_ >> 6), c = lane & 15, g4 = lane >> 4;
    f32x4* red = (f32x4*)smem;
    for (int unit = blockIdx.x; unit < 512; unit += gridDim.x) {
        const int which = unit >> 8, b = (unit >> 7) & 1, kvh = (unit >> 5) & 3, ntile = unit & 31;
        const u16* Wt = (const u16*)(ws + (which ? OFF_WCV : OFF_WCK));
        const int colbase = (which ? 1280 : 1024) + kvh * 64;
        const int n = ntile * 16 + c;
        const u16* Wl = Wt + c * 32 + g4 * 8;
        f32x4 acc[4];
#pragma unroll
        for (int e = 0; e < 4; ++e) acc[e] = f32x4{0.f, 0.f, 0.f, 0.f};
#pragma unroll 4
        for (int k4 = 0; k4 < 16; ++k4) {
            const int kk = w * 16 + k4;
            const int j = kk >> 1, d0 = (kk & 1) * 32 + g4 * 8;
            int s = 16 * n + j; s = min(s, 8191);
            const bf16x8 xf = *(const bf16x8*)(H + ((size_t)b * 8192 + s) * LD + colbase + d0);
            bf16x8 wf[4];
#pragma unroll
            for (int e = 0; e < 4; ++e) wf[e] = *(const bf16x8*)(Wl + (size_t)(e * 64 + kk) * 512);
            if (which == 0) {
#pragma unroll
                for (int e = 0; e < 4; ++e) acc[e] = MFMA16(wf[e], xf, acc[e]);
            } else {
#pragma unroll
                for (int e = 0; e < 4; ++e) acc[e] = MFMA16(xf, wf[e], acc[e]);
            }
        }
        __syncthreads();
#pragma unroll
        for (int e = 0; e < 4; ++e) red[(w * 4 + e) * 64 + lane] = acc[e];
        __syncthreads();
        const int e = w;
        const f32x4 r4 = (red[(0 * 4 + e) * 64 + lane] + red[(1 * 4 + e) * 64 + lane]) + (red[(2 * 4 + e) * 64 + lane] + red[(3 * 4 + e) * 64 + lane]);
        if (which == 0) {
            u16* kc = (u16*)(ws + OFF_KCMP) + ((size_t)(b * 4 + kvh) * 32 + ntile) * 1024 + c * 32;
            const int e0 = e * 16 + g4 * 4;
            const f32x4 bv = *(const f32x4*)(bias + e0);
            const f32x4 r = r4 + bv;
            *(u32x2*)(kc + (e0 >> 5) * 512 + (e0 & 31)) = u32x2{pack2(r[0], r[1]), pack2(r[2], r[3])};
        } else {
            u16* vc = (u16*)(ws + OFF_VCMP) + (((size_t)(b * 4 + kvh) * 32 + ntile) * 64) * 16;
            const int ee = e * 16 + c;
            const float bv = bias[64 + ee];
            *(u32x2*)(vc + ee * 16 + g4 * 4) = u32x2{pack2(r4[0] + bv, r4[1] + bv), pack2(r4[2] + bv, r4[3] + bv)};
        }
    }
}

DEV void attnC_phase(const Prm& P, unsigned char* smem) {
    const int tid_ = opaque_tid();
    unsigned char* ws = P.ws;
    const u16* H = (const u16*)(ws + OFF_H);
    u16* G = (u16*)(ws + OFF_G);
    constexpr int LD = 3840;
    float* imp = (float*)smem;
    float* scb = (float*)(smem + 32768);
    float* oslc = (float*)(smem + 34816);
    const int tid = tid_, lane = tid & 63, w = __builtin_amdgcn_readfirstlane(tid >> 6), c = lane & 15, g4 = lane >> 4;
    const int xcd_ = blockIdx.x & 7, slot_ = blockIdx.x >> 3, nslot_ = gridDim.x >> 3;
    unsigned* qcnt = (unsigned*)(P.ws + OFF_BAR) + 3584 + xcd_ * 16;
    volatile int* tkt = (volatile int*)(smem + 51456);
    if (tid == 0) tkt[0] = (int)xb_add(qcnt, 1u);
    for (int i = tid; i < 8192; i += 256) imp[i] = 0.f;
    __syncthreads();
    (void)slot_; (void)nslot_;
    for (int par_ = 0;; par_ ^= 1) {
        const int ticket = __builtin_amdgcn_readfirstlane(tkt[par_]);
        if (ticket >= 512) break;
        if (tid == 0) tkt[par_ ^ 1] = (int)xb_add(qcnt, 1u);
        const int tile = 511 - ticket;
        const int b = xcd_ >> 2, kvh = xcd_ & 3;
        const int t0 = tile * 16;
        const int head = kvh * 4 + w;
        const size_t rowq = (size_t)b * 8192 + t0 + c;
        const u16* Hq = H + rowq * LD + head * 64 + g4 * 8;
        const bf16x8 q0 = *(const bf16x8*)Hq, q1 = *(const bf16x8*)(Hq + 32);
        f32x4 oacc[4];
#pragma unroll
        for (int d = 0; d < 4; ++d) oacc[d] = f32x4{0.f, 0.f, 0.f, 0.f};
        const int nmax = (t0 + c - 31) >> 4;
        const int nmaxw = (t0 - 16) >> 4;
        const float g0 = sigmoidf_(bf2f(H[rowq * LD + 3584 + head]));
        const float g1 = sigmoidf_(bf2f(H[rowq * LD + 3584 + 16 + head]));
        const float g2 = sigmoidf_(bf2f(H[rowq * LD + 3584 + 32 + head]));
        if (nmaxw >= 0) {
            const int nsteps = (nmaxw >> 5) + 1;
            const char* Kb = (const char*)((const u16*)(ws + OFF_KCMP) + ((size_t)(b * 4 + kvh) * 32) * 1024);
            const char* Vb = (const char*)((const u16*)(ws + OFF_VCMP) + ((size_t)(b * 4 + kvh) * 32) * 1024);
            const unsigned kl = c * 64 + g4 * 16, vl = c * 32 + g4 * 8;
            float m = NEG_INF, l = 0.f;
#define CM_LOAD(R, S) do { const int na_ = (S) * 32; const unsigned ba_ = (unsigned)(na_ >> 4) * 2048u, bb_ = (unsigned)min((na_ >> 4) + 1, 31) * 2048u; \
        load_kv(R, Kb, ba_ + kl, bb_ + kl, Vb, ba_ + vl, bb_ + vl); } while (0)
#define CM_PASS1(R, S) do { const int na_ = (S) * 32; f32x4 sa, sb; qk_scores(R, q0, q1, sa, sb); float mx = NEG_INF; float x[8]; \
        _Pragma("unroll") for (int j = 0; j < 8; ++j) { const int n = na_ + (j >> 2) * 16 + g4 * 4 + (j & 3); \
            x[j] = (n <= nmax) ? ((j < 4) ? sa[j & 3] : sb[j & 3]) * 0.125f : NEG_INF; mx = fmaxf(mx, x[j]); } \
        const float mn = fmaxf(m, mx); const float mu = (mn == NEG_INF) ? 0.f : mn; float ps = 0.f; \
        _Pragma("unroll") for (int j = 0; j < 8; ++j) ps += __expf(x[j] - mu); \
        l = l * __expf(m - mu) + ps; m = mn; } while (0)
            RING4(nsteps, CM_LOAD, CM_PASS1);
            float mall = red16_max(m);
            mall = (mall == NEG_INF) ? 0.f : mall;
            l = l * __expf(m - mall);
            l = red16_sum(l);
            const float invl = (l > 0.f) ? 1.f / l : 0.f;
#define CM_PASS2(R, S) do { const int na_ = (S) * 32; f32x4 sa, sb; qk_scores(R, q0, q1, sa, sb); float p[8]; \
        _Pragma("unroll") for (int j = 0; j < 8; ++j) { const int n = na_ + (j >> 2) * 16 + g4 * 4 + (j & 3); \
            const float sv = ((j < 4) ? sa[j & 3] : sb[j & 3]) * 0.125f; \
            p[j] = (n <= nmax) ? __expf(sv - mall) * invl : 0.f; \
            if (n <= nmax) atomicAdd(&imp[n * 16 + c], p[j]); } \
        const bf16x8 pf = pack8(p); \
        oacc[0] = MFMA16(R.v0, pf, oacc[0]); oacc[1] = MFMA16(R.v1, pf, oacc[1]); \
        oacc[2] = MFMA16(R.v2, pf, oacc[2]); oacc[3] = MFMA16(R.v3, pf, oacc[3]); } while (0)
            RING4(nsteps, CM_LOAD, CM_PASS2);
#undef CM_LOAD
#undef CM_PASS1
#undef CM_PASS2
#pragma unroll
            for (int d = 0; d < 4; ++d) oacc[d] *= g0;
        }
        {
            float m = NEG_INF, l = 0.f;
            f32x4 o[4];
#pragma unroll
            for (int d = 0; d < 4; ++d) o[d] = f32x4{0.f, 0.f, 0.f, 0.f};
            const char* Kb = (const char*)((const u16*)(ws + OFF_KI1) + ((size_t)(b * 4 + kvh) * 512) * 1024);
            const char* Vb = (const char*)((const u16*)(ws + OFF_VT1) + ((size_t)(b * 4 + kvh) * 512) * 1024);
            band_loop(tid_, m, l, o, q0, q1, Kb, Vb, 0, t0 - 528, 17, t0 + c, t0, 15, 511);
            l = red16_sum(l);
            const float sc = g2 / l;
#pragma unroll
            for (int d = 0; d < 4; ++d) oacc[d] += o[d] * sc;
        }
        __syncthreads();
        unsigned long long* msk = (unsigned long long*)(smem + 51200) + w * 8;
#pragma unroll 1
        for (int i = 0; i < 4; ++i) {
            const int tok = 4 * w + i, tq = t0 + tok, cur = tq >> 6;
            float my0, my1;
            {
                const int j0 = lane, j1 = lane + 64;
                float a0 = 2.f * (imp[(4 * j0) * 16 + tok] + imp[(4 * j0 + 1) * 16 + tok] + imp[(4 * j0 + 2) * 16 + tok]) + imp[(4 * j0 + 3) * 16 + tok];
                if (j0 > 0) a0 += imp[(4 * j0 - 1) * 16 + tok];
                const float a1 = 2.f * (imp[(4 * j1) * 16 + tok] + imp[(4 * j1 + 1) * 16 + tok] + imp[(4 * j1 + 2) * 16 + tok]) + imp[(4 * j1 + 3) * 16 + tok]
                                 + imp[(4 * j1 - 1) * 16 + tok];
                const bool f0 = (j0 == 0) || (j0 == cur) || (j0 == cur - 1);
                const bool f1 = (j1 == cur) || (j1 == cur - 1);
                my0 = f0 ? 1e4f : ((j0 <= cur) ? a0 : -1.f);
                my1 = f1 ? 1e4f : ((j1 <= cur) ? a1 : -1.f);
            }
            const unsigned k0 = (lane <= cur) ? (__float_as_uint(my0) + 1u) : 0u;
            const unsigned k1 = (lane + 64 <= cur) ? (__float_as_uint(my1) + 1u) : 0u;
            unsigned T = 0u;
#pragma unroll
            for (int bit = 31; bit >= 0; --bit) {
                const unsigned tr = T | (1u << bit);
                const int cnt = __builtin_popcountll(__ballot(k0 >= tr)) + __builtin_popcountll(__ballot(k1 >= tr));
                if (cnt >= 16) T = tr;
            }
            const unsigned long long eq0 = __ballot(k0 == T), eq1 = __ballot(k1 == T);
            const int need = 16 - __builtin_popcountll(__ballot(k0 > T)) - __builtin_popcountll(__ballot(k1 > T));
            const unsigned long long lm = (1ull << lane) - 1ull;
            const bool s0 = (k0 > 0u) && (k0 > T || (k0 == T && __builtin_popcountll(eq0 & lm) < need));
            const bool s1 = (k1 > 0u) && (k1 > T || (k1 == T && __builtin_popcountll(eq0) + __builtin_popcountll(eq1 & lm) < need));
            const unsigned long long lo = __ballot(s0);
            const unsigned long long hi = __ballot(s1);
            if (lane == 0) { msk[i * 2] = lo; msk[i * 2 + 1] = hi; }
        }
#pragma unroll 4
        for (int i = 0; i < 32; ++i) { const int e = i * 64 + lane; imp[(e >> 2) * 16 + 4 * w + (e & 3)] = 0.f; }
        __builtin_amdgcn_fence(__ATOMIC_RELEASE, "wavefront"); __builtin_amdgcn_wave_barrier(); __builtin_amdgcn_fence(__ATOMIC_ACQUIRE, "wavefront");
        {
            const int tokL = 4 * w + (c >> 2), tq = t0 + tokL, hd = kvh * 4 + (c & 3);
            const size_t rq = (size_t)b * 8192 + tq;
            const u16* Hs = H + rq * LD + hd * 64 + g4 * 8;
            const bf16x8 s0 = *(const bf16x8*)Hs, s1 = *(const bf16x8*)(Hs + 32);
            const char* Kb = (const char*)((const u16*)(ws + OFF_KI0) + ((size_t)(b * 4 + kvh) * 512) * 1024);
            const char* Vb = (const char*)((const u16*)(ws + OFF_VT0) + ((size_t)(b * 4 + kvh) * 512) * 1024);
            const unsigned kl = c * 64 + g4 * 16, vl = c * 32 + g4 * 8;
            float m = NEG_INF, l = 0.f;
            f32x4 o[4];
#pragma unroll
            for (int d = 0; d < 4; ++d) o[d] = f32x4{0.f, 0.f, 0.f, 0.f};
            const int ti = c >> 2;
            const unsigned long long mylo = msk[ti * 2], myhi = msk[ti * 2 + 1];
            const unsigned long long ulo = msk[0] | msk[2] | msk[4] | msk[6];
            const unsigned long long uhi = msk[1] | msk[3] | msk[5] | msk[7];
            const unsigned long long alo = msk[0] & msk[2] & msk[4] & msk[6], ahi = msk[1] & msk[3] & msk[5] & msk[7];
            int* blist = (int*)(scb + w * 128);
            const int nlo = __builtin_popcountll(ulo), nblk = nlo + __builtin_popcountll(uhi);
            if ((ulo >> lane) & 1ull) blist[__builtin_popcountll(ulo & ((1ull << lane) - 1ull))] = lane;
            if ((uhi >> lane) & 1ull) blist[nlo + __builtin_popcountll(uhi & ((1ull << lane) - 1ull))] = 64 + lane;
            __builtin_amdgcn_fence(__ATOMIC_RELEASE, "wavefront");
            __builtin_amdgcn_wave_barrier();
            __builtin_amdgcn_fence(__ATOMIC_ACQUIRE, "wavefront");
#pragma unroll 1
            for (int e_ = 0; e_ < nblk; ++e_) {
                const int j_ = __builtin_amdgcn_readfirstlane(blist[e_]);
                const unsigned kb_ = (unsigned)(j_ * 4) * 2048u;
                KV ta, tb;
                load_kv(ta, Kb, kb_ + kl, kb_ + 2048u + kl, Vb, kb_ + vl, kb_ + 2048u + vl);
                load_kv(tb, Kb, kb_ + 4096u + kl, kb_ + 6144u + kl, Vb, kb_ + 4096u + vl, kb_ + 6144u + vl);
                const bool selj = (j_ < 64) ? ((mylo >> j_) & 1ull) : ((myhi >> (j_ - 64)) & 1ull);
                const bool alls_ = (j_ < 64) ? ((alo >> j_) & 1ull) : ((ahi >> (j_ - 64)) & 1ull);
                const int ua_ = j_ * 64;
                const bool fa_ = alls_ && (ua_ + 31 <= t0 + 4 * w), fb_ = alls_ && (ua_ + 63 <= t0 + 4 * w);
                const int d0_ = selj ? (tq - ua_ - g4 * 4) : -(1 << 30);
                flash_core2(m, l, o, s0, s1, ta, tb, fa_, fb_, d0_, selj ? (d0_ - 32) : -(1 << 30), 0x7fffffffu);
            }
            l = red16_sum(l);
            const float inv = 1.f / l;
#pragma unroll
            for (int dt = 0; dt < 4; ++dt)
                *(f32x4*)(oslc + (tokL * 4 + (c & 3)) * 64 + dt * 16 + g4 * 4) = o[dt] * inv;
        }
        __syncthreads();
#pragma unroll
        for (int dt = 0; dt < 4; ++dt) {
            const int dh = dt * 16 + g4 * 4;
            const f32x4 os = *(const f32x4*)(oslc + (c * 4 + w) * 64 + dh);
            const f32x4 r = oacc[dt] + os * g1;
            const u32x2 z = *(const u32x2*)(H + rowq * LD + 2560 + head * 64 + dh);
            const float r0 = r[0] * siluf_(bflo(z[0])), r1 = r[1] * siluf_(bfhi(z[0]));
            const float r2 = r[2] * siluf_(bflo(z[1])), r3 = r[3] * siluf_(bfhi(z[1]));
            *(u32x2*)(G + kb_off((int)rowq, head * 64 + dh, 1024)) = u32x2{pack2(r0, r1), pack2(r2, r3)};
        }
    }
}

#ifndef PROBE_DUP
#define PROBE_DUP 0
#endif
#define REP(k) for (int rep_ = 0; rep_ < 1 + ((PROBE_DUP >> (k)) & 1); ++rep_)
constexpr int LDS_BYTES = 3 * GSTAGE + 64;
__global__ void __launch_bounds__(256, 2) mk_fwd(Prm P) {
    extern __shared__ __attribute__((aligned(16))) unsigned char smem[];
    unsigned* xb_words = (unsigned*)(smem + 3 * GSTAGE);
    if (threadIdx.x < 4) xb_words[threadIdx.x] = 0u;
    __syncthreads();
    XcdBarrier bar = xcd_barrier_post((unsigned*)(P.ws + OFF_BAR), (volatile LAS unsigned*)xb_words);
    unsigned char* ws = P.ws;

    phase0(P, smem);
    if (P.ws == nullptr) cg::this_grid().sync();
    xcd_barrier(bar);

#pragma unroll 1
    for (int layer = 0; layer < 4; ++layer) {
        const int kind = layer % 3, lj = layer / 3;
        const u16* Win; const u16* Wout; int N, nsub;
        if (kind == 0)      { Win = (const u16*)(ws + OFF_WA_IN + (size_t)lj * SZ_WA_IN); Wout = (const u16*)(ws + OFF_WA_OUT + (size_t)lj * SZ_SQ); N = 2560; nsub = 4; }
        else if (kind == 1) { Win = (const u16*)(ws + OFF_WB_IN); Wout = (const u16*)(ws + OFF_WB_OUT); N = 2304; nsub = 1; }
        else                { Win = (const u16*)(ws + OFF_WC_IN); Wout = (const u16*)(ws + OFF_WC_OUT); N = 3840; nsub = 1; }
#pragma unroll 1
        for (int sub = 0; sub < nsub; ++sub) {
            REP(0) gemm_in_phase(smem, P, kind, Win + (size_t)sub * 2560 * 1024, N);
            xcd_barrier(bar);
            if (kind == 0) REP(1) attnA_phase(P, sub);
            else if (kind == 1) REP(2) attnB_phase(P);
            else { REP(3) compress_phase(P, smem); xcd_barrier(bar); REP(4) attnC_phase(P, smem); }
            xcd_barrier(bar);
        }
        gemm_out_phase(smem, P, Wout, layer == 0 ? P.in[0] : P.out);
        xcd_barrier(bar);
        ln_phase(P, layer);
        xcd_barrier(bar);
        gemm_gate_phase(smem, P, (const u16*)(ws + OFF_WG + (size_t)layer * SZ_SQ), (const u16*)(ws + OFF_WP + (size_t)layer * SZ_WP));
        if (layer < 3) xcd_barrier(bar);
    }
}

extern "C" void kernel_launch(void* const* d_in, const int* in_sizes, int n_in, void* d_out, int out_size, void* d_ws, size_t ws_size,
                              hipStream_t stream) {
    static int grid_blocks = 0;
    if (!grid_blocks) {
        int dev = 0, cus = 0, per_cu = 0;
        (void)hipGetDevice(&dev);
        (void)hipDeviceGetAttribute(&cus, hipDeviceAttributeMultiprocessorCount, dev);
        (void)hipFuncSetAttribute((const void*)mk_fwd, hipFuncAttributeMaxDynamicSharedMemorySize, LDS_BYTES);
        (void)hipOccupancyMaxActiveBlocksPerMultiprocessor(&per_cu, (const void*)mk_fwd, 256, LDS_BYTES);
        if (per_cu > 2) per_cu = 2;
        if (per_cu < 1) per_cu = 1;
        grid_blocks = cus * per_cu;
        if (ws_size < WS_END || n_in != 16) { fprintf(stderr, "kernel_launch: workspace too small (%zu < %zu) or n_in %d != 16\n", ws_size, (size_t)WS_END, n_in); grid_blocks = -1; }
    }
    if (grid_blocks < 0) return;
    (void)hipMemsetAsync((char*)d_ws + OFF_BAR, 0, 16384, stream);
    Prm p{};
    for (int i = 0; i < 16; ++i) p.in[i] = (const float*)d_in[i];
    p.out = (float*)d_out; p.ws = (unsigned char*)d_ws;
    void* args[] = {&p};
    hipError_t e = hipLaunchCooperativeKernel((const void*)mk_fwd, dim3(grid_blocks), dim3(256), args, LDS_BYTES, stream);
    if (e != hipSuccess) fprintf(stderr, "cooperative launch failed: %s (grid %d)\n", hipGetErrorString(e), grid_blocks);
}
```
